# Optimizing an MI355X kernel written in HIP

```python
import math
import jax, jax.numpy as jnp
from jax import lax
import numpy as np

D_MODEL = 1024
BATCH = 4
SEQ = 4096
DEPTH = 4
DEC_BATCH = 128
DEC_SEQ = 4
PAST_LEN = 2048
PAGE_SIZE = 128

N_MIXERS = 3
N_A = (DEPTH + 2) // 3
N_B = (DEPTH + 1) // 3
N_C = DEPTH // 3
DEEPNORM_ALPHA = (2 * DEPTH) ** 0.25
DEEPNORM_BETA = (8 * DEPTH) ** -0.25
LN_EPS = 1e-5
NORM_EPS = 1e-6
D_FF = 2816
PLE_DIM = 256
A_CHUNK = 128
A_INNER = 2 * D_MODEL
A_GROUPS = 16
A_GROUP_DIM = A_INNER // A_GROUPS
GDN_H = 8
GDN_DK = D_MODEL // GDN_H
GDN_DV = D_MODEL // GDN_H
GDN_WK = GDN_H * GDN_DK
GDN_WV = GDN_H * GDN_DV
GDN_QKV = 2 * GDN_WK + GDN_WV
GDN_PROJ = GDN_QKV + GDN_WV + 2 * GDN_H
GDN_CONV = 4
GDN_CHUNK = 64
NSA_H = 16
NSA_DH = D_MODEL // NSA_H
NSA_G = 4
NSA_HG = NSA_H // NSA_G
NSA_L_CMP = 32
NSA_L_SLC = 64
NSA_CMP_PER_SLC = NSA_L_SLC // NSA_L_CMP
NSA_N_SEL = 16
NSA_WINDOW = 512
NSA_WIN_QBLK = 128
NSA_SEL_ROWS = 128
NSA_CMP_HID = 256
NSA_Q = NSA_H * NSA_DH
NSA_KV = NSA_G * NSA_DH
NSA_PROJ = NSA_Q + 6 * NSA_KV + 3 * NSA_H
NSA_FORCE = 100.0
NEG_INF = -1e30
NUM_BUCKETS = 32
MAX_DISTANCE = 128

kernel_name = 'hybrid_chunkmlp_gdn_nsa_step'


def layer_norm(x, g, b):
    xf = x.astype(jnp.float32)
    mu = xf.mean(-1, keepdims=True)
    var = jnp.square(xf - mu).mean(-1, keepdims=True)
    y = (xf - mu) * lax.rsqrt(var + LN_EPS) * g.astype(jnp.float32) + b.astype(jnp.float32)
    return y.astype(x.dtype)


def rms_norm(x, g):
    xf = x.astype(jnp.float32)
    return xf * lax.rsqrt(jnp.square(xf).mean(-1, keepdims=True) + NORM_EPS) * g.astype(jnp.float32)


def l2_normalize(x):
    xf = x.astype(jnp.float32)
    return (xf * lax.rsqrt(jnp.square(xf).sum(-1, keepdims=True) + NORM_EPS)).astype(x.dtype)


def post_norm(x, y, g, b):
    return layer_norm(DEEPNORM_ALPHA * x + y, g, b)


def swiglu(x, w_up, w_down):
    a, b = jnp.split(x @ w_up, 2, axis=-1)
    return (jax.nn.silu(a) * b) @ w_down


def masked_softmax(logits, mask, axis=-1):
    p = jax.nn.softmax(jnp.where(mask, logits, NEG_INF), axis=axis)
    return jnp.where(mask, p, 0.0)


def t5_bucket(dist):
    n = jnp.maximum(dist, 0)
    max_exact = NUM_BUCKETS // 2
    nf = jnp.maximum(n, 1).astype(jnp.float32)
    large = max_exact + (jnp.log(nf / max_exact) / math.log(MAX_DISTANCE / max_exact)
                         * (NUM_BUCKETS - max_exact)).astype(jnp.int32)
    large = jnp.minimum(large, NUM_BUCKETS - 1)
    return jnp.where(n < max_exact, n, large)


def t5_bias(tab, dist):
    return tab.astype(jnp.float32)[t5_bucket(dist)]


def chunk_mlp_mixer(x, w_in, ln_g, ln_b, w_s, b_s, w_out):
    B, T, _ = x.shape
    h = jax.nn.gelu(x @ w_in)
    u, v = h[..., :A_INNER], h[..., A_INNER:]
    v = layer_norm(v, ln_g, ln_b)
    n_chunks = -(-T // A_CHUNK)
    vb = jnp.pad(v, ((0, 0), (0, n_chunks * A_CHUNK - T), (0, 0)))
    vb = vb.reshape(B, n_chunks, A_CHUNK, A_GROUPS, A_GROUP_DIM)
    causal = jnp.tril(jnp.ones((A_CHUNK, A_CHUNK), bool))
    w_causal = jnp.where(causal, w_s, 0.0)
    s = jnp.einsum('gts,bnsgd->bntgd', w_causal, vb) + b_s.T[:, :, None]
    s = s.reshape(B, n_chunks * A_CHUNK, A_INNER)[:, :T]
    return (u * s) @ w_out, v


def gated_delta_chunked(q, k, v, g, beta, s0):
    B, T, H, _ = q.shape
    DV = v.shape[-1]
    C = min(GDN_CHUNK, T)
    n = -(-T // C)
    pad = n * C - T

    def blocks(a):
        a = jnp.pad(a, [(0, 0), (0, pad)] + [(0, 0)] * (a.ndim - 2))
        a = a.reshape((B, n, C) + a.shape[2:])
        return jnp.moveaxis(a, (1, 3), (0, 2)).astype(jnp.float32)

    qc, kc, vc, gc, bc = blocks(q), blocks(k), blocks(v), blocks(g), blocks(beta)
    gcum = jnp.cumsum(gc, axis=-1)
    incl = jnp.tril(jnp.ones((C, C), bool))
    strict = jnp.tril(jnp.ones((C, C), bool), -1)
    diff = gcum[..., :, None] - gcum[..., None, :]
    decay = jnp.where(incl, jnp.exp(jnp.where(incl, diff, 0.0)), 0.0)
    kbeta = kc * bc[..., None]
    a_mat = jnp.where(strict, jnp.einsum('nbhid,nbhjd->nbhij', kbeta, kc) * decay, 0.0)
    eye = jnp.eye(C, dtype=jnp.float32)
    t_inv = lax.linalg.triangular_solve(a_mat + eye, jnp.broadcast_to(eye, a_mat.shape),
                                        left_side=True, lower=True, unit_diagonal=True)
    u = t_inv @ (vc * bc[..., None])
    w = t_inv @ (kbeta * jnp.exp(gcum)[..., None])
    qk = jnp.where(incl, jnp.einsum('nbhid,nbhjd->nbhij', qc, kc) * decay, 0.0)

    def step(s, inp):
        q_i, k_i, u_i, w_i, g_i, qk_i = inp
        v_new = u_i - w_i @ s
        o_i = (q_i * jnp.exp(g_i)[..., None]) @ s + qk_i @ v_new
        g_last = g_i[..., -1:]
        s = s * jnp.exp(g_last)[..., None] + jnp.einsum(
            'bhcd,bhce->bhde', k_i * jnp.exp(g_last - g_i)[..., None], v_new)
        return s, o_i

    s_final, o = lax.scan(step, s0.astype(jnp.float32), (qc, kc, u, w, gcum, qk))
    o = jnp.moveaxis(o, (0, 2), (1, 3)).reshape(B, n * C, H, DV)[:, :T]
    return o, s_final.astype(s0.dtype)


def gated_deltanet_mixer(x, conv_buf, s0, w_in, conv_w, a_log, dt_bias, norm_g, w_out):
    B, T, _ = x.shape
    proj = x @ w_in
    qkv = proj[..., :GDN_QKV]
    z = proj[..., GDN_QKV:GDN_QKV + GDN_WV]
    b_logit = proj[..., GDN_QKV + GDN_WV:GDN_QKV + GDN_WV + GDN_H]
    a_logit = proj[..., GDN_QKV + GDN_WV + GDN_H:]
    xc = jnp.concatenate([conv_buf.astype(qkv.dtype), qkv], axis=1)
    conv = xc[:, 0:T] * conv_w[0]
    for j in range(1, GDN_CONV):
        conv = conv + xc[:, j:j + T] * conv_w[j]
    qkv = jax.nn.silu(conv)
    new_buf = xc[:, -(GDN_CONV - 1):]
    q = l2_normalize(qkv[..., :GDN_WK].reshape(B, T, GDN_H, GDN_DK)) * (GDN_DK ** -0.5)
    k = l2_normalize(qkv[..., GDN_WK:2 * GDN_WK].reshape(B, T, GDN_H, GDN_DK))
    v = qkv[..., 2 * GDN_WK:].reshape(B, T, GDN_H, GDN_DV)
    beta = jax.nn.sigmoid(b_logit)
    g = -jnp.exp(a_log) * jax.nn.softplus(a_logit + dt_bias)
    o, s_new = gated_delta_chunked(q, k, v, g, beta, s0)
    o = rms_norm(o, norm_g) * jax.nn.silu(z.reshape(B, T, GDN_H, GDN_DV)).astype(jnp.float32)
    return o.astype(x.dtype).reshape(B, T, GDN_WV) @ w_out, new_buf, s_new


def nsa_compress(rows, pe, w1, w2):
    B, Tk, G, dh = rows.shape
    n_cmp = Tk // NSA_L_CMP
    blk = rows[:, :n_cmp * NSA_L_CMP].reshape(B, n_cmp, NSA_L_CMP, G, dh) + pe[:, None, :]
    flat = jnp.swapaxes(blk, 2, 3).reshape(B, n_cmp, G, NSA_L_CMP * dh)
    return jax.nn.gelu(flat @ w1) @ w2


def nsa_compressed_attn(q, q_pos, k_cmp, v_cmp, tab):
    B, T, H, dh = q.shape
    n_cmp = k_cmp.shape[1]
    qg = q.reshape(B, T, NSA_G, NSA_HG, dh)
    s = jnp.einsum('btghd,bngd->bghtn', qg, k_cmp).astype(jnp.float32) * (dh ** -0.5)
    blk_end = jnp.arange(n_cmp) * NSA_L_CMP + NSA_L_CMP - 1
    dist = q_pos[:, None] - blk_end[None, :]
    bias = t5_bias(tab, dist).reshape(T, n_cmp, NSA_G, NSA_HG).transpose(2, 3, 0, 1)
    p = masked_softmax(s + bias, dist >= 0)
    o = jnp.einsum('bghtn,bngd->btghd', p.astype(v_cmp.dtype), v_cmp).reshape(B, T, H, dh)
    return o, p


def nsa_select_blocks(p_cmp, q_pos, n_keys):
    n_slc = -(-n_keys // NSA_L_SLC)
    ps = p_cmp.sum(axis=2)
    ps = jnp.pad(ps, ((0, 0), (0, 0), (0, 0), (0, n_slc * NSA_CMP_PER_SLC - ps.shape[-1])))
    ps = ps.reshape(ps.shape[:3] + (n_slc, NSA_CMP_PER_SLC)).sum(-1)
    j = jnp.arange(n_slc)[None, :]
    jq = (q_pos // NSA_L_SLC)[:, None]
    forced = (j == 0) | (j == jq) | (j == jq - 1)
    score = jnp.where(forced, NSA_FORCE, jnp.where(j > jq, -1.0, ps))
    _, idx = lax.top_k(score, min(NSA_N_SEL, n_slc))
    return idx


def nsa_selected_attn(q, q_pos, k_slc, v_slc, blk_idx, tab):
    B, T, H, dh = q.shape
    Tk = k_slc.shape[1]
    n_slc = -(-Tk // NSA_L_SLC)
    n_sel = blk_idx.shape[-1]

    def to_blocks(a):
        a = jnp.pad(a, ((0, 0), (0, n_slc * NSA_L_SLC - Tk), (0, 0), (0, 0)))
        return a.reshape(B, n_slc, NSA_L_SLC, NSA_G, dh).transpose(0, 3, 1, 2, 4)

    kb, vb = to_blocks(k_slc), to_blocks(v_slc)
    N = B * T
    n_steps = -(-N // NSA_SEL_ROWS)
    pad = n_steps * NSA_SEL_ROWS - N

    def rows(a):
        a = jnp.pad(a, [(0, pad)] + [(0, 0)] * (a.ndim - 1))
        return a.reshape((n_steps, NSA_SEL_ROWS) + a.shape[1:])

    rq = rows(q.reshape(N, NSA_G, NSA_HG, dh))
    rb = rows(jnp.repeat(jnp.arange(B, dtype=jnp.int32), T))
    rt = rows(jnp.tile(q_pos, B))
    ri = rows(jnp.swapaxes(blk_idx, 1, 2).reshape(N, NSA_G, n_sel))
    g_ids = jnp.arange(NSA_G)[None, :, None]
    tab_g = tab.astype(jnp.float32).reshape(NUM_BUCKETS, NSA_G, NSA_HG)
    offs = jnp.arange(NSA_L_SLC)

    def step(args):
        q_r, b_r, t_r, i_r = args
        k_g = kb[b_r[:, None, None], g_ids, i_r]
        v_g = vb[b_r[:, None, None], g_ids, i_r]
        k_pos = i_r[..., None] * NSA_L_SLC + offs
        dist = t_r[:, None, None, None] - k_pos
        bias = jnp.moveaxis(tab_g[t5_bucket(dist), jnp.arange(NSA_G)[None, :, None, None]], -1, 2)
        s = jnp.einsum('rghd,rgnld->rghnl', q_r, k_g).astype(jnp.float32) * (dh ** -0.5) + bias
        p = masked_softmax(s, (dist >= 0)[:, :, None], axis=(-2, -1))
        return jnp.einsum('rghnl,rgnld->rghd', p.astype(v_g.dtype), v_g)

    o = lax.map(step, (rq, rb, rt, ri))
    return o.reshape(n_steps * NSA_SEL_ROWS, H, dh)[:N].reshape(B, T, H, dh)


def nsa_window_attn(q, q_pos0, k_win, v_win, tab):
    B, T, H, dh = q.shape
    Wp = k_win.shape[1] - T
    QB = min(NSA_WIN_QBLK, T)
    nqb = -(-T // QB)
    front = NSA_WINDOW - Wp
    back = nqb * QB - T
    K = NSA_WINDOW + QB
    kidx = jnp.arange(nqb)[:, None] * QB + jnp.arange(K)[None, :]
    kb = jnp.pad(k_win, ((0, 0), (front, back), (0, 0), (0, 0)))[:, kidx]
    vb = jnp.pad(v_win, ((0, 0), (front, back), (0, 0), (0, 0)))[:, kidx]
    qb = jnp.pad(q, ((0, 0), (0, back), (0, 0), (0, 0))).reshape(B, nqb, QB, NSA_G, NSA_HG, dh)
    qpos = q_pos0 + jnp.arange(nqb * QB).reshape(nqb, QB)
    kpos = q_pos0 - NSA_WINDOW + kidx
    dist = qpos[:, :, None] - kpos[:, None, :]
    mask = (dist >= 0) & (dist < NSA_WINDOW) & (kpos[:, None, :] >= 0)
    bias = t5_bias(tab, dist).reshape(nqb, QB, K, NSA_G, NSA_HG).transpose(0, 3, 4, 1, 2)
    s = jnp.einsum('bjqghd,bjkgd->bjghqk', qb, kb).astype(jnp.float32) * (dh ** -0.5) + bias
    p = masked_softmax(s, mask[:, None, None])
    o = jnp.einsum('bjghqk,bjkgd->bjqghd', p.astype(vb.dtype), vb)
    return o.reshape(B, nqb * QB, H, dh)[:, :T]


def nsa_mixer(x, q_pos0, kv_past, win_past, w_in, gate_b, cmp_pe, cmp_w1, cmp_w2, tab, w_out):
    B, T, _ = x.shape
    proj = x @ w_in
    q = proj[..., :NSA_Q].reshape(B, T, NSA_H, NSA_DH)
    kv_new = proj[..., NSA_Q:NSA_Q + 4 * NSA_KV].reshape(B, T, 4, NSA_G, NSA_DH)
    win_new = proj[..., NSA_Q + 4 * NSA_KV:NSA_Q + 6 * NSA_KV].reshape(B, T, 2, NSA_G, NSA_DH)
    gates = jax.nn.sigmoid(proj[..., NSA_Q + 6 * NSA_KV:] + gate_b).reshape(B, T, 3, NSA_H)
    kv = jnp.concatenate([kv_past.astype(x.dtype), kv_new], axis=1)
    win = jnp.concatenate([win_past.astype(x.dtype), win_new], axis=1)
    q_pos = q_pos0 + jnp.arange(T)
    k_cmp = nsa_compress(kv[:, :, 0], cmp_pe[0], cmp_w1[0], cmp_w2[0])
    v_cmp = nsa_compress(kv[:, :, 1], cmp_pe[1], cmp_w1[1], cmp_w2[1])
    o_cmp, p_cmp = nsa_compressed_attn(q, q_pos, k_cmp, v_cmp, tab)
    blk_idx = nsa_select_blocks(p_cmp, q_pos, kv.shape[1])
    o_slc = nsa_selected_attn(q, q_pos, kv[:, :, 2], kv[:, :, 3], blk_idx, tab)
    o_win = nsa_window_attn(q, q_pos0, win[:, :, 0], win[:, :, 1], tab)
    o = (gates[:, :, 0, :, None] * o_cmp + gates[:, :, 1, :, None] * o_slc
         + gates[:, :, 2, :, None] * o_win)
    return o.reshape(B, T, NSA_Q) @ w_out, kv_new, win_new


def setup_inputs(seed: int = 0) -> dict:
    key = jax.random.key(seed)
    keys = jax.random.split(key, 48)
    counter = [0]

    def nxt():
        counter[0] += 1
        return keys[counter[0] - 1]

    def rnd(shape, scale):
        return jax.random.normal(nxt(), shape, jnp.float32) * scale

    n_pages = PAST_LEN // PAGE_SIZE
    n_used = DEC_BATCH * n_pages
    n_phys = n_used + max(1, n_used // 4)
    wbuf = min(NSA_WINDOW, PAST_LEN)
    f32 = jnp.float32
    x_prompt = rnd((BATCH, SEQ, D_MODEL), 1.0)
    x_sample = rnd((DEC_BATCH, DEC_SEQ, D_MODEL), 1.0)
    state_gdn_s = rnd((N_B, DEC_BATCH, GDN_H, GDN_DK, GDN_DV), 0.5)
    state_gdn_conv = rnd((N_B, DEC_BATCH, GDN_CONV - 1, GDN_QKV), 1.0)
    cache_nsa_kv = rnd((N_C, n_phys, PAGE_SIZE, 4, NSA_G, NSA_DH), 1.0)
    cache_nsa_win = rnd((N_C, DEC_BATCH, wbuf, 2, NSA_G, NSA_DH), 1.0)
    page_table = jax.random.permutation(nxt(), n_phys)[:n_used].reshape(DEC_BATCH, n_pages).astype(jnp.int32)
    p_prompt = rnd((DEPTH, BATCH, SEQ, PLE_DIM), 1.0)
    p_sample = rnd((DEPTH, DEC_BATCH, DEC_SEQ, PLE_DIM), 1.0)
    ln_g = 1.0 + rnd((DEPTH, 3, D_MODEL), 0.05)
    ln_b = rnd((DEPTH, 3, D_MODEL), 0.02)
    ffn_w_up = rnd((DEPTH, 2, D_MODEL, 2 * D_FF), D_MODEL ** -0.5)
    ffn_w_down = rnd((DEPTH, 2, D_FF, D_MODEL), D_FF ** -0.5 * DEEPNORM_BETA)
    ple_w_gate = rnd((DEPTH, D_MODEL, D_MODEL), D_MODEL ** -0.5)
    ple_w_proj = rnd((DEPTH, PLE_DIM, D_MODEL), PLE_DIM ** -0.5)
    a_w_in = rnd((N_A, D_MODEL, 2 * A_INNER), D_MODEL ** -0.5)
    a_ln_g = 1.0 + rnd((N_A, A_INNER), 0.05)
    a_ln_b = rnd((N_A, A_INNER), 0.02)
    a_w_s = rnd((N_A, A_GROUPS, A_CHUNK, A_CHUNK), 0.5 * A_CHUNK ** -0.5)
    a_b_s = 1.0 + rnd((N_A, A_GROUPS, A_CHUNK), 0.1)
    a_w_out = rnd((N_A, A_INNER, D_MODEL), A_INNER ** -0.5 * DEEPNORM_BETA)
    gdn_w_in = rnd((N_B, D_MODEL, GDN_PROJ), D_MODEL ** -0.5)
    gdn_conv_w = rnd((N_B, GDN_CONV, GDN_QKV), GDN_CONV ** -0.5)
    gdn_a_log = jnp.log(jax.random.uniform(nxt(), (N_B, GDN_H), f32, 1.0, 16.0))
    dt = jnp.exp(jax.random.uniform(nxt(), (N_B, GDN_H), f32, math.log(1e-3), math.log(0.1)))
    gdn_dt_bias = dt + jnp.log(-jnp.expm1(-dt))
    gdn_norm_g = 1.0 + rnd((N_B, GDN_DV), 0.05)
    gdn_w_out = rnd((N_B, GDN_WV, D_MODEL), GDN_WV ** -0.5 * DEEPNORM_BETA)
    nsa_w_in = rnd((N_C, D_MODEL, NSA_PROJ), D_MODEL ** -0.5)
    nsa_gate_b = rnd((N_C, 3 * NSA_H), 0.01)
    nsa_cmp_pe = rnd((N_C, 2, NSA_L_CMP, NSA_DH), 0.1)
    nsa_cmp_w1 = rnd((N_C, 2, NSA_L_CMP * NSA_DH, NSA_CMP_HID), (NSA_L_CMP * NSA_DH) ** -0.5)
    nsa_cmp_w2 = rnd((N_C, 2, NSA_CMP_HID, NSA_DH), NSA_CMP_HID ** -0.5)
    nsa_w_out = rnd((N_C, NSA_Q, D_MODEL), NSA_Q ** -0.5 * DEEPNORM_BETA)
    t5_bias_table = rnd((NUM_BUCKETS, NSA_H), 0.5)
    return {'x_prompt': x_prompt, 'x_sample': x_sample, 'state_gdn_s': state_gdn_s,
            'state_gdn_conv': state_gdn_conv, 'cache_nsa_kv': cache_nsa_kv,
            'cache_nsa_win': cache_nsa_win, 'page_table': page_table,
            'p_prompt': p_prompt, 'p_sample': p_sample, 'ln_g': ln_g, 'ln_b': ln_b,
            'ffn_w_up': ffn_w_up, 'ffn_w_down': ffn_w_down, 'ple_w_gate': ple_w_gate,
            'ple_w_proj': ple_w_proj, 'a_w_in': a_w_in, 'a_ln_g': a_ln_g, 'a_ln_b': a_ln_b,
            'a_w_s': a_w_s, 'a_b_s': a_b_s, 'a_w_out': a_w_out, 'gdn_w_in': gdn_w_in,
            'gdn_conv_w': gdn_conv_w, 'gdn_a_log': gdn_a_log, 'gdn_dt_bias': gdn_dt_bias,
            'gdn_norm_g': gdn_norm_g, 'gdn_w_out': gdn_w_out, 'nsa_w_in': nsa_w_in,
            'nsa_gate_b': nsa_gate_b, 'nsa_cmp_pe': nsa_cmp_pe, 'nsa_cmp_w1': nsa_cmp_w1,
            'nsa_cmp_w2': nsa_cmp_w2, 'nsa_w_out': nsa_w_out, 't5_bias_table': t5_bias_table}


def reference(x_prompt, x_sample, state_gdn_s, state_gdn_conv, cache_nsa_kv, cache_nsa_win,
              page_table, p_prompt, p_sample, ln_g, ln_b, ffn_w_up, ffn_w_down, ple_w_gate,
              ple_w_proj, a_w_in, a_ln_g, a_ln_b, a_w_s, a_b_s, a_w_out, gdn_w_in, gdn_conv_w,
              gdn_a_log, gdn_dt_bias, gdn_norm_g, gdn_w_out, nsa_w_in, nsa_gate_b, nsa_cmp_pe,
              nsa_cmp_w1, nsa_cmp_w2, nsa_w_out, t5_bias_table):
    bp, tp, _ = x_prompt.shape
    bs = x_sample.shape[0]
    n_pages = page_table.shape[1]
    past_len = n_pages * cache_nsa_kv.shape[2]
    xp, xs = x_prompt, x_sample
    a_v_s, gdn_s_p, gdn_c_p, gdn_s_s, gdn_c_s = [], [], [], [], []
    kv_p, win_p, kv_s, win_s = [], [], [], []
    ia = ib = ic = 0
    for i in range(DEPTH):
        xp = post_norm(xp, 0.5 * swiglu(xp, ffn_w_up[i, 0], ffn_w_down[i, 0]), ln_g[i, 0], ln_b[i, 0])
        xs = post_norm(xs, 0.5 * swiglu(xs, ffn_w_up[i, 0], ffn_w_down[i, 0]), ln_g[i, 0], ln_b[i, 0])
        kind = i % N_MIXERS
        if kind == 0:
            yp, _ = chunk_mlp_mixer(xp, a_w_in[ia], a_ln_g[ia], a_ln_b[ia], a_w_s[ia], a_b_s[ia], a_w_out[ia])
            ys, v_rows = chunk_mlp_mixer(xs, a_w_in[ia], a_ln_g[ia], a_ln_b[ia], a_w_s[ia], a_b_s[ia], a_w_out[ia])
            a_v_s.append(v_rows)
            ia += 1
        elif kind == 1:
            zero_buf = jnp.zeros((bp, GDN_CONV - 1, GDN_QKV), xp.dtype)
            zero_s = jnp.zeros((bp, GDN_H, GDN_DK, GDN_DV), xp.dtype)
            yp, buf_p, s_p = gated_deltanet_mixer(xp, zero_buf, zero_s, gdn_w_in[ib], gdn_conv_w[ib],
                                                  gdn_a_log[ib], gdn_dt_bias[ib], gdn_norm_g[ib], gdn_w_out[ib])
            ys, buf_s, s_s = gated_deltanet_mixer(xs, state_gdn_conv[ib], state_gdn_s[ib], gdn_w_in[ib],
                                                  gdn_conv_w[ib], gdn_a_log[ib], gdn_dt_bias[ib],
                                                  gdn_norm_g[ib], gdn_w_out[ib])
            gdn_s_p.append(s_p)
            gdn_c_p.append(buf_p)
            gdn_s_s.append(s_s)
            gdn_c_s.append(buf_s)
            ib += 1
        else:
            empty_kv = jnp.zeros((bp, 0, 4, NSA_G, NSA_DH), xp.dtype)
            empty_win = jnp.zeros((bp, 0, 2, NSA_G, NSA_DH), xp.dtype)
            yp, kvn_p, winn_p = nsa_mixer(xp, 0, empty_kv, empty_win, nsa_w_in[ic], nsa_gate_b[ic],
                                          nsa_cmp_pe[ic], nsa_cmp_w1[ic], nsa_cmp_w2[ic], t5_bias_table,
                                          nsa_w_out[ic])
            kv_past = cache_nsa_kv[ic][page_table].reshape(bs, past_len, 4, NSA_G, NSA_DH)
            ys, kvn_s, winn_s = nsa_mixer(xs, past_len, kv_past, cache_nsa_win[ic], nsa_w_in[ic],
                                          nsa_gate_b[ic], nsa_cmp_pe[ic], nsa_cmp_w1[ic], nsa_cmp_w2[ic],
                                          t5_bias_table, nsa_w_out[ic])
            kv_p.append(kvn_p)
            win_p.append(winn_p[:, tp - min(NSA_WINDOW, tp):])
            kv_s.append(kvn_s)
            win_s.append(winn_s)
            ic += 1
        xp = post_norm(xp, yp, ln_g[i, 1], ln_b[i, 1])
        xs = post_norm(xs, ys, ln_g[i, 1], ln_b[i, 1])
        xp = post_norm(xp, 0.5 * swiglu(xp, ffn_w_up[i, 1], ffn_w_down[i, 1]), ln_g[i, 2], ln_b[i, 2])
        xs = post_norm(xs, 0.5 * swiglu(xs, ffn_w_up[i, 1], ffn_w_down[i, 1]), ln_g[i, 2], ln_b[i, 2])
        xp = xp + jax.nn.sigmoid(xp @ ple_w_gate[i]) * (p_prompt[i] @ ple_w_proj[i])
        xs = xs + jax.nn.sigmoid(xs @ ple_w_gate[i]) * (p_sample[i] @ ple_w_proj[i])
    return (xp, xs, jnp.stack(a_v_s), jnp.stack(gdn_s_p), jnp.stack(gdn_c_p), jnp.stack(gdn_s_s),
            jnp.stack(gdn_c_s), jnp.stack(kv_p), jnp.stack(win_p), jnp.stack(kv_s), jnp.stack(win_s))
```

```cpp
#include <hip/hip_runtime.h>
#include <cstdio>
#include <cstdint>
namespace pg8 {
#define PG8_LAS __attribute__((address_space(3)))
typedef unsigned short bf16_t;
typedef short bf16x8 __attribute__((ext_vector_type(8)));
typedef float f32x4 __attribute__((ext_vector_type(4)));
typedef unsigned u32x4 __attribute__((ext_vector_type(4)));
constexpr int BM = 256, BK = 64, HALF = 128, HTB = HALF * BK * 2  , STAGE_BYTES = 8 * HTB, NXCD = 8, WGM = 8;

__host__ __device__ __forceinline__ int lds_byte(int r, int c) { const int st = (r >> 4) * 2 + (c >> 5), rr = r & 15, cc = c & 31, ob = rr * 64 + cc * 2; return st * 1024 + (ob ^ (((ob >> 9) & 1) << 5)); }
__host__ __device__ __forceinline__ void stage_rc(int b, int& R, int& C) { const int st = b / 1024, sb = b % 1024, swz = sb ^ (((sb >> 9) & 1) << 5); R = (st >> 1) * 16 + swz / 64; C = (st & 1) * 32 + (swz % 64) / 2; }
__host__ __device__ __forceinline__ int perm32(int rho) { const int n = rho >> 4, i = rho & 15; return 8 * (i >> 2) + 4 * n + (i & 3); }

struct Unit { int pm, pn; };
struct Gemm { const bf16_t* A; const bf16_t* Bt; int M, N, K; };

struct StaticOrder {
    int nM, nN, nwg, G, c;
    __host__ __device__ void init(int M, int N, int G_, int c_) { nM = M / BM; nN = N / BM; nwg = nM * nN; G = G_; c = c_; }
    __host__ __device__ bool next(int i, Unit& u) const {
        const long L = (long)i * G + c; if (L >= nwg) return false;
        int wgid = (int)L; { const int q = nwg / NXCD, r = nwg % NXCD, xcd = wgid % NXCD, off = wgid / NXCD; wgid = (xcd < r ? xcd * (q + 1) : r * (q + 1) + (xcd - r) * q) + off; }
        const int nig = WGM * nN, gid = wgid / nig, fm = gid * WGM, gsz = (nM - fm) < WGM ? (nM - fm) : WGM;
        u.pm = fm + ((wgid % nig) % gsz); u.pn = (wgid % nig) / gsz; return true;
    }
    __device__ __forceinline__ void a_ready(const Unit&) const {}
    __device__ __forceinline__ void done(const Unit&) const {}
};

__device__ __forceinline__ unsigned cvt_pk_bf16(float lo, float hi) { unsigned r; asm volatile("v_cvt_pk_bf16_f32 %0, %1, %2" : "=v"(r) : "v"(lo), "v"(hi)); return r; }
typedef unsigned u32x2 __attribute__((ext_vector_type(2)));
__device__ __forceinline__ float fast_sigmoid(float x) { return __frcp_rn(1.0f + __expf(-x)); }
__device__ __forceinline__ float silu_f(float x) { return x * fast_sigmoid(x); }
__device__ __forceinline__ float gelu_tanh_f(float x) { const float y = 1.5957691216057308f * (x + 0.044715f * x * x * x); return x * fast_sigmoid(y); }
__device__ __forceinline__ u32x2 pack4(f32x4 v) { u32x2 w; w.x = cvt_pk_bf16(v[0], v[1]); w.y = cvt_pk_bf16(v[2], v[3]); return w; }

struct EpiGate {
    static constexpr bool PERM = false, AFTER_DRAIN = false;
    bf16_t* H; int ldh;
    __device__ __forceinline__ void operator()(const f32x4 (&acc)[2][2][4][2], const Unit& u, int wr, int wc, int fr, int fq) const {
        const int row0 = u.pm * BM + wr * 64 + fr, col0 = u.pn * HALF + wc * 32 + 4 * fq;
#pragma unroll
        for (int ai = 0; ai < 2; ++ai)
#pragma unroll
            for (int m = 0; m < 4; ++m) { bf16_t* rowp = H + (size_t)(row0 + ai * HALF + m * 16) * ldh + col0;
#pragma unroll
                for (int n = 0; n < 2; ++n) { const f32x4 a = acc[ai][0][m][n], b = acc[ai][1][m][n]; f32x4 h;
#pragma unroll
                    for (int j = 0; j < 4; ++j) h[j] = silu_f(a[j]) * b[j];
                    *(u32x2*)(rowp + n * 16) = pack4(h); } }
    }
};
struct EpiResid {
    static constexpr bool PERM = false, AFTER_DRAIN = false;
    const float* X; float* PRE; float alpha, s;
    __device__ __forceinline__ void operator()(const f32x4 (&acc)[2][2][4][2], const Unit& u, int wr, int wc, int fr, int fq) const {
        const int row0 = u.pm * BM + wr * 64 + fr, col0 = u.pn * BM + wc * 32 + 4 * fq;
#pragma unroll
        for (int ai = 0; ai < 2; ++ai)
#pragma unroll
            for (int m = 0; m < 4; ++m) { const size_t off = (size_t)(row0 + ai * HALF + m * 16) * 1024 + col0;
#pragma unroll
                for (int bj = 0; bj < 2; ++bj)
#pragma unroll
                    for (int n = 0; n < 2; ++n) { const f32x4 x = *(const f32x4*)(X + off + bj * HALF + n * 16); *(f32x4*)(PRE + off + bj * HALF + n * 16) = x * alpha + acc[ai][bj][m][n] * s; } }
    }
};
struct EpiF32 {
    static constexpr bool PERM = false, AFTER_DRAIN = false;
    float* C; int ldc;
    __device__ __forceinline__ void operator()(const f32x4 (&acc)[2][2][4][2], const Unit& u, int wr, int wc, int fr, int fq) const {
        const int row0 = u.pm * BM + wr * 64 + fr, col0 = u.pn * BM + wc * 32 + 4 * fq;
#pragma unroll
        for (int ai = 0; ai < 2; ++ai)
#pragma unroll
            for (int m = 0; m < 4; ++m) { float* rowp = C + (size_t)(row0 + ai * HALF + m * 16) * ldc + col0;
#pragma unroll
                for (int bj = 0; bj < 2; ++bj)
#pragma unroll
                    for (int n = 0; n < 2; ++n) *(f32x4*)(rowp + bj * HALF + n * 16) = acc[ai][bj][m][n]; }
    }
};
struct EpiPle {
    static constexpr bool PERM = false, AFTER_DRAIN = false;
    float* X; const float* P; bf16_t* XN; float* OUT;
    __device__ __forceinline__ void operator()(const f32x4 (&acc)[2][2][4][2], const Unit& u, int wr, int wc, int fr, int fq) const {
        const int row0 = u.pm * BM + wr * 64 + fr, col0 = u.pn * BM + wc * 32 + 4 * fq;
#pragma unroll
        for (int ai = 0; ai < 2; ++ai)
#pragma unroll
            for (int m = 0; m < 4; ++m) { const size_t off = (size_t)(row0 + ai * HALF + m * 16) * 1024 + col0;
#pragma unroll
                for (int bj = 0; bj < 2; ++bj)
#pragma unroll
                    for (int n = 0; n < 2; ++n) { const size_t o = off + bj * HALF + n * 16; const f32x4 x = *(const f32x4*)(X + o), p = *(const f32x4*)(P + o), a = acc[ai][bj][m][n]; f32x4 y;
#pragma unroll
                        for (int j = 0; j < 4; ++j) y[j] = x[j] + fast_sigmoid(a[j]) * p[j];
                        *(f32x4*)(X + o) = y; *(u32x2*)(XN + o) = pack4(y); if (OUT) *(f32x4*)(OUT + o) = y; } }
    }
};
struct EpiAin {
    static constexpr bool PERM = false, AFTER_DRAIN = false;
    bf16_t* U; float* V;
    __device__ __forceinline__ void operator()(const f32x4 (&acc)[2][2][4][2], const Unit& u, int wr, int wc, int fr, int fq) const {
        const int row0 = u.pm * BM + wr * 64 + fr; const bool isu = u.pn < 8; const int col0 = (isu ? u.pn : u.pn - 8) * BM + wc * 32 + 4 * fq;
#pragma unroll
        for (int ai = 0; ai < 2; ++ai)
#pragma unroll
            for (int m = 0; m < 4; ++m) { const size_t off = (size_t)(row0 + ai * HALF + m * 16) * 2048 + col0;
#pragma unroll
                for (int bj = 0; bj < 2; ++bj)
#pragma unroll
                    for (int n = 0; n < 2; ++n) { const f32x4 a = acc[ai][bj][m][n]; f32x4 y;
#pragma unroll
                        for (int j = 0; j < 4; ++j) y[j] = gelu_tanh_f(a[j]);
                        if (isu) *(u32x2*)(U + off + bj * HALF + n * 16) = pack4(y); else *(f32x4*)(V + off + bj * HALF + n * 16) = y; } }
    }
};
struct EpiCmp {
    static constexpr bool PERM = false, AFTER_DRAIN = false;
    bf16_t* HC;
    __device__ __forceinline__ void operator()(const f32x4 (&acc)[2][2][4][2], const Unit& u, int wr, int wc, int fr, int fq) const {
        const int row0 = u.pm * BM + wr * 64 + fr, col0 = u.pn * BM + wc * 32 + 4 * fq;
#pragma unroll
        for (int ai = 0; ai < 2; ++ai)
#pragma unroll
            for (int m = 0; m < 4; ++m) { bf16_t* rowp = HC + (size_t)(row0 + ai * HALF + m * 16) * 256 + col0;
#pragma unroll
                for (int bj = 0; bj < 2; ++bj)
#pragma unroll
                    for (int n = 0; n < 2; ++n) { const f32x4 a = acc[ai][bj][m][n]; f32x4 y;
#pragma unroll
                        for (int j = 0; j < 4; ++j) y[j] = gelu_tanh_f(a[j]);
                        *(u32x2*)(rowp + bj * HALF + n * 16) = pack4(y); } }
    }
};
template <class Epi, class Sched, bool ALIGN_EPI = false, bool SP2 = false>
__device__ __forceinline__ void gemm_phase(PG8_LAS unsigned char* lds, const Gemm g, const Sched& S, const Epi& E) {
    const int tid = threadIdx.x, wid = __builtin_amdgcn_readfirstlane(tid >> 6), lane = tid & 63, wr = wid >> 2, wc = wid & 3, fr = lane & 15, fq = lane >> 4;
    const int K = g.K, nt = K / BK;
    unsigned voffA[2], voffB[2];
#pragma unroll
    for (int i = 0; i < 2; ++i) { int R, C; stage_rc(tid * 16 + i * 8192, R, C); const int Rb = Epi::PERM ? ((R & ~31) + perm32(R & 31)) : R;
        voffA[i] = (unsigned)(R * K + C) * 2u; voffB[i] = (unsigned)(Rb * K + C) * 2u; }
    const size_t kstep = (size_t)(BK * 2);
    const size_t hstep = (size_t)HALF * K * 2;
    const size_t tstep = 2 * hstep;
    const unsigned ldsw = (unsigned)wid * 1024u;
    const int aoff = lds_byte(wr * 64 + fr, fq * 8), boff = lds_byte(wc * 32 + fr, fq * 8);
#define PG8_SA(b, h) (((b) * 2 + (h)) * HTB)
#define PG8_SB(b, h) ((4 + (b) * 2 + (h)) * HTB)
#define PG8_STAGE(bufoff, gbase, voff) do { _Pragma("unroll") for (int _i = 0; _i < 2; ++_i) \
        __builtin_amdgcn_global_load_lds((const unsigned*)((const char*)(gbase) + (voff)[_i]), (PG8_LAS unsigned*)(lds + (bufoff) + ldsw + _i * 8192), 16, 0, 0); } while (0)
#define PG8_LDA(dst, b, h) do { _Pragma("unroll") for (int m = 0; m < 4; ++m) _Pragma("unroll") for (int k = 0; k < 2; ++k) dst[m][k] = *(const PG8_LAS bf16x8*)(lds + PG8_SA(b, h) + aoff + m * 2048 + k * 1024); } while (0)
#define PG8_LDB(dst, b, h) do { _Pragma("unroll") for (int n = 0; n < 2; ++n) _Pragma("unroll") for (int k = 0; k < 2; ++k) dst[n][k] = *(const PG8_LAS bf16x8*)(lds + PG8_SB(b, h) + boff + n * 2048 + k * 1024); } while (0)
#define PG8_MMA(ai, bj, At, Bt) do { __builtin_amdgcn_s_setprio(1); _Pragma("unroll") for (int m = 0; m < 4; ++m) _Pragma("unroll") for (int n = 0; n < 2; ++n) _Pragma("unroll") for (int k = 0; k < 2; ++k) \
        acc[ai][bj][m][n] = __builtin_amdgcn_mfma_f32_16x16x32_bf16(Bt[n][k], At[m][k], acc[ai][bj][m][n], 0, 0, 0); __builtin_amdgcn_s_setprio(0); } while (0)
#define PG8_WAIT_V(n) asm volatile("s_waitcnt vmcnt(" #n ")" ::: "memory")
#define PG8_WAIT_L(n) asm volatile("s_waitcnt lgkmcnt(" #n ")" ::: "memory")
#define PG8_BAR __builtin_amdgcn_s_barrier()
#define PG8_SCHED __builtin_amdgcn_sched_barrier(0)
    Unit cur, nxt; int ui = 0;
    if (!S.next(0, cur)) return;
    f32x4 acc[2][2][4][2];
#pragma unroll
    for (int a = 0; a < 2; ++a)
#pragma unroll
        for (int b = 0; b < 2; ++b)
#pragma unroll
            for (int m = 0; m < 4; ++m)
#pragma unroll
                for (int n = 0; n < 2; ++n) acc[a][b][m][n] = (f32x4){0.f, 0.f, 0.f, 0.f};
    bf16x8 At[4][2], B0[2][2], B1[2][2];
    const char* cA = (const char*)g.A + (size_t)cur.pm * tstep; const char* cB = (const char*)g.Bt + (size_t)cur.pn * tstep;
    S.a_ready(cur);
    if constexpr (SP2) {
        PG8_STAGE(PG8_SB(0, 0), cB, voffB); PG8_STAGE(PG8_SB(0, 1), cB + hstep, voffB); PG8_STAGE(PG8_SA(0, 0), cA, voffA); PG8_STAGE(PG8_SA(0, 1), cA + hstep, voffA);
        if (wr == 1) PG8_BAR;
        PG8_WAIT_V(2); PG8_BAR;
        PG8_STAGE(PG8_SB(1, 0), cB + kstep, voffB); PG8_STAGE(PG8_SA(1, 0), cA + kstep, voffA); PG8_STAGE(PG8_SB(1, 1), cB + hstep + kstep, voffB);
        PG8_WAIT_V(6); PG8_BAR;
    } else {
        PG8_STAGE(PG8_SB(0, 0), cB, voffB); PG8_STAGE(PG8_SA(0, 0), cA, voffA); PG8_STAGE(PG8_SB(0, 1), cB + hstep, voffB); PG8_STAGE(PG8_SA(0, 1), cA + hstep, voffA);
        if (wr == 1) PG8_BAR;
        PG8_WAIT_V(4); PG8_BAR;
        PG8_STAGE(PG8_SB(1, 0), cB + kstep, voffB); PG8_STAGE(PG8_SA(1, 0), cA + kstep, voffA); PG8_STAGE(PG8_SB(1, 1), cB + hstep + kstep, voffB);
        PG8_WAIT_V(6); PG8_BAR;
    }
    for (;;) {
        const bool has_next = S.next(ui + 1, nxt);
        const char* nA = has_next ? (const char*)g.A + (size_t)nxt.pm * tstep : cA; const char* nB = has_next ? (const char*)g.Bt + (size_t)nxt.pn * tstep : cB;
        for (int t = 0; t < nt; t += 2) {
            const bool last = (t == nt - 2);
            const char* a1 = cA + (size_t)(t + 1) * kstep;
            const char* a2 = last ? nA : cA + (size_t)(t + 2) * kstep; const char* b2 = last ? nB : cB + (size_t)(t + 2) * kstep;
            const char* a3 = a2 + kstep; const char* b3 = b2 + kstep;
            if (last && has_next) S.a_ready(nxt);
            if constexpr (SP2) {
            PG8_LDB(B0, 0, 0); PG8_LDB(B1, 0, 1); PG8_SCHED; PG8_LDA(At, 0, 0); PG8_STAGE(PG8_SA(1, 1), a1 + hstep, voffA);
            PG8_WAIT_V(8); PG8_WAIT_L(0); PG8_BAR; PG8_MMA(0, 0, At, B0); PG8_MMA(0, 1, At, B1); PG8_BAR; PG8_SCHED;
            PG8_LDA(At, 0, 1); PG8_STAGE(PG8_SB(0, 0), b2, voffB); PG8_STAGE(PG8_SB(0, 1), b2 + hstep, voffB); PG8_STAGE(PG8_SA(0, 0), a2, voffA);
            PG8_WAIT_V(8); PG8_WAIT_L(0); PG8_BAR; PG8_MMA(1, 0, At, B0); PG8_MMA(1, 1, At, B1); PG8_BAR; PG8_SCHED;
            PG8_LDB(B0, 1, 0); PG8_LDB(B1, 1, 1); PG8_SCHED; PG8_LDA(At, 1, 0); PG8_STAGE(PG8_SA(0, 1), a2 + hstep, voffA);
            PG8_WAIT_V(8); PG8_WAIT_L(0); PG8_BAR; PG8_MMA(0, 0, At, B0); PG8_MMA(0, 1, At, B1); PG8_BAR; PG8_SCHED;
            PG8_LDA(At, 1, 1); PG8_STAGE(PG8_SB(1, 0), b3, voffB); PG8_STAGE(PG8_SB(1, 1), b3 + hstep, voffB); PG8_STAGE(PG8_SA(1, 0), a3, voffA);
            PG8_WAIT_V(8); PG8_WAIT_L(0); PG8_BAR; PG8_MMA(1, 0, At, B0); PG8_MMA(1, 1, At, B1); PG8_BAR; PG8_SCHED;
            } else {
            PG8_LDB(B0, 0, 0); PG8_SCHED; PG8_LDA(At, 0, 0); PG8_STAGE(PG8_SA(1, 1), a1 + hstep, voffA);
            PG8_WAIT_L(8); PG8_BAR; PG8_WAIT_L(0); PG8_MMA(0, 0, At, B0); PG8_BAR; PG8_SCHED;
            PG8_LDB(B1, 0, 1); PG8_STAGE(PG8_SB(0, 0), b2, voffB);
            PG8_BAR; PG8_WAIT_L(0); PG8_MMA(0, 1, At, B1); PG8_BAR;
            PG8_LDA(At, 0, 1); PG8_STAGE(PG8_SA(0, 0), a2, voffA);
            PG8_BAR; PG8_WAIT_L(0); PG8_MMA(1, 0, At, B0); PG8_BAR; PG8_SCHED;
            PG8_STAGE(PG8_SB(0, 1), b2 + hstep, voffB);
            PG8_WAIT_V(6); PG8_BAR; PG8_MMA(1, 1, At, B1); PG8_BAR;
            PG8_LDB(B0, 1, 0); PG8_SCHED; PG8_LDA(At, 1, 0); PG8_STAGE(PG8_SA(0, 1), a2 + hstep, voffA);
            PG8_WAIT_L(8); PG8_BAR; PG8_WAIT_L(0); PG8_MMA(0, 0, At, B0); PG8_BAR; PG8_SCHED;
            PG8_LDB(B1, 1, 1); PG8_STAGE(PG8_SB(1, 0), b3, voffB);
            PG8_BAR; PG8_WAIT_L(0); PG8_MMA(0, 1, At, B1); PG8_BAR;
            PG8_LDA(At, 1, 1); PG8_STAGE(PG8_SA(1, 0), a3, voffA);
            PG8_BAR; PG8_WAIT_L(0); PG8_MMA(1, 0, At, B0); PG8_BAR; PG8_SCHED;
            PG8_STAGE(PG8_SB(1, 1), b3 + hstep, voffB);
            PG8_WAIT_V(6); PG8_BAR; PG8_MMA(1, 1, At, B1); PG8_BAR;
            }
        }
        if constexpr (ALIGN_EPI) { if (wr == 0) PG8_BAR; }
        if constexpr (!Epi::AFTER_DRAIN) { E(acc, cur, wr, wc, fr, fq); S.done(cur); }
        if (!has_next) break;
#pragma unroll
        for (int a = 0; a < 2; ++a)
#pragma unroll
            for (int b = 0; b < 2; ++b)
#pragma unroll
                for (int m = 0; m < 4; ++m)
#pragma unroll
                    for (int n = 0; n < 2; ++n) acc[a][b][m][n] = (f32x4){0.f, 0.f, 0.f, 0.f};
        cur = nxt; cA = nA; cB = nB; ++ui;
        if constexpr (ALIGN_EPI) { if (wr == 1) PG8_BAR; }
    }
    PG8_WAIT_V(0);
    if constexpr (!ALIGN_EPI) { if (wr == 0) PG8_BAR; }
    PG8_BAR;
    if constexpr (Epi::AFTER_DRAIN) { E.fused(acc, cur, wr, wc, fr, fq, lds, wid, lane); S.done(cur); }
#undef PG8_SA
#undef PG8_SB
#undef PG8_STAGE
#undef PG8_LDA
#undef PG8_LDB
#undef PG8_MMA
#undef PG8_WAIT_V
#undef PG8_WAIT_L
#undef PG8_BAR
#undef PG8_SCHED
}
}
constexpr int NWAVES = 8;
constexpr int MP = 16384, MS = 512, M = 16896, D = 1024, DFF = 2816, PLE = 256, SEQ = 4096, NB = 4, DB = 128, DSQ = 4;
constexpr int NBIN = 4352, NBIN_REAL = 4112, NCIN = 2816, NCIN_REAL = 2608;
constexpr int CMP_ROWS = 34816;
constexpr float ALPHA = 1.681792830507429f, LN_EPS = 1e-5f, NORM_EPS = 1e-6f;
constexpr size_t O_YP = 0, O_YS = 16777216, O_AV = 17301504, O_GSP = 19398656, O_GCP = 19922944, O_GSS = 19959808, O_GCS = 36737024,
                 O_KVP = 37916672, O_WINP = 54693888, O_KVS = 55742464, O_WINS = 56266752, O_END = 56528896;
constexpr size_t CTL_BYTES = 1u << 20;
constexpr size_t SZ_WUP = (size_t)5632 * 1024 * 2, SZ_WDN = (size_t)1024 * 2816 * 2, SZ_WG = (size_t)1024 * 1024 * 2, SZ_WP = (size_t)1024 * 256 * 2,
                 SZ_WAIN = (size_t)4096 * 1024 * 2, SZ_WAOUT = (size_t)1024 * 2048 * 2, SZ_WBIN = (size_t)NBIN * 1024 * 2, SZ_WCIN = (size_t)NCIN * 1024 * 2, SZ_WC1 = (size_t)256 * 2048 * 2;
constexpr size_t WS_WUP = CTL_BYTES, WS_WDN = WS_WUP + 8 * SZ_WUP, WS_WG = WS_WDN + 8 * SZ_WDN, WS_WP = WS_WG + 4 * SZ_WG, WS_WAIN = WS_WP + 4 * SZ_WP, WS_WAOUT = WS_WAIN + 2 * SZ_WAIN,
                 WS_WBIN = WS_WAOUT + 2 * SZ_WAOUT, WS_WBOUT = WS_WBIN + SZ_WBIN, WS_WCIN = WS_WBOUT + SZ_WG, WS_WCOUT = WS_WCIN + SZ_WCIN, WS_WC1 = WS_WCOUT + SZ_WG;
constexpr size_t WS_X = WS_WC1 + 2 * SZ_WC1;
constexpr size_t WS_XN = WS_X + (size_t)M * 1024 * 4;
constexpr size_t WS_XNB = WS_XN + (size_t)M * 1024 * 2;
constexpr size_t WS_PRE = WS_XNB + (size_t)M * 1024 * 2;
constexpr size_t WS_H = WS_PRE + (size_t)M * 1024 * 4;
constexpr size_t WS_PBF = WS_H + (size_t)M * 2816 * 2;
constexpr size_t WS_PP = WS_PBF + (size_t)4 * M * 256 * 2;
constexpr size_t WS_MIX = WS_PP + (size_t)4 * M * 1024 * 4;
constexpr size_t WA_U = WS_MIX, WA_V = WA_U + (size_t)M * 2048 * 2, WA_US = WA_V + (size_t)M * 2048 * 4, WA_ST = WA_US + (size_t)M * 2048 * 2, WA_END = WA_ST + (size_t)M * 8;
constexpr size_t GUNITS = 2048;
constexpr size_t WB_PROJ = WS_MIX, WB_W = WB_PROJ + (size_t)M * NBIN * 4, WB_U = WB_W + GUNITS * 64 * 128 * 4, WB_QG = WB_U + GUNITS * 64 * 128 * 4, WB_KD = WB_QG + GUNITS * 64 * 128 * 4,
                 WB_QK = WB_KD + GUNITS * 64 * 128 * 4, WB_EG = WB_QK + GUNITS * 64 * 64 * 4, WB_O = WB_EG + 65536, WB_OG = WB_O + (size_t)M * 1024 * 4, WB_END = WB_OG + (size_t)M * 1024 * 2;
constexpr size_t WC_PROJ = WS_MIX, WC_ACMP = WC_PROJ + (size_t)M * NCIN * 4, WC_HC = WC_ACMP + (size_t)2 * CMP_ROWS * 2048 * 2, WC_KCV = WC_HC + (size_t)2 * CMP_ROWS * 256 * 2,
                 WC_OA = WC_KCV + (size_t)2 * CMP_ROWS * 64 * 4, WC_END = WC_OA + (size_t)M * 1024 * 2;
constexpr size_t WS_END = (WB_END > WC_END ? (WB_END > WA_END ? WB_END : WA_END) : (WC_END > WA_END ? WC_END : WA_END));
static_assert(WS_X % 256 == 0 && WS_MIX % 256 == 0 && WB_W % 256 == 0 && WC_ACMP % 256 == 0, "alignment");
constexpr int CW_TMO = 0, CW_BAR = 4096;
constexpr int LDS_BYTES = 147456, MISC_OFF = LDS_BYTES - 512;

#define GAS __attribute__((address_space(1)))
#define LAS __attribute__((address_space(3)))
typedef unsigned short bf16;
typedef float f32x4 __attribute__((ext_vector_type(4)));
typedef float f32x2 __attribute__((ext_vector_type(2)));
typedef unsigned u32x2 __attribute__((ext_vector_type(2)));
typedef unsigned u32x4 __attribute__((ext_vector_type(4)));
#define LDS_WAIT() asm volatile("s_waitcnt lgkmcnt(0)" ::: "memory")
__device__ __forceinline__ unsigned f2bf(float f) { unsigned u = __builtin_bit_cast(unsigned, f); return (u + 0x7fffu + ((u >> 16) & 1u)) >> 16; }
__device__ __forceinline__ unsigned pk2(float lo, float hi) { return f2bf(lo) | (f2bf(hi) << 16); }
__device__ __forceinline__ float bf2f(bf16 b) { return __builtin_bit_cast(float, ((unsigned)b) << 16); }
__device__ __forceinline__ float wave_sum(float v) {
#pragma unroll
    for (int o = 1; o < 64; o <<= 1) v += __shfl_xor(v, o);
    return v;
}
__device__ __forceinline__ float wave_max(float v) {
#pragma unroll
    for (int o = 1; o < 64; o <<= 1) v = fmaxf(v, __shfl_xor(v, o));
    return v;
}
__device__ __forceinline__ float sigmoid_f(float x) { return 1.0f / (1.0f + __expf(-x)); }
__device__ __forceinline__ float siluf(float x) { return x * sigmoid_f(x); }
__device__ __forceinline__ float readlane_f(float v, int k) { return __builtin_bit_cast(float, __builtin_amdgcn_readlane(__builtin_bit_cast(int, v), k)); }
#define XB_TMO      128
#define XB_XCNT(j)  (256  + 64 * (j))
#define XB_XSUB(j)  (1280 + 64 * (j))
#define XB_XGEN(j)  (2304 + 64 * (j))
#define XB_TOP      3328
#define XB_TOPGEN   3392
#define XCD_BAR_WORDS 3456
#define XB_SPIN_CAP (1u << 18)

__device__ __forceinline__ unsigned xb_ld(unsigned* p)              { return __hip_atomic_load(p, __ATOMIC_RELAXED, __HIP_MEMORY_SCOPE_AGENT); }
__device__ __forceinline__ unsigned xb_add(unsigned* p, unsigned v) { return __hip_atomic_fetch_add(p, v, __ATOMIC_RELAXED, __HIP_MEMORY_SCOPE_AGENT); }
__device__ __forceinline__ unsigned xb_xcc_id() { return (unsigned)__builtin_amdgcn_s_getreg((3 << 11) | 20) & 0xFu; }
#define XB_SPIN(cond, bar) do { unsigned _sp = 0; while (cond) { __builtin_amdgcn_s_sleep(1); \
    if ((++_sp & 255u) == 0u) { if (xb_ld(&(bar)[XB_TMO])) break; if (_sp > XB_SPIN_CAP) { atomicAdd(&(bar)[XB_TMO], 1u); break; } } } } while (0)

struct XcdBarrier {
    unsigned* bar; unsigned x;
    volatile LAS unsigned* st;
};

__device__ __forceinline__ XcdBarrier xcd_barrier_post(unsigned* bar, volatile LAS unsigned* st) {
    XcdBarrier b; b.bar = bar; b.x = xb_xcc_id(); b.st = st;
    if (threadIdx.x == 0) (void)xb_add(&bar[XB_XCNT(b.x)], 1u);
    return b;
}
__device__ __forceinline__ void xcd_barrier_complete(unsigned* bar, unsigned x, unsigned& nloc, unsigned& nx) {
    const unsigned G = gridDim.x * gridDim.y * gridDim.z;
    unsigned sum, cnt, mine, sp = 0u;
    for (;;) {
        sum = 0u; cnt = 0u; mine = 0u;
#pragma unroll
        for (unsigned j = 0; j < 16; ++j) { const unsigned c = xb_ld(&bar[XB_XCNT(j)]); sum += c; cnt += (c > 0u) ? 1u : 0u; mine = (j == x) ? c : mine; }
        if (sum == G) break;
        __builtin_amdgcn_s_sleep(1);
        if ((++sp & 255u) == 0u) { if (xb_ld(&bar[XB_TMO])) break; if (sp > XB_SPIN_CAP) { atomicAdd(&bar[XB_TMO], 1u); break; } }
    }
    nloc = mine > 0u ? mine : 1u; nx = cnt > 0u ? cnt : 1u;
}

__device__ __forceinline__ void xcd_barrier(const XcdBarrier& b) {
    asm volatile("s_waitcnt vmcnt(0)" ::: "memory");
    __syncthreads();
    if (threadIdx.x == 0) {
        unsigned* bar = b.bar;
        __builtin_amdgcn_s_waitcnt(0);
        unsigned nloc = b.st[0], nx = b.st[1];
        if (nloc == 0u) { xcd_barrier_complete(bar, b.x, nloc, nx); b.st[0] = nloc; b.st[1] = nx; }
        const unsigned old = xb_add(&bar[XB_XSUB(b.x)], 1u);
        const unsigned gen = old / nloc;
        if (old + 1u == (gen + 1u) * nloc) {
            __builtin_amdgcn_fence(__ATOMIC_RELEASE, "agent");
            asm volatile("s_waitcnt vmcnt(0)" ::: "memory");
            const unsigned og = xb_add(&bar[XB_TOP], 1u);
            const unsigned tg = og / nx;
            if (og + 1u == (tg + 1u) * nx) xb_add(&bar[XB_TOPGEN], 1u);
            else XB_SPIN(xb_ld(&bar[XB_TOPGEN]) == tg, bar);
            __builtin_amdgcn_fence(__ATOMIC_ACQUIRE, "agent");
            xb_add(&bar[XB_XGEN(b.x)], 1u);
            asm volatile("s_waitcnt vmcnt(0)" ::: "memory");
        } else {
            XB_SPIN(xb_ld(&bar[XB_XGEN(b.x)]) == gen, bar);
            __builtin_amdgcn_fence(__ATOMIC_ACQUIRE, "agent");
            asm volatile("s_waitcnt vmcnt(0)" ::: "memory");
        }
    }
    __syncthreads();
}
enum { I_XP = 0, I_XS, I_GS, I_GCONV, I_CKV, I_CWIN, I_PT, I_PP, I_PS, I_LNG, I_LNB, I_WUP, I_WDN, I_WG, I_WPJ, I_AWIN, I_ALNG, I_ALNB, I_AWS, I_ABS, I_AWOUT,
       I_BWIN, I_BCONV, I_BALOG, I_BDT, I_BNG, I_BWOUT, I_CWIN_W, I_CGB, I_CPE, I_CW1, I_CW2, I_CWOUT, I_T5, N_IN };
struct Ctx {
    LAS unsigned char* lds; unsigned char* ws; float* out; const float* const* in;
    int tid, lane, wave, G, gw, NGW;
};
#define WSF(off) ((float*)(c.ws + (off)))
#define WSB(off) ((bf16*)(c.ws + (off)))

__device__ __forceinline__ void tr_item(const float* W, int K, int N, bf16* WT, int mode, LAS float* scr, int item, int lane) {
    const int nblk = (N + 31) >> 5, kb = item / nblk, nb = item - kb * nblk, k0 = 64 * kb, n0 = 32 * nb;
    const int nn = n0 + (lane & 31); const bool ok = nn < N;
#pragma unroll 8
    for (int i = 0; i < 32; ++i) { const int kk = 2 * i + (lane >> 5); scr[kk * 33 + (lane & 31)] = ok ? W[(size_t)(k0 + kk) * N + nn] : 0.f; }
    LDS_WAIT(); asm volatile("" ::: "memory");
    const int cch = lane & 7;
#pragma unroll
    for (int j = 0; j < 4; ++j) { const int nl = (lane >> 3) + 8 * j, n = n0 + nl; const LAS float* s = scr + (8 * cch) * 33 + nl;
        if (n < N) { u32x4 o; o.x = pk2(s[0 * 33], s[1 * 33]); o.y = pk2(s[2 * 33], s[3 * 33]); o.z = pk2(s[4 * 33], s[5 * 33]); o.w = pk2(s[6 * 33], s[7 * 33]);
            int drow = n; if (mode == 1) { const int half = n >= DFF ? 1 : 0, idx = n - half * DFF; drow = (idx >> 7) * 256 + half * 128 + (idx & 127); }
            *(u32x4*)(WT + (size_t)drow * K + k0 + 8 * cch) = o; } }
    LDS_WAIT(); asm volatile("" ::: "memory");
}
__device__ __forceinline__ void prologue_phase(const Ctx& c) {
    LAS float* scr = (LAS float*)(c.lds + c.wave * 16384);
    constexpr int IT_UP = 16 * 176, IT_DN = 44 * 32, IT_G = 16 * 32, IT_P = 4 * 32, IT_AIN = 16 * 128, IT_AOUT = 32 * 32, IT_BIN = 16 * 129, IT_CIN = 16 * 82, IT_C1 = 32 * 8;
    constexpr int NIT = 8 * IT_UP + 8 * IT_DN + 4 * IT_G + 4 * IT_P + 2 * IT_AIN + 2 * IT_AOUT + IT_BIN + IT_G + IT_CIN + IT_G + 2 * IT_C1;
    for (int it = c.gw; it < NIT; it += c.NGW) {
        int r = it, mi;
        if (r < 8 * IT_UP) { mi = r / IT_UP; tr_item(c.in[I_WUP] + (size_t)mi * 1024 * 5632, 1024, 5632, WSB(WS_WUP + mi * SZ_WUP), 1, scr, r - mi * IT_UP, c.lane); continue; } r -= 8 * IT_UP;
        if (r < 8 * IT_DN) { mi = r / IT_DN; tr_item(c.in[I_WDN] + (size_t)mi * 2816 * 1024, 2816, 1024, WSB(WS_WDN + mi * SZ_WDN), 0, scr, r - mi * IT_DN, c.lane); continue; } r -= 8 * IT_DN;
        if (r < 4 * IT_G) { mi = r / IT_G; tr_item(c.in[I_WG] + (size_t)mi * 1024 * 1024, 1024, 1024, WSB(WS_WG + mi * SZ_WG), 0, scr, r - mi * IT_G, c.lane); continue; } r -= 4 * IT_G;
        if (r < 4 * IT_P) { mi = r / IT_P; tr_item(c.in[I_WPJ] + (size_t)mi * 256 * 1024, 256, 1024, WSB(WS_WP + mi * SZ_WP), 0, scr, r - mi * IT_P, c.lane); continue; } r -= 4 * IT_P;
        if (r < 2 * IT_AIN) { mi = r / IT_AIN; tr_item(c.in[I_AWIN] + (size_t)mi * 1024 * 4096, 1024, 4096, WSB(WS_WAIN + mi * SZ_WAIN), 0, scr, r - mi * IT_AIN, c.lane); continue; } r -= 2 * IT_AIN;
        if (r < 2 * IT_AOUT) { mi = r / IT_AOUT; tr_item(c.in[I_AWOUT] + (size_t)mi * 2048 * 1024, 2048, 1024, WSB(WS_WAOUT + mi * SZ_WAOUT), 0, scr, r - mi * IT_AOUT, c.lane); continue; } r -= 2 * IT_AOUT;
        if (r < IT_BIN) { tr_item(c.in[I_BWIN], 1024, NBIN_REAL, WSB(WS_WBIN), 0, scr, r, c.lane); continue; } r -= IT_BIN;
        if (r < IT_G) { tr_item(c.in[I_BWOUT], 1024, 1024, WSB(WS_WBOUT), 0, scr, r, c.lane); continue; } r -= IT_G;
        if (r < IT_CIN) { tr_item(c.in[I_CWIN_W], 1024, NCIN_REAL, WSB(WS_WCIN), 0, scr, r, c.lane); continue; } r -= IT_CIN;
        if (r < IT_G) { tr_item(c.in[I_CWOUT], 1024, 1024, WSB(WS_WCOUT), 0, scr, r, c.lane); continue; } r -= IT_G;
        mi = r / IT_C1; tr_item(c.in[I_CW1] + (size_t)mi * 2048 * 256, 2048, 256, WSB(WS_WC1 + mi * SZ_WC1), 0, scr, r - mi * IT_C1, c.lane);
    }
    for (int r = c.gw; r < (NBIN - NBIN_REAL) + (NCIN - NCIN_REAL); r += c.NGW) {
        bf16* row = r < (NBIN - NBIN_REAL) ? WSB(WS_WBIN) + (size_t)(NBIN_REAL + r) * 1024 : WSB(WS_WCIN) + (size_t)(NCIN_REAL + r - (NBIN - NBIN_REAL)) * 1024;
        const u32x4 z = {0u, 0u, 0u, 0u}; *(u32x4*)(row + c.lane * 8) = z; *(u32x4*)(row + 512 + c.lane * 8) = z; }
    for (int row = c.gw; row < M; row += c.NGW) {
        const float* src = row < MP ? c.in[I_XP] + (size_t)row * 1024 : c.in[I_XS] + (size_t)(row - MP) * 1024;
        float* xd = WSF(WS_X) + (size_t)row * 1024; bf16* xn = WSB(WS_XNB) + (size_t)row * 1024;
#pragma unroll
        for (int j = 0; j < 4; ++j) { const f32x4 v = *((const f32x4*)src + c.lane + 64 * j); *((f32x4*)xd + c.lane + 64 * j) = v; u32x2 w; w.x = pk2(v.x, v.y); w.y = pk2(v.z, v.w); *((u32x2*)xn + c.lane + 64 * j) = w; }
    }
    for (int r = c.gw; r < 4 * M; r += c.NGW) {
        const int l = r / M, row = r - l * M;
        const float* src = row < MP ? c.in[I_PP] + ((size_t)l * MP + row) * 256 : c.in[I_PS] + ((size_t)l * MS + (row - MP)) * 256;
        const f32x4 v = *((const f32x4*)src + c.lane); u32x2 w; w.x = pk2(v.x, v.y); w.y = pk2(v.z, v.w); *((u32x2*)(WSB(WS_PBF) + (size_t)r * 256) + c.lane) = w;
    }
}
__device__ __forceinline__ void ln_phase(const Ctx& c, const float* g, const float* b) {
    f32x4 gv[4], bv[4];
#pragma unroll
    for (int j = 0; j < 4; ++j) { gv[j] = *((const f32x4*)g + c.lane + 64 * j); bv[j] = *((const f32x4*)b + c.lane + 64 * j); }
    for (int row = c.gw; row < M; row += c.NGW) {
        const f32x4* p = (const f32x4*)(WSF(WS_PRE) + (size_t)row * 1024) + c.lane;
        f32x4 v[4]; float s = 0.f;
#pragma unroll
        for (int j = 0; j < 4; ++j) { v[j] = p[64 * j]; s += (v[j].x + v[j].y) + (v[j].z + v[j].w); }
        const float mean = wave_sum(s) * (1.f / 1024.f); float s2 = 0.f;
#pragma unroll
        for (int j = 0; j < 4; ++j) { v[j] = v[j] - mean; s2 += (v[j].x * v[j].x + v[j].y * v[j].y) + (v[j].z * v[j].z + v[j].w * v[j].w); }
        const float rstd = 1.f / sqrtf(wave_sum(s2) * (1.f / 1024.f) + LN_EPS);
        float* xd = WSF(WS_X) + (size_t)row * 1024; bf16* xn = WSB(WS_XN) + (size_t)row * 1024;
#pragma unroll
        for (int j = 0; j < 4; ++j) { const f32x4 y = v[j] * rstd * gv[j] + bv[j]; *((f32x4*)xd + c.lane + 64 * j) = y; u32x2 w; w.x = pk2(y.x, y.y); w.y = pk2(y.z, y.w); *((u32x2*)xn + c.lane + 64 * j) = w; }
    }
}
__device__ __forceinline__ void a_stats_phase(const Ctx& c, int ia) {
    const float* lg = c.in[I_ALNG] + ia * 2048; const float* lb = c.in[I_ALNB] + ia * 2048;
    for (int row = c.gw; row < M; row += c.NGW) {
        const f32x4* p = (const f32x4*)(WSF(WA_V) + (size_t)row * 2048) + c.lane;
        f32x4 v[8]; float s = 0.f;
#pragma unroll
        for (int j = 0; j < 8; ++j) { v[j] = p[64 * j]; s += (v[j].x + v[j].y) + (v[j].z + v[j].w); }
        const float mean = wave_sum(s) * (1.f / 2048.f); float s2 = 0.f;
#pragma unroll
        for (int j = 0; j < 8; ++j) { v[j] = v[j] - mean; s2 += (v[j].x * v[j].x + v[j].y * v[j].y) + (v[j].z * v[j].z + v[j].w * v[j].w); }
        const float rstd = 1.f / sqrtf(wave_sum(s2) * (1.f / 2048.f) + LN_EPS);
        if (c.lane == 0) { WSF(WA_ST)[2 * row] = mean; WSF(WA_ST)[2 * row + 1] = rstd; }
        if (row >= MP) { float* o = c.out + O_AV + ((size_t)ia * MS + (row - MP)) * 2048;
#pragma unroll
            for (int j = 0; j < 8; ++j) { const f32x4 gg = *((const f32x4*)lg + c.lane + 64 * j), bb = *((const f32x4*)lb + c.lane + 64 * j); *((f32x4*)o + c.lane + 64 * j) = v[j] * rstd * gg + bb; } }
    }
}
__device__ __forceinline__ void a_sgu_phase(const Ctx& c, int ia) {
    LAS float* vn = (LAS float*)c.lds;
    LAS float* wT = vn + 128 * 128;
    const float* ws = c.in[I_AWS] + (size_t)ia * 16 * 128 * 128; const float* bs = c.in[I_ABS] + ia * 16 * 128;
    const float* lg = c.in[I_ALNG] + ia * 2048; const float* lb = c.in[I_ALNB] + ia * 2048;
    const float* V = WSF(WA_V); const float* ST = WSF(WA_ST); const bf16* U = WSB(WA_U); bf16* US = WSB(WA_US);
    for (int unit = blockIdx.x; unit < 2048 + DB; unit += c.G) {
        if (unit < 2048) {
            const int g = unit & 15, n = (unit >> 4) & 31, b = unit >> 9, rowbase = b * SEQ + n * 128;
            __syncthreads();
            for (int idx = c.tid; idx < 4096; idx += 512) { const int s = idx >> 5, c4 = idx & 31, row = rowbase + s;
                const f32x4 v = *(const f32x4*)(V + (size_t)row * 2048 + g * 128 + c4 * 4); const float mean = ST[2 * row], rstd = ST[2 * row + 1];
                const f32x4 gg = *(const f32x4*)(lg + g * 128 + c4 * 4), bb = *(const f32x4*)(lb + g * 128 + c4 * 4);
                *(LAS f32x4*)(vn + s * 128 + c4 * 4) = (v - mean) * rstd * gg + bb; }
            for (int idx = c.tid; idx < 4096; idx += 512) { const int t = idx >> 5, s4 = idx & 31; const f32x4 w = *(const f32x4*)(ws + ((size_t)g * 128 + t) * 128 + s4 * 4); const int pt = (t & 3) * 32 + (t >> 2);
#pragma unroll
                for (int k = 0; k < 4; ++k) { const int s = 4 * s4 + k; wT[s * 128 + pt] = (s <= t) ? w[k] : 0.f; } }
            __syncthreads();
            const int d = c.tid & 127, tq = c.tid >> 7;
            float acc[32];
#pragma unroll
            for (int i = 0; i < 32; ++i) acc[i] = 0.f;
            for (int s = 0; s < 128; ++s) { const float v = vn[s * 128 + d];
#pragma unroll
                for (int i4 = 0; i4 < 8; ++i4) { const f32x4 w4 = *(const LAS f32x4*)(wT + s * 128 + tq * 32 + 4 * i4);
                    acc[4 * i4 + 0] += w4.x * v; acc[4 * i4 + 1] += w4.y * v; acc[4 * i4 + 2] += w4.z * v; acc[4 * i4 + 3] += w4.w * v; } }
#pragma unroll
            for (int i = 0; i < 32; ++i) { const int t = tq + 4 * i; const size_t o = (size_t)(rowbase + t) * 2048 + g * 128 + d;
                US[o] = (bf16)f2bf((acc[i] + bs[g * 128 + t]) * bf2f(U[o])); }
        } else {
            const int sb = unit - 2048, c0 = c.tid * 4, g = c0 >> 7;
            const f32x4 gg = *(const f32x4*)(lg + c0), bb = *(const f32x4*)(lb + c0);
            f32x4 vnr[4];
#pragma unroll
            for (int t = 0; t < 4; ++t) { const int row = MP + 4 * sb + t; const f32x4 v = *(const f32x4*)(V + (size_t)row * 2048 + c0); vnr[t] = (v - ST[2 * row]) * ST[2 * row + 1] * gg + bb; }
#pragma unroll
            for (int t = 0; t < 4; ++t) { const int row = MP + 4 * sb + t; f32x4 sv = {0.f, 0.f, 0.f, 0.f};
#pragma unroll
                for (int s = 0; s <= t; ++s) sv += vnr[s] * ws[((size_t)g * 128 + t) * 128 + s];
                sv += bs[g * 128 + t];
                const u32x2 uu = *(const u32x2*)(U + (size_t)row * 2048 + c0);
                f32x4 y; y.x = sv.x * bf2f((bf16)(uu.x & 0xffff)); y.y = sv.y * bf2f((bf16)(uu.x >> 16)); y.z = sv.z * bf2f((bf16)(uu.y & 0xffff)); y.w = sv.w * bf2f((bf16)(uu.y >> 16));
                u32x2 w; w.x = pk2(y.x, y.y); w.y = pk2(y.z, y.w); *(u32x2*)(US + (size_t)row * 2048 + c0) = w; }
        }
    }
}
__device__ __forceinline__ void gdn_prep_phase(const Ctx& c) {
    const float* PJ = WSF(WB_PROJ); const float* cw = c.in[I_BCONV]; const float* alog = c.in[I_BALOG]; const float* dtb = c.in[I_BDT];
    float* GW = WSF(WB_W); float* GU = WSF(WB_U); float* GQG = WSF(WB_QG); float* GKD = WSF(WB_KD); float* GQK = WSF(WB_QK); float* GEG = WSF(WB_EG);
    for (int unit = blockIdx.x; unit < 2048 + 1024; unit += c.G) {
        __syncthreads();
        LAS float* lb = (LAS float*)c.lds; asm volatile("" : "+v"(lb));
        LAS float* qf = lb; LAS float* kf = qf + 64 * 129; LAS float* vf = kf + 64 * 129; LAS float* Am = vf + 64 * 129; LAS float* gc = Am + 64 * 65; LAS float* bt = gc + 64;
        if (unit < 2048) {
            const int ci = unit & 63, h = (unit >> 6) & 7, b = unit >> 9, rb = b * SEQ + ci * 64;
            if (c.tid < 64) { const size_t row = rb + c.tid; const float bl = PJ[row * NBIN + 4096 + h], al = PJ[row * NBIN + 4104 + h];
                const float x = al + dtb[h]; const float sp = x > 20.f ? x : log1pf(expf(x)); float g = -expf(alog[h]) * sp;
#pragma unroll
                for (int o = 1; o < 64; o <<= 1) { const float t = __shfl_up(g, o); if (c.lane >= o) g += t; }
                gc[c.tid] = g; bt[c.tid] = sigmoid_f(bl); }
#pragma unroll 1
            for (int i = 0; i < 8; ++i) { const int tk = c.wave * 8 + i, tabs = ci * 64 + tk; const size_t row = rb + tk;
#pragma unroll
                for (int part = 0; part < 3; ++part) { const int ch = part * 1024 + h * 128 + 2 * c.lane; float a0 = 0.f, a1 = 0.f;
#pragma unroll
                    for (int j = 0; j < 4; ++j) { if (tabs - 3 + j >= 0) { const f32x2 x = *(const f32x2*)(PJ + (row - 3 + j) * NBIN + ch); const f32x2 w = *(const f32x2*)(cw + j * 3072 + ch); a0 += x.x * w.x; a1 += x.y * w.y; } }
                    a0 = siluf(a0); a1 = siluf(a1);
                    if (part < 2) { const float ss = wave_sum(a0 * a0 + a1 * a1); const float sc = (1.f / sqrtf(ss + NORM_EPS)) * (part == 0 ? 0.08838834764831845f : 1.f); a0 *= sc; a1 *= sc; }
                    LAS float* dst = (part == 0 ? qf : (part == 1 ? kf : vf)) + tk * 129 + 2 * c.lane; dst[0] = a0; dst[1] = a1; } }
            __syncthreads();
            { const int j = c.lane, ig = c.wave; float kk[8], qk[8];
#pragma unroll
              for (int ii = 0; ii < 8; ++ii) { kk[ii] = 0.f; qk[ii] = 0.f; }
              for (int d = 0; d < 128; ++d) { const float kj = kf[j * 129 + d];
#pragma unroll
                  for (int ii = 0; ii < 8; ++ii) { kk[ii] += kf[(ig * 8 + ii) * 129 + d] * kj; qk[ii] += qf[(ig * 8 + ii) * 129 + d] * kj; } }
#pragma unroll
              for (int ii = 0; ii < 8; ++ii) { const int i = ig * 8 + ii; const float dec = (i >= j) ? expf(gc[i] - gc[j]) : 0.f;
                  Am[i * 65 + j] = (i > j) ? bt[i] * kk[ii] * dec : 0.f; GQK[((size_t)unit * 64 + i) * 64 + j] = (i >= j) ? qk[ii] * dec : 0.f; } }
            __syncthreads();
            if (c.tid < 256) { const bool isw = c.tid >= 128; const int cc = c.tid & 127; float x[64]; float* dst = (isw ? GW : GU) + (size_t)unit * 64 * 128 + cc;
#pragma unroll
                for (int i = 0; i < 64; ++i) { float r = isw ? kf[i * 129 + cc] * bt[i] * expf(gc[i]) : vf[i * 129 + cc] * bt[i];
#pragma unroll
                    for (int j = 0; j < i; ++j) r -= Am[i * 65 + j] * x[j];
                    x[i] = r; dst[i * 128] = r; } }
            for (int idx = c.tid; idx < 64 * 128; idx += 512) { const int cc = idx >> 7, dk = idx & 127;
                GQG[(size_t)unit * 8192 + idx] = qf[cc * 129 + dk] * expf(gc[cc]); GKD[(size_t)unit * 8192 + idx] = kf[cc * 129 + dk] * expf(gc[63] - gc[cc]); }
            if (c.tid == 0) GEG[unit] = expf(gc[63]);
        } else {
            const int su = unit - 2048, h = su & 7, b = su >> 3;
            LAS float* q4 = lb; LAS float* k4 = q4 + 512; LAS float* v4 = k4 + 512; LAS float* red = v4 + 512; LAS float* o4 = red + 512; LAS float* g4 = o4 + 512; LAS float* b4 = g4 + 4;
            const float* cst = c.in[I_GCONV] + (size_t)b * 3 * 3072;
            { const int t = c.tid >> 7, chl = c.tid & 127;
#pragma unroll
              for (int part = 0; part < 3; ++part) { const int ch = part * 1024 + h * 128 + chl; float a = 0.f;
#pragma unroll
                  for (int j = 0; j < 4; ++j) { const int mm = t + j; const float x = mm < 3 ? cst[mm * 3072 + ch] : PJ[(size_t)(MP + 4 * b + mm - 3) * NBIN + ch]; a += x * cw[j * 3072 + ch]; }
                  (part == 0 ? q4 : (part == 1 ? k4 : v4))[t * 128 + chl] = siluf(a); }
              if (c.tid < 4) { const size_t row = MP + 4 * b + c.tid; const float bl = PJ[row * NBIN + 4096 + h], al = PJ[row * NBIN + 4104 + h];
                  const float x = al + dtb[h]; const float sp = x > 20.f ? x : log1pf(expf(x)); g4[c.tid] = -expf(alog[h]) * sp; b4[c.tid] = sigmoid_f(bl); } }
            __syncthreads();
            { const int t = c.tid >> 7, chl = c.tid & 127; float sq = 0.f, sk = 0.f;
              for (int d = 0; d < 128; ++d) { const float a = q4[t * 128 + d], bb = k4[t * 128 + d]; sq += a * a; sk += bb * bb; }
              const float qv = q4[t * 128 + chl] * (1.f / sqrtf(sq + NORM_EPS)) * 0.08838834764831845f, kv = k4[t * 128 + chl] * (1.f / sqrtf(sk + NORM_EPS));
              __syncthreads();
              q4[t * 128 + chl] = qv; k4[t * 128 + chl] = kv; }
            __syncthreads();
            const int dv = c.tid & 127, part = c.tid >> 7;
            float S[32];
            const float* S0 = c.in[I_GS] + (((size_t)b * 8 + h) * 128 + part * 32) * 128 + dv;
#pragma unroll
            for (int i = 0; i < 32; ++i) S[i] = S0[(size_t)i * 128];
#pragma unroll 1
            for (int t = 0; t < 4; ++t) { const float a = expf(g4[t]); float p = 0.f;
#pragma unroll
                for (int i = 0; i < 32; ++i) p += k4[t * 128 + part * 32 + i] * S[i];
                red[part * 128 + dv] = p; __syncthreads();
                const float kS = (red[dv] + red[128 + dv]) + (red[256 + dv] + red[384 + dv]); const float vnew = b4[t] * (v4[t * 128 + dv] - a * kS); float po = 0.f;
#pragma unroll
                for (int i = 0; i < 32; ++i) { S[i] = a * S[i] + k4[t * 128 + part * 32 + i] * vnew; po += q4[t * 128 + part * 32 + i] * S[i]; }
                __syncthreads(); red[part * 128 + dv] = po; __syncthreads();
                if (part == 0) o4[t * 128 + dv] = (red[dv] + red[128 + dv]) + (red[256 + dv] + red[384 + dv]);
                __syncthreads(); }
            float* So = c.out + O_GSS + (((size_t)b * 8 + h) * 128 + part * 32) * 128 + dv;
#pragma unroll
            for (int i = 0; i < 32; ++i) So[(size_t)i * 128] = S[i];
            { const int t = c.tid >> 7; float ms = 0.f;
              for (int d = 0; d < 128; ++d) { const float o = o4[t * 128 + d]; ms += o * o; }
              const size_t row = MP + 4 * b + t; const float z = PJ[row * NBIN + 3072 + h * 128 + dv];
              const float y = o4[t * 128 + dv] * (1.f / sqrtf(ms * (1.f / 128.f) + NORM_EPS)) * c.in[I_BNG][dv] * siluf(z);
              WSB(WB_OG)[row * 1024 + h * 128 + dv] = (bf16)f2bf(y); }
        }
    }
    for (size_t idx = (size_t)blockIdx.x * 512 + c.tid; idx < 36864 + 1179648; idx += (size_t)c.G * 512) {
        if (idx < 36864) { const int b = (int)(idx / 9216), r = (int)(idx % 9216), j = r / 3072, ch = r % 3072; c.out[O_GCP + idx] = PJ[((size_t)b * SEQ + SEQ - 3 + j) * NBIN + ch]; }
        else { const size_t k = idx - 36864; const int b = (int)(k / 9216), r = (int)(k % 9216), j = r / 3072, ch = r % 3072; c.out[O_GCS + k] = PJ[((size_t)MP + 4 * b + 1 + j) * NBIN + ch]; }
    }
}
__device__ __forceinline__ void gdn_scan_phase(const Ctx& c) {
    LAS float* Wl = (LAS float*)c.lds; LAS float* Ql = Wl + 64 * 132; LAS float* Kl = Ql + 64 * 132; LAS float* QKl = Kl + 64 * 128; LAS float* Sl = QKl + 64 * 65; LAS float* VN = Sl + 128 * 16; LAS float* Ul = VN + 64 * 16;
    const float* GW = WSF(WB_W); const float* GU = WSF(WB_U); const float* GQG = WSF(WB_QG); const float* GKD = WSF(WB_KD); const float* GQK = WSF(WB_QK); const float* GEG = WSF(WB_EG);
    float* GO = WSF(WB_O);
    for (int unit = blockIdx.x; unit < 256; unit += c.G) {
        const int dvs = unit & 7, h = (unit >> 3) & 7, b = unit >> 6;
        const int dv = c.tid & 15, cg = c.tid >> 4;
        __syncthreads();
        for (int i = c.tid; i < 128 * 16; i += 512) Sl[i] = 0.f;
        for (int ci = 0; ci < 64; ++ci) {
            const size_t pu = ((size_t)b * 8 + h) * 64 + ci;
            __syncthreads();
#pragma unroll
            for (int k = 0; k < 4; ++k) { const int idx = c.tid + 512 * k, r = idx >> 5, c4 = idx & 31;
                *(LAS f32x4*)(Wl + r * 132 + 4 * c4) = *(const f32x4*)(GW + pu * 8192 + idx * 4); *(LAS f32x4*)(Ql + r * 132 + 4 * c4) = *(const f32x4*)(GQG + pu * 8192 + idx * 4);
                *(LAS f32x4*)(Kl + r * 128 + 4 * c4) = *(const f32x4*)(GKD + pu * 8192 + idx * 4); }
#pragma unroll
            for (int k = 0; k < 8; ++k) { const int idx = c.tid + 512 * k, r = idx >> 6, j = idx & 63; QKl[r * 65 + j] = GQK[pu * 4096 + idx]; }
#pragma unroll
            for (int k = 0; k < 2; ++k) { const int idx = c.tid + 512 * k, r = idx >> 4, j = idx & 15; Ul[r * 16 + j] = GU[pu * 8192 + r * 128 + dvs * 16 + j]; }
            const float eg = GEG[pu];
            __syncthreads();
            float qs[2];
#pragma unroll
            for (int e = 0; e < 2; ++e) { const int cc = cg + 32 * e; float ws = 0.f, q = 0.f;
                for (int dk = 0; dk < 128; ++dk) { const float s = Sl[dk * 16 + dv]; ws += Wl[cc * 132 + dk] * s; q += Ql[cc * 132 + dk] * s; }
                VN[cc * 16 + dv] = Ul[cc * 16 + dv] - ws; qs[e] = q; }
            __syncthreads();
#pragma unroll
            for (int e = 0; e < 2; ++e) { const int cc = cg + 32 * e; float o = qs[e];
                for (int j = 0; j <= cc; ++j) o += QKl[cc * 65 + j] * VN[j * 16 + dv];
                GO[((size_t)b * SEQ + ci * 64 + cc) * 1024 + h * 128 + dvs * 16 + dv] = o; }
#pragma unroll
            for (int e = 0; e < 4; ++e) { const int dk = cg + 32 * e; float s = Sl[dk * 16 + dv] * eg;
                for (int c2 = 0; c2 < 64; ++c2) s += Kl[c2 * 128 + dk] * VN[c2 * 16 + dv];
                Sl[dk * 16 + dv] = s; }
        }
        __syncthreads();
        for (int i = c.tid; i < 128 * 16; i += 512) { const int dk = i >> 4, j = i & 15; c.out[O_GSP + (((size_t)b * 8 + h) * 128 + dk) * 128 + dvs * 16 + j] = Sl[i]; }
    }
}
__device__ __forceinline__ void gdn_post_phase(const Ctx& c) {
    const float* GO = WSF(WB_O); const float* PJ = WSF(WB_PROJ); const float* ng = c.in[I_BNG];
    for (int row = c.gw; row < MP; row += c.NGW) {
        const f32x4* p = (const f32x4*)(GO + (size_t)row * 1024 + c.lane * 16); f32x4 v[4]; float s = 0.f;
#pragma unroll
        for (int j = 0; j < 4; ++j) { v[j] = p[j]; s += (v[j].x * v[j].x + v[j].y * v[j].y) + (v[j].z * v[j].z + v[j].w * v[j].w); }
        s += __shfl_xor(s, 1); s += __shfl_xor(s, 2); s += __shfl_xor(s, 4);
        const float r = 1.f / sqrtf(s * (1.f / 128.f) + NORM_EPS);
        const f32x4* zp = (const f32x4*)(PJ + (size_t)row * NBIN + 3072 + c.lane * 16); const f32x4* gp = (const f32x4*)(ng + (c.lane & 7) * 16);
        u32x2* op = (u32x2*)(WSB(WB_OG) + (size_t)row * 1024 + c.lane * 16);
#pragma unroll
        for (int j = 0; j < 4; ++j) { const f32x4 z = zp[j], g = gp[j]; f32x4 y; y.x = v[j].x * r * g.x * siluf(z.x); y.y = v[j].y * r * g.y * siluf(z.y); y.z = v[j].z * r * g.z * siluf(z.z); y.w = v[j].w * r * g.w * siluf(z.w);
            u32x2 w; w.x = pk2(y.x, y.y); w.y = pk2(y.z, y.w); op[j] = w; }
    }
}
__device__ const unsigned char T5_LUT[128] = {0, 1, 2, 3, 4, 5, 6, 7, 8, 9, 10, 11, 12, 13, 14, 15, 16, 16, 16, 17, 17, 18, 18, 18, 19, 19, 19, 20, 20, 20, 20, 21, 21, 21, 21, 22, 22, 22, 22, 22, 23, 23, 23, 23, 23, 23, 24, 24, 24, 24, 24, 24, 25, 25, 25, 25, 25, 25, 25, 26, 26, 26, 26, 26, 26, 26, 26, 27, 27, 27, 27, 27, 27, 27, 27, 27, 27, 28, 28, 28, 28, 28, 28, 28, 28, 28, 28, 29, 29, 29, 29, 29, 29, 29, 29, 29, 29, 29, 29, 30, 30, 30, 30, 30, 30, 30, 30, 30, 30, 30, 30, 30, 30, 31, 31, 31, 31, 31, 31, 31, 31, 31, 31, 31, 31, 31, 31, 31};
__device__ __forceinline__ void nsa_prep_phase(const Ctx& c) {
    const float* PJ = WSF(WC_PROJ);
    for (size_t i4 = (size_t)blockIdx.x * 512 + c.tid; i4 < (size_t)M * 256; i4 += (size_t)c.G * 512) { const size_t row = i4 >> 8; const int c4 = (int)(i4 & 255);
        const f32x4 v = *(const f32x4*)(PJ + row * NCIN + 1024 + c4 * 4);
        if (row < MP) *(f32x4*)(c.out + O_KVP + row * 1024 + c4 * 4) = v; else *(f32x4*)(c.out + O_KVS + (row - MP) * 1024 + c4 * 4) = v; }
    for (size_t i4 = (size_t)blockIdx.x * 512 + c.tid; i4 < (size_t)(2048 + MS) * 128; i4 += (size_t)c.G * 512) { const size_t r = i4 >> 7; const int c4 = (int)(i4 & 127);
        const size_t row = r < 2048 ? (r >> 9) * SEQ + (SEQ - 512) + (r & 511) : MP + (r - 2048);
        const f32x4 v = *(const f32x4*)(PJ + row * NCIN + 2048 + c4 * 4);
        if (r < 2048) *(f32x4*)(c.out + O_WINP + r * 512 + c4 * 4) = v; else *(f32x4*)(c.out + O_WINS + (r - 2048) * 512 + c4 * 4) = v; }
    bf16* AC = WSB(WC_ACMP); const float* pe = c.in[I_CPE]; const int* pt = (const int*)c.in[I_PT]; const float* ckv = c.in[I_CKV];
    for (int R = c.gw; R < 2 * CMP_ROWS; R += c.NGW) {
        const int which = R >= CMP_ROWS ? 1 : 0, r = R - which * CMP_ROWS;
        const float* src; size_t lstride;
        if (r < 2048) { const int g = r & 3, n = (r >> 2) & 127, b = r >> 9; src = PJ + ((size_t)b * SEQ + 32 * n) * NCIN + 1024 + which * 256 + g * 64; lstride = NCIN; }
        else { const int q = r - 2048, g = q & 3, n = (q >> 2) & 63, b = q >> 8; const int page = pt[b * 16 + (n >> 2)];
            src = ckv + (((size_t)page * 128 + (n & 3) * 32) * 16 + which * 4 + g) * 64; lstride = 1024; }
#pragma unroll
        for (int k = 0; k < 8; ++k) { const int idx = c.lane + 64 * k, l = idx >> 4, d4 = idx & 15;
            const f32x4 v = *(const f32x4*)(src + (size_t)l * lstride + d4 * 4) + *(const f32x4*)(pe + (which * 32 + l) * 64 + d4 * 4);
            u32x2 w; w.x = pk2(v.x, v.y); w.y = pk2(v.z, v.w); *(u32x2*)(AC + (size_t)R * 2048 + l * 64 + d4 * 4) = w; }
    }
}
__device__ __forceinline__ void nsa_cmp2_phase(const Ctx& c) {
    LAS float* w2 = (LAS float*)c.lds;
    __syncthreads();
    for (int i = c.tid; i < 2 * 256 * 64 / 4; i += 512) *(LAS f32x4*)(w2 + 4 * i) = *((const f32x4*)c.in[I_CW2] + i);
    __syncthreads();
    const bf16* HC = WSB(WC_HC); float* KCV = WSF(WC_KCV);
    for (int R = c.gw; R < 2 * CMP_ROWS; R += c.NGW) {
        const LAS float* w = w2 + (R >= CMP_ROWS ? 256 * 64 : 0) + c.lane; const u32x4* hp = (const u32x4*)(HC + (size_t)R * 256); float a = 0.f;
#pragma unroll 4
        for (int k8 = 0; k8 < 32; ++k8) { const u32x4 hv = hp[k8]; const unsigned hw[4] = {hv.x, hv.y, hv.z, hv.w};
#pragma unroll
            for (int j = 0; j < 4; ++j) { a += bf2f((bf16)(hw[j] & 0xffff)) * w[(8 * k8 + 2 * j) * 64]; a += bf2f((bf16)(hw[j] >> 16)) * w[(8 * k8 + 2 * j + 1) * 64]; } }
        KCV[(size_t)R * 64 + c.lane] = a;
    }
}
struct AttSt { float m[4], l[4]; f32x4 o[4]; };
__device__ __forceinline__ void att_reset(AttSt& s) {
#pragma unroll
    for (int h = 0; h < 4; ++h) { s.m[h] = -1e30f; s.l[h] = 0.f; s.o[h] = (f32x4){0.f, 0.f, 0.f, 0.f}; } }
__device__ __forceinline__ void att_scores(const LAS float* qs, const LAS float* tabl, const float* kptr, bool valid, int dist, int g, float (&s)[4]) {
    const f32x4* kp = (const f32x4*)kptr;
    s[0] = s[1] = s[2] = s[3] = 0.f;
#pragma unroll 1
    for (int c4 = 0; c4 < 4; ++c4) {
        f32x4 kv[4];
#pragma unroll
        for (int u = 0; u < 4; ++u) kv[u] = kp[c4 * 4 + u];
#pragma unroll
        for (int u = 0; u < 4; ++u)
#pragma unroll
            for (int h = 0; h < 4; ++h) { const f32x4 q = *(const LAS f32x4*)(qs + h * 64 + (c4 * 4 + u) * 4); s[h] += (q.x * kv[u].x + q.y * kv[u].y) + (q.z * kv[u].z + q.w * kv[u].w); } }
    const int dd = dist < 0 ? 0 : dist; const int bk = dd < 128 ? (int)T5_LUT[dd] : 31;
    const f32x4 bias = *(const LAS f32x4*)(tabl + bk * 16 + g * 4);
#pragma unroll
    for (int h = 0; h < 4; ++h) s[h] = valid ? s[h] + bias[h] : -1e30f;
}
__device__ __forceinline__ void att_pv(AttSt& st, LAS f32x4* P, LAS unsigned long long* R, const float (&p)[4], const float* rowp, int voff, int lane) {
    P[lane] = (f32x4){p[0], p[1], p[2], p[3]}; R[lane] = (unsigned long long)rowp;
    LDS_WAIT();
#pragma unroll 8
    for (int i = 0; i < 16; ++i) { const int key = 4 * i + (lane >> 4); const f32x4 p4 = P[key]; const float* rp = (const float*)R[key];
        const f32x4 v = *(const f32x4*)(rp + voff + (lane & 15) * 4);
        st.o[0] += v * p4.x; st.o[1] += v * p4.y; st.o[2] += v * p4.z; st.o[3] += v * p4.w; }
    LDS_WAIT();
}
__device__ __forceinline__ void att_block(AttSt& st, const LAS float* qs, const LAS float* tabl, LAS f32x4* P, LAS unsigned long long* R, const float* kptr, const float* safe, bool valid, int dist, int voff, int g, int lane) {
    const float* rowp = valid ? kptr : safe; float s[4], p[4];
    att_scores(qs, tabl, rowp, valid, dist, g, s);
#pragma unroll
    for (int h = 0; h < 4; ++h) { const float mx = wave_max(s[h]), mn = fmaxf(st.m[h], mx), sc = __expf(st.m[h] - mn); p[h] = valid ? __expf(s[h] - mn) : 0.f;
        st.l[h] = st.l[h] * sc + wave_sum(p[h]); st.o[h] *= sc; st.m[h] = mn; }
    att_pv(st, P, R, p, rowp, voff, lane);
}
__device__ __forceinline__ void att_finish(AttSt& st, const float (&gate)[4], f32x4 (&acc)[4]) {
#pragma unroll
    for (int h = 0; h < 4; ++h) { f32x4 o = st.o[h];
#pragma unroll
        for (int k = 0; k < 4; ++k) { o[k] += __shfl_xor(o[k], 16); o[k] += __shfl_xor(o[k], 32); }
        const float inv = st.l[h] > 0.f ? gate[h] / st.l[h] : 0.f; acc[h] += o * inv; }
}
__device__ __forceinline__ void nsa_attn_phase(const Ctx& c) {
    LAS float* tabl = (LAS float*)c.lds;
    LAS float* qs = tabl + 512 + c.wave * 768;
    LAS f32x4* P = (LAS f32x4*)(qs + 256); LAS unsigned long long* R = (LAS unsigned long long*)(qs + 512); LAS float* pcs = qs + 640;
    __syncthreads();
    for (int i = c.tid; i < 512; i += 512) tabl[i] = c.in[I_T5][i];
    __syncthreads();
    const float* PJ = WSF(WC_PROJ); const float* KCV = WSF(WC_KCV); const float* gb = c.in[I_CGB]; const int* pt = (const int*)c.in[I_PT]; const float* ckv = c.in[I_CKV]; const float* cwin = c.in[I_CWIN];
    bf16* OA = WSB(WC_OA);
    for (int item = c.gw; item < 65536 + 2048; item += c.NGW) {
        int lane = c.lane; asm volatile("" : "+v"(lane));
        const bool smp = item >= 65536; int b, g, t, qpos, ncmp, nslc; size_t row;
        if (!smp) { g = item & 3; b = (item >> 2) & 3; t = item >> 4; qpos = t; row = (size_t)b * SEQ + t; ncmp = 128; nslc = 64; }
        else { const int q = item - 65536; g = q & 3; t = (q >> 2) & 3; b = q >> 4; qpos = 2048 + t; row = (size_t)MP + 4 * b + t; ncmp = 64; nslc = 33; }
        const float* qrow = PJ + row * NCIN;
        { const f32x4 qv = *(const f32x4*)(qrow + g * 256 + lane * 4); *(LAS f32x4*)(qs + lane * 4) = qv * 0.125f; }
        float gv = 0.f; if (lane < 12) { const int gi = (lane >> 2) * 16 + g * 4 + (lane & 3); gv = sigmoid_f(qrow[2560 + gi] + gb[gi]); }
        float gate_c[4], gate_s[4], gate_w[4];
#pragma unroll
        for (int h = 0; h < 4; ++h) { gate_c[h] = readlane_f(gv, h); gate_s[h] = readlane_f(gv, 4 + h); gate_w[h] = readlane_f(gv, 8 + h); }
        LDS_WAIT();
        f32x4 acc[4];
#pragma unroll
        for (int h = 0; h < 4; ++h) acc[h] = (f32x4){0.f, 0.f, 0.f, 0.f};
        AttSt st;
        float ps;
        { const size_t kc0 = smp ? (size_t)2048 + ((size_t)b * 64) * 4 + g : ((size_t)b * 128) * 4 + g;
          const float* safe = KCV; float s0[4], s1[4];
          const int n0 = lane, n1 = lane + 64; const int d0 = qpos - (32 * n0 + 31), d1 = qpos - (32 * n1 + 31);
          const bool v0 = n0 < ncmp && d0 >= 0, v1 = n1 < ncmp && d1 >= 0;
          const float* k0p = v0 ? KCV + (kc0 + 4 * (size_t)n0) * 64 : safe; const float* k1p = v1 ? KCV + (kc0 + 4 * (size_t)n1) * 64 : safe;
          att_scores(qs, tabl, k0p, v0, d0, g, s0); att_scores(qs, tabl, k1p, v1, d1, g, s1);
          att_reset(st); float p0[4], p1[4], pc0 = 0.f, pc1 = 0.f;
#pragma unroll
          for (int h = 0; h < 4; ++h) { const float mx = wave_max(fmaxf(s0[h], s1[h])); p0[h] = v0 ? __expf(s0[h] - mx) : 0.f; p1[h] = v1 ? __expf(s1[h] - mx) : 0.f;
              const float l = wave_sum(p0[h] + p1[h]); const float inv = l > 0.f ? 1.f / l : 0.f; p0[h] *= inv; p1[h] *= inv; pc0 += p0[h]; pc1 += p1[h]; st.l[h] = l > 0.f ? 1.f : 0.f; }
          att_pv(st, P, R, p0, k0p, CMP_ROWS * 64, lane); att_pv(st, P, R, p1, k1p, CMP_ROWS * 64, lane);
          att_finish(st, gate_c, acc);
          pcs[lane] = pc0; pcs[64 + lane] = pc1; LDS_WAIT();
          ps = (2 * lane + 1 < ncmp) ? pcs[2 * lane] + pcs[2 * lane + 1] : 0.f; LDS_WAIT(); }
        const int jq = qpos >> 6; unsigned long long sel;
        { const bool forced = (lane == 0) || (lane == jq) || (lane == jq - 1);
          float sc = forced ? 100.f : (lane > jq ? -1.f : ps); if (lane >= nslc) sc = -__builtin_inff();
          int cnt = 0;
#pragma unroll 4
          for (int k = 0; k < 64; ++k) { const float sk = readlane_f(sc, k); cnt += (sk > sc || (sk == sc && k < lane)) ? 1 : 0; }
          sel = __ballot(cnt < 16); }
        att_reset(st);
        { const float* safe = qrow + 1536;
          unsigned long long todo = sel & (jq >= 63 ? ~0ull : ((1ull << (jq + 1)) - 1ull));
          while (todo) { const int j = __builtin_ctzll(todo); todo &= todo - 1ull;
              const int kpos = 64 * j + lane; const bool valid = kpos <= qpos; const float* kptr;
              if (!smp) kptr = PJ + ((size_t)b * SEQ + kpos) * NCIN + 1536 + g * 64;
              else if (j < 32) { const int page = pt[b * 16 + (j >> 1)]; kptr = ckv + (((size_t)page * 128 + (j & 1) * 64 + lane) * 16 + 8 + g) * 64; }
              else kptr = PJ + ((size_t)MP + 4 * b + (lane & 3)) * NCIN + 1536 + g * 64;
              att_block(st, qs, tabl, P, R, kptr, safe, valid, qpos - kpos, 256, g, lane); } }
        att_finish(st, gate_s, acc);
        att_reset(st);
        { const float* safe = qrow + 2048;
          for (int cb = 0; cb < 8; ++cb) { const int kpos = qpos - 511 + 64 * cb + lane; if (qpos - 511 + 64 * cb + 63 < 0) continue;
              const bool valid = kpos >= 0; const float* kptr;
              if (!smp) kptr = PJ + ((size_t)b * SEQ + (valid ? kpos : 0)) * NCIN + 2048 + g * 64;
              else if (kpos < 2048) kptr = cwin + (((size_t)b * 512 + (kpos - 1536)) * 2) * 256 + g * 64;
              else kptr = PJ + ((size_t)MP + 4 * b + (kpos - 2048)) * NCIN + 2048 + g * 64;
              att_block(st, qs, tabl, P, R, kptr, safe, valid, qpos - kpos, 256, g, lane); } }
        att_finish(st, gate_w, acc);
        if (lane < 16) {
#pragma unroll
            for (int h = 0; h < 4; ++h) { u32x2 w; w.x = pk2(acc[h].x, acc[h].y); w.y = pk2(acc[h].z, acc[h].w); *(u32x2*)(OA + row * 1024 + (g * 4 + h) * 64 + lane * 4) = w; } }
    }
}
constexpr int PH_PER_SUB = 9, N_PHASES = 2 + 12 * PH_PER_SUB;
struct Args { const float* in[N_IN]; float* out; unsigned char* ws; int ph_lo, ph_hi, bli, pad; };
__host__ __device__ inline bool phase_exists(int ph) {
    if (ph < 2) return true; const int r = ph - 2, sub3 = r / PH_PER_SUB, slot = r % PH_PER_SUB, L = sub3 / 3, s = sub3 % 3, kind = (L == 1) ? 1 : (L == 2 ? 2 : 0);
    if (slot == 0 || slot == 5 || slot == 6) return true;
    if (slot == 7) return s == 2;
    if (slot == 8) return false;
    if (s != 1) return false;
    if (kind == 0) return slot <= 2; if (kind == 1) return slot <= 3; return true;
}

#define IN(k) (lo <= (k) && (k) < hi)
#define SEAM(k) do { if (IN(k) && (k) + 1 < hi) xcd_barrier(bar); } while (0)
template <int L, int S> __device__ __forceinline__ void run_sub(const Ctx& c, const XcdBarrier& bar, const int lo, const int hi) {
    constexpr int kind = (L == 1) ? 1 : (L == 2 ? 2 : 0), ia = (L == 3) ? 1 : 0, base = 2 + (3 * L + S) * PH_PER_SUB;
    LAS unsigned char* ring = c.lds;
    if (IN(base)) {
        if constexpr (S != 1) { constexpr int j = S >> 1; pg8::Gemm g{S == 0 ? WSB(WS_XNB) : WSB(WS_XN), WSB(WS_WUP + (size_t)(2 * L + j) * SZ_WUP), M, 5632, 1024}; pg8::StaticOrder So; So.init(M, 5632, c.G, (int)blockIdx.x);
            pg8::EpiGate E{WSB(WS_H), DFF}; pg8::gemm_phase<pg8::EpiGate, pg8::StaticOrder, true, true>(ring, g, So, E); }
        else if constexpr (kind == 0) { pg8::Gemm g{WSB(WS_XN), WSB(WS_WAIN + (size_t)ia * SZ_WAIN), M, 4096, 1024}; pg8::StaticOrder So; So.init(M, 4096, c.G, (int)blockIdx.x);
            pg8::EpiAin E{WSB(WA_U), WSF(WA_V)}; pg8::gemm_phase<pg8::EpiAin, pg8::StaticOrder, true, true>(ring, g, So, E); }
        else { constexpr int N = kind == 1 ? NBIN : NCIN; pg8::Gemm g{WSB(WS_XN), kind == 1 ? WSB(WS_WBIN) : WSB(WS_WCIN), M, N, 1024}; pg8::StaticOrder So; So.init(M, N, c.G, (int)blockIdx.x);
            pg8::EpiF32 E{WSF(WS_MIX), N}; pg8::gemm_phase<pg8::EpiF32, pg8::StaticOrder, true, true>(ring, g, So, E); }
    } SEAM(base);
    if constexpr (S == 1) {
        if (IN(base + 1)) { if constexpr (kind == 0) a_stats_phase(c, ia); else if constexpr (kind == 1) gdn_prep_phase(c); else nsa_prep_phase(c); } SEAM(base + 1);
        if (IN(base + 2)) { if constexpr (kind == 0) a_sgu_phase(c, ia); else if constexpr (kind == 1) gdn_scan_phase(c);
            else {
                { pg8::Gemm g{WSB(WC_ACMP), WSB(WS_WC1), CMP_ROWS, 256, 2048}; pg8::StaticOrder So; So.init(CMP_ROWS, 256, c.G, (int)blockIdx.x);
                  pg8::EpiCmp E{WSB(WC_HC)}; pg8::gemm_phase<pg8::EpiCmp, pg8::StaticOrder, true, true>(ring, g, So, E); }
                { pg8::Gemm g{WSB(WC_ACMP) + (size_t)CMP_ROWS * 2048, WSB(WS_WC1 + SZ_WC1), CMP_ROWS, 256, 2048}; pg8::StaticOrder So; So.init(CMP_ROWS, 256, c.G, (int)((blockIdx.x + 128u) % (unsigned)c.G));
                  pg8::EpiCmp E{WSB(WC_HC) + (size_t)CMP_ROWS * 256}; pg8::gemm_phase<pg8::EpiCmp, pg8::StaticOrder, true, true>(ring, g, So, E); } } } SEAM(base + 2);
        if constexpr (kind != 0) { if (IN(base + 3)) { if constexpr (kind == 1) gdn_post_phase(c); else nsa_cmp2_phase(c); } SEAM(base + 3); }
        if constexpr (kind == 2) { if (IN(base + 4)) nsa_attn_phase(c); SEAM(base + 4); }
    }
    if (IN(base + 5)) {
        const bf16* A; const bf16* Bt; int K; float sc;
        if constexpr (S != 1) { A = WSB(WS_H); Bt = WSB(WS_WDN + (size_t)(2 * L + (S >> 1)) * SZ_WDN); K = DFF; sc = 0.5f; }
        else if constexpr (kind == 0) { A = WSB(WA_US); Bt = WSB(WS_WAOUT + (size_t)ia * SZ_WAOUT); K = 2048; sc = 1.f; }
        else if constexpr (kind == 1) { A = WSB(WB_OG); Bt = WSB(WS_WBOUT); K = 1024; sc = 1.f; }
        else { A = WSB(WC_OA); Bt = WSB(WS_WCOUT); K = 1024; sc = 1.f; }
        pg8::Gemm g{A, Bt, M, 1024, K}; pg8::StaticOrder So; So.init(M, 1024, c.G, (int)blockIdx.x);
        pg8::EpiResid E{WSF(WS_X), WSF(WS_PRE), ALPHA, sc}; pg8::gemm_phase<pg8::EpiResid, pg8::StaticOrder, true, true>(ring, g, So, E);
    } SEAM(base + 5);
    if (IN(base + 6)) { ln_phase(c, c.in[I_LNG] + (size_t)(3 * L + S) * 1024, c.in[I_LNB] + (size_t)(3 * L + S) * 1024); } SEAM(base + 6);
    if constexpr (S == 2) { if (IN(base + 7)) { pg8::Gemm g{WSB(WS_XN), WSB(WS_WG + (size_t)L * SZ_WG), M, 1024, 1024}; pg8::StaticOrder So; So.init(M, 1024, c.G, (int)blockIdx.x);
            pg8::EpiPle E{WSF(WS_X), WSF(WS_PP) + (size_t)L * M * 1024, WSB(WS_XNB), L == 3 ? c.out : nullptr}; pg8::gemm_phase<pg8::EpiPle, pg8::StaticOrder, true, true>(ring, g, So, E); } SEAM(base + 7); }
}
template <int l> __device__ __forceinline__ void ple_proj(const Ctx& c) {
    pg8::Gemm g{WSB(WS_PBF) + (size_t)l * M * 256, WSB(WS_WP + l * SZ_WP), M, 1024, 256}; pg8::StaticOrder So; So.init(M, 1024, c.G, (int)blockIdx.x);
    pg8::EpiF32 E{WSF(WS_PP) + (size_t)l * M * 1024, 1024}; pg8::gemm_phase<pg8::EpiF32, pg8::StaticOrder, true, true>(c.lds, g, So, E);
}
__global__ void __launch_bounds__(NWAVES * 64, 2) fwd(Args args) {
    extern __shared__ __attribute__((aligned(16))) unsigned char lds_raw[];
    Ctx c; c.lds = (LAS unsigned char*)lds_raw; c.ws = args.ws; c.out = args.out; c.in = args.in;
    c.tid = threadIdx.x; c.lane = c.tid & 63; c.wave = __builtin_amdgcn_readfirstlane(c.tid >> 6); c.G = gridDim.x; c.gw = blockIdx.x * NWAVES + c.wave; c.NGW = c.G * NWAVES;
    volatile LAS unsigned* MISC = (volatile LAS unsigned*)(c.lds + MISC_OFF);
    for (int u = c.tid; u < 128; u += NWAVES * 64) MISC[u] = 0u;
    __syncthreads();
    unsigned* ctl = (unsigned*)c.ws;
    XcdBarrier bar = xcd_barrier_post(ctl + CW_BAR + args.bli * XCD_BAR_WORDS, MISC + 8);
    const int lo = args.ph_lo, hi = args.ph_hi;
    if (IN(0)) { prologue_phase(c); } SEAM(0);
    if (IN(1)) { ple_proj<0>(c); ple_proj<1>(c); ple_proj<2>(c); ple_proj<3>(c); } SEAM(1);
    run_sub<0, 0>(c, bar, lo, hi); run_sub<0, 1>(c, bar, lo, hi); run_sub<0, 2>(c, bar, lo, hi);
    run_sub<1, 0>(c, bar, lo, hi); run_sub<1, 1>(c, bar, lo, hi); run_sub<1, 2>(c, bar, lo, hi);
    run_sub<2, 0>(c, bar, lo, hi); run_sub<2, 1>(c, bar, lo, hi); run_sub<2, 2>(c, bar, lo, hi);
    run_sub<3, 0>(c, bar, lo, hi); run_sub<3, 1>(c, bar, lo, hi); run_sub<3, 2>(c, bar, lo, hi);
}
#undef IN
#undef SEAM

#ifndef ONE_LAUNCH
#define ONE_LAUNCH 0
#endif
extern "C" void kernel_launch(void* const* d_in, const int* in_sizes, int n_in, void* d_out, int out_size, void* d_ws, size_t ws_size, hipStream_t stream) {
    static int grid = 0;
    if (grid == 0) {
        if (n_in != N_IN || (size_t)out_size != O_END || ws_size < WS_END) { fprintf(stderr, "kernel_launch: unexpected problem: n_in %d out %d ws %zu (need %zu)\n", n_in, out_size, ws_size, (size_t)WS_END); grid = -1; return; }
        int dev = 0, cus = 0, per_cu = 0;
        if (hipGetDevice(&dev) != hipSuccess || hipDeviceGetAttribute(&cus, hipDeviceAttributeMultiprocessorCount, dev) != hipSuccess) { grid = -1; return; }
        if (hipFuncSetAttribute((const void*)fwd, hipFuncAttributeMaxDynamicSharedMemorySize, LDS_BYTES) != hipSuccess) { fprintf(stderr, "kernel_launch: hipFuncSetAttribute failed\n"); grid = -1; return; }
        if (hipOccupancyMaxActiveBlocksPerMultiprocessor(&per_cu, (const void*)fwd, NWAVES * 64, LDS_BYTES) != hipSuccess || per_cu < 1) fprintf(stderr, "kernel_launch: occupancy query says %d\n", per_cu);
        (void)hipGetLastError();
        grid = cus;
    }
    if (grid < 0) return;
    (void)hipMemsetAsync(d_ws, 0, CTL_BYTES, stream);
    Args a{};
    for (int i = 0; i < N_IN; ++i) a.in[i] = (const float*)d_in[i];
    a.out = (float*)d_out; a.ws = (unsigned char*)d_ws; a.pad = 0;
#if ONE_LAUNCH
    a.ph_lo = 0; a.ph_hi = N_PHASES; a.bli = 0;
    hipLaunchKernelGGL(fwd, dim3(grid), dim3(NWAVES * 64), LDS_BYTES, stream, a);
#else
    for (int ph = 0; ph < N_PHASES; ++ph) { if (!phase_exists(ph)) continue; a.ph_lo = ph; a.ph_hi = ph + 1; a.bli = 0;
        hipLaunchKernelGGL(fwd, dim3(grid), dim3(NWAVES * 64), LDS_BYTES, stream, a); }
#endif
}
```

```cpp
#include <hip/hip_runtime.h>
#include <cstdio>
#include <cstdint>
namespace pg8 {
#define PG8_LAS __attribute__((address_space(3)))
typedef unsigned short bf16_t;
typedef short bf16x8 __attribute__((ext_vector_type(8)));
typedef float f32x4 __attribute__((ext_vector_type(4)));
typedef unsigned u32x4 __attribute__((ext_vector_type(4)));
constexpr int BM = 256, BK = 64, HALF = 128, HTB = HALF * BK * 2  , STAGE_BYTES = 8 * HTB, NXCD = 8, WGM = 8;

__host__ __device__ __forceinline__ int lds_byte(int r, int c) { const int st = (r >> 4) * 2 + (c >> 5), rr = r & 15, cc = c & 31, ob = rr * 64 + cc * 2; return st * 1024 + (ob ^ (((ob >> 9) & 1) << 5)); }
__host__ __device__ __forceinline__ void stage_rc(int b, int& R, int& C) { const int st = b / 1024, sb = b % 1024, swz = sb ^ (((sb >> 9) & 1) << 5); R = (st >> 1) * 16 + swz / 64; C = (st & 1) * 32 + (swz % 64) / 2; }
__host__ __device__ __forceinline__ int perm32(int rho) { const int n = rho >> 4, i = rho & 15; return 8 * (i >> 2) + 4 * n + (i & 3); }

struct Unit { int pm, pn; };
struct Gemm { const bf16_t* A; const bf16_t* Bt; int M, N, K; };

struct StaticOrder {
    int nM, nN, nwg, G, c;
    __host__ __device__ void init(int M, int N, int G_, int c_) { nM = M / BM; nN = N / BM; nwg = nM * nN; G = G_; c = c_; }
    __host__ __device__ bool next(int i, Unit& u) const {
        const long L = (long)i * G + c; if (L >= nwg) return false;
        int wgid = (int)L; { const int q = nwg / NXCD, r = nwg % NXCD, xcd = wgid % NXCD, off = wgid / NXCD; wgid = (xcd < r ? xcd * (q + 1) : r * (q + 1) + (xcd - r) * q) + off; }
        const int nig = WGM * nN, gid = wgid / nig, fm = gid * WGM, gsz = (nM - fm) < WGM ? (nM - fm) : WGM;
        u.pm = fm + ((wgid % nig) % gsz); u.pn = (wgid % nig) / gsz; return true;
    }
    __device__ __forceinline__ void a_ready(const Unit&) const {}
    __device__ __forceinline__ void done(const Unit&) const {}
};

__device__ __forceinline__ unsigned cvt_pk_bf16(float lo, float hi) { unsigned r; asm volatile("v_cvt_pk_bf16_f32 %0, %1, %2" : "=v"(r) : "v"(lo), "v"(hi)); return r; }
typedef unsigned u32x2 __attribute__((ext_vector_type(2)));
__device__ __forceinline__ float fast_sigmoid(float x) { return __frcp_rn(1.0f + __expf(-x)); }
__device__ __forceinline__ float silu_f(float x) { return x * fast_sigmoid(x); }
__device__ __forceinline__ float gelu_tanh_f(float x) { const float y = 1.5957691216057308f * (x + 0.044715f * x * x * x); return x * fast_sigmoid(y); }
__device__ __forceinline__ u32x2 pack4(f32x4 v) { u32x2 w; w.x = cvt_pk_bf16(v[0], v[1]); w.y = cvt_pk_bf16(v[2], v[3]); return w; }

struct EpiGate {
    static constexpr bool PERM = false, AFTER_DRAIN = false;
    bf16_t* H; int ldh;
    __device__ __forceinline__ void operator()(const f32x4 (&acc)[2][2][4][2], const Unit& u, int wr, int wc, int fr, int fq) const {
        const int row0 = u.pm * BM + wr * 64 + fr, col0 = u.pn * HALF + wc * 32 + 4 * fq;
#pragma unroll
        for (int ai = 0; ai < 2; ++ai)
#pragma unroll
            for (int m = 0; m < 4; ++m) { bf16_t* rowp = H + (size_t)(row0 + ai * HALF + m * 16) * ldh + col0;
#pragma unroll
                for (int n = 0; n < 2; ++n) { const f32x4 a = acc[ai][0][m][n], b = acc[ai][1][m][n]; f32x4 h;
#pragma unroll
                    for (int j = 0; j < 4; ++j) h[j] = silu_f(a[j]) * b[j];
                    *(u32x2*)(rowp + n * 16) = pack4(h); } }
    }
};
struct EpiResid {
    static constexpr bool PERM = false, AFTER_DRAIN = false;
    const float* X; float* PRE; float alpha, s;
    __device__ __forceinline__ void operator()(const f32x4 (&acc)[2][2][4][2], const Unit& u, int wr, int wc, int fr, int fq) const {
        const int row0 = u.pm * BM + wr * 64 + fr, col0 = u.pn * BM + wc * 32 + 4 * fq;
#pragma unroll
        for (int ai = 0; ai < 2; ++ai)
#pragma unroll
            for (int m = 0; m < 4; ++m) { const size_t off = (size_t)(row0 + ai * HALF + m * 16) * 1024 + col0;
#pragma unroll
                for (int bj = 0; bj < 2; ++bj)
#pragma unroll
                    for (int n = 0; n < 2; ++n) { const f32x4 x = *(const f32x4*)(X + off + bj * HALF + n * 16); *(f32x4*)(PRE + off + bj * HALF + n * 16) = x * alpha + acc[ai][bj][m][n] * s; } }
    }
};
struct EpiF32 {
    static constexpr bool PERM = false, AFTER_DRAIN = false;
    float* C; int ldc;
    __device__ __forceinline__ void operator()(const f32x4 (&acc)[2][2][4][2], const Unit& u, int wr, int wc, int fr, int fq) const {
        const int row0 = u.pm * BM + wr * 64 + fr, col0 = u.pn * BM + wc * 32 + 4 * fq;
#pragma unroll
        for (int ai = 0; ai < 2; ++ai)
#pragma unroll
            for (int m = 0; m < 4; ++m) { float* rowp = C + (size_t)(row0 + ai * HALF + m * 16) * ldc + col0;
#pragma unroll
                for (int bj = 0; bj < 2; ++bj)
#pragma unroll
                    for (int n = 0; n < 2; ++n) *(f32x4*)(rowp + bj * HALF + n * 16) = acc[ai][bj][m][n]; }
    }
};
struct EpiPle {
    static constexpr bool PERM = false, AFTER_DRAIN = false;
    float* X; const float* P; bf16_t* XN; float* OUT;
    __device__ __forceinline__ void operator()(const f32x4 (&acc)[2][2][4][2], const Unit& u, int wr, int wc, int fr, int fq) const {
        const int row0 = u.pm * BM + wr * 64 + fr, col0 = u.pn * BM + wc * 32 + 4 * fq;
#pragma unroll
        for (int ai = 0; ai < 2; ++ai)
#pragma unroll
            for (int m = 0; m < 4; ++m) { const size_t off = (size_t)(row0 + ai * HALF + m * 16) * 1024 + col0;
#pragma unroll
                for (int bj = 0; bj < 2; ++bj)
#pragma unroll
                    for (int n = 0; n < 2; ++n) { const size_t o = off + bj * HALF + n * 16; const f32x4 x = *(const f32x4*)(X + o), p = *(const f32x4*)(P + o), a = acc[ai][bj][m][n]; f32x4 y;
#pragma unroll
                        for (int j = 0; j < 4; ++j) y[j] = x[j] + fast_sigmoid(a[j]) * p[j];
                        *(f32x4*)(X + o) = y; *(u32x2*)(XN + o) = pack4(y); if (OUT) *(f32x4*)(OUT + o) = y; } }
    }
};
struct EpiAin {
    static constexpr bool PERM = false, AFTER_DRAIN = false;
    bf16_t* U; float* V;
    __device__ __forceinline__ void operator()(const f32x4 (&acc)[2][2][4][2], const Unit& u, int wr, int wc, int fr, int fq) const {
        const int row0 = u.pm * BM + wr * 64 + fr; const bool isu = u.pn < 8; const int col0 = (isu ? u.pn : u.pn - 8) * BM + wc * 32 + 4 * fq;
#pragma unroll
        for (int ai = 0; ai < 2; ++ai)
#pragma unroll
            for (int m = 0; m < 4; ++m) { const size_t off = (size_t)(row0 + ai * HALF + m * 16) * 2048 + col0;
#pragma unroll
                for (int bj = 0; bj < 2; ++bj)
#pragma unroll
                    for (int n = 0; n < 2; ++n) { const f32x4 a = acc[ai][bj][m][n]; f32x4 y;
#pragma unroll
                        for (int j = 0; j < 4; ++j) y[j] = gelu_tanh_f(a[j]);
                        if (isu) *(u32x2*)(U + off + bj * HALF + n * 16) = pack4(y); else *(f32x4*)(V + off + bj * HALF + n * 16) = y; } }
    }
};
struct EpiCmp {
    static constexpr bool PERM = false, AFTER_DRAIN = false;
    bf16_t* HC;
    __device__ __forceinline__ void operator()(const f32x4 (&acc)[2][2][4][2], const Unit& u, int wr, int wc, int fr, int fq) const {
        const int row0 = u.pm * BM + wr * 64 + fr, col0 = u.pn * BM + wc * 32 + 4 * fq;
#pragma unroll
        for (int ai = 0; ai < 2; ++ai)
#pragma unroll
            for (int m = 0; m < 4; ++m) { bf16_t* rowp = HC + (size_t)(row0 + ai * HALF + m * 16) * 256 + col0;
#pragma unroll
                for (int bj = 0; bj < 2; ++bj)
#pragma unroll
                    for (int n = 0; n < 2; ++n) { const f32x4 a = acc[ai][bj][m][n]; f32x4 y;
#pragma unroll
                        for (int j = 0; j < 4; ++j) y[j] = gelu_tanh_f(a[j]);
                        *(u32x2*)(rowp + bj * HALF + n * 16) = pack4(y); } }
    }
};
template <class Epi, class Sched, bool ALIGN_EPI = false, bool SP2 = false>
__device__ __forceinline__ void gemm_phase(PG8_LAS unsigned char* lds, const Gemm g, const Sched& S, const Epi& E) {
    const int tid = threadIdx.x, wid = __builtin_amdgcn_readfirstlane(tid >> 6), lane = tid & 63, wr = wid >> 2, wc = wid & 3, fr = lane & 15, fq = lane >> 4;
    const int K = g.K, nt = K / BK;
    unsigned voffA[2], voffB[2];
#pragma unroll
    for (int i = 0; i < 2; ++i) { int R, C; stage_rc(tid * 16 + i * 8192, R, C); const int Rb = Epi::PERM ? ((R & ~31) + perm32(R & 31)) : R;
        voffA[i] = (unsigned)(R * K + C) * 2u; voffB[i] = (unsigned)(Rb * K + C) * 2u; }
    const size_t kstep = (size_t)(BK * 2);
    const size_t hstep = (size_t)HALF * K * 2;
    const size_t tstep = 2 * hstep;
    const unsigned ldsw = (unsigned)wid * 1024u;
    const int aoff = lds_byte(wr * 64 + fr, fq * 8), boff = lds_byte(wc * 32 + fr, fq * 8);
#define PG8_SA(b, h) (((b) * 2 + (h)) * HTB)
#define PG8_SB(b, h) ((4 + (b) * 2 + (h)) * HTB)
#define PG8_STAGE(bufoff, gbase, voff) do { _Pragma("unroll") for (int _i = 0; _i < 2; ++_i) \
        __builtin_amdgcn_global_load_lds((const unsigned*)((const char*)(gbase) + (voff)[_i]), (PG8_LAS unsigned*)(lds + (bufoff) + ldsw + _i * 8192), 16, 0, 0); } while (0)
#define PG8_LDA(dst, b, h) do { _Pragma("unroll") for (int m = 0; m < 4; ++m) _Pragma("unroll") for (int k = 0; k < 2; ++k) dst[m][k] = *(const PG8_LAS bf16x8*)(lds + PG8_SA(b, h) + aoff + m * 2048 + k * 1024); } while (0)
#define PG8_LDB(dst, b, h) do { _Pragma("unroll") for (int n = 0; n < 2; ++n) _Pragma("unroll") for (int k = 0; k < 2; ++k) dst[n][k] = *(const PG8_LAS bf16x8*)(lds + PG8_SB(b, h) + boff + n * 2048 + k * 1024); } while (0)
#define PG8_MMA(ai, bj, At, Bt) do { __builtin_amdgcn_s_setprio(1); _Pragma("unroll") for (int m = 0; m < 4; ++m) _Pragma("unroll") for (int n = 0; n < 2; ++n) _Pragma("unroll") for (int k = 0; k < 2; ++k) \
        acc[ai][bj][m][n] = __builtin_amdgcn_mfma_f32_16x16x32_bf16(Bt[n][k], At[m][k], acc[ai][bj][m][n], 0, 0, 0); __builtin_amdgcn_s_setprio(0); } while (0)
#define PG8_WAIT_V(n) asm volatile("s_waitcnt vmcnt(" #n ")" ::: "memory")
#define PG8_WAIT_L(n) asm volatile("s_waitcnt lgkmcnt(" #n ")" ::: "memory")
#define PG8_BAR __builtin_amdgcn_s_barrier()
#define PG8_SCHED __builtin_amdgcn_sched_barrier(0)
    Unit cur, nxt; int ui = 0;
    if (!S.next(0, cur)) return;
    f32x4 acc[2][2][4][2];
#pragma unroll
    for (int a = 0; a < 2; ++a)
#pragma unroll
        for (int b = 0; b < 2; ++b)
#pragma unroll
            for (int m = 0; m < 4; ++m)
#pragma unroll
                for (int n = 0; n < 2; ++n) acc[a][b][m][n] = (f32x4){0.f, 0.f, 0.f, 0.f};
    bf16x8 At[4][2], B0[2][2], B1[2][2];
    const char* cA = (const char*)g.A + (size_t)cur.pm * tstep; const char* cB = (const char*)g.Bt + (size_t)cur.pn * tstep;
    S.a_ready(cur);
    if constexpr (SP2) {
        PG8_STAGE(PG8_SB(0, 0), cB, voffB); PG8_STAGE(PG8_SB(0, 1), cB + hstep, voffB); PG8_STAGE(PG8_SA(0, 0), cA, voffA); PG8_STAGE(PG8_SA(0, 1), cA + hstep, voffA);
        if (wr == 1) PG8_BAR;
        PG8_WAIT_V(2); PG8_BAR;
        PG8_STAGE(PG8_SB(1, 0), cB + kstep, voffB); PG8_STAGE(PG8_SA(1, 0), cA + kstep, voffA); PG8_STAGE(PG8_SB(1, 1), cB + hstep + kstep, voffB);
        PG8_WAIT_V(6); PG8_BAR;
    } else {
        PG8_STAGE(PG8_SB(0, 0), cB, voffB); PG8_STAGE(PG8_SA(0, 0), cA, voffA); PG8_STAGE(PG8_SB(0, 1), cB + hstep, voffB); PG8_STAGE(PG8_SA(0, 1), cA + hstep, voffA);
        if (wr == 1) PG8_BAR;
        PG8_WAIT_V(4); PG8_BAR;
        PG8_STAGE(PG8_SB(1, 0), cB + kstep, voffB); PG8_STAGE(PG8_SA(1, 0), cA + kstep, voffA); PG8_STAGE(PG8_SB(1, 1), cB + hstep + kstep, voffB);
        PG8_WAIT_V(6); PG8_BAR;
    }
    for (;;) {
        const bool has_next = S.next(ui + 1, nxt);
        const char* nA = has_next ? (const char*)g.A + (size_t)nxt.pm * tstep : cA; const char* nB = has_next ? (const char*)g.Bt + (size_t)nxt.pn * tstep : cB;
        for (int t = 0; t < nt; t += 2) {
            const bool last = (t == nt - 2);
            const char* a1 = cA + (size_t)(t + 1) * kstep;
            const char* a2 = last ? nA : cA + (size_t)(t + 2) * kstep; const char* b2 = last ? nB : cB + (size_t)(t + 2) * kstep;
            const char* a3 = a2 + kstep; const char* b3 = b2 + kstep;
            if (last && has_next) S.a_ready(nxt);
            if constexpr (SP2) {
            PG8_LDB(B0, 0, 0); PG8_LDB(B1, 0, 1); PG8_SCHED; PG8_LDA(At, 0, 0); PG8_STAGE(PG8_SA(1, 1), a1 + hstep, voffA);
            PG8_WAIT_V(8); PG8_WAIT_L(0); PG8_BAR; PG8_MMA(0, 0, At, B0); PG8_MMA(0, 1, At, B1); PG8_BAR; PG8_SCHED;
            PG8_LDA(At, 0, 1); PG8_STAGE(PG8_SB(0, 0), b2, voffB); PG8_STAGE(PG8_SB(0, 1), b2 + hstep, voffB); PG8_STAGE(PG8_SA(0, 0), a2, voffA);
            PG8_WAIT_V(8); PG8_WAIT_L(0); PG8_BAR; PG8_MMA(1, 0, At, B0); PG8_MMA(1, 1, At, B1); PG8_BAR; PG8_SCHED;
            PG8_LDB(B0, 1, 0); PG8_LDB(B1, 1, 1); PG8_SCHED; PG8_LDA(At, 1, 0); PG8_STAGE(PG8_SA(0, 1), a2 + hstep, voffA);
            PG8_WAIT_V(8); PG8_WAIT_L(0); PG8_BAR; PG8_MMA(0, 0, At, B0); PG8_MMA(0, 1, At, B1); PG8_BAR; PG8_SCHED;
            PG8_LDA(At, 1, 1); PG8_STAGE(PG8_SB(1, 0), b3, voffB); PG8_STAGE(PG8_SB(1, 1), b3 + hstep, voffB); PG8_STAGE(PG8_SA(1, 0), a3, voffA);
            PG8_WAIT_V(8); PG8_WAIT_L(0); PG8_BAR; PG8_MMA(1, 0, At, B0); PG8_MMA(1, 1, At, B1); PG8_BAR; PG8_SCHED;
            } else {
            PG8_LDB(B0, 0, 0); PG8_SCHED; PG8_LDA(At, 0, 0); PG8_STAGE(PG8_SA(1, 1), a1 + hstep, voffA);
            PG8_WAIT_L(8); PG8_BAR; PG8_WAIT_L(0); PG8_MMA(0, 0, At, B0); PG8_BAR; PG8_SCHED;
            PG8_LDB(B1, 0, 1); PG8_STAGE(PG8_SB(0, 0), b2, voffB);
            PG8_BAR; PG8_WAIT_L(0); PG8_MMA(0, 1, At, B1); PG8_BAR;
            PG8_LDA(At, 0, 1); PG8_STAGE(PG8_SA(0, 0), a2, voffA);
            PG8_BAR; PG8_WAIT_L(0); PG8_MMA(1, 0, At, B0); PG8_BAR; PG8_SCHED;
            PG8_STAGE(PG8_SB(0, 1), b2 + hstep, voffB);
            PG8_WAIT_V(6); PG8_BAR; PG8_MMA(1, 1, At, B1); PG8_BAR;
            PG8_LDB(B0, 1, 0); PG8_SCHED; PG8_LDA(At, 1, 0); PG8_STAGE(PG8_SA(0, 1), a2 + hstep, voffA);
            PG8_WAIT_L(8); PG8_BAR; PG8_WAIT_L(0); PG8_MMA(0, 0, At, B0); PG8_BAR; PG8_SCHED;
            PG8_LDB(B1, 1, 1); PG8_STAGE(PG8_SB(1, 0), b3, voffB);
            PG8_BAR; PG8_WAIT_L(0); PG8_MMA(0, 1, At, B1); PG8_BAR;
            PG8_LDA(At, 1, 1); PG8_STAGE(PG8_SA(1, 0), a3, voffA);
            PG8_BAR; PG8_WAIT_L(0); PG8_MMA(1, 0, At, B0); PG8_BAR; PG8_SCHED;
            PG8_STAGE(PG8_SB(1, 1), b3 + hstep, voffB);
            PG8_WAIT_V(6); PG8_BAR; PG8_MMA(1, 1, At, B1); PG8_BAR;
            }
        }
        if constexpr (ALIGN_EPI) { if (wr == 0) PG8_BAR; }
        if constexpr (!Epi::AFTER_DRAIN) { E(acc, cur, wr, wc, fr, fq); S.done(cur); }
        if (!has_next) break;
#pragma unroll
        for (int a = 0; a < 2; ++a)
#pragma unroll
            for (int b = 0; b < 2; ++b)
#pragma unroll
                for (int m = 0; m < 4; ++m)
#pragma unroll
                    for (int n = 0; n < 2; ++n) acc[a][b][m][n] = (f32x4){0.f, 0.f, 0.f, 0.f};
        cur = nxt; cA = nA; cB = nB; ++ui;
        if constexpr (ALIGN_EPI) { if (wr == 1) PG8_BAR; }
    }
    PG8_WAIT_V(0);
    if constexpr (!ALIGN_EPI) { if (wr == 0) PG8_BAR; }
    PG8_BAR;
    if constexpr (Epi::AFTER_DRAIN) { E.fused(acc, cur, wr, wc, fr, fq, lds, wid, lane); S.done(cur); }
#undef PG8_SA
#undef PG8_SB
#undef PG8_STAGE
#undef PG8_LDA
#undef PG8_LDB
#undef PG8_MMA
#undef PG8_WAIT_V
#undef PG8_WAIT_L
#undef PG8_BAR
#undef PG8_SCHED
}
}
constexpr int NWAVES = 8;
constexpr int MP = 16384, MS = 512, M = 16896, D = 1024, DFF = 2816, PLE = 256, SEQ = 4096, NB = 4, DB = 128, DSQ = 4;
constexpr int NBIN = 4352, NBIN_REAL = 4112, NCIN = 2816, NCIN_REAL = 2608;
constexpr int CMP_ROWS = 34816;
constexpr float ALPHA = 1.681792830507429f, LN_EPS = 1e-5f, NORM_EPS = 1e-6f;
constexpr size_t O_YP = 0, O_YS = 16777216, O_AV = 17301504, O_GSP = 19398656, O_GCP = 19922944, O_GSS = 19959808, O_GCS = 36737024,
                 O_KVP = 37916672, O_WINP = 54693888, O_KVS = 55742464, O_WINS = 56266752, O_END = 56528896;
constexpr size_t CTL_BYTES = 1u << 20;
constexpr size_t SZ_WUP = (size_t)5632 * 1024 * 2, SZ_WDN = (size_t)1024 * 2816 * 2, SZ_WG = (size_t)1024 * 1024 * 2, SZ_WP = (size_t)1024 * 256 * 2,
                 SZ_WAIN = (size_t)4096 * 1024 * 2, SZ_WAOUT = (size_t)1024 * 2048 * 2, SZ_WBIN = (size_t)NBIN * 1024 * 2, SZ_WCIN = (size_t)NCIN * 1024 * 2, SZ_WC1 = (size_t)256 * 2048 * 2;
constexpr size_t WS_WUP = CTL_BYTES, WS_WDN = WS_WUP + 8 * SZ_WUP, WS_WG = WS_WDN + 8 * SZ_WDN, WS_WP = WS_WG + 4 * SZ_WG, WS_WAIN = WS_WP + 4 * SZ_WP, WS_WAOUT = WS_WAIN + 2 * SZ_WAIN,
                 WS_WBIN = WS_WAOUT + 2 * SZ_WAOUT, WS_WBOUT = WS_WBIN + SZ_WBIN, WS_WCIN = WS_WBOUT + SZ_WG, WS_WCOUT = WS_WCIN + SZ_WCIN, WS_WC1 = WS_WCOUT + SZ_WG;
constexpr size_t WS_X = WS_WC1 + 2 * SZ_WC1;
constexpr size_t WS_XN = WS_X + (size_t)M * 1024 * 4;
constexpr size_t WS_XNB = WS_XN + (size_t)M * 1024 * 2;
constexpr size_t WS_PRE = WS_XNB + (size_t)M * 1024 * 2;
constexpr size_t WS_H = WS_PRE + (size_t)M * 1024 * 4;
constexpr size_t WS_PBF = WS_H + (size_t)M * 2816 * 2;
constexpr size_t WS_PP = WS_PBF + (size_t)4 * M * 256 * 2;
constexpr size_t WS_MIX = WS_PP + (size_t)4 * M * 1024 * 4;
constexpr size_t WA_U = WS_MIX, WA_V = WA_U + (size_t)M * 2048 * 2, WA_US = WA_V + (size_t)M * 2048 * 4, WA_ST = WA_US + (size_t)M * 2048 * 2, WA_END = WA_ST + (size_t)M * 8;
constexpr size_t GUNITS = 2048;
constexpr size_t WB_PROJ = WS_MIX, WB_W = WB_PROJ + (size_t)M * NBIN * 4, WB_U = WB_W + GUNITS * 64 * 128 * 4, WB_QG = WB_U + GUNITS * 64 * 128 * 4, WB_KD = WB_QG + GUNITS * 64 * 128 * 4,
                 WB_QK = WB_KD + GUNITS * 64 * 128 * 4, WB_EG = WB_QK + GUNITS * 64 * 64 * 4, WB_O = WB_EG + 65536, WB_OG = WB_O + (size_t)M * 1024 * 4, WB_END = WB_OG + (size_t)M * 1024 * 2;
constexpr size_t WC_PROJ = WS_MIX, WC_ACMP = WC_PROJ + (size_t)M * NCIN * 4, WC_HC = WC_ACMP + (size_t)2 * CMP_ROWS * 2048 * 2, WC_KCV = WC_HC + (size_t)2 * CMP_ROWS * 256 * 2,
                 WC_OA = WC_KCV + (size_t)2 * CMP_ROWS * 64 * 4, WC_END = WC_OA + (size_t)M * 1024 * 2;
constexpr size_t WS_END = (WB_END > WC_END ? (WB_END > WA_END ? WB_END : WA_END) : (WC_END > WA_END ? WC_END : WA_END));
static_assert(WS_X % 256 == 0 && WS_MIX % 256 == 0 && WB_W % 256 == 0 && WC_ACMP % 256 == 0, "alignment");
constexpr int CW_TMO = 0, CW_BAR = 4096;
constexpr int LDS_BYTES = 147456, MISC_OFF = LDS_BYTES - 512;

#define GAS __attribute__((address_space(1)))
#define LAS __attribute__((address_space(3)))
typedef unsigned short bf16;
typedef float f32x4 __attribute__((ext_vector_type(4)));
typedef float f32x2 __attribute__((ext_vector_type(2)));
typedef unsigned u32x2 __attribute__((ext_vector_type(2)));
typedef unsigned u32x4 __attribute__((ext_vector_type(4)));
#define LDS_WAIT() asm volatile("s_waitcnt lgkmcnt(0)" ::: "memory")
__device__ __forceinline__ unsigned f2bf(float f) { unsigned u = __builtin_bit_cast(unsigned, f); return (u + 0x7fffu + ((u >> 16) & 1u)) >> 16; }
__device__ __forceinline__ unsigned pk2(float lo, float hi) { return f2bf(lo) | (f2bf(hi) << 16); }
__device__ __forceinline__ float bf2f(bf16 b) { return __builtin_bit_cast(float, ((unsigned)b) << 16); }
__device__ __forceinline__ float wave_sum(float v) {
#pragma unroll
    for (int o = 1; o < 64; o <<= 1) v += __shfl_xor(v, o);
    return v;
}
__device__ __forceinline__ float wave_max(float v) {
#pragma unroll
    for (int o = 1; o < 64; o <<= 1) v = fmaxf(v, __shfl_xor(v, o));
    return v;
}
__device__ __forceinline__ float sigmoid_f(float x) { return 1.0f / (1.0f + __expf(-x)); }
__device__ __forceinline__ float siluf(float x) { return x * sigmoid_f(x); }
__device__ __forceinline__ float readlane_f(float v, int k) { return __builtin_bit_cast(float, __builtin_amdgcn_readlane(__builtin_bit_cast(int, v), k)); }
#define XB_TMO      128
#define XB_XCNT(j)  (256  + 64 * (j))
#define XB_XSUB(j)  (1280 + 64 * (j))
#define XB_XGEN(j)  (2304 + 64 * (j))
#define XB_TOP      3328
#define XB_TOPGEN   3392
#define XCD_BAR_WORDS 3456
#define XB_SPIN_CAP (1u << 18)

__device__ __forceinline__ unsigned xb_ld(unsigned* p)              { return __hip_atomic_load(p, __ATOMIC_RELAXED, __HIP_MEMORY_SCOPE_AGENT); }
__device__ __forceinline__ unsigned xb_add(unsigned* p, unsigned v) { return __hip_atomic_fetch_add(p, v, __ATOMIC_RELAXED, __HIP_MEMORY_SCOPE_AGENT); }
__device__ __forceinline__ unsigned xb_xcc_id() { return (unsigned)__builtin_amdgcn_s_getreg((3 << 11) | 20) & 0xFu; }
#define XB_SPIN(cond, bar) do { unsigned _sp = 0; while (cond) { __builtin_amdgcn_s_sleep(1); \
    if ((++_sp & 255u) == 0u) { if (xb_ld(&(bar)[XB_TMO])) break; if (_sp > XB_SPIN_CAP) { atomicAdd(&(bar)[XB_TMO], 1u); break; } } } } while (0)

struct XcdBarrier {
    unsigned* bar; unsigned x;
    volatile LAS unsigned* st;
};

__device__ __forceinline__ XcdBarrier xcd_barrier_post(unsigned* bar, volatile LAS unsigned* st) {
    XcdBarrier b; b.bar = bar; b.x = xb_xcc_id(); b.st = st;
    if (threadIdx.x == 0) (void)xb_add(&bar[XB_XCNT(b.x)], 1u);
    return b;
}
__device__ __forceinline__ void xcd_barrier_complete(unsigned* bar, unsigned x, unsigned& nloc, unsigned& nx) {
    const unsigned G = gridDim.x * gridDim.y * gridDim.z;
    unsigned sum, cnt, mine, sp = 0u;
    for (;;) {
        sum = 0u; cnt = 0u; mine = 0u;
#pragma unroll
        for (unsigned j = 0; j < 16; ++j) { const unsigned c = xb_ld(&bar[XB_XCNT(j)]); sum += c; cnt += (c > 0u) ? 1u : 0u; mine = (j == x) ? c : mine; }
        if (sum == G) break;
        __builtin_amdgcn_s_sleep(1);
        if ((++sp & 255u) == 0u) { if (xb_ld(&bar[XB_TMO])) break; if (sp > XB_SPIN_CAP) { atomicAdd(&bar[XB_TMO], 1u); break; } }
    }
    nloc = mine > 0u ? mine : 1u; nx = cnt > 0u ? cnt : 1u;
}

__device__ __forceinline__ void xcd_barrier(const XcdBarrier& b) {
    asm volatile("s_waitcnt vmcnt(0)" ::: "memory");
    __syncthreads();
    if (threadIdx.x == 0) {
        unsigned* bar = b.bar;
        __builtin_amdgcn_s_waitcnt(0);
        unsigned nloc = b.st[0], nx = b.st[1];
        if (nloc == 0u) { xcd_barrier_complete(bar, b.x, nloc, nx); b.st[0] = nloc; b.st[1] = nx; }
        const unsigned old = xb_add(&bar[XB_XSUB(b.x)], 1u);
        const unsigned gen = old / nloc;
        if (old + 1u == (gen + 1u) * nloc) {
            __builtin_amdgcn_fence(__ATOMIC_RELEASE, "agent");
            asm volatile("s_waitcnt vmcnt(0)" ::: "memory");
            const unsigned og = xb_add(&bar[XB_TOP], 1u);
            const unsigned tg = og / nx;
            if (og + 1u == (tg + 1u) * nx) xb_add(&bar[XB_TOPGEN], 1u);
            else XB_SPIN(xb_ld(&bar[XB_TOPGEN]) == tg, bar);
            __builtin_amdgcn_fence(__ATOMIC_ACQUIRE, "agent");
            xb_add(&bar[XB_XGEN(b.x)], 1u);
            asm volatile("s_waitcnt vmcnt(0)" ::: "memory");
        } else {
            XB_SPIN(xb_ld(&bar[XB_XGEN(b.x)]) == gen, bar);
            __builtin_amdgcn_fence(__ATOMIC_ACQUIRE, "agent");
            asm volatile("s_waitcnt vmcnt(0)" ::: "memory");
        }
    }
    __syncthreads();
}
enum { I_XP = 0, I_XS, I_GS, I_GCONV, I_CKV, I_CWIN, I_PT, I_PP, I_PS, I_LNG, I_LNB, I_WUP, I_WDN, I_WG, I_WPJ, I_AWIN, I_ALNG, I_ALNB, I_AWS, I_ABS, I_AWOUT,
       I_BWIN, I_BCONV, I_BALOG, I_BDT, I_BNG, I_BWOUT, I_CWIN_W, I_CGB, I_CPE, I_CW1, I_CW2, I_CWOUT, I_T5, N_IN };
struct Ctx {
    LAS unsigned char* lds; unsigned char* ws; float* out; const float* const* in;
    int tid, lane, wave, G, gw, NGW;
};
#define WSF(off) ((float*)(c.ws + (off)))
#define WSB(off) ((bf16*)(c.ws + (off)))

__device__ __forceinline__ void tr_item(const float* W, int K, int N, bf16* WT, int mode, LAS float* scr, int item, int lane) {
    const int nblk = (N + 31) >> 5, kb = item / nblk, nb = item - kb * nblk, k0 = 64 * kb, n0 = 32 * nb;
    const int nn = n0 + (lane & 31); const bool ok = nn < N;
#pragma unroll 8
    for (int i = 0; i < 32; ++i) { const int kk = 2 * i + (lane >> 5); scr[kk * 33 + (lane & 31)] = ok ? W[(size_t)(k0 + kk) * N + nn] : 0.f; }
    LDS_WAIT(); asm volatile("" ::: "memory");
    const int cch = lane & 7;
#pragma unroll
    for (int j = 0; j < 4; ++j) { const int nl = (lane >> 3) + 8 * j, n = n0 + nl; const LAS float* s = scr + (8 * cch) * 33 + nl;
        if (n < N) { u32x4 o; o.x = pk2(s[0 * 33], s[1 * 33]); o.y = pk2(s[2 * 33], s[3 * 33]); o.z = pk2(s[4 * 33], s[5 * 33]); o.w = pk2(s[6 * 33], s[7 * 33]);
            int drow = n; if (mode == 1) { const int half = n >= DFF ? 1 : 0, idx = n - half * DFF; drow = (idx >> 7) * 256 + half * 128 + (idx & 127); }
            *(u32x4*)(WT + (size_t)drow * K + k0 + 8 * cch) = o; } }
    LDS_WAIT(); asm volatile("" ::: "memory");
}
__device__ __forceinline__ void prologue_phase(const Ctx& c) {
    LAS float* scr = (LAS float*)(c.lds + c.wave * 16384);
    constexpr int IT_UP = 16 * 176, IT_DN = 44 * 32, IT_G = 16 * 32, IT_P = 4 * 32, IT_AIN = 16 * 128, IT_AOUT = 32 * 32, IT_BIN = 16 * 129, IT_CIN = 16 * 82, IT_C1 = 32 * 8;
    constexpr int NIT = 8 * IT_UP + 8 * IT_DN + 4 * IT_G + 4 * IT_P + 2 * IT_AIN + 2 * IT_AOUT + IT_BIN + IT_G + IT_CIN + IT_G + 2 * IT_C1;
    for (int it = c.gw; it < NIT; it += c.NGW) {
        int r = it, mi;
        if (r < 8 * IT_UP) { mi = r / IT_UP; tr_item(c.in[I_WUP] + (size_t)mi * 1024 * 5632, 1024, 5632, WSB(WS_WUP + mi * SZ_WUP), 1, scr, r - mi * IT_UP, c.lane); continue; } r -= 8 * IT_UP;
        if (r < 8 * IT_DN) { mi = r / IT_DN; tr_item(c.in[I_WDN] + (size_t)mi * 2816 * 1024, 2816, 1024, WSB(WS_WDN + mi * SZ_WDN), 0, scr, r - mi * IT_DN, c.lane); continue; } r -= 8 * IT_DN;
        if (r < 4 * IT_G) { mi = r / IT_G; tr_item(c.in[I_WG] + (size_t)mi * 1024 * 1024, 1024, 1024, WSB(WS_WG + mi * SZ_WG), 0, scr, r - mi * IT_G, c.lane); continue; } r -= 4 * IT_G;
        if (r < 4 * IT_P) { mi = r / IT_P; tr_item(c.in[I_WPJ] + (size_t)mi * 256 * 1024, 256, 1024, WSB(WS_WP + mi * SZ_WP), 0, scr, r - mi * IT_P, c.lane); continue; } r -= 4 * IT_P;
        if (r < 2 * IT_AIN) { mi = r / IT_AIN; tr_item(c.in[I_AWIN] + (size_t)mi * 1024 * 4096, 1024, 4096, WSB(WS_WAIN + mi * SZ_WAIN), 0, scr, r - mi * IT_AIN, c.lane); continue; } r -= 2 * IT_AIN;
        if (r < 2 * IT_AOUT) { mi = r / IT_AOUT; tr_item(c.in[I_AWOUT] + (size_t)mi * 2048 * 1024, 2048, 1024, WSB(WS_WAOUT + mi * SZ_WAOUT), 0, scr, r - mi * IT_AOUT, c.lane); continue; } r -= 2 * IT_AOUT;
        if (r < IT_BIN) { tr_item(c.in[I_BWIN], 1024, NBIN_REAL, WSB(WS_WBIN), 0, scr, r, c.lane); continue; } r -= IT_BIN;
        if (r < IT_G) { tr_item(c.in[I_BWOUT], 1024, 1024, WSB(WS_WBOUT), 0, scr, r, c.lane); continue; } r -= IT_G;
        if (r < IT_CIN) { tr_item(c.in[I_CWIN_W], 1024, NCIN_REAL, WSB(WS_WCIN), 0, scr, r, c.lane); continue; } r -= IT_CIN;
        if (r < IT_G) { tr_item(c.in[I_CWOUT], 1024, 1024, WSB(WS_WCOUT), 0, scr, r, c.lane); continue; } r -= IT_G;
        mi = r / IT_C1; tr_item(c.in[I_CW1] + (size_t)mi * 2048 * 256, 2048, 256, WSB(WS_WC1 + mi * SZ_WC1), 0, scr, r - mi * IT_C1, c.lane);
    }
    for (int r = c.gw; r < (NBIN - NBIN_REAL) + (NCIN - NCIN_REAL); r += c.NGW) {
        bf16* row = r < (NBIN - NBIN_REAL) ? WSB(WS_WBIN) + (size_t)(NBIN_REAL + r) * 1024 : WSB(WS_WCIN) + (size_t)(NCIN_REAL + r - (NBIN - NBIN_REAL)) * 1024;
        const u32x4 z = {0u, 0u, 0u, 0u}; *(u32x4*)(row + c.lane * 8) = z; *(u32x4*)(row + 512 + c.lane * 8) = z; }
    for (int row = c.gw; row < M; row += c.NGW) {
        const float* src = row < MP ? c.in[I_XP] + (size_t)row * 1024 : c.in[I_XS] + (size_t)(row - MP) * 1024;
        float* xd = WSF(WS_X) + (size_t)row * 1024; bf16* xn = WSB(WS_XNB) + (size_t)row * 1024;
#pragma unroll
        for (int j = 0; j < 4; ++j) { const f32x4 v = *((const f32x4*)src + c.lane + 64 * j); *((f32x4*)xd + c.lane + 64 * j) = v; u32x2 w; w.x = pk2(v.x, v.y); w.y = pk2(v.z, v.w); *((u32x2*)xn + c.lane + 64 * j) = w; }
    }
    for (int r = c.gw; r < 4 * M; r += c.NGW) {
        const int l = r / M, row = r - l * M;
        const float* src = row < MP ? c.in[I_PP] + ((size_t)l * MP + row) * 256 : c.in[I_PS] + ((size_t)l * MS + (row - MP)) * 256;
        const f32x4 v = *((const f32x4*)src + c.lane); u32x2 w; w.x = pk2(v.x, v.y); w.y = pk2(v.z, v.w); *((u32x2*)(WSB(WS_PBF) + (size_t)r * 256) + c.lane) = w;
    }
}
__device__ __forceinline__ void ln_phase(const Ctx& c, const float* g, const float* b) {
    f32x4 gv[4], bv[4];
#pragma unroll
    for (int j = 0; j < 4; ++j) { gv[j] = *((const f32x4*)g + c.lane + 64 * j); bv[j] = *((const f32x4*)b + c.lane + 64 * j); }
    for (int row = c.gw; row < M; row += c.NGW) {
        const f32x4* p = (const f32x4*)(WSF(WS_PRE) + (size_t)row * 1024) + c.lane;
        f32x4 v[4]; float s = 0.f;
#pragma unroll
        for (int j = 0; j < 4; ++j) { v[j] = p[64 * j]; s += (v[j].x + v[j].y) + (v[j].z + v[j].w); }
        const float mean = wave_sum(s) * (1.f / 1024.f); float s2 = 0.f;
#pragma unroll
        for (int j = 0; j < 4; ++j) { v[j] = v[j] - mean; s2 += (v[j].x * v[j].x + v[j].y * v[j].y) + (v[j].z * v[j].z + v[j].w * v[j].w); }
        const float rstd = 1.f / sqrtf(wave_sum(s2) * (1.f / 1024.f) + LN_EPS);
        float* xd = WSF(WS_X) + (size_t)row * 1024; bf16* xn = WSB(WS_XN) + (size_t)row * 1024;
#pragma unroll
        for (int j = 0; j < 4; ++j) { const f32x4 y = v[j] * rstd * gv[j] + bv[j]; *((f32x4*)xd + c.lane + 64 * j) = y; u32x2 w; w.x = pk2(y.x, y.y); w.y = pk2(y.z, y.w); *((u32x2*)xn + c.lane + 64 * j) = w; }
    }
}
__device__ __forceinline__ void a_stats_phase(const Ctx& c, int ia) {
    const float* lg = c.in[I_ALNG] + ia * 2048; const float* lb = c.in[I_ALNB] + ia * 2048;
    for (int row = c.gw; row < M; row += c.NGW) {
        const f32x4* p = (const f32x4*)(WSF(WA_V) + (size_t)row * 2048) + c.lane;
        f32x4 v[8]; float s = 0.f;
#pragma unroll
        for (int j = 0; j < 8; ++j) { v[j] = p[64 * j]; s += (v[j].x + v[j].y) + (v[j].z + v[j].w); }
        const float mean = wave_sum(s) * (1.f / 2048.f); float s2 = 0.f;
#pragma unroll
        for (int j = 0; j < 8; ++j) { v[j] = v[j] - mean; s2 += (v[j].x * v[j].x + v[j].y * v[j].y) + (v[j].z * v[j].z + v[j].w * v[j].w); }
        const float rstd = 1.f / sqrtf(wave_sum(s2) * (1.f / 2048.f) + LN_EPS);
        if (c.lane == 0) { WSF(WA_ST)[2 * row] = mean; WSF(WA_ST)[2 * row + 1] = rstd; }
        if (row >= MP) { float* o = c.out + O_AV + ((size_t)ia * MS + (row - MP)) * 2048;
#pragma unroll
            for (int j = 0; j < 8; ++j) { const f32x4 gg = *((const f32x4*)lg + c.lane + 64 * j), bb = *((const f32x4*)lb + c.lane + 64 * j); *((f32x4*)o + c.lane + 64 * j) = v[j] * rstd * gg + bb; } }
    }
}
__device__ __forceinline__ void a_sgu_phase(const Ctx& c, int ia) {
    LAS float* vn = (LAS float*)c.lds;
    LAS float* wT = vn + 128 * 128;
    const float* ws = c.in[I_AWS] + (size_t)ia * 16 * 128 * 128; const float* bs = c.in[I_ABS] + ia * 16 * 128;
    const float* lg = c.in[I_ALNG] + ia * 2048; const float* lb = c.in[I_ALNB] + ia * 2048;
    const float* V = WSF(WA_V); const float* ST = WSF(WA_ST); const bf16* U = WSB(WA_U); bf16* US = WSB(WA_US);
    for (int unit = blockIdx.x; unit < 2048 + DB; unit += c.G) {
        if (unit < 2048) {
            const int g = unit & 15, n = (unit >> 4) & 31, b = unit >> 9, rowbase = b * SEQ + n * 128;
            __syncthreads();
            for (int idx = c.tid; idx < 4096; idx += 512) { const int s = idx >> 5, c4 = idx & 31, row = rowbase + s;
                const f32x4 v = *(const f32x4*)(V + (size_t)row * 2048 + g * 128 + c4 * 4); const float mean = ST[2 * row], rstd = ST[2 * row + 1];
                const f32x4 gg = *(const f32x4*)(lg + g * 128 + c4 * 4), bb = *(const f32x4*)(lb + g * 128 + c4 * 4);
                *(LAS f32x4*)(vn + s * 128 + c4 * 4) = (v - mean) * rstd * gg + bb; }
            for (int idx = c.tid; idx < 4096; idx += 512) { const int t = idx >> 5, s4 = idx & 31; const f32x4 w = *(const f32x4*)(ws + ((size_t)g * 128 + t) * 128 + s4 * 4); const int pt = (t & 3) * 32 + (t >> 2);
#pragma unroll
                for (int k = 0; k < 4; ++k) { const int s = 4 * s4 + k; wT[s * 128 + pt] = (s <= t) ? w[k] : 0.f; } }
            __syncthreads();
            const int d = c.tid & 127, tq = c.tid >> 7;
            float acc[32];
#pragma unroll
            for (int i = 0; i < 32; ++i) acc[i] = 0.f;
            for (int s = 0; s < 128; ++s) { const float v = vn[s * 128 + d];
#pragma unroll
                for (int i4 = 0; i4 < 8; ++i4) { const f32x4 w4 = *(const LAS f32x4*)(wT + s * 128 + tq * 32 + 4 * i4);
                    acc[4 * i4 + 0] += w4.x * v; acc[4 * i4 + 1] += w4.y * v; acc[4 * i4 + 2] += w4.z * v; acc[4 * i4 + 3] += w4.w * v; } }
#pragma unroll
            for (int i = 0; i < 32; ++i) { const int t = tq + 4 * i; const size_t o = (size_t)(rowbase + t) * 2048 + g * 128 + d;
                US[o] = (bf16)f2bf((acc[i] + bs[g * 128 + t]) * bf2f(U[o])); }
        } else {
            const int sb = unit - 2048, c0 = c.tid * 4, g = c0 >> 7;
            const f32x4 gg = *(const f32x4*)(lg + c0), bb = *(const f32x4*)(lb + c0);
            f32x4 vnr[4];
#pragma unroll
            for (int t = 0; t < 4; ++t) { const int row = MP + 4 * sb + t; const f32x4 v = *(const f32x4*)(V + (size_t)row * 2048 + c0); vnr[t] = (v - ST[2 * row]) * ST[2 * row + 1] * gg + bb; }
#pragma unroll
            for (int t = 0; t < 4; ++t) { const int row = MP + 4 * sb + t; f32x4 sv = {0.f, 0.f, 0.f, 0.f};
#pragma unroll
                for (int s = 0; s <= t; ++s) sv += vnr[s] * ws[((size_t)g * 128 + t) * 128 + s];
                sv += bs[g * 128 + t];
                const u32x2 uu = *(const u32x2*)(U + (size_t)row * 2048 + c0);
                f32x4 y; y.x = sv.x * bf2f((bf16)(uu.x & 0xffff)); y.y = sv.y * bf2f((bf16)(uu.x >> 16)); y.z = sv.z * bf2f((bf16)(uu.y & 0xffff)); y.w = sv.w * bf2f((bf16)(uu.y >> 16));
                u32x2 w; w.x = pk2(y.x, y.y); w.y = pk2(y.z, y.w); *(u32x2*)(US + (size_t)row * 2048 + c0) = w; }
        }
    }
}
__device__ __forceinline__ void gdn_prep_phase(const Ctx& c) {
    const float* PJ = WSF(WB_PROJ); const float* cw = c.in[I_BCONV]; const float* alog = c.in[I_BALOG]; const float* dtb = c.in[I_BDT];
    float* GW = WSF(WB_W); float* GU = WSF(WB_U); float* GQG = WSF(WB_QG); float* GKD = WSF(WB_KD); float* GQK = WSF(WB_QK); float* GEG = WSF(WB_EG);
    for (int unit = blockIdx.x; unit < 2048 + 1024; unit += c.G) {
        __syncthreads();
        LAS float* lb = (LAS float*)c.lds; asm volatile("" : "+v"(lb));
        LAS float* qf = lb; LAS float* kf = qf + 64 * 129; LAS float* vf = kf + 64 * 129; LAS float* Am = vf + 64 * 129; LAS float* gc = Am + 64 * 65; LAS float* bt = gc + 64;
        if (unit < 2048) {
            const int ci = unit & 63, h = (unit >> 6) & 7, b = unit >> 9, rb = b * SEQ + ci * 64;
            if (c.tid < 64) { const size_t row = rb + c.tid; const float bl = PJ[row * NBIN + 4096 + h], al = PJ[row * NBIN + 4104 + h];
                const float x = al + dtb[h]; const float sp = x > 20.f ? x : log1pf(expf(x)); float g = -expf(alog[h]) * sp;
#pragma unroll
                for (int o = 1; o < 64; o <<= 1) { const float t = __shfl_up(g, o); if (c.lane >= o) g += t; }
                gc[c.tid] = g; bt[c.tid] = sigmoid_f(bl); }
#pragma unroll 1
            for (int i = 0; i < 8; ++i) { const int tk = c.wave * 8 + i, tabs = ci * 64 + tk; const size_t row = rb + tk;
#pragma unroll
                for (int part = 0; part < 3; ++part) { const int ch = part * 1024 + h * 128 + 2 * c.lane; float a0 = 0.f, a1 = 0.f;
#pragma unroll
                    for (int j = 0; j < 4; ++j) { if (tabs - 3 + j >= 0) { const f32x2 x = *(const f32x2*)(PJ + (row - 3 + j) * NBIN + ch); const f32x2 w = *(const f32x2*)(cw + j * 3072 + ch); a0 += x.x * w.x; a1 += x.y * w.y; } }
                    a0 = siluf(a0); a1 = siluf(a1);
                    if (part < 2) { const float ss = wave_sum(a0 * a0 + a1 * a1); const float sc = (1.f / sqrtf(ss + NORM_EPS)) * (part == 0 ? 0.08838834764831845f : 1.f); a0 *= sc; a1 *= sc; }
                    LAS float* dst = (part == 0 ? qf : (part == 1 ? kf : vf)) + tk * 129 + 2 * c.lane; dst[0] = a0; dst[1] = a1; } }
            __syncthreads();
            { const int j = c.lane, ig = c.wave; float kk[8], qk[8];
#pragma unroll
              for (int ii = 0; ii < 8; ++ii) { kk[ii] = 0.f; qk[ii] = 0.f; }
              for (int d = 0; d < 128; ++d) { const float kj = kf[j * 129 + d];
#pragma unroll
                  for (int ii = 0; ii < 8; ++ii) { kk[ii] += kf[(ig * 8 + ii) * 129 + d] * kj; qk[ii] += qf[(ig * 8 + ii) * 129 + d] * kj; } }
#pragma unroll
              for (int ii = 0; ii < 8; ++ii) { const int i = ig * 8 + ii; const float dec = (i >= j) ? expf(gc[i] - gc[j]) : 0.f;
                  Am[i * 65 + j] = (i > j) ? bt[i] * kk[ii] * dec : 0.f; GQK[((size_t)unit * 64 + i) * 64 + j] = (i >= j) ? qk[ii] * dec : 0.f; } }
            __syncthreads();
            if (c.tid < 256) { const bool isw = c.tid >= 128; const int cc = c.tid & 127; float x[64]; float* dst = (isw ? GW : GU) + (size_t)unit * 64 * 128 + cc;
#pragma unroll
                for (int i = 0; i < 64; ++i) { float r = isw ? kf[i * 129 + cc] * bt[i] * expf(gc[i]) : vf[i * 129 + cc] * bt[i];
#pragma unroll
                    for (int j = 0; j < i; ++j) r -= Am[i * 65 + j] * x[j];
                    x[i] = r; dst[i * 128] = r; } }
            for (int idx = c.tid; idx < 64 * 128; idx += 512) { const int cc = idx >> 7, dk = idx & 127;
                GQG[(size_t)unit * 8192 + idx] = qf[cc * 129 + dk] * expf(gc[cc]); GKD[(size_t)unit * 8192 + idx] = kf[cc * 129 + dk] * expf(gc[63] - gc[cc]); }
            if (c.tid == 0) GEG[unit] = expf(gc[63]);
        } else {
            const int su = unit - 2048, h = su & 7, b = su >> 3;
            LAS float* q4 = lb; LAS float* k4 = q4 + 512; LAS float* v4 = k4 + 512; LAS float* red = v4 + 512; LAS float* o4 = red + 512; LAS float* g4 = o4 + 512; LAS float* b4 = g4 + 4;
            const float* cst = c.in[I_GCONV] + (size_t)b * 3 * 3072;
            { const int t = c.tid >> 7, chl = c.tid & 127;
#pragma unroll
              for (int part = 0; part < 3; ++part) { const int ch = part * 1024 + h * 128 + chl; float a = 0.f;
#pragma unroll
                  for (int j = 0; j < 4; ++j) { const int mm = t + j; const float x = mm < 3 ? cst[mm * 3072 + ch] : PJ[(size_t)(MP + 4 * b + mm - 3) * NBIN + ch]; a += x * cw[j * 3072 + ch]; }
                  (part == 0 ? q4 : (part == 1 ? k4 : v4))[t * 128 + chl] = siluf(a); }
              if (c.tid < 4) { const size_t row = MP + 4 * b + c.tid; const float bl = PJ[row * NBIN + 4096 + h], al = PJ[row * NBIN + 4104 + h];
                  const float x = al + dtb[h]; const float sp = x > 20.f ? x : log1pf(expf(x)); g4[c.tid] = -expf(alog[h]) * sp; b4[c.tid] = sigmoid_f(bl); } }
            __syncthreads();
            { const int t = c.tid >> 7, chl = c.tid & 127; float sq = 0.f, sk = 0.f;
              for (int d = 0; d < 128; ++d) { const float a = q4[t * 128 + d], bb = k4[t * 128 + d]; sq += a * a; sk += bb * bb; }
              const float qv = q4[t * 128 + chl] * (1.f / sqrtf(sq + NORM_EPS)) * 0.08838834764831845f, kv = k4[t * 128 + chl] * (1.f / sqrtf(sk + NORM_EPS));
              __syncthreads();
              q4[t * 128 + chl] = qv; k4[t * 128 + chl] = kv; }
            __syncthreads();
            const int dv = c.tid & 127, part = c.tid >> 7;
            float S[32];
            const float* S0 = c.in[I_GS] + (((size_t)b * 8 + h) * 128 + part * 32) * 128 + dv;
#pragma unroll
            for (int i = 0; i < 32; ++i) S[i] = S0[(size_t)i * 128];
#pragma unroll 1
            for (int t = 0; t < 4; ++t) { const float a = expf(g4[t]); float p = 0.f;
#pragma unroll
                for (int i = 0; i < 32; ++i) p += k4[t * 128 + part * 32 + i] * S[i];
                red[part * 128 + dv] = p; __syncthreads();
                const float kS = (red[dv] + red[128 + dv]) + (red[256 + dv] + red[384 + dv]); const float vnew = b4[t] * (v4[t * 128 + dv] - a * kS); float po = 0.f;
#pragma unroll
                for (int i = 0; i < 32; ++i) { S[i] = a * S[i] + k4[t * 128 + part * 32 + i] * vnew; po += q4[t * 128 + part * 32 + i] * S[i]; }
                __syncthreads(); red[part * 128 + dv] = po; __syncthreads();
                if (part == 0) o4[t * 128 + dv] = (red[dv] + red[128 + dv]) + (red[256 + dv] + red[384 + dv]);
                __syncthreads(); }
            float* So = c.out + O_GSS + (((size_t)b * 8 + h) * 128 + part * 32) * 128 + dv;
#pragma unroll
            for (int i = 0; i < 32; ++i) So[(size_t)i * 128] = S[i];
            { const int t = c.tid >> 7; float ms = 0.f;
              for (int d = 0; d < 128; ++d) { const float o = o4[t * 128 + d]; ms += o * o; }
              const size_t row = MP + 4 * b + t; const float z = PJ[row * NBIN + 3072 + h * 128 + dv];
              const float y = o4[t * 128 + dv] * (1.f / sqrtf(ms * (1.f / 128.f) + NORM_EPS)) * c.in[I_BNG][dv] * siluf(z);
              WSB(WB_OG)[row * 1024 + h * 128 + dv] = (bf16)f2bf(y); }
        }
    }
    for (size_t idx = (size_t)blockIdx.x * 512 + c.tid; idx < 36864 + 1179648; idx += (size_t)c.G * 512) {
        if (idx < 36864) { const int b = (int)(idx / 9216), r = (int)(idx % 9216), j = r / 3072, ch = r % 3072; c.out[O_GCP + idx] = PJ[((size_t)b * SEQ + SEQ - 3 + j) * NBIN + ch]; }
        else { const size_t k = idx - 36864; const int b = (int)(k / 9216), r = (int)(k % 9216), j = r / 3072, ch = r % 3072; c.out[O_GCS + k] = PJ[((size_t)MP + 4 * b + 1 + j) * NBIN + ch]; }
    }
}
__device__ __forceinline__ void gdn_scan_phase(const Ctx& c) {
    LAS float* Wl = (LAS float*)c.lds; LAS float* Ql = Wl + 64 * 132; LAS float* Kl = Ql + 64 * 132; LAS float* QKl = Kl + 64 * 128; LAS float* Sl = QKl + 64 * 65; LAS float* VN = Sl + 128 * 16; LAS float* Ul = VN + 64 * 16;
    const float* GW = WSF(WB_W); const float* GU = WSF(WB_U); const float* GQG = WSF(WB_QG); const float* GKD = WSF(WB_KD); const float* GQK = WSF(WB_QK); const float* GEG = WSF(WB_EG);
    float* GO = WSF(WB_O);
    for (int unit = blockIdx.x; unit < 256; unit += c.G) {
        const int dvs = unit & 7, h = (unit >> 3) & 7, b = unit >> 6;
        const int dv = c.tid & 15, cg = c.tid >> 4;
        __syncthreads();
        for (int i = c.tid; i < 128 * 16; i += 512) Sl[i] = 0.f;
        for (int ci = 0; ci < 64; ++ci) {
            const size_t pu = ((size_t)b * 8 + h) * 64 + ci;
            __syncthreads();
#pragma unroll
            for (int k = 0; k < 4; ++k) { const int idx = c.tid + 512 * k, r = idx >> 5, c4 = idx & 31;
                *(LAS f32x4*)(Wl + r * 132 + 4 * c4) = *(const f32x4*)(GW + pu * 8192 + idx * 4); *(LAS f32x4*)(Ql + r * 132 + 4 * c4) = *(const f32x4*)(GQG + pu * 8192 + idx * 4);
                *(LAS f32x4*)(Kl + r * 128 + 4 * c4) = *(const f32x4*)(GKD + pu * 8192 + idx * 4); }
#pragma unroll
            for (int k = 0; k < 8; ++k) { const int idx = c.tid + 512 * k, r = idx >> 6, j = idx & 63; QKl[r * 65 + j] = GQK[pu * 4096 + idx]; }
#pragma unroll
            for (int k = 0; k < 2; ++k) { const int idx = c.tid + 512 * k, r = idx >> 4, j = idx & 15; Ul[r * 16 + j] = GU[pu * 8192 + r * 128 + dvs * 16 + j]; }
            const float eg = GEG[pu];
            __syncthreads();
            float qs[2];
#pragma unroll
            for (int e = 0; e < 2; ++e) { const int cc = cg + 32 * e; float ws = 0.f, q = 0.f;
                for (int dk = 0; dk < 128; ++dk) { const float s = Sl[dk * 16 + dv]; ws += Wl[cc * 132 + dk] * s; q += Ql[cc * 132 + dk] * s; }
                VN[cc * 16 + dv] = Ul[cc * 16 + dv] - ws; qs[e] = q; }
            __syncthreads();
#pragma unroll
            for (int e = 0; e < 2; ++e) { const int cc = cg + 32 * e; float o = qs[e];
                for (int j = 0; j <= cc; ++j) o += QKl[cc * 65 + j] * VN[j * 16 + dv];
                GO[((size_t)b * SEQ + ci * 64 + cc) * 1024 + h * 128 + dvs * 16 + dv] = o; }
#pragma unroll
            for (int e = 0; e < 4; ++e) { const int dk = cg + 32 * e; float s = Sl[dk * 16 + dv] * eg;
                for (int c2 = 0; c2 < 64; ++c2) s += Kl[c2 * 128 + dk] * VN[c2 * 16 + dv];
                Sl[dk * 16 + dv] = s; }
        }
        __syncthreads();
        for (int i = c.tid; i < 128 * 16; i += 512) { const int dk = i >> 4, j = i & 15; c.out[O_GSP + (((size_t)b * 8 + h) * 128 + dk) * 128 + dvs * 16 + j] = Sl[i]; }
    }
}
__device__ __forceinline__ void gdn_post_phase(const Ctx& c) {
    const float* GO = WSF(WB_O); const float* PJ = WSF(WB_PROJ); const float* ng = c.in[I_BNG];
    for (int row = c.gw; row < MP; row += c.NGW) {
        const f32x4* p = (const f32x4*)(GO + (size_t)row * 1024 + c.lane * 16); f32x4 v[4]; float s = 0.f;
#pragma unroll
        for (int j = 0; j < 4; ++j) { v[j] = p[j]; s += (v[j].x * v[j].x + v[j].y * v[j].y) + (v[j].z * v[j].z + v[j].w * v[j].w); }
        s += __shfl_xor(s, 1); s += __shfl_xor(s, 2); s += __shfl_xor(s, 4);
        const float r = 1.f / sqrtf(s * (1.f / 128.f) + NORM_EPS);
        const f32x4* zp = (const f32x4*)(PJ + (size_t)row * NBIN + 3072 + c.lane * 16); const f32x4* gp = (const f32x4*)(ng + (c.lane & 7) * 16);
        u32x2* op = (u32x2*)(WSB(WB_OG) + (size_t)row * 1024 + c.lane * 16);
#pragma unroll
        for (int j = 0; j < 4; ++j) { const f32x4 z = zp[j], g = gp[j]; f32x4 y; y.x = v[j].x * r * g.x * siluf(z.x); y.y = v[j].y * r * g.y * siluf(z.y); y.z = v[j].z * r * g.z * siluf(z.z); y.w = v[j].w * r * g.w * siluf(z.w);
            u32x2 w; w.x = pk2(y.x, y.y); w.y = pk2(y.z, y.w); op[j] = w; }
    }
}
__device__ const unsigned char T5_LUT[128] = {0, 1, 2, 3, 4, 5, 6, 7, 8, 9, 10, 11, 12, 13, 14, 15, 16, 16, 16, 17, 17, 18, 18, 18, 19, 19, 19, 20, 20, 20, 20, 21, 21, 21, 21, 22, 22, 22, 22, 22, 23, 23, 23, 23, 23, 23, 24, 24, 24, 24, 24, 24, 25, 25, 25, 25, 25, 25, 25, 26, 26, 26, 26, 26, 26, 26, 26, 27, 27, 27, 27, 27, 27, 27, 27, 27, 27, 28, 28, 28, 28, 28, 28, 28, 28, 28, 28, 29, 29, 29, 29, 29, 29, 29, 29, 29, 29, 29, 29, 30, 30, 30, 30, 30, 30, 30, 30, 30, 30, 30, 30, 30, 30, 31, 31, 31, 31, 31, 31, 31, 31, 31, 31, 31, 31, 31, 31, 31};
__device__ __forceinline__ void nsa_prep_phase(const Ctx& c) {
    const float* PJ = WSF(WC_PROJ);
    for (size_t i4 = (size_t)blockIdx.x * 512 + c.tid; i4 < (size_t)M * 256; i4 += (size_t)c.G * 512) { const size_t row = i4 >> 8; const int c4 = (int)(i4 & 255);
        const f32x4 v = *(const f32x4*)(PJ + row * NCIN + 1024 + c4 * 4);
        if (row < MP) *(f32x4*)(c.out + O_KVP + row * 1024 + c4 * 4) = v; else *(f32x4*)(c.out + O_KVS + (row - MP) * 1024 + c4 * 4) = v; }
    for (size_t i4 = (size_t)blockIdx.x * 512 + c.tid; i4 < (size_t)(2048 + MS) * 128; i4 += (size_t)c.G * 512) { const size_t r = i4 >> 7; const int c4 = (int)(i4 & 127);
        const size_t row = r < 2048 ? (r >> 9) * SEQ + (SEQ - 512) + (r & 511) : MP + (r - 2048);
        const f32x4 v = *(const f32x4*)(PJ + row * NCIN + 2048 + c4 * 4);
        if (r < 2048) *(f32x4*)(c.out + O_WINP + r * 512 + c4 * 4) = v; else *(f32x4*)(c.out + O_WINS + (r - 2048) * 512 + c4 * 4) = v; }
    bf16* AC = WSB(WC_ACMP); const float* pe = c.in[I_CPE]; const int* pt = (const int*)c.in[I_PT]; const float* ckv = c.in[I_CKV];
    for (int R = c.gw; R < 2 * CMP_ROWS; R += c.NGW) {
        const int which = R >= CMP_ROWS ? 1 : 0, r = R - which * CMP_ROWS;
        const float* src; size_t lstride;
        if (r < 2048) { const int g = r & 3, n = (r >> 2) & 127, b = r >> 9; src = PJ + ((size_t)b * SEQ + 32 * n) * NCIN + 1024 + which * 256 + g * 64; lstride = NCIN; }
        else { const int q = r - 2048, g = q & 3, n = (q >> 2) & 63, b = q >> 8; const int page = pt[b * 16 + (n >> 2)];
            src = ckv + (((size_t)page * 128 + (n & 3) * 32) * 16 + which * 4 + g) * 64; lstride = 1024; }
#pragma unroll
        for (int k = 0; k < 8; ++k) { const int idx = c.lane + 64 * k, l = idx >> 4, d4 = idx & 15;
            const f32x4 v = *(const f32x4*)(src + (size_t)l * lstride + d4 * 4) + *(const f32x4*)(pe + (which * 32 + l) * 64 + d4 * 4);
            u32x2 w; w.x = pk2(v.x, v.y); w.y = pk2(v.z, v.w); *(u32x2*)(AC + (size_t)R * 2048 + l * 64 + d4 * 4) = w; }
    }
}
__device__ __forceinline__ void nsa_cmp2_phase(const Ctx& c) {
    LAS float* w2 = (LAS float*)c.lds;
    __syncthreads();
    for (int i = c.tid; i < 2 * 256 * 64 / 4; i += 512) *(LAS f32x4*)(w2 + 4 * i) = *((const f32x4*)c.in[I_CW2] + i);
    __syncthreads();
    const bf16* HC = WSB(WC_HC); float* KCV = WSF(WC_KCV);
    for (int R = c.gw; R < 2 * CMP_ROWS; R += c.NGW) {
        const LAS float* w = w2 + (R >= CMP_ROWS ? 256 * 64 : 0) + c.lane; const u32x4* hp = (const u32x4*)(HC + (size_t)R * 256); float a = 0.f;
#pragma unroll 4
        for (int k8 = 0; k8 < 32; ++k8) { const u32x4 hv = hp[k8]; const unsigned hw[4] = {hv.x, hv.y, hv.z, hv.w};
#pragma unroll
            for (int j = 0; j < 4; ++j) { a += bf2f((bf16)(hw[j] & 0xffff)) * w[(8 * k8 + 2 * j) * 64]; a += bf2f((bf16)(hw[j] >> 16)) * w[(8 * k8 + 2 * j + 1) * 64]; } }
        KCV[(size_t)R * 64 + c.lane] = a;
    }
}
struct AttSt { float m[4], l[4]; f32x4 o[4]; };
__device__ __forceinline__ void att_reset(AttSt& s) {
#pragma unroll
    for (int h = 0; h < 4; ++h) { s.m[h] = -1e30f; s.l[h] = 0.f; s.o[h] = (f32x4){0.f, 0.f, 0.f, 0.f}; } }
__device__ __forceinline__ void att_scores(const LAS float* qs, const LAS float* tabl, const float* kptr, bool valid, int dist, int g, float (&s)[4]) {
    const f32x4* kp = (const f32x4*)kptr;
    s[0] = s[1] = s[2] = s[3] = 0.f;
#pragma unroll 1
    for (int c4 = 0; c4 < 4; ++c4) {
        f32x4 kv[4];
#pragma unroll
        for (int u = 0; u < 4; ++u) kv[u] = kp[c4 * 4 + u];
#pragma unroll
        for (int u = 0; u < 4; ++u)
#pragma unroll
            for (int h = 0; h < 4; ++h) { const f32x4 q = *(const LAS f32x4*)(qs + h * 64 + (c4 * 4 + u) * 4); s[h] += (q.x * kv[u].x + q.y * kv[u].y) + (q.z * kv[u].z + q.w * kv[u].w); } }
    const int dd = dist < 0 ? 0 : dist; const int bk = dd < 128 ? (int)T5_LUT[dd] : 31;
    const f32x4 bias = *(const LAS f32x4*)(tabl + bk * 16 + g * 4);
#pragma unroll
    for (int h = 0; h < 4; ++h) s[h] = valid ? s[h] + bias[h] : -1e30f;
}
__device__ __forceinline__ void att_pv(AttSt& st, LAS f32x4* P, LAS unsigned long long* R, const float (&p)[4], const float* rowp, int voff, int lane) {
    P[lane] = (f32x4){p[0], p[1], p[2], p[3]}; R[lane] = (unsigned long long)rowp;
    LDS_WAIT();
#pragma unroll 8
    for (int i = 0; i < 16; ++i) { const int key = 4 * i + (lane >> 4); const f32x4 p4 = P[key]; const float* rp = (const float*)R[key];
        const f32x4 v = *(const f32x4*)(rp + voff + (lane & 15) * 4);
        st.o[0] += v * p4.x; st.o[1] += v * p4.y; st.o[2] += v * p4.z; st.o[3] += v * p4.w; }
    LDS_WAIT();
}
__device__ __forceinline__ void att_block(AttSt& st, const LAS float* qs, const LAS float* tabl, LAS f32x4* P, LAS unsigned long long* R, const float* kptr, const float* safe, bool valid, int dist, int voff, int g, int lane) {
    const float* rowp = valid ? kptr : safe; float s[4], p[4];
    att_scores(qs, tabl, rowp, valid, dist, g, s);
#pragma unroll
    for (int h = 0; h < 4; ++h) { const float mx = wave_max(s[h]), mn = fmaxf(st.m[h], mx), sc = __expf(st.m[h] - mn); p[h] = valid ? __expf(s[h] - mn) : 0.f;
        st.l[h] = st.l[h] * sc + wave_sum(p[h]); st.o[h] *= sc; st.m[h] = mn; }
    att_pv(st, P, R, p, rowp, voff, lane);
}
__device__ __forceinline__ void att_finish(AttSt& st, const float (&gate)[4], f32x4 (&acc)[4]) {
#pragma unroll
    for (int h = 0; h < 4; ++h) { f32x4 o = st.o[h];
#pragma unroll
        for (int k = 0; k < 4; ++k) { o[k] += __shfl_xor(o[k], 16); o[k] += __shfl_xor(o[k], 32); }
        const float inv = st.l[h] > 0.f ? gate[h] / st.l[h] : 0.f; acc[h] += o * inv; }
}
__device__ __forceinline__ void nsa_attn_phase(const Ctx& c) {
    LAS float* tabl = (LAS float*)c.lds;
    LAS float* qs = tabl + 512 + c.wave * 768;
    LAS f32x4* P = (LAS f32x4*)(qs + 256); LAS unsigned long long* R = (LAS unsigned long long*)(qs + 512); LAS float* pcs = qs + 640;
    __syncthreads();
    for (int i = c.tid; i < 512; i += 512) tabl[i] = c.in[I_T5][i];
    __syncthreads();
    const float* PJ = WSF(WC_PROJ); const float* KCV = WSF(WC_KCV); const float* gb = c.in[I_CGB]; const int* pt = (const int*)c.in[I_PT]; const float* ckv = c.in[I_CKV]; const float* cwin = c.in[I_CWIN];
    bf16* OA = WSB(WC_OA);
    for (int item = c.gw; item < 65536 + 2048; item += c.NGW) {
        int lane = c.lane; asm volatile("" : "+v"(lane));
        const bool smp = item >= 65536; int b, g, t, qpos, ncmp, nslc; size_t row;
        if (!smp) { g = item & 3; b = (item >> 2) & 3; t = item >> 4; qpos = t; row = (size_t)b * SEQ + t; ncmp = 128; nslc = 64; }
        else { const int q = item - 65536; g = q & 3; t = (q >> 2) & 3; b = q >> 4; qpos = 2048 + t; row = (size_t)MP + 4 * b + t; ncmp = 64; nslc = 33; }
        const float* qrow = PJ + row * NCIN;
        { const f32x4 qv = *(const f32x4*)(qrow + g * 256 + lane * 4); *(LAS f32x4*)(qs + lane * 4) = qv * 0.125f; }
        float gv = 0.f; if (lane < 12) { const int gi = (lane >> 2) * 16 + g * 4 + (lane & 3); gv = sigmoid_f(qrow[2560 + gi] + gb[gi]); }
        float gate_c[4], gate_s[4], gate_w[4];
#pragma unroll
        for (int h = 0; h < 4; ++h) { gate_c[h] = readlane_f(gv, h); gate_s[h] = readlane_f(gv, 4 + h); gate_w[h] = readlane_f(gv, 8 + h); }
        LDS_WAIT();
        f32x4 acc[4];
#pragma unroll
        for (int h = 0; h < 4; ++h) acc[h] = (f32x4){0.f, 0.f, 0.f, 0.f};
        AttSt st;
        float ps;
        { const size_t kc0 = smp ? (size_t)2048 + ((size_t)b * 64) * 4 + g : ((size_t)b * 128) * 4 + g;
          const float* safe = KCV; float s0[4], s1[4];
          const int n0 = lane, n1 = lane + 64; const int d0 = qpos - (32 * n0 + 31), d1 = qpos - (32 * n1 + 31);
          const bool v0 = n0 < ncmp && d0 >= 0, v1 = n1 < ncmp && d1 >= 0;
          const float* k0p = v0 ? KCV + (kc0 + 4 * (size_t)n0) * 64 : safe; const float* k1p = v1 ? KCV + (kc0 + 4 * (size_t)n1) * 64 : safe;
          att_scores(qs, tabl, k0p, v0, d0, g, s0); att_scores(qs, tabl, k1p, v1, d1, g, s1);
          att_reset(st); float p0[4], p1[4], pc0 = 0.f, pc1 = 0.f;
#pragma unroll
          for (int h = 0; h < 4; ++h) { const float mx = wave_max(fmaxf(s0[h], s1[h])); p0[h] = v0 ? __expf(s0[h] - mx) : 0.f; p1[h] = v1 ? __expf(s1[h] - mx) : 0.f;
              const float l = wave_sum(p0[h] + p1[h]); const float inv = l > 0.f ? 1.f / l : 0.f; p0[h] *= inv; p1[h] *= inv; pc0 += p0[h]; pc1 += p1[h]; st.l[h] = l > 0.f ? 1.f : 0.f; }
          att_pv(st, P, R, p0, k0p, CMP_ROWS * 64, lane); att_pv(st, P, R, p1, k1p, CMP_ROWS * 64, lane);
          att_finish(st, gate_c, acc);
          pcs[lane] = pc0; pcs[64 + lane] = pc1; LDS_WAIT();
          ps = (2 * lane + 1 < ncmp) ? pcs[2 * lane] + pcs[2 * lane + 1] : 0.f; LDS_WAIT(); }
        const int jq = qpos >> 6; unsigned long long sel;
        { const bool forced = (lane == 0) || (lane == jq) || (lane == jq - 1);
          float sc = forced ? 100.f : (lane > jq ? -1.f : ps); if (lane >= nslc) sc = -__builtin_inff();
          int cnt = 0;
#pragma unroll 4
          for (int k = 0; k < 64; ++k) { const float sk = readlane_f(sc, k); cnt += (sk > sc || (sk == sc && k < lane)) ? 1 : 0; }
          sel = __ballot(cnt < 16); }
        att_reset(st);
        { const float* safe = qrow + 1536;
          unsigned long long todo = sel & (jq >= 63 ? ~0ull : ((1ull << (jq + 1)) - 1ull));
          while (todo) { const int j = __builtin_ctzll(todo); todo &= todo - 1ull;
              const int kpos = 64 * j + lane; const bool valid = kpos <= qpos; const float* kptr;
              if (!smp) kptr = PJ + ((size_t)b * SEQ + kpos) * NCIN + 1536 + g * 64;
              else if (j < 32) { const int page = pt[b * 16 + (j >> 1)]; kptr = ckv + (((size_t)page * 128 + (j & 1) * 64 + lane) * 16 + 8 + g) * 64; }
              else kptr = PJ + ((size_t)MP + 4 * b + (lane & 3)) * NCIN + 1536 + g * 64;
              att_block(st, qs, tabl, P, R, kptr, safe, valid, qpos - kpos, 256, g, lane); } }
        att_finish(st, gate_s, acc);
        att_reset(st);
        { const float* safe = qrow + 2048;
          for (int cb = 0; cb < 8; ++cb) { const int kpos = qpos - 511 + 64 * cb + lane; if (qpos - 511 + 64 * cb + 63 < 0) continue;
              const bool valid = kpos >= 0; const float* kptr;
              if (!smp) kptr = PJ + ((size_t)b * SEQ + (valid ? kpos : 0)) * NCIN + 2048 + g * 64;
              else if (kpos < 2048) kptr = cwin + (((size_t)b * 512 + (kpos - 1536)) * 2) * 256 + g * 64;
              else kptr = PJ + ((size_t)MP + 4 * b + (kpos - 2048)) * NCIN + 2048 + g * 64;
              att_block(st, qs, tabl, P, R, kptr, safe, valid, qpos - kpos, 256, g, lane); } }
        att_finish(st, gate_w, acc);
        if (lane < 16) {
#pragma unroll
            for (int h = 0; h < 4; ++h) { u32x2 w; w.x = pk2(acc[h].x, acc[h].y); w.y = pk2(acc[h].z, acc[h].w); *(u32x2*)(OA + row * 1024 + (g * 4 + h) * 64 + lane * 4) = w; } }
    }
}
constexpr int PH_PER_SUB = 9, N_PHASES = 2 + 12 * PH_PER_SUB;
struct Args { const float* in[N_IN]; float* out; unsigned char* ws; int ph_lo, ph_hi, bli, pad; };
__host__ __device__ inline bool phase_exists(int ph) {
    if (ph < 2) return true; const int r = ph - 2, sub3 = r / PH_PER_SUB, slot = r % PH_PER_SUB, L = sub3 / 3, s = sub3 % 3, kind = (L == 1) ? 1 : (L == 2 ? 2 : 0);
    if (slot == 0 || slot == 5 || slot == 6) return true;
    if (slot == 7) return s == 2;
    if (slot == 8) return false;
    if (s != 1) return false;
    if (kind == 0) return slot <= 2; if (kind == 1) return slot <= 3; return true;
}

#define IN(k) (lo <= (k) && (k) < hi)
#define SEAM(k) do { if (IN(k) && (k) + 1 < hi) xcd_barrier(bar); } while (0)
template <int L, int S> __device__ __forceinline__ void run_sub(const Ctx& c, const XcdBarrier& bar, const int lo, const int hi) {
    constexpr int kind = (L == 1) ? 1 : (L == 2 ? 2 : 0), ia = (L == 3) ? 1 : 0, base = 2 + (3 * L + S) * PH_PER_SUB;
    LAS unsigned char* ring = c.lds;
    if (IN(base)) {
        if constexpr (S != 1) { constexpr int j = S >> 1; pg8::Gemm g{S == 0 ? WSB(WS_XNB) : WSB(WS_XN), WSB(WS_WUP + (size_t)(2 * L + j) * SZ_WUP), M, 5632, 1024}; pg8::StaticOrder So; So.init(M, 5632, c.G, (int)blockIdx.x);
            pg8::EpiGate E{WSB(WS_H), DFF}; pg8::gemm_phase<pg8::EpiGate, pg8::StaticOrder, true, true>(ring, g, So, E); }
        else if constexpr (kind == 0) { pg8::Gemm g{WSB(WS_XN), WSB(WS_WAIN + (size_t)ia * SZ_WAIN), M, 4096, 1024}; pg8::StaticOrder So; So.init(M, 4096, c.G, (int)blockIdx.x);
            pg8::EpiAin E{WSB(WA_U), WSF(WA_V)}; pg8::gemm_phase<pg8::EpiAin, pg8::StaticOrder, true, true>(ring, g, So, E); }
        else { constexpr int N = kind == 1 ? NBIN : NCIN; pg8::Gemm g{WSB(WS_XN), kind == 1 ? WSB(WS_WBIN) : WSB(WS_WCIN), M, N, 1024}; pg8::StaticOrder So; So.init(M, N, c.G, (int)blockIdx.x);
            pg8::EpiF32 E{WSF(WS_MIX), N}; pg8::gemm_phase<pg8::EpiF32, pg8::StaticOrder, true, true>(ring, g, So, E); }
    } SEAM(base);
    if constexpr (S == 1) {
        if (IN(base + 1)) { if constexpr (kind == 0) a_stats_phase(c, ia); else if constexpr (kind == 1) gdn_prep_phase(c); else nsa_prep_phase(c); } SEAM(base + 1);
        if (IN(base + 2)) { if constexpr (kind == 0) a_sgu_phase(c, ia); else if constexpr (kind == 1) gdn_scan_phase(c);
            else {
                { pg8::Gemm g{WSB(WC_ACMP), WSB(WS_WC1), CMP_ROWS, 256, 2048}; pg8::StaticOrder So; So.init(CMP_ROWS, 256, c.G, (int)blockIdx.x);
                  pg8::EpiCmp E{WSB(WC_HC)}; pg8::gemm_phase<pg8::EpiCmp, pg8::StaticOrder, true, true>(ring, g, So, E); }
                { pg8::Gemm g{WSB(WC_ACMP) + (size_t)CMP_ROWS * 2048, WSB(WS_WC1 + SZ_WC1), CMP_ROWS, 256, 2048}; pg8::StaticOrder So; So.init(CMP_ROWS, 256, c.G, (int)((blockIdx.x + 128u) % (unsigned)c.G));
                  pg8::EpiCmp E{WSB(WC_HC) + (size_t)CMP_ROWS * 256}; pg8::gemm_phase<pg8::EpiCmp, pg8::StaticOrder, true, true>(ring, g, So, E); } } } SEAM(base + 2);
        if constexpr (kind != 0) { if (IN(base + 3)) { if constexpr (kind == 1) gdn_post_phase(c); else nsa_cmp2_phase(c); } SEAM(base + 3); }
        if constexpr (kind == 2) { if (IN(base + 4)) nsa_attn_phase(c); SEAM(base + 4); }
    }
    if (IN(base + 5)) {
        const bf16* A; const bf16* Bt; int K; float sc;
        if constexpr (S != 1) { A = WSB(WS_H); Bt = WSB(WS_WDN + (size_t)(2 * L + (S >> 1)) * SZ_WDN); K = DFF; sc = 0.5f; }
        else if constexpr (kind == 0) { A = WSB(WA_US); Bt = WSB(WS_WAOUT + (size_t)ia * SZ_WAOUT); K = 2048; sc = 1.f; }
        else if constexpr (kind == 1) { A = WSB(WB_OG); Bt = WSB(WS_WBOUT); K = 1024; sc = 1.f; }
        else { A = WSB(WC_OA); Bt = WSB(WS_WCOUT); K = 1024; sc = 1.f; }
        pg8::Gemm g{A, Bt, M, 1024, K}; pg8::StaticOrder So; So.init(M, 1024, c.G, (int)blockIdx.x);
        pg8::EpiResid E{WSF(WS_X), WSF(WS_PRE), ALPHA, sc}; pg8::gemm_phase<pg8::EpiResid, pg8::StaticOrder, true, true>(ring, g, So, E);
    } SEAM(base + 5);
    if (IN(base + 6)) { ln_phase(c, c.in[I_LNG] + (size_t)(3 * L + S) * 1024, c.in[I_LNB] + (size_t)(3 * L + S) * 1024); } SEAM(base + 6);
    if constexpr (S == 2) { if (IN(base + 7)) { pg8::Gemm g{WSB(WS_XN), WSB(WS_WG + (size_t)L * SZ_WG), M, 1024, 1024}; pg8::StaticOrder So; So.init(M, 1024, c.G, (int)blockIdx.x);
            pg8::EpiPle E{WSF(WS_X), WSF(WS_PP) + (size_t)L * M * 1024, WSB(WS_XNB), L == 3 ? c.out : nullptr}; pg8::gemm_phase<pg8::EpiPle, pg8::StaticOrder, true, true>(ring, g, So, E); } SEAM(base + 7); }
}
template <int l> __device__ __forceinline__ void ple_proj(const Ctx& c) {
    pg8::Gemm g{WSB(WS_PBF) + (size_t)l * M * 256, WSB(WS_WP + l * SZ_WP), M, 1024, 256}; pg8::StaticOrder So; So.init(M, 1024, c.G, (int)blockIdx.x);
    pg8::EpiF32 E{WSF(WS_PP) + (size_t)l * M * 1024, 1024}; pg8::gemm_phase<pg8::EpiF32, pg8::StaticOrder, true, true>(c.lds, g, So, E);
}
__global__ void __launch_bounds__(NWAVES * 64, 2) fwd(Args args) {
    extern __shared__ __attribute__((aligned(16))) unsigned char lds_raw[];
    Ctx c; c.lds = (LAS unsigned char*)lds_raw; c.ws = args.ws; c.out = args.out; c.in = args.in;
    c.tid = threadIdx.x; c.lane = c.tid & 63; c.wave = __builtin_amdgcn_readfirstlane(c.tid >> 6); c.G = gridDim.x; c.gw = blockIdx.x * NWAVES + c.wave; c.NGW = c.G * NWAVES;
    volatile LAS unsigned* MISC = (volatile LAS unsigned*)(c.lds + MISC_OFF);
    for (int u = c.tid; u < 128; u += NWAVES * 64) MISC[u] = 0u;
    __syncthreads();
    unsigned* ctl = (unsigned*)c.ws;
    XcdBarrier bar = xcd_barrier_post(ctl + CW_BAR + args.bli * XCD_BAR_WORDS, MISC + 8);
    const int lo = args.ph_lo, hi = args.ph_hi;
    if (IN(0)) { prologue_phase(c); } SEAM(0);
    if (IN(1)) { ple_proj<0>(c); ple_proj<1>(c); ple_proj<2>(c); ple_proj<3>(c); } SEAM(1);
    run_sub<0, 0>(c, bar, lo, hi); run_sub<0, 1>(c, bar, lo, hi); run_sub<0, 2>(c, bar, lo, hi);
    run_sub<1, 0>(c, bar, lo, hi); run_sub<1, 1>(c, bar, lo, hi); run_sub<1, 2>(c, bar, lo, hi);
    run_sub<2, 0>(c, bar, lo, hi); run_sub<2, 1>(c, bar, lo, hi); run_sub<2, 2>(c, bar, lo, hi);
    run_sub<3, 0>(c, bar, lo, hi); run_sub<3, 1>(c, bar, lo, hi); run_sub<3, 2>(c, bar, lo, hi);
}
#undef IN
#undef SEAM

#ifndef ONE_LAUNCH
#define ONE_LAUNCH 1
#endif
extern "C" void kernel_launch(void* const* d_in, const int* in_sizes, int n_in, void* d_out, int out_size, void* d_ws, size_t ws_size, hipStream_t stream) {
    static int grid = 0;
    if (grid == 0) {
        if (n_in != N_IN || (size_t)out_size != O_END || ws_size < WS_END) { fprintf(stderr, "kernel_launch: unexpected problem: n_in %d out %d ws %zu (need %zu)\n", n_in, out_size, ws_size, (size_t)WS_END); grid = -1; return; }
        int dev = 0, cus = 0, per_cu = 0;
        if (hipGetDevice(&dev) != hipSuccess || hipDeviceGetAttribute(&cus, hipDeviceAttributeMultiprocessorCount, dev) != hipSuccess) { grid = -1; return; }
        if (hipFuncSetAttribute((const void*)fwd, hipFuncAttributeMaxDynamicSharedMemorySize, LDS_BYTES) != hipSuccess) { fprintf(stderr, "kernel_launch: hipFuncSetAttribute failed\n"); grid = -1; return; }
        if (hipOccupancyMaxActiveBlocksPerMultiprocessor(&per_cu, (const void*)fwd, NWAVES * 64, LDS_BYTES) != hipSuccess || per_cu < 1) fprintf(stderr, "kernel_launch: occupancy query says %d\n", per_cu);
        (void)hipGetLastError();
        grid = cus;
    }
    if (grid < 0) return;
    (void)hipMemsetAsync(d_ws, 0, CTL_BYTES, stream);
    Args a{};
    for (int i = 0; i < N_IN; ++i) a.in[i] = (const float*)d_in[i];
    a.out = (float*)d_out; a.ws = (unsigned char*)d_ws; a.pad = 0;
#if ONE_LAUNCH
    a.ph_lo = 0; a.ph_hi = N_PHASES; a.bli = 0;
    hipLaunchKernelGGL(fwd, dim3(grid), dim3(NWAVES * 64), LDS_BYTES, stream, a);
#else
    for (int ph = 0; ph < N_PHASES; ++ph) { if (!phase_exists(ph)) continue; a.ph_lo = ph; a.ph_hi = ph + 1; a.bli = 0;
        hipLaunchKernelGGL(fwd, dim3(grid), dim3(NWAVES * 64), LDS_BYTES, stream, a); }
#endif
}
```

```cpp
#include <hip/hip_runtime.h>
#include <cstdio>
#include <cstdint>
namespace pg8 {
#define PG8_LAS __attribute__((address_space(3)))
typedef unsigned short bf16_t;
typedef short bf16x8 __attribute__((ext_vector_type(8)));
typedef float f32x4 __attribute__((ext_vector_type(4)));
typedef unsigned u32x4 __attribute__((ext_vector_type(4)));
constexpr int BM = 256, BK = 64, HALF = 128, HTB = HALF * BK * 2  , STAGE_BYTES = 8 * HTB, NXCD = 8, WGM = 8;

__host__ __device__ __forceinline__ int lds_byte(int r, int c) { const int st = (r >> 4) * 2 + (c >> 5), rr = r & 15, cc = c & 31, ob = rr * 64 + cc * 2; return st * 1024 + (ob ^ (((ob >> 9) & 1) << 5)); }
__host__ __device__ __forceinline__ void stage_rc(int b, int& R, int& C) { const int st = b / 1024, sb = b % 1024, swz = sb ^ (((sb >> 9) & 1) << 5); R = (st >> 1) * 16 + swz / 64; C = (st & 1) * 32 + (swz % 64) / 2; }
__host__ __device__ __forceinline__ int perm32(int rho) { const int n = rho >> 4, i = rho & 15; return 8 * (i >> 2) + 4 * n + (i & 3); }

struct Unit { int pm, pn; };
struct Gemm { const bf16_t* A; const bf16_t* Bt; int M, N, K; };

struct StaticOrder {
    int nM, nN, nwg, G, c;
    __host__ __device__ void init(int M, int N, int G_, int c_) { nM = M / BM; nN = N / BM; nwg = nM * nN; G = G_; c = c_; }
    __host__ __device__ bool next(int i, Unit& u) const {
        const long L = (long)i * G + c; if (L >= nwg) return false;
        int wgid = (int)L; { const int q = nwg / NXCD, r = nwg % NXCD, xcd = wgid % NXCD, off = wgid / NXCD; wgid = (xcd < r ? xcd * (q + 1) : r * (q + 1) + (xcd - r) * q) + off; }
        const int nig = WGM * nN, gid = wgid / nig, fm = gid * WGM, gsz = (nM - fm) < WGM ? (nM - fm) : WGM;
        u.pm = fm + ((wgid % nig) % gsz); u.pn = (wgid % nig) / gsz; return true;
    }
    __device__ __forceinline__ void a_ready(const Unit&) const {}
    __device__ __forceinline__ void done(const Unit&) const {}
};

__device__ __forceinline__ unsigned cvt_pk_bf16(float lo, float hi) { unsigned r; asm volatile("v_cvt_pk_bf16_f32 %0, %1, %2" : "=v"(r) : "v"(lo), "v"(hi)); return r; }
typedef unsigned u32x2 __attribute__((ext_vector_type(2)));
__device__ __forceinline__ float fast_sigmoid(float x) { return __frcp_rn(1.0f + __expf(-x)); }
__device__ __forceinline__ float silu_f(float x) { return x * fast_sigmoid(x); }
__device__ __forceinline__ float gelu_tanh_f(float x) { const float y = 1.5957691216057308f * (x + 0.044715f * x * x * x); return x * fast_sigmoid(y); }
__device__ __forceinline__ u32x2 pack4(f32x4 v) { u32x2 w; w.x = cvt_pk_bf16(v[0], v[1]); w.y = cvt_pk_bf16(v[2], v[3]); return w; }

struct EpiGate {
    static constexpr bool PERM = false, AFTER_DRAIN = false;
    bf16_t* H; int ldh;
    __device__ __forceinline__ void operator()(const f32x4 (&acc)[2][2][4][2], const Unit& u, int wr, int wc, int fr, int fq) const {
        const int row0 = u.pm * BM + wr * 64 + fr, col0 = u.pn * HALF + wc * 32 + 4 * fq;
#pragma unroll
        for (int ai = 0; ai < 2; ++ai)
#pragma unroll
            for (int m = 0; m < 4; ++m) { bf16_t* rowp = H + (size_t)(row0 + ai * HALF + m * 16) * ldh + col0;
#pragma unroll
                for (int n = 0; n < 2; ++n) { const f32x4 a = acc[ai][0][m][n], b = acc[ai][1][m][n]; f32x4 h;
#pragma unroll
                    for (int j = 0; j < 4; ++j) h[j] = silu_f(a[j]) * b[j];
                    *(u32x2*)(rowp + n * 16) = pack4(h); } }
    }
};
struct EpiResid {
    static constexpr bool PERM = false, AFTER_DRAIN = false;
    const float* X; float* PRE; float alpha, s;
    __device__ __forceinline__ void operator()(const f32x4 (&acc)[2][2][4][2], const Unit& u, int wr, int wc, int fr, int fq) const {
        const int row0 = u.pm * BM + wr * 64 + fr, col0 = u.pn * BM + wc * 32 + 4 * fq;
#pragma unroll
        for (int ai = 0; ai < 2; ++ai)
#pragma unroll
            for (int m = 0; m < 4; ++m) { const size_t off = (size_t)(row0 + ai * HALF + m * 16) * 1024 + col0;
#pragma unroll
                for (int bj = 0; bj < 2; ++bj)
#pragma unroll
                    for (int n = 0; n < 2; ++n) { const f32x4 x = *(const f32x4*)(X + off + bj * HALF + n * 16); *(f32x4*)(PRE + off + bj * HALF + n * 16) = x * alpha + acc[ai][bj][m][n] * s; } }
    }
};
struct EpiF32 {
    static constexpr bool PERM = false, AFTER_DRAIN = false;
    float* C; int ldc;
    __device__ __forceinline__ void operator()(const f32x4 (&acc)[2][2][4][2], const Unit& u, int wr, int wc, int fr, int fq) const {
        const int row0 = u.pm * BM + wr * 64 + fr, col0 = u.pn * BM + wc * 32 + 4 * fq;
#pragma unroll
        for (int ai = 0; ai < 2; ++ai)
#pragma unroll
            for (int m = 0; m < 4; ++m) { float* rowp = C + (size_t)(row0 + ai * HALF + m * 16) * ldc + col0;
#pragma unroll
                for (int bj = 0; bj < 2; ++bj)
#pragma unroll
                    for (int n = 0; n < 2; ++n) *(f32x4*)(rowp + bj * HALF + n * 16) = acc[ai][bj][m][n]; }
    }
};
struct EpiPle {
    static constexpr bool PERM = false, AFTER_DRAIN = false;
    float* X; const float* P; bf16_t* XN; float* OUT;
    __device__ __forceinline__ void operator()(const f32x4 (&acc)[2][2][4][2], const Unit& u, int wr, int wc, int fr, int fq) const {
        const int row0 = u.pm * BM + wr * 64 + fr, col0 = u.pn * BM + wc * 32 + 4 * fq;
#pragma unroll
        for (int ai = 0; ai < 2; ++ai)
#pragma unroll
            for (int m = 0; m < 4; ++m) { const size_t off = (size_t)(row0 + ai * HALF + m * 16) * 1024 + col0;
#pragma unroll
                for (int bj = 0; bj < 2; ++bj)
#pragma unroll
                    for (int n = 0; n < 2; ++n) { const size_t o = off + bj * HALF + n * 16; const f32x4 x = *(const f32x4*)(X + o), p = *(const f32x4*)(P + o), a = acc[ai][bj][m][n]; f32x4 y;
#pragma unroll
                        for (int j = 0; j < 4; ++j) y[j] = x[j] + fast_sigmoid(a[j]) * p[j];
                        *(f32x4*)(X + o) = y; *(u32x2*)(XN + o) = pack4(y); if (OUT) *(f32x4*)(OUT + o) = y; } }
    }
};
struct EpiAin {
    static constexpr bool PERM = false, AFTER_DRAIN = false;
    bf16_t* U; float* V;
    __device__ __forceinline__ void operator()(const f32x4 (&acc)[2][2][4][2], const Unit& u, int wr, int wc, int fr, int fq) const {
        const int row0 = u.pm * BM + wr * 64 + fr; const bool isu = u.pn < 8; const int col0 = (isu ? u.pn : u.pn - 8) * BM + wc * 32 + 4 * fq;
#pragma unroll
        for (int ai = 0; ai < 2; ++ai)
#pragma unroll
            for (int m = 0; m < 4; ++m) { const size_t off = (size_t)(row0 + ai * HALF + m * 16) * 2048 + col0;
#pragma unroll
                for (int bj = 0; bj < 2; ++bj)
#pragma unroll
                    for (int n = 0; n < 2; ++n) { const f32x4 a = acc[ai][bj][m][n]; f32x4 y;
#pragma unroll
                        for (int j = 0; j < 4; ++j) y[j] = gelu_tanh_f(a[j]);
                        if (isu) *(u32x2*)(U + off + bj * HALF + n * 16) = pack4(y); else *(f32x4*)(V + off + bj * HALF + n * 16) = y; } }
    }
};
struct EpiCmp {
    static constexpr bool PERM = false, AFTER_DRAIN = false;
    bf16_t* HC;
    __device__ __forceinline__ void operator()(const f32x4 (&acc)[2][2][4][2], const Unit& u, int wr, int wc, int fr, int fq) const {
        const int row0 = u.pm * BM + wr * 64 + fr, col0 = u.pn * BM + wc * 32 + 4 * fq;
#pragma unroll
        for (int ai = 0; ai < 2; ++ai)
#pragma unroll
            for (int m = 0; m < 4; ++m) { bf16_t* rowp = HC + (size_t)(row0 + ai * HALF + m * 16) * 256 + col0;
#pragma unroll
                for (int bj = 0; bj < 2; ++bj)
#pragma unroll
                    for (int n = 0; n < 2; ++n) { const f32x4 a = acc[ai][bj][m][n]; f32x4 y;
#pragma unroll
                        for (int j = 0; j < 4; ++j) y[j] = gelu_tanh_f(a[j]);
                        *(u32x2*)(rowp + bj * HALF + n * 16) = pack4(y); } }
    }
};
template <class Epi, class Sched, bool ALIGN_EPI = false, bool SP2 = false>
__device__ __forceinline__ void gemm_phase(PG8_LAS unsigned char* lds, const Gemm g, const Sched& S, const Epi& E) {
    const int tid = threadIdx.x, wid = __builtin_amdgcn_readfirstlane(tid >> 6), lane = tid & 63, wr = wid >> 2, wc = wid & 3, fr = lane & 15, fq = lane >> 4;
    const int K = g.K, nt = K / BK;
    unsigned voffA[2], voffB[2];
#pragma unroll
    for (int i = 0; i < 2; ++i) { int R, C; stage_rc(tid * 16 + i * 8192, R, C); const int Rb = Epi::PERM ? ((R & ~31) + perm32(R & 31)) : R;
        voffA[i] = (unsigned)(R * K + C) * 2u; voffB[i] = (unsigned)(Rb * K + C) * 2u; }
    const size_t kstep = (size_t)(BK * 2);
    const size_t hstep = (size_t)HALF * K * 2;
    const size_t tstep = 2 * hstep;
    const unsigned ldsw = (unsigned)wid * 1024u;
    const int aoff = lds_byte(wr * 64 + fr, fq * 8), boff = lds_byte(wc * 32 + fr, fq * 8);
#define PG8_SA(b, h) (((b) * 2 + (h)) * HTB)
#define PG8_SB(b, h) ((4 + (b) * 2 + (h)) * HTB)
#define PG8_STAGE(bufoff, gbase, voff) do { _Pragma("unroll") for (int _i = 0; _i < 2; ++_i) \
        __builtin_amdgcn_global_load_lds((const unsigned*)((const char*)(gbase) + (voff)[_i]), (PG8_LAS unsigned*)(lds + (bufoff) + ldsw + _i * 8192), 16, 0, 0); } while (0)
#define PG8_LDA(dst, b, h) do { _Pragma("unroll") for (int m = 0; m < 4; ++m) _Pragma("unroll") for (int k = 0; k < 2; ++k) dst[m][k] = *(const PG8_LAS bf16x8*)(lds + PG8_SA(b, h) + aoff + m * 2048 + k * 1024); } while (0)
#define PG8_LDB(dst, b, h) do { _Pragma("unroll") for (int n = 0; n < 2; ++n) _Pragma("unroll") for (int k = 0; k < 2; ++k) dst[n][k] = *(const PG8_LAS bf16x8*)(lds + PG8_SB(b, h) + boff + n * 2048 + k * 1024); } while (0)
#define PG8_MMA(ai, bj, At, Bt) do { __builtin_amdgcn_s_setprio(1); _Pragma("unroll") for (int m = 0; m < 4; ++m) _Pragma("unroll") for (int n = 0; n < 2; ++n) _Pragma("unroll") for (int k = 0; k < 2; ++k) \
        acc[ai][bj][m][n] = __builtin_amdgcn_mfma_f32_16x16x32_bf16(Bt[n][k], At[m][k], acc[ai][bj][m][n], 0, 0, 0); __builtin_amdgcn_s_setprio(0); } while (0)
#define PG8_WAIT_V(n) asm volatile("s_waitcnt vmcnt(" #n ")" ::: "memory")
#define PG8_WAIT_L(n) asm volatile("s_waitcnt lgkmcnt(" #n ")" ::: "memory")
#define PG8_BAR __builtin_amdgcn_s_barrier()
#define PG8_SCHED __builtin_amdgcn_sched_barrier(0)
    Unit cur, nxt; int ui = 0;
    if (!S.next(0, cur)) return;
    f32x4 acc[2][2][4][2];
#pragma unroll
    for (int a = 0; a < 2; ++a)
#pragma unroll
        for (int b = 0; b < 2; ++b)
#pragma unroll
            for (int m = 0; m < 4; ++m)
#pragma unroll
                for (int n = 0; n < 2; ++n) acc[a][b][m][n] = (f32x4){0.f, 0.f, 0.f, 0.f};
    bf16x8 At[4][2], B0[2][2], B1[2][2];
    const char* cA = (const char*)g.A + (size_t)cur.pm * tstep; const char* cB = (const char*)g.Bt + (size_t)cur.pn * tstep;
    S.a_ready(cur);
    if constexpr (SP2) {
        PG8_STAGE(PG8_SB(0, 0), cB, voffB); PG8_STAGE(PG8_SB(0, 1), cB + hstep, voffB); PG8_STAGE(PG8_SA(0, 0), cA, voffA); PG8_STAGE(PG8_SA(0, 1), cA + hstep, voffA);
        if (wr == 1) PG8_BAR;
        PG8_WAIT_V(2); PG8_BAR;
        PG8_STAGE(PG8_SB(1, 0), cB + kstep, voffB); PG8_STAGE(PG8_SA(1, 0), cA + kstep, voffA); PG8_STAGE(PG8_SB(1, 1), cB + hstep + kstep, voffB);
        PG8_WAIT_V(6); PG8_BAR;
    } else {
        PG8_STAGE(PG8_SB(0, 0), cB, voffB); PG8_STAGE(PG8_SA(0, 0), cA, voffA); PG8_STAGE(PG8_SB(0, 1), cB + hstep, voffB); PG8_STAGE(PG8_SA(0, 1), cA + hstep, voffA);
        if (wr == 1) PG8_BAR;
        PG8_WAIT_V(4); PG8_BAR;
        PG8_STAGE(PG8_SB(1, 0), cB + kstep, voffB); PG8_STAGE(PG8_SA(1, 0), cA + kstep, voffA); PG8_STAGE(PG8_SB(1, 1), cB + hstep + kstep, voffB);
        PG8_WAIT_V(6); PG8_BAR;
    }
    for (;;) {
        const bool has_next = S.next(ui + 1, nxt);
        const char* nA = has_next ? (const char*)g.A + (size_t)nxt.pm * tstep : cA; const char* nB = has_next ? (const char*)g.Bt + (size_t)nxt.pn * tstep : cB;
        for (int t = 0; t < nt; t += 2) {
            const bool last = (t == nt - 2);
            const char* a1 = cA + (size_t)(t + 1) * kstep;
            const char* a2 = last ? nA : cA + (size_t)(t + 2) * kstep; const char* b2 = last ? nB : cB + (size_t)(t + 2) * kstep;
            const char* a3 = a2 + kstep; const char* b3 = b2 + kstep;
            if (last && has_next) S.a_ready(nxt);
            if constexpr (SP2) {
            PG8_LDB(B0, 0, 0); PG8_LDB(B1, 0, 1); PG8_SCHED; PG8_LDA(At, 0, 0); PG8_STAGE(PG8_SA(1, 1), a1 + hstep, voffA);
            PG8_WAIT_V(8); PG8_WAIT_L(0); PG8_BAR; PG8_MMA(0, 0, At, B0); PG8_MMA(0, 1, At, B1); PG8_BAR; PG8_SCHED;
            PG8_LDA(At, 0, 1); PG8_STAGE(PG8_SB(0, 0), b2, voffB); PG8_STAGE(PG8_SB(0, 1), b2 + hstep, voffB); PG8_STAGE(PG8_SA(0, 0), a2, voffA);
            PG8_WAIT_V(8); PG8_WAIT_L(0); PG8_BAR; PG8_MMA(1, 0, At, B0); PG8_MMA(1, 1, At, B1); PG8_BAR; PG8_SCHED;
            PG8_LDB(B0, 1, 0); PG8_LDB(B1, 1, 1); PG8_SCHED; PG8_LDA(At, 1, 0); PG8_STAGE(PG8_SA(0, 1), a2 + hstep, voffA);
            PG8_WAIT_V(8); PG8_WAIT_L(0); PG8_BAR; PG8_MMA(0, 0, At, B0); PG8_MMA(0, 1, At, B1); PG8_BAR; PG8_SCHED;
            PG8_LDA(At, 1, 1); PG8_STAGE(PG8_SB(1, 0), b3, voffB); PG8_STAGE(PG8_SB(1, 1), b3 + hstep, voffB); PG8_STAGE(PG8_SA(1, 0), a3, voffA);
            PG8_WAIT_V(8); PG8_WAIT_L(0); PG8_BAR; PG8_MMA(1, 0, At, B0); PG8_MMA(1, 1, At, B1); PG8_BAR; PG8_SCHED;
            } else {
            PG8_LDB(B0, 0, 0); PG8_SCHED; PG8_LDA(At, 0, 0); PG8_STAGE(PG8_SA(1, 1), a1 + hstep, voffA);
            PG8_WAIT_L(8); PG8_BAR; PG8_WAIT_L(0); PG8_MMA(0, 0, At, B0); PG8_BAR; PG8_SCHED;
            PG8_LDB(B1, 0, 1); PG8_STAGE(PG8_SB(0, 0), b2, voffB);
            PG8_BAR; PG8_WAIT_L(0); PG8_MMA(0, 1, At, B1); PG8_BAR;
            PG8_LDA(At, 0, 1); PG8_STAGE(PG8_SA(0, 0), a2, voffA);
            PG8_BAR; PG8_WAIT_L(0); PG8_MMA(1, 0, At, B0); PG8_BAR; PG8_SCHED;
            PG8_STAGE(PG8_SB(0, 1), b2 + hstep, voffB);
            PG8_WAIT_V(6); PG8_BAR; PG8_MMA(1, 1, At, B1); PG8_BAR;
            PG8_LDB(B0, 1, 0); PG8_SCHED; PG8_LDA(At, 1, 0); PG8_STAGE(PG8_SA(0, 1), a2 + hstep, voffA);
            PG8_WAIT_L(8); PG8_BAR; PG8_WAIT_L(0); PG8_MMA(0, 0, At, B0); PG8_BAR; PG8_SCHED;
            PG8_LDB(B1, 1, 1); PG8_STAGE(PG8_SB(1, 0), b3, voffB);
            PG8_BAR; PG8_WAIT_L(0); PG8_MMA(0, 1, At, B1); PG8_BAR;
            PG8_LDA(At, 1, 1); PG8_STAGE(PG8_SA(1, 0), a3, voffA);
            PG8_BAR; PG8_WAIT_L(0); PG8_MMA(1, 0, At, B0); PG8_BAR; PG8_SCHED;
            PG8_STAGE(PG8_SB(1, 1), b3 + hstep, voffB);
            PG8_WAIT_V(6); PG8_BAR; PG8_MMA(1, 1, At, B1); PG8_BAR;
            }
        }
        if constexpr (ALIGN_EPI) { if (wr == 0) PG8_BAR; }
        if constexpr (!Epi::AFTER_DRAIN) { E(acc, cur, wr, wc, fr, fq); S.done(cur); }
        if (!has_next) break;
#pragma unroll
        for (int a = 0; a < 2; ++a)
#pragma unroll
            for (int b = 0; b < 2; ++b)
#pragma unroll
                for (int m = 0; m < 4; ++m)
#pragma unroll
                    for (int n = 0; n < 2; ++n) acc[a][b][m][n] = (f32x4){0.f, 0.f, 0.f, 0.f};
        cur = nxt; cA = nA; cB = nB; ++ui;
        if constexpr (ALIGN_EPI) { if (wr == 1) PG8_BAR; }
    }
    PG8_WAIT_V(0);
    if constexpr (!ALIGN_EPI) { if (wr == 0) PG8_BAR; }
    PG8_BAR;
    if constexpr (Epi::AFTER_DRAIN) { E.fused(acc, cur, wr, wc, fr, fq, lds, wid, lane); S.done(cur); }
#undef PG8_SA
#undef PG8_SB
#undef PG8_STAGE
#undef PG8_LDA
#undef PG8_LDB
#undef PG8_MMA
#undef PG8_WAIT_V
#undef PG8_WAIT_L
#undef PG8_BAR
#undef PG8_SCHED
}
}
constexpr int NWAVES = 8;
constexpr int MP = 16384, MS = 512, M = 16896, D = 1024, DFF = 2816, PLE = 256, SEQ = 4096, NB = 4, DB = 128, DSQ = 4;
constexpr int NBIN = 4352, NBIN_REAL = 4112, NCIN = 2816, NCIN_REAL = 2608;
constexpr int CMP_ROWS = 34816;
constexpr float ALPHA = 1.681792830507429f, LN_EPS = 1e-5f, NORM_EPS = 1e-6f;
constexpr size_t O_YP = 0, O_YS = 16777216, O_AV = 17301504, O_GSP = 19398656, O_GCP = 19922944, O_GSS = 19959808, O_GCS = 36737024,
                 O_KVP = 37916672, O_WINP = 54693888, O_KVS = 55742464, O_WINS = 56266752, O_END = 56528896;
constexpr size_t CTL_BYTES = 1u << 20;
constexpr size_t SZ_WUP = (size_t)5632 * 1024 * 2, SZ_WDN = (size_t)1024 * 2816 * 2, SZ_WG = (size_t)1024 * 1024 * 2, SZ_WP = (size_t)1024 * 256 * 2,
                 SZ_WAIN = (size_t)4096 * 1024 * 2, SZ_WAOUT = (size_t)1024 * 2048 * 2, SZ_WBIN = (size_t)NBIN * 1024 * 2, SZ_WCIN = (size_t)NCIN * 1024 * 2, SZ_WC1 = (size_t)256 * 2048 * 2;
constexpr size_t WS_WUP = CTL_BYTES, WS_WDN = WS_WUP + 8 * SZ_WUP, WS_WG = WS_WDN + 8 * SZ_WDN, WS_WP = WS_WG + 4 * SZ_WG, WS_WAIN = WS_WP + 4 * SZ_WP, WS_WAOUT = WS_WAIN + 2 * SZ_WAIN,
                 WS_WBIN = WS_WAOUT + 2 * SZ_WAOUT, WS_WBOUT = WS_WBIN + SZ_WBIN, WS_WCIN = WS_WBOUT + SZ_WG, WS_WCOUT = WS_WCIN + SZ_WCIN, WS_WC1 = WS_WCOUT + SZ_WG;
constexpr size_t WS_X = WS_WC1 + 2 * SZ_WC1;
constexpr size_t WS_XN = WS_X + (size_t)M * 1024 * 4;
constexpr size_t WS_XNB = WS_XN + (size_t)M * 1024 * 2;
constexpr size_t WS_PRE = WS_XNB + (size_t)M * 1024 * 2;
constexpr size_t WS_H = WS_PRE + (size_t)M * 1024 * 4;
constexpr size_t WS_PBF = WS_H + (size_t)M * 2816 * 2;
constexpr size_t WS_PP = WS_PBF + (size_t)4 * M * 256 * 2;
constexpr size_t WS_MIX = WS_PP + (size_t)4 * M * 1024 * 4;
constexpr size_t WA_U = WS_MIX, WA_V = WA_U + (size_t)M * 2048 * 2, WA_US = WA_V + (size_t)M * 2048 * 4, WA_ST = WA_US + (size_t)M * 2048 * 2, WA_END = WA_ST + (size_t)M * 8;
constexpr size_t GUNITS = 2048;
constexpr size_t WB_PROJ = WS_MIX, WB_W = WB_PROJ + (size_t)M * NBIN * 4, WB_U = WB_W + GUNITS * 64 * 128 * 4, WB_QG = WB_U + GUNITS * 64 * 128 * 4, WB_KD = WB_QG + GUNITS * 64 * 128 * 4,
                 WB_QK = WB_KD + GUNITS * 64 * 128 * 4, WB_EG = WB_QK + GUNITS * 64 * 64 * 4, WB_O = WB_EG + 65536, WB_OG = WB_O + (size_t)M * 1024 * 4, WB_END = WB_OG + (size_t)M * 1024 * 2;
constexpr size_t WC_PROJ = WS_MIX, WC_ACMP = WC_PROJ + (size_t)M * NCIN * 4, WC_HC = WC_ACMP + (size_t)2 * CMP_ROWS * 2048 * 2, WC_KCV = WC_HC + (size_t)2 * CMP_ROWS * 256 * 2,
                 WC_OA = WC_KCV + (size_t)2 * CMP_ROWS * 64 * 4, WC_KSB = WC_OA + (size_t)M * 1024 * 2, WC_VST = WC_KSB + (size_t)16 * SEQ * 64 * 2, WC_KWB = WC_VST + (size_t)16 * SEQ * 64 * 2, WC_VWT = WC_KWB + (size_t)16 * SEQ * 64 * 2,
                 WC_KCB = WC_VWT + (size_t)16 * SEQ * 64 * 2, WC_VCT = WC_KCB + (size_t)16 * 128 * 64 * 2, WC_END = WC_VCT + (size_t)16 * 128 * 64 * 2;
constexpr size_t WS_END = (WB_END > WC_END ? (WB_END > WA_END ? WB_END : WA_END) : (WC_END > WA_END ? WC_END : WA_END));
static_assert(WS_X % 256 == 0 && WS_MIX % 256 == 0 && WB_W % 256 == 0 && WC_ACMP % 256 == 0, "alignment");
constexpr int CW_TMO = 0, CW_BAR = 4096;
constexpr int LDS_BYTES = 147456, MISC_OFF = LDS_BYTES - 512;

#define GAS __attribute__((address_space(1)))
#define LAS __attribute__((address_space(3)))
typedef unsigned short bf16;
typedef float f32x4 __attribute__((ext_vector_type(4)));
typedef float f32x2 __attribute__((ext_vector_type(2)));
typedef unsigned u32x2 __attribute__((ext_vector_type(2)));
typedef unsigned u32x4 __attribute__((ext_vector_type(4)));
#define LDS_WAIT() asm volatile("s_waitcnt lgkmcnt(0)" ::: "memory")
__device__ __forceinline__ unsigned f2bf(float f) { unsigned u = __builtin_bit_cast(unsigned, f); return (u + 0x7fffu + ((u >> 16) & 1u)) >> 16; }
__device__ __forceinline__ unsigned pk2(float lo, float hi) { return f2bf(lo) | (f2bf(hi) << 16); }
__device__ __forceinline__ float bf2f(bf16 b) { return __builtin_bit_cast(float, ((unsigned)b) << 16); }
__device__ __forceinline__ float wave_sum(float v) {
#pragma unroll
    for (int o = 1; o < 64; o <<= 1) v += __shfl_xor(v, o);
    return v;
}
__device__ __forceinline__ float wave_max(float v) {
#pragma unroll
    for (int o = 1; o < 64; o <<= 1) v = fmaxf(v, __shfl_xor(v, o));
    return v;
}
__device__ __forceinline__ float sigmoid_f(float x) { return 1.0f / (1.0f + __expf(-x)); }
__device__ __forceinline__ float siluf(float x) { return x * sigmoid_f(x); }
__device__ __forceinline__ float readlane_f(float v, int k) { return __builtin_bit_cast(float, __builtin_amdgcn_readlane(__builtin_bit_cast(int, v), k)); }
#define XB_TMO      128
#define XB_XCNT(j)  (256  + 64 * (j))
#define XB_XSUB(j)  (1280 + 64 * (j))
#define XB_XGEN(j)  (2304 + 64 * (j))
#define XB_TOP      3328
#define XB_TOPGEN   3392
#define XCD_BAR_WORDS 3456
#define XB_SPIN_CAP (1u << 18)

__device__ __forceinline__ unsigned xb_ld(unsigned* p)              { return __hip_atomic_load(p, __ATOMIC_RELAXED, __HIP_MEMORY_SCOPE_AGENT); }
__device__ __forceinline__ unsigned xb_add(unsigned* p, unsigned v) { return __hip_atomic_fetch_add(p, v, __ATOMIC_RELAXED, __HIP_MEMORY_SCOPE_AGENT); }
__device__ __forceinline__ unsigned xb_xcc_id() { return (unsigned)__builtin_amdgcn_s_getreg((3 << 11) | 20) & 0xFu; }
#define XB_SPIN(cond, bar) do { unsigned _sp = 0; while (cond) { __builtin_amdgcn_s_sleep(1); \
    if ((++_sp & 255u) == 0u) { if (xb_ld(&(bar)[XB_TMO])) break; if (_sp > XB_SPIN_CAP) { atomicAdd(&(bar)[XB_TMO], 1u); break; } } } } while (0)

struct XcdBarrier {
    unsigned* bar; unsigned x;
    volatile LAS unsigned* st;
};

__device__ __forceinline__ XcdBarrier xcd_barrier_post(unsigned* bar, volatile LAS unsigned* st) {
    XcdBarrier b; b.bar = bar; b.x = xb_xcc_id(); b.st = st;
    if (threadIdx.x == 0) (void)xb_add(&bar[XB_XCNT(b.x)], 1u);
    return b;
}
__device__ __forceinline__ void xcd_barrier_complete(unsigned* bar, unsigned x, unsigned& nloc, unsigned& nx) {
    const unsigned G = gridDim.x * gridDim.y * gridDim.z;
    unsigned sum, cnt, mine, sp = 0u;
    for (;;) {
        sum = 0u; cnt = 0u; mine = 0u;
#pragma unroll
        for (unsigned j = 0; j < 16; ++j) { const unsigned c = xb_ld(&bar[XB_XCNT(j)]); sum += c; cnt += (c > 0u) ? 1u : 0u; mine = (j == x) ? c : mine; }
        if (sum == G) break;
        __builtin_amdgcn_s_sleep(1);
        if ((++sp & 255u) == 0u) { if (xb_ld(&bar[XB_TMO])) break; if (sp > XB_SPIN_CAP) { atomicAdd(&bar[XB_TMO], 1u); break; } }
    }
    nloc = mine > 0u ? mine : 1u; nx = cnt > 0u ? cnt : 1u;
}

__device__ __forceinline__ void xcd_barrier(const XcdBarrier& b) {
    asm volatile("s_waitcnt vmcnt(0)" ::: "memory");
    __syncthreads();
    if (threadIdx.x == 0) {
        unsigned* bar = b.bar;
        __builtin_amdgcn_s_waitcnt(0);
        unsigned nloc = b.st[0], nx = b.st[1];
        if (nloc == 0u) { xcd_barrier_complete(bar, b.x, nloc, nx); b.st[0] = nloc; b.st[1] = nx; }
        const unsigned old = xb_add(&bar[XB_XSUB(b.x)], 1u);
        const unsigned gen = old / nloc;
        if (old + 1u == (gen + 1u) * nloc) {
            __builtin_amdgcn_fence(__ATOMIC_RELEASE, "agent");
            asm volatile("s_waitcnt vmcnt(0)" ::: "memory");
            const unsigned og = xb_add(&bar[XB_TOP], 1u);
            const unsigned tg = og / nx;
            if (og + 1u == (tg + 1u) * nx) xb_add(&bar[XB_TOPGEN], 1u);
            else XB_SPIN(xb_ld(&bar[XB_TOPGEN]) == tg, bar);
            __builtin_amdgcn_fence(__ATOMIC_ACQUIRE, "agent");
            xb_add(&bar[XB_XGEN(b.x)], 1u);
            asm volatile("s_waitcnt vmcnt(0)" ::: "memory");
        } else {
            XB_SPIN(xb_ld(&bar[XB_XGEN(b.x)]) == gen, bar);
            __builtin_amdgcn_fence(__ATOMIC_ACQUIRE, "agent");
            asm volatile("s_waitcnt vmcnt(0)" ::: "memory");
        }
    }
    __syncthreads();
}
enum { I_XP = 0, I_XS, I_GS, I_GCONV, I_CKV, I_CWIN, I_PT, I_PP, I_PS, I_LNG, I_LNB, I_WUP, I_WDN, I_WG, I_WPJ, I_AWIN, I_ALNG, I_ALNB, I_AWS, I_ABS, I_AWOUT,
       I_BWIN, I_BCONV, I_BALOG, I_BDT, I_BNG, I_BWOUT, I_CWIN_W, I_CGB, I_CPE, I_CW1, I_CW2, I_CWOUT, I_T5, N_IN };
struct Ctx {
    LAS unsigned char* lds; unsigned char* ws; float* out; const float* const* in;
    int tid, lane, wave, G, gw, NGW;
};
#define WSF(off) ((float*)(c.ws + (off)))
#define WSB(off) ((bf16*)(c.ws + (off)))

__device__ __forceinline__ void tr_item(const float* W, int K, int N, bf16* WT, int mode, LAS float* scr, int item, int lane) {
    const int nblk = (N + 31) >> 5, kb = item / nblk, nb = item - kb * nblk, k0 = 64 * kb, n0 = 32 * nb;
    const int nn = n0 + (lane & 31); const bool ok = nn < N;
#pragma unroll 8
    for (int i = 0; i < 32; ++i) { const int kk = 2 * i + (lane >> 5); scr[kk * 33 + (lane & 31)] = ok ? W[(size_t)(k0 + kk) * N + nn] : 0.f; }
    LDS_WAIT(); asm volatile("" ::: "memory");
    const int cch = lane & 7;
#pragma unroll
    for (int j = 0; j < 4; ++j) { const int nl = (lane >> 3) + 8 * j, n = n0 + nl; const LAS float* s = scr + (8 * cch) * 33 + nl;
        if (n < N) { u32x4 o; o.x = pk2(s[0 * 33], s[1 * 33]); o.y = pk2(s[2 * 33], s[3 * 33]); o.z = pk2(s[4 * 33], s[5 * 33]); o.w = pk2(s[6 * 33], s[7 * 33]);
            int drow = n; if (mode == 1) { const int half = n >= DFF ? 1 : 0, idx = n - half * DFF; drow = (idx >> 7) * 256 + half * 128 + (idx & 127); }
            *(u32x4*)(WT + (size_t)drow * K + k0 + 8 * cch) = o; } }
    LDS_WAIT(); asm volatile("" ::: "memory");
}
__device__ __forceinline__ void prologue_phase(const Ctx& c) {
    LAS float* scr = (LAS float*)(c.lds + c.wave * 16384);
    constexpr int IT_UP = 16 * 176, IT_DN = 44 * 32, IT_G = 16 * 32, IT_P = 4 * 32, IT_AIN = 16 * 128, IT_AOUT = 32 * 32, IT_BIN = 16 * 129, IT_CIN = 16 * 82, IT_C1 = 32 * 8;
    constexpr int NIT = 8 * IT_UP + 8 * IT_DN + 4 * IT_G + 4 * IT_P + 2 * IT_AIN + 2 * IT_AOUT + IT_BIN + IT_G + IT_CIN + IT_G + 2 * IT_C1;
    for (int it = c.gw; it < NIT; it += c.NGW) {
        int r = it, mi;
        if (r < 8 * IT_UP) { mi = r / IT_UP; tr_item(c.in[I_WUP] + (size_t)mi * 1024 * 5632, 1024, 5632, WSB(WS_WUP + mi * SZ_WUP), 1, scr, r - mi * IT_UP, c.lane); continue; } r -= 8 * IT_UP;
        if (r < 8 * IT_DN) { mi = r / IT_DN; tr_item(c.in[I_WDN] + (size_t)mi * 2816 * 1024, 2816, 1024, WSB(WS_WDN + mi * SZ_WDN), 0, scr, r - mi * IT_DN, c.lane); continue; } r -= 8 * IT_DN;
        if (r < 4 * IT_G) { mi = r / IT_G; tr_item(c.in[I_WG] + (size_t)mi * 1024 * 1024, 1024, 1024, WSB(WS_WG + mi * SZ_WG), 0, scr, r - mi * IT_G, c.lane); continue; } r -= 4 * IT_G;
        if (r < 4 * IT_P) { mi = r / IT_P; tr_item(c.in[I_WPJ] + (size_t)mi * 256 * 1024, 256, 1024, WSB(WS_WP + mi * SZ_WP), 0, scr, r - mi * IT_P, c.lane); continue; } r -= 4 * IT_P;
        if (r < 2 * IT_AIN) { mi = r / IT_AIN; tr_item(c.in[I_AWIN] + (size_t)mi * 1024 * 4096, 1024, 4096, WSB(WS_WAIN + mi * SZ_WAIN), 0, scr, r - mi * IT_AIN, c.lane); continue; } r -= 2 * IT_AIN;
        if (r < 2 * IT_AOUT) { mi = r / IT_AOUT; tr_item(c.in[I_AWOUT] + (size_t)mi * 2048 * 1024, 2048, 1024, WSB(WS_WAOUT + mi * SZ_WAOUT), 0, scr, r - mi * IT_AOUT, c.lane); continue; } r -= 2 * IT_AOUT;
        if (r < IT_BIN) { tr_item(c.in[I_BWIN], 1024, NBIN_REAL, WSB(WS_WBIN), 0, scr, r, c.lane); continue; } r -= IT_BIN;
        if (r < IT_G) { tr_item(c.in[I_BWOUT], 1024, 1024, WSB(WS_WBOUT), 0, scr, r, c.lane); continue; } r -= IT_G;
        if (r < IT_CIN) { tr_item(c.in[I_CWIN_W], 1024, NCIN_REAL, WSB(WS_WCIN), 0, scr, r, c.lane); continue; } r -= IT_CIN;
        if (r < IT_G) { tr_item(c.in[I_CWOUT], 1024, 1024, WSB(WS_WCOUT), 0, scr, r, c.lane); continue; } r -= IT_G;
        mi = r / IT_C1; tr_item(c.in[I_CW1] + (size_t)mi * 2048 * 256, 2048, 256, WSB(WS_WC1 + mi * SZ_WC1), 0, scr, r - mi * IT_C1, c.lane);
    }
    for (int r = c.gw; r < (NBIN - NBIN_REAL) + (NCIN - NCIN_REAL); r += c.NGW) {
        bf16* row = r < (NBIN - NBIN_REAL) ? WSB(WS_WBIN) + (size_t)(NBIN_REAL + r) * 1024 : WSB(WS_WCIN) + (size_t)(NCIN_REAL + r - (NBIN - NBIN_REAL)) * 1024;
        const u32x4 z = {0u, 0u, 0u, 0u}; *(u32x4*)(row + c.lane * 8) = z; *(u32x4*)(row + 512 + c.lane * 8) = z; }
    for (int row = c.gw; row < M; row += c.NGW) {
        const float* src = row < MP ? c.in[I_XP] + (size_t)row * 1024 : c.in[I_XS] + (size_t)(row - MP) * 1024;
        float* xd = WSF(WS_X) + (size_t)row * 1024; bf16* xn = WSB(WS_XNB) + (size_t)row * 1024;
#pragma unroll
        for (int j = 0; j < 4; ++j) { const f32x4 v = *((const f32x4*)src + c.lane + 64 * j); *((f32x4*)xd + c.lane + 64 * j) = v; u32x2 w; w.x = pk2(v.x, v.y); w.y = pk2(v.z, v.w); *((u32x2*)xn + c.lane + 64 * j) = w; }
    }
    for (int r = c.gw; r < 4 * M; r += c.NGW) {
        const int l = r / M, row = r - l * M;
        const float* src = row < MP ? c.in[I_PP] + ((size_t)l * MP + row) * 256 : c.in[I_PS] + ((size_t)l * MS + (row - MP)) * 256;
        const f32x4 v = *((const f32x4*)src + c.lane); u32x2 w; w.x = pk2(v.x, v.y); w.y = pk2(v.z, v.w); *((u32x2*)(WSB(WS_PBF) + (size_t)r * 256) + c.lane) = w;
    }
}
__device__ __forceinline__ void ln_phase(const Ctx& c, const float* g, const float* b) {
    f32x4 gv[4], bv[4];
#pragma unroll
    for (int j = 0; j < 4; ++j) { gv[j] = *((const f32x4*)g + c.lane + 64 * j); bv[j] = *((const f32x4*)b + c.lane + 64 * j); }
    for (int row = c.gw; row < M; row += c.NGW) {
        const f32x4* p = (const f32x4*)(WSF(WS_PRE) + (size_t)row * 1024) + c.lane;
        f32x4 v[4]; float s = 0.f;
#pragma unroll
        for (int j = 0; j < 4; ++j) { v[j] = p[64 * j]; s += (v[j].x + v[j].y) + (v[j].z + v[j].w); }
        const float mean = wave_sum(s) * (1.f / 1024.f); float s2 = 0.f;
#pragma unroll
        for (int j = 0; j < 4; ++j) { v[j] = v[j] - mean; s2 += (v[j].x * v[j].x + v[j].y * v[j].y) + (v[j].z * v[j].z + v[j].w * v[j].w); }
        const float rstd = 1.f / sqrtf(wave_sum(s2) * (1.f / 1024.f) + LN_EPS);
        float* xd = WSF(WS_X) + (size_t)row * 1024; bf16* xn = WSB(WS_XN) + (size_t)row * 1024;
#pragma unroll
        for (int j = 0; j < 4; ++j) { const f32x4 y = v[j] * rstd * gv[j] + bv[j]; *((f32x4*)xd + c.lane + 64 * j) = y; u32x2 w; w.x = pk2(y.x, y.y); w.y = pk2(y.z, y.w); *((u32x2*)xn + c.lane + 64 * j) = w; }
    }
}
__device__ __forceinline__ void a_stats_phase(const Ctx& c, int ia) {
    const float* lg = c.in[I_ALNG] + ia * 2048; const float* lb = c.in[I_ALNB] + ia * 2048;
    for (int row = c.gw; row < M; row += c.NGW) {
        const f32x4* p = (const f32x4*)(WSF(WA_V) + (size_t)row * 2048) + c.lane;
        f32x4 v[8]; float s = 0.f;
#pragma unroll
        for (int j = 0; j < 8; ++j) { v[j] = p[64 * j]; s += (v[j].x + v[j].y) + (v[j].z + v[j].w); }
        const float mean = wave_sum(s) * (1.f / 2048.f); float s2 = 0.f;
#pragma unroll
        for (int j = 0; j < 8; ++j) { v[j] = v[j] - mean; s2 += (v[j].x * v[j].x + v[j].y * v[j].y) + (v[j].z * v[j].z + v[j].w * v[j].w); }
        const float rstd = 1.f / sqrtf(wave_sum(s2) * (1.f / 2048.f) + LN_EPS);
        if (c.lane == 0) { WSF(WA_ST)[2 * row] = mean; WSF(WA_ST)[2 * row + 1] = rstd; }
        if (row >= MP) { float* o = c.out + O_AV + ((size_t)ia * MS + (row - MP)) * 2048;
#pragma unroll
            for (int j = 0; j < 8; ++j) { const f32x4 gg = *((const f32x4*)lg + c.lane + 64 * j), bb = *((const f32x4*)lb + c.lane + 64 * j); *((f32x4*)o + c.lane + 64 * j) = v[j] * rstd * gg + bb; } }
    }
}
__device__ __forceinline__ void a_sgu_phase(const Ctx& c, int ia) {
    LAS float* vn = (LAS float*)c.lds;
    LAS float* wT = vn + 128 * 128;
    const float* ws = c.in[I_AWS] + (size_t)ia * 16 * 128 * 128; const float* bs = c.in[I_ABS] + ia * 16 * 128;
    const float* lg = c.in[I_ALNG] + ia * 2048; const float* lb = c.in[I_ALNB] + ia * 2048;
    const float* V = WSF(WA_V); const float* ST = WSF(WA_ST); const bf16* U = WSB(WA_U); bf16* US = WSB(WA_US);
    for (int unit = blockIdx.x; unit < 2048 + DB; unit += c.G) {
        if (unit < 2048) {
            const int g = unit & 15, n = (unit >> 4) & 31, b = unit >> 9, rowbase = b * SEQ + n * 128;
            __syncthreads();
            for (int idx = c.tid; idx < 4096; idx += 512) { const int s = idx >> 5, c4 = idx & 31, row = rowbase + s;
                const f32x4 v = *(const f32x4*)(V + (size_t)row * 2048 + g * 128 + c4 * 4); const float mean = ST[2 * row], rstd = ST[2 * row + 1];
                const f32x4 gg = *(const f32x4*)(lg + g * 128 + c4 * 4), bb = *(const f32x4*)(lb + g * 128 + c4 * 4);
                *(LAS f32x4*)(vn + s * 128 + c4 * 4) = (v - mean) * rstd * gg + bb; }
            for (int idx = c.tid; idx < 4096; idx += 512) { const int t = idx >> 5, s4 = idx & 31; const f32x4 w = *(const f32x4*)(ws + ((size_t)g * 128 + t) * 128 + s4 * 4); const int pt = (t & 3) * 32 + (t >> 2);
#pragma unroll
                for (int k = 0; k < 4; ++k) { const int s = 4 * s4 + k; wT[s * 128 + pt] = (s <= t) ? w[k] : 0.f; } }
            __syncthreads();
            const int d = c.tid & 127, tq = c.tid >> 7;
            float acc[32];
#pragma unroll
            for (int i = 0; i < 32; ++i) acc[i] = 0.f;
            for (int s = 0; s < 128; ++s) { const float v = vn[s * 128 + d];
#pragma unroll
                for (int i4 = 0; i4 < 8; ++i4) { const f32x4 w4 = *(const LAS f32x4*)(wT + s * 128 + tq * 32 + 4 * i4);
                    acc[4 * i4 + 0] += w4.x * v; acc[4 * i4 + 1] += w4.y * v; acc[4 * i4 + 2] += w4.z * v; acc[4 * i4 + 3] += w4.w * v; } }
#pragma unroll
            for (int i = 0; i < 32; ++i) { const int t = tq + 4 * i; const size_t o = (size_t)(rowbase + t) * 2048 + g * 128 + d;
                US[o] = (bf16)f2bf((acc[i] + bs[g * 128 + t]) * bf2f(U[o])); }
        } else {
            const int sb = unit - 2048, c0 = c.tid * 4, g = c0 >> 7;
            const f32x4 gg = *(const f32x4*)(lg + c0), bb = *(const f32x4*)(lb + c0);
            f32x4 vnr[4];
#pragma unroll
            for (int t = 0; t < 4; ++t) { const int row = MP + 4 * sb + t; const f32x4 v = *(const f32x4*)(V + (size_t)row * 2048 + c0); vnr[t] = (v - ST[2 * row]) * ST[2 * row + 1] * gg + bb; }
#pragma unroll
            for (int t = 0; t < 4; ++t) { const int row = MP + 4 * sb + t; f32x4 sv = {0.f, 0.f, 0.f, 0.f};
#pragma unroll
                for (int s = 0; s <= t; ++s) sv += vnr[s] * ws[((size_t)g * 128 + t) * 128 + s];
                sv += bs[g * 128 + t];
                const u32x2 uu = *(const u32x2*)(U + (size_t)row * 2048 + c0);
                f32x4 y; y.x = sv.x * bf2f((bf16)(uu.x & 0xffff)); y.y = sv.y * bf2f((bf16)(uu.x >> 16)); y.z = sv.z * bf2f((bf16)(uu.y & 0xffff)); y.w = sv.w * bf2f((bf16)(uu.y >> 16));
                u32x2 w; w.x = pk2(y.x, y.y); w.y = pk2(y.z, y.w); *(u32x2*)(US + (size_t)row * 2048 + c0) = w; }
        }
    }
}
__device__ __forceinline__ void gdn_prep_phase(const Ctx& c) {
    const float* PJ = WSF(WB_PROJ); const float* cw = c.in[I_BCONV]; const float* alog = c.in[I_BALOG]; const float* dtb = c.in[I_BDT];
    float* GW = WSF(WB_W); float* GU = WSF(WB_U); float* GQG = WSF(WB_QG); float* GKD = WSF(WB_KD); float* GQK = WSF(WB_QK); float* GEG = WSF(WB_EG);
    for (int unit = blockIdx.x; unit < 2048 + 1024; unit += c.G) {
        __syncthreads();
        LAS float* lb = (LAS float*)c.lds; asm volatile("" : "+v"(lb));
        LAS float* qf = lb; LAS float* kf = qf + 64 * 129; LAS float* vf = kf + 64 * 129; LAS float* Am = vf + 64 * 129; LAS float* gc = Am + 64 * 65; LAS float* bt = gc + 64;
        if (unit < 2048) {
            const int ci = unit & 63, h = (unit >> 6) & 7, b = unit >> 9, rb = b * SEQ + ci * 64;
            if (c.tid < 64) { const size_t row = rb + c.tid; const float bl = PJ[row * NBIN + 4096 + h], al = PJ[row * NBIN + 4104 + h];
                const float x = al + dtb[h]; const float sp = x > 20.f ? x : log1pf(expf(x)); float g = -expf(alog[h]) * sp;
#pragma unroll
                for (int o = 1; o < 64; o <<= 1) { const float t = __shfl_up(g, o); if (c.lane >= o) g += t; }
                gc[c.tid] = g; bt[c.tid] = sigmoid_f(bl); }
#pragma unroll 1
            for (int i = 0; i < 8; ++i) { const int tk = c.wave * 8 + i, tabs = ci * 64 + tk; const size_t row = rb + tk;
#pragma unroll
                for (int part = 0; part < 3; ++part) { const int ch = part * 1024 + h * 128 + 2 * c.lane; float a0 = 0.f, a1 = 0.f;
#pragma unroll
                    for (int j = 0; j < 4; ++j) { if (tabs - 3 + j >= 0) { const f32x2 x = *(const f32x2*)(PJ + (row - 3 + j) * NBIN + ch); const f32x2 w = *(const f32x2*)(cw + j * 3072 + ch); a0 += x.x * w.x; a1 += x.y * w.y; } }
                    a0 = siluf(a0); a1 = siluf(a1);
                    if (part < 2) { const float ss = wave_sum(a0 * a0 + a1 * a1); const float sc = (1.f / sqrtf(ss + NORM_EPS)) * (part == 0 ? 0.08838834764831845f : 1.f); a0 *= sc; a1 *= sc; }
                    LAS float* dst = (part == 0 ? qf : (part == 1 ? kf : vf)) + tk * 129 + 2 * c.lane; dst[0] = a0; dst[1] = a1; } }
            __syncthreads();
            { const int j = c.lane, ig = c.wave; float kk[8], qk[8];
#pragma unroll
              for (int ii = 0; ii < 8; ++ii) { kk[ii] = 0.f; qk[ii] = 0.f; }
              for (int d = 0; d < 128; ++d) { const float kj = kf[j * 129 + d];
#pragma unroll
                  for (int ii = 0; ii < 8; ++ii) { kk[ii] += kf[(ig * 8 + ii) * 129 + d] * kj; qk[ii] += qf[(ig * 8 + ii) * 129 + d] * kj; } }
#pragma unroll
              for (int ii = 0; ii < 8; ++ii) { const int i = ig * 8 + ii; const float dec = (i >= j) ? expf(gc[i] - gc[j]) : 0.f;
                  Am[i * 65 + j] = (i > j) ? bt[i] * kk[ii] * dec : 0.f; GQK[((size_t)unit * 64 + i) * 64 + j] = (i >= j) ? qk[ii] * dec : 0.f; } }
            __syncthreads();
            if (c.tid < 256) { const bool isw = c.tid >= 128; const int cc = c.tid & 127; float x[64]; float* dst = (isw ? GW : GU) + (size_t)unit * 64 * 128 + cc;
#pragma unroll
                for (int i = 0; i < 64; ++i) { float r = isw ? kf[i * 129 + cc] * bt[i] * expf(gc[i]) : vf[i * 129 + cc] * bt[i];
#pragma unroll
                    for (int j = 0; j < i; ++j) r -= Am[i * 65 + j] * x[j];
                    x[i] = r; dst[i * 128] = r; } }
            for (int idx = c.tid; idx < 64 * 128; idx += 512) { const int cc = idx >> 7, dk = idx & 127;
                GQG[(size_t)unit * 8192 + idx] = qf[cc * 129 + dk] * expf(gc[cc]); GKD[(size_t)unit * 8192 + idx] = kf[cc * 129 + dk] * expf(gc[63] - gc[cc]); }
            if (c.tid == 0) GEG[unit] = expf(gc[63]);
        } else {
            const int su = unit - 2048, h = su & 7, b = su >> 3;
            LAS float* q4 = lb; LAS float* k4 = q4 + 512; LAS float* v4 = k4 + 512; LAS float* red = v4 + 512; LAS float* o4 = red + 512; LAS float* g4 = o4 + 512; LAS float* b4 = g4 + 4;
            const float* cst = c.in[I_GCONV] + (size_t)b * 3 * 3072;
            { const int t = c.tid >> 7, chl = c.tid & 127;
#pragma unroll
              for (int part = 0; part < 3; ++part) { const int ch = part * 1024 + h * 128 + chl; float a = 0.f;
#pragma unroll
                  for (int j = 0; j < 4; ++j) { const int mm = t + j; const float x = mm < 3 ? cst[mm * 3072 + ch] : PJ[(size_t)(MP + 4 * b + mm - 3) * NBIN + ch]; a += x * cw[j * 3072 + ch]; }
                  (part == 0 ? q4 : (part == 1 ? k4 : v4))[t * 128 + chl] = siluf(a); }
              if (c.tid < 4) { const size_t row = MP + 4 * b + c.tid; const float bl = PJ[row * NBIN + 4096 + h], al = PJ[row * NBIN + 4104 + h];
                  const float x = al + dtb[h]; const float sp = x > 20.f ? x : log1pf(expf(x)); g4[c.tid] = -expf(alog[h]) * sp; b4[c.tid] = sigmoid_f(bl); } }
            __syncthreads();
            { const int t = c.tid >> 7, chl = c.tid & 127; float sq = 0.f, sk = 0.f;
              for (int d = 0; d < 128; ++d) { const float a = q4[t * 128 + d], bb = k4[t * 128 + d]; sq += a * a; sk += bb * bb; }
              const float qv = q4[t * 128 + chl] * (1.f / sqrtf(sq + NORM_EPS)) * 0.08838834764831845f, kv = k4[t * 128 + chl] * (1.f / sqrtf(sk + NORM_EPS));
              __syncthreads();
              q4[t * 128 + chl] = qv; k4[t * 128 + chl] = kv; }
            __syncthreads();
            const int dv = c.tid & 127, part = c.tid >> 7;
            float S[32];
            const float* S0 = c.in[I_GS] + (((size_t)b * 8 + h) * 128 + part * 32) * 128 + dv;
#pragma unroll
            for (int i = 0; i < 32; ++i) S[i] = S0[(size_t)i * 128];
#pragma unroll 1
            for (int t = 0; t < 4; ++t) { const float a = expf(g4[t]); float p = 0.f;
#pragma unroll
                for (int i = 0; i < 32; ++i) p += k4[t * 128 + part * 32 + i] * S[i];
                red[part * 128 + dv] = p; __syncthreads();
                const float kS = (red[dv] + red[128 + dv]) + (red[256 + dv] + red[384 + dv]); const float vnew = b4[t] * (v4[t * 128 + dv] - a * kS); float po = 0.f;
#pragma unroll
                for (int i = 0; i < 32; ++i) { S[i] = a * S[i] + k4[t * 128 + part * 32 + i] * vnew; po += q4[t * 128 + part * 32 + i] * S[i]; }
                __syncthreads(); red[part * 128 + dv] = po; __syncthreads();
                if (part == 0) o4[t * 128 + dv] = (red[dv] + red[128 + dv]) + (red[256 + dv] + red[384 + dv]);
                __syncthreads(); }
            float* So = c.out + O_GSS + (((size_t)b * 8 + h) * 128 + part * 32) * 128 + dv;
#pragma unroll
            for (int i = 0; i < 32; ++i) So[(size_t)i * 128] = S[i];
            { const int t = c.tid >> 7; float ms = 0.f;
              for (int d = 0; d < 128; ++d) { const float o = o4[t * 128 + d]; ms += o * o; }
              const size_t row = MP + 4 * b + t; const float z = PJ[row * NBIN + 3072 + h * 128 + dv];
              const float y = o4[t * 128 + dv] * (1.f / sqrtf(ms * (1.f / 128.f) + NORM_EPS)) * c.in[I_BNG][dv] * siluf(z);
              WSB(WB_OG)[row * 1024 + h * 128 + dv] = (bf16)f2bf(y); }
        }
    }
    for (size_t idx = (size_t)blockIdx.x * 512 + c.tid; idx < 36864 + 1179648; idx += (size_t)c.G * 512) {
        if (idx < 36864) { const int b = (int)(idx / 9216), r = (int)(idx % 9216), j = r / 3072, ch = r % 3072; c.out[O_GCP + idx] = PJ[((size_t)b * SEQ + SEQ - 3 + j) * NBIN + ch]; }
        else { const size_t k = idx - 36864; const int b = (int)(k / 9216), r = (int)(k % 9216), j = r / 3072, ch = r % 3072; c.out[O_GCS + k] = PJ[((size_t)MP + 4 * b + 1 + j) * NBIN + ch]; }
    }
}
__device__ __forceinline__ void gdn_scan_phase(const Ctx& c) {
    LAS float* Wl = (LAS float*)c.lds; LAS float* Ql = Wl + 64 * 132; LAS float* Kl = Ql + 64 * 132; LAS float* QKl = Kl + 64 * 128; LAS float* Sl = QKl + 64 * 65; LAS float* VN = Sl + 128 * 16; LAS float* Ul = VN + 64 * 16;
    const float* GW = WSF(WB_W); const float* GU = WSF(WB_U); const float* GQG = WSF(WB_QG); const float* GKD = WSF(WB_KD); const float* GQK = WSF(WB_QK); const float* GEG = WSF(WB_EG);
    float* GO = WSF(WB_O);
    for (int unit = blockIdx.x; unit < 256; unit += c.G) {
        const int dvs = unit & 7, h = (unit >> 3) & 7, b = unit >> 6;
        const int dv = c.tid & 15, cg = c.tid >> 4;
        __syncthreads();
        for (int i = c.tid; i < 128 * 16; i += 512) Sl[i] = 0.f;
        for (int ci = 0; ci < 64; ++ci) {
            const size_t pu = ((size_t)b * 8 + h) * 64 + ci;
            __syncthreads();
#pragma unroll
            for (int k = 0; k < 4; ++k) { const int idx = c.tid + 512 * k, r = idx >> 5, c4 = idx & 31;
                *(LAS f32x4*)(Wl + r * 132 + 4 * c4) = *(const f32x4*)(GW + pu * 8192 + idx * 4); *(LAS f32x4*)(Ql + r * 132 + 4 * c4) = *(const f32x4*)(GQG + pu * 8192 + idx * 4);
                *(LAS f32x4*)(Kl + r * 128 + 4 * c4) = *(const f32x4*)(GKD + pu * 8192 + idx * 4); }
#pragma unroll
            for (int k = 0; k < 8; ++k) { const int idx = c.tid + 512 * k, r = idx >> 6, j = idx & 63; QKl[r * 65 + j] = GQK[pu * 4096 + idx]; }
#pragma unroll
            for (int k = 0; k < 2; ++k) { const int idx = c.tid + 512 * k, r = idx >> 4, j = idx & 15; Ul[r * 16 + j] = GU[pu * 8192 + r * 128 + dvs * 16 + j]; }
            const float eg = GEG[pu];
            __syncthreads();
            float qs[2];
#pragma unroll
            for (int e = 0; e < 2; ++e) { const int cc = cg + 32 * e; float ws = 0.f, q = 0.f;
                for (int dk = 0; dk < 128; ++dk) { const float s = Sl[dk * 16 + dv]; ws += Wl[cc * 132 + dk] * s; q += Ql[cc * 132 + dk] * s; }
                VN[cc * 16 + dv] = Ul[cc * 16 + dv] - ws; qs[e] = q; }
            __syncthreads();
#pragma unroll
            for (int e = 0; e < 2; ++e) { const int cc = cg + 32 * e; float o = qs[e];
                for (int j = 0; j <= cc; ++j) o += QKl[cc * 65 + j] * VN[j * 16 + dv];
                GO[((size_t)b * SEQ + ci * 64 + cc) * 1024 + h * 128 + dvs * 16 + dv] = o; }
#pragma unroll
            for (int e = 0; e < 4; ++e) { const int dk = cg + 32 * e; float s = Sl[dk * 16 + dv] * eg;
                for (int c2 = 0; c2 < 64; ++c2) s += Kl[c2 * 128 + dk] * VN[c2 * 16 + dv];
                Sl[dk * 16 + dv] = s; }
        }
        __syncthreads();
        for (int i = c.tid; i < 128 * 16; i += 512) { const int dk = i >> 4, j = i & 15; c.out[O_GSP + (((size_t)b * 8 + h) * 128 + dk) * 128 + dvs * 16 + j] = Sl[i]; }
    }
}
__device__ __forceinline__ void gdn_post_phase(const Ctx& c) {
    const float* GO = WSF(WB_O); const float* PJ = WSF(WB_PROJ); const float* ng = c.in[I_BNG];
    for (int row = c.gw; row < MP; row += c.NGW) {
        const f32x4* p = (const f32x4*)(GO + (size_t)row * 1024 + c.lane * 16); f32x4 v[4]; float s = 0.f;
#pragma unroll
        for (int j = 0; j < 4; ++j) { v[j] = p[j]; s += (v[j].x * v[j].x + v[j].y * v[j].y) + (v[j].z * v[j].z + v[j].w * v[j].w); }
        s += __shfl_xor(s, 1); s += __shfl_xor(s, 2); s += __shfl_xor(s, 4);
        const float r = 1.f / sqrtf(s * (1.f / 128.f) + NORM_EPS);
        const f32x4* zp = (const f32x4*)(PJ + (size_t)row * NBIN + 3072 + c.lane * 16); const f32x4* gp = (const f32x4*)(ng + (c.lane & 7) * 16);
        u32x2* op = (u32x2*)(WSB(WB_OG) + (size_t)row * 1024 + c.lane * 16);
#pragma unroll
        for (int j = 0; j < 4; ++j) { const f32x4 z = zp[j], g = gp[j]; f32x4 y; y.x = v[j].x * r * g.x * siluf(z.x); y.y = v[j].y * r * g.y * siluf(z.y); y.z = v[j].z * r * g.z * siluf(z.z); y.w = v[j].w * r * g.w * siluf(z.w);
            u32x2 w; w.x = pk2(y.x, y.y); w.y = pk2(y.z, y.w); op[j] = w; }
    }
}
__device__ const unsigned char T5_LUT[128] = {0, 1, 2, 3, 4, 5, 6, 7, 8, 9, 10, 11, 12, 13, 14, 15, 16, 16, 16, 17, 17, 18, 18, 18, 19, 19, 19, 20, 20, 20, 20, 21, 21, 21, 21, 22, 22, 22, 22, 22, 23, 23, 23, 23, 23, 23, 24, 24, 24, 24, 24, 24, 25, 25, 25, 25, 25, 25, 25, 26, 26, 26, 26, 26, 26, 26, 26, 27, 27, 27, 27, 27, 27, 27, 27, 27, 27, 28, 28, 28, 28, 28, 28, 28, 28, 28, 28, 29, 29, 29, 29, 29, 29, 29, 29, 29, 29, 29, 29, 30, 30, 30, 30, 30, 30, 30, 30, 30, 30, 30, 30, 30, 30, 31, 31, 31, 31, 31, 31, 31, 31, 31, 31, 31, 31, 31, 31, 31};
__device__ __forceinline__ void nsa_prep_phase(const Ctx& c) {
    const float* PJ = WSF(WC_PROJ);
    for (size_t i4 = (size_t)blockIdx.x * 512 + c.tid; i4 < (size_t)M * 256; i4 += (size_t)c.G * 512) { const size_t row = i4 >> 8; const int c4 = (int)(i4 & 255);
        const f32x4 v = *(const f32x4*)(PJ + row * NCIN + 1024 + c4 * 4);
        if (row < MP) *(f32x4*)(c.out + O_KVP + row * 1024 + c4 * 4) = v; else *(f32x4*)(c.out + O_KVS + (row - MP) * 1024 + c4 * 4) = v; }
    for (size_t i4 = (size_t)blockIdx.x * 512 + c.tid; i4 < (size_t)(2048 + MS) * 128; i4 += (size_t)c.G * 512) { const size_t r = i4 >> 7; const int c4 = (int)(i4 & 127);
        const size_t row = r < 2048 ? (r >> 9) * SEQ + (SEQ - 512) + (r & 511) : MP + (r - 2048);
        const f32x4 v = *(const f32x4*)(PJ + row * NCIN + 2048 + c4 * 4);
        if (r < 2048) *(f32x4*)(c.out + O_WINP + r * 512 + c4 * 4) = v; else *(f32x4*)(c.out + O_WINS + (r - 2048) * 512 + c4 * 4) = v; }
    { LAS bf16* vt = (LAS bf16*)c.lds;
      bf16* KSB = WSB(WC_KSB); bf16* VST = WSB(WC_VST); bf16* KWB = WSB(WC_KWB); bf16* VWT = WSB(WC_VWT);
      for (int u = blockIdx.x; u < 256; u += c.G) { const int b = u >> 6, tb = u & 63; const size_t row0 = (size_t)b * SEQ + 64 * tb;
          __syncthreads();
          for (int idx = c.tid; idx < 64 * 256; idx += 512) { const int t = idx >> 8, q = idx & 255, sect = q >> 6, c4 = q & 63;
              const f32x4 v = *(const f32x4*)(PJ + (row0 + t) * NCIN + 1536 + sect * 256 + c4 * 4); u32x2 w; w.x = pk2(v.x, v.y); w.y = pk2(v.z, v.w);
              const int g = c4 >> 4, d = (c4 & 15) * 4;
              if (sect == 0) *(u32x2*)(KSB + (((size_t)(b * 4 + g) * SEQ + 64 * tb + t) * 64 + d)) = w;
              else if (sect == 2) *(u32x2*)(KWB + (((size_t)(b * 4 + g) * SEQ + 64 * tb + t) * 64 + d)) = w;
              else *(LAS u32x2*)(vt + t * 520 + (sect == 1 ? 0 : 256) + c4 * 4) = w; }
          __syncthreads();
          for (int idx = c.tid; idx < 512 * 8; idx += 512) { const int col = idx >> 3, ch = idx & 7; unsigned short e[8];
#pragma unroll
              for (int k = 0; k < 8; ++k) e[k] = vt[(8 * ch + k) * 520 + col];
              u32x4 w; w.x = e[0] | ((unsigned)e[1] << 16); w.y = e[2] | ((unsigned)e[3] << 16); w.z = e[4] | ((unsigned)e[5] << 16); w.w = e[6] | ((unsigned)e[7] << 16);
              const int cc = col & 255, g = cc >> 6, d = cc & 63; bf16* dst = (col < 256 ? VST : VWT) + ((size_t)(b * 4 + g) * 64 + d) * SEQ + 64 * tb + 8 * ch;
              *(u32x4*)dst = w; } }
      __syncthreads(); }
    bf16* AC = WSB(WC_ACMP); const float* pe = c.in[I_CPE]; const int* pt = (const int*)c.in[I_PT]; const float* ckv = c.in[I_CKV];
    for (int R = c.gw; R < 2 * CMP_ROWS; R += c.NGW) {
        const int which = R >= CMP_ROWS ? 1 : 0, r = R - which * CMP_ROWS;
        const float* src; size_t lstride;
        if (r < 2048) { const int g = r & 3, n = (r >> 2) & 127, b = r >> 9; src = PJ + ((size_t)b * SEQ + 32 * n) * NCIN + 1024 + which * 256 + g * 64; lstride = NCIN; }
        else { const int q = r - 2048, g = q & 3, n = (q >> 2) & 63, b = q >> 8; const int page = pt[b * 16 + (n >> 2)];
            src = ckv + (((size_t)page * 128 + (n & 3) * 32) * 16 + which * 4 + g) * 64; lstride = 1024; }
#pragma unroll
        for (int k = 0; k < 8; ++k) { const int idx = c.lane + 64 * k, l = idx >> 4, d4 = idx & 15;
            const f32x4 v = *(const f32x4*)(src + (size_t)l * lstride + d4 * 4) + *(const f32x4*)(pe + (which * 32 + l) * 64 + d4 * 4);
            u32x2 w; w.x = pk2(v.x, v.y); w.y = pk2(v.z, v.w); *(u32x2*)(AC + (size_t)R * 2048 + l * 64 + d4 * 4) = w; }
    }
}
__device__ __forceinline__ void nsa_cmp2_phase(const Ctx& c) {
    LAS float* w2 = (LAS float*)c.lds;
    __syncthreads();
    for (int i = c.tid; i < 2 * 256 * 64 / 4; i += 512) *(LAS f32x4*)(w2 + 4 * i) = *((const f32x4*)c.in[I_CW2] + i);
    __syncthreads();
    const bf16* HC = WSB(WC_HC); float* KCV = WSF(WC_KCV);
    for (int R = c.gw; R < 2 * CMP_ROWS; R += c.NGW) {
        const LAS float* w = w2 + (R >= CMP_ROWS ? 256 * 64 : 0) + c.lane; const u32x4* hp = (const u32x4*)(HC + (size_t)R * 256); float a = 0.f;
#pragma unroll 4
        for (int k8 = 0; k8 < 32; ++k8) { const u32x4 hv = hp[k8]; const unsigned hw[4] = {hv.x, hv.y, hv.z, hv.w};
#pragma unroll
            for (int j = 0; j < 4; ++j) { a += bf2f((bf16)(hw[j] & 0xffff)) * w[(8 * k8 + 2 * j) * 64]; a += bf2f((bf16)(hw[j] >> 16)) * w[(8 * k8 + 2 * j + 1) * 64]; } }
        KCV[(size_t)R * 64 + c.lane] = a;
        { const int which = R >= CMP_ROWS ? 1 : 0, r = R - which * CMP_ROWS;
          if (r < 2048) { const int g = r & 3, n = (r >> 2) & 127, b = r >> 9; if (which == 0) WSB(WC_KCB)[((size_t)(b * 4 + g) * 128 + n) * 64 + c.lane] = (bf16)f2bf(a); else WSB(WC_VCT)[((size_t)(b * 4 + g) * 64 + c.lane) * 128 + n] = (bf16)f2bf(a); } }
    }
}
struct AttSt { float m[4], l[4]; f32x4 o[4]; };
__device__ __forceinline__ void att_reset(AttSt& s) {
#pragma unroll
    for (int h = 0; h < 4; ++h) { s.m[h] = -1e30f; s.l[h] = 0.f; s.o[h] = (f32x4){0.f, 0.f, 0.f, 0.f}; } }
__device__ __forceinline__ void att_scores(const LAS float* qs, const LAS float* tabl, const float* kptr, bool valid, int dist, int g, float (&s)[4]) {
    const f32x4* kp = (const f32x4*)kptr;
    s[0] = s[1] = s[2] = s[3] = 0.f;
#pragma unroll 1
    for (int c4 = 0; c4 < 4; ++c4) {
        f32x4 kv[4];
#pragma unroll
        for (int u = 0; u < 4; ++u) kv[u] = kp[c4 * 4 + u];
#pragma unroll
        for (int u = 0; u < 4; ++u)
#pragma unroll
            for (int h = 0; h < 4; ++h) { const f32x4 q = *(const LAS f32x4*)(qs + h * 64 + (c4 * 4 + u) * 4); s[h] += (q.x * kv[u].x + q.y * kv[u].y) + (q.z * kv[u].z + q.w * kv[u].w); } }
    const int dd = dist < 0 ? 0 : dist; const int bk = dd < 128 ? (int)T5_LUT[dd] : 31;
    const f32x4 bias = *(const LAS f32x4*)(tabl + bk * 16 + g * 4);
#pragma unroll
    for (int h = 0; h < 4; ++h) s[h] = valid ? s[h] + bias[h] : -1e30f;
}
__device__ __forceinline__ void att_pv(AttSt& st, LAS f32x4* P, LAS unsigned long long* R, const float (&p)[4], const float* rowp, int voff, int lane) {
    P[lane] = (f32x4){p[0], p[1], p[2], p[3]}; R[lane] = (unsigned long long)rowp;
    LDS_WAIT();
#pragma unroll 8
    for (int i = 0; i < 16; ++i) { const int key = 4 * i + (lane >> 4); const f32x4 p4 = P[key]; const float* rp = (const float*)R[key];
        const f32x4 v = *(const f32x4*)(rp + voff + (lane & 15) * 4);
        st.o[0] += v * p4.x; st.o[1] += v * p4.y; st.o[2] += v * p4.z; st.o[3] += v * p4.w; }
    LDS_WAIT();
}
__device__ __forceinline__ void att_block(AttSt& st, const LAS float* qs, const LAS float* tabl, LAS f32x4* P, LAS unsigned long long* R, const float* kptr, const float* safe, bool valid, int dist, int voff, int g, int lane) {
    const float* rowp = valid ? kptr : safe; float s[4], p[4];
    att_scores(qs, tabl, rowp, valid, dist, g, s);
#pragma unroll
    for (int h = 0; h < 4; ++h) { const float mx = wave_max(s[h]), mn = fmaxf(st.m[h], mx), sc = __expf(st.m[h] - mn); p[h] = valid ? __expf(s[h] - mn) : 0.f;
        st.l[h] = st.l[h] * sc + wave_sum(p[h]); st.o[h] *= sc; st.m[h] = mn; }
    att_pv(st, P, R, p, rowp, voff, lane);
}
__device__ __forceinline__ void att_finish(AttSt& st, const float (&gate)[4], f32x4 (&acc)[4]) {
#pragma unroll
    for (int h = 0; h < 4; ++h) { f32x4 o = st.o[h];
#pragma unroll
        for (int k = 0; k < 4; ++k) { o[k] += __shfl_xor(o[k], 16); o[k] += __shfl_xor(o[k], 32); }
        const float inv = st.l[h] > 0.f ? gate[h] / st.l[h] : 0.f; acc[h] += o * inv; }
}
__device__ __forceinline__ void nsa_attn_phase(const Ctx& c, const int item0) {
    LAS float* tabl = (LAS float*)c.lds;
    LAS float* qs = tabl + 512 + c.wave * 768;
    LAS f32x4* P = (LAS f32x4*)(qs + 256); LAS unsigned long long* R = (LAS unsigned long long*)(qs + 512); LAS float* pcs = qs + 640;
    __syncthreads();
    for (int i = c.tid; i < 512; i += 512) tabl[i] = c.in[I_T5][i];
    __syncthreads();
    const float* PJ = WSF(WC_PROJ); const float* KCV = WSF(WC_KCV); const float* gb = c.in[I_CGB]; const int* pt = (const int*)c.in[I_PT]; const float* ckv = c.in[I_CKV]; const float* cwin = c.in[I_CWIN];
    bf16* OA = WSB(WC_OA);
    for (int item = item0 + c.gw; item < 65536 + 2048; item += c.NGW) {
        int lane = c.lane; asm volatile("" : "+v"(lane));
        const bool smp = item >= 65536; int b, g, t, qpos, ncmp, nslc; size_t row;
        if (!smp) { g = item & 3; b = (item >> 2) & 3; t = item >> 4; qpos = t; row = (size_t)b * SEQ + t; ncmp = 128; nslc = 64; }
        else { const int q = item - 65536; g = q & 3; t = (q >> 2) & 3; b = q >> 4; qpos = 2048 + t; row = (size_t)MP + 4 * b + t; ncmp = 64; nslc = 33; }
        const float* qrow = PJ + row * NCIN;
        { const f32x4 qv = *(const f32x4*)(qrow + g * 256 + lane * 4); *(LAS f32x4*)(qs + lane * 4) = qv * 0.125f; }
        float gv = 0.f; if (lane < 12) { const int gi = (lane >> 2) * 16 + g * 4 + (lane & 3); gv = sigmoid_f(qrow[2560 + gi] + gb[gi]); }
        float gate_c[4], gate_s[4], gate_w[4];
#pragma unroll
        for (int h = 0; h < 4; ++h) { gate_c[h] = readlane_f(gv, h); gate_s[h] = readlane_f(gv, 4 + h); gate_w[h] = readlane_f(gv, 8 + h); }
        LDS_WAIT();
        f32x4 acc[4];
#pragma unroll
        for (int h = 0; h < 4; ++h) acc[h] = (f32x4){0.f, 0.f, 0.f, 0.f};
        AttSt st;
        float ps;
        { const size_t kc0 = smp ? (size_t)2048 + ((size_t)b * 64) * 4 + g : ((size_t)b * 128) * 4 + g;
          const float* safe = KCV; float s0[4], s1[4];
          const int n0 = lane, n1 = lane + 64; const int d0 = qpos - (32 * n0 + 31), d1 = qpos - (32 * n1 + 31);
          const bool v0 = n0 < ncmp && d0 >= 0, v1 = n1 < ncmp && d1 >= 0;
          const float* k0p = v0 ? KCV + (kc0 + 4 * (size_t)n0) * 64 : safe; const float* k1p = v1 ? KCV + (kc0 + 4 * (size_t)n1) * 64 : safe;
          att_scores(qs, tabl, k0p, v0, d0, g, s0); att_scores(qs, tabl, k1p, v1, d1, g, s1);
          att_reset(st); float p0[4], p1[4], pc0 = 0.f, pc1 = 0.f;
#pragma unroll
          for (int h = 0; h < 4; ++h) { const float mx = wave_max(fmaxf(s0[h], s1[h])); p0[h] = v0 ? __expf(s0[h] - mx) : 0.f; p1[h] = v1 ? __expf(s1[h] - mx) : 0.f;
              const float l = wave_sum(p0[h] + p1[h]); const float inv = l > 0.f ? 1.f / l : 0.f; p0[h] *= inv; p1[h] *= inv; pc0 += p0[h]; pc1 += p1[h]; st.l[h] = l > 0.f ? 1.f : 0.f; }
          att_pv(st, P, R, p0, k0p, CMP_ROWS * 64, lane); att_pv(st, P, R, p1, k1p, CMP_ROWS * 64, lane);
          att_finish(st, gate_c, acc);
          pcs[lane] = pc0; pcs[64 + lane] = pc1; LDS_WAIT();
          ps = (2 * lane + 1 < ncmp) ? pcs[2 * lane] + pcs[2 * lane + 1] : 0.f; LDS_WAIT(); }
        const int jq = qpos >> 6; unsigned long long sel;
        { const bool forced = (lane == 0) || (lane == jq) || (lane == jq - 1);
          float sc = forced ? 100.f : (lane > jq ? -1.f : ps); if (lane >= nslc) sc = -__builtin_inff();
          int cnt = 0;
#pragma unroll 4
          for (int k = 0; k < 64; ++k) { const float sk = readlane_f(sc, k); cnt += (sk > sc || (sk == sc && k < lane)) ? 1 : 0; }
          sel = __ballot(cnt < 16); }
        att_reset(st);
        { const float* safe = qrow + 1536;
          unsigned long long todo = sel & (jq >= 63 ? ~0ull : ((1ull << (jq + 1)) - 1ull));
          while (todo) { const int j = __builtin_ctzll(todo); todo &= todo - 1ull;
              const int kpos = 64 * j + lane; const bool valid = kpos <= qpos; const float* kptr;
              if (!smp) kptr = PJ + ((size_t)b * SEQ + kpos) * NCIN + 1536 + g * 64;
              else if (j < 32) { const int page = pt[b * 16 + (j >> 1)]; kptr = ckv + (((size_t)page * 128 + (j & 1) * 64 + lane) * 16 + 8 + g) * 64; }
              else kptr = PJ + ((size_t)MP + 4 * b + (lane & 3)) * NCIN + 1536 + g * 64;
              att_block(st, qs, tabl, P, R, kptr, safe, valid, qpos - kpos, 256, g, lane); } }
        att_finish(st, gate_s, acc);
        att_reset(st);
        { const float* safe = qrow + 2048;
          for (int cb = 0; cb < 8; ++cb) { const int kpos = qpos - 511 + 64 * cb + lane; if (qpos - 511 + 64 * cb + 63 < 0) continue;
              const bool valid = kpos >= 0; const float* kptr;
              if (!smp) kptr = PJ + ((size_t)b * SEQ + (valid ? kpos : 0)) * NCIN + 2048 + g * 64;
              else if (kpos < 2048) kptr = cwin + (((size_t)b * 512 + (kpos - 1536)) * 2) * 256 + g * 64;
              else kptr = PJ + ((size_t)MP + 4 * b + (kpos - 2048)) * NCIN + 2048 + g * 64;
              att_block(st, qs, tabl, P, R, kptr, safe, valid, qpos - kpos, 256, g, lane); } }
        att_finish(st, gate_w, acc);
        if (lane < 16) {
#pragma unroll
            for (int h = 0; h < 4; ++h) { u32x2 w; w.x = pk2(acc[h].x, acc[h].y); w.y = pk2(acc[h].z, acc[h].w); *(u32x2*)(OA + row * 1024 + (g * 4 + h) * 64 + lane * 4) = w; } }
    }
}
typedef short bf16x8_t __attribute__((ext_vector_type(8)));
#define MFMA16(a, b, cc) __builtin_amdgcn_mfma_f32_16x16x32_bf16((a), (b), (cc), 0, 0, 0)
constexpr int AT_ROWB = 144;
constexpr int AT_KB = 0, AT_VB = 2 * 64 * AT_ROWB, AT_PS = 4 * 64 * AT_ROWB, AT_SEL = AT_PS + 4 * 64 * 64 * 4, AT_BIAS = AT_SEL + 512, AT_END = AT_BIAS + 16 * 128 * 4;
static_assert(AT_END <= MISC_OFF, "attention LDS map");
struct AtRegs { u32x4 k, v; };
__device__ __forceinline__ AtRegs at_load(const bf16* kbase, const bf16* vbase, int vpitch, int tid) {
    AtRegs r; r.k = *(const u32x4*)(kbase + tid * 8); r.v = *(const u32x4*)(vbase + (size_t)(tid >> 3) * vpitch + (tid & 7) * 8); return r; }
__device__ __forceinline__ void at_store(LAS unsigned char* L, int buf, const AtRegs& r, int tid) {
    *(LAS u32x4*)(L + AT_KB + buf * 64 * AT_ROWB + (tid >> 3) * AT_ROWB + (tid & 7) * 16) = r.k; *(LAS u32x4*)(L + AT_VB + buf * 64 * AT_ROWB + (tid >> 3) * AT_ROWB + (tid & 7) * 16) = r.v; }
__device__ __forceinline__ void at_qk(LAS unsigned char* L, int buf, const bf16x8_t (&qf)[2][2], f32x4 (&st)[4][2], int fr, int rq) {
#pragma unroll
    for (int mb = 0; mb < 4; ++mb) { st[mb][0] = (f32x4){0.f, 0.f, 0.f, 0.f}; st[mb][1] = (f32x4){0.f, 0.f, 0.f, 0.f}; }
#pragma unroll
    for (int s = 0; s < 2; ++s)
#pragma unroll
        for (int mb = 0; mb < 4; ++mb) { const bf16x8_t kf = *(const LAS bf16x8_t*)(L + AT_KB + buf * 64 * AT_ROWB + (16 * mb + fr) * AT_ROWB + (32 * s + 8 * rq) * 2);
            st[mb][0] = MFMA16(kf, qf[0][s], st[mb][0]); st[mb][1] = MFMA16(kf, qf[1][s], st[mb][1]); }
}
__device__ __forceinline__ void at_pv(LAS unsigned char* L, int buf, const f32x4 (&st)[4][2], f32x4 (&ot)[4][2], int fr, int rq) {
#pragma unroll
    for (int s = 0; s < 2; ++s) { bf16x8_t pf[2];
#pragma unroll
        for (int nb = 0; nb < 2; ++nb) { u32x4 w; w.x = pk2(st[2 * s][nb].x, st[2 * s][nb].y); w.y = pk2(st[2 * s][nb].z, st[2 * s][nb].w); w.z = pk2(st[2 * s + 1][nb].x, st[2 * s + 1][nb].y); w.w = pk2(st[2 * s + 1][nb].z, st[2 * s + 1][nb].w);
            pf[nb] = __builtin_bit_cast(bf16x8_t, w); }
#pragma unroll
        for (int mb = 0; mb < 4; ++mb) { const LAS unsigned char* vp = L + AT_VB + buf * 64 * AT_ROWB + (16 * mb + fr) * AT_ROWB + (32 * s + 4 * rq) * 2;
            u32x4 w; const u32x2 lo = *(const LAS u32x2*)vp, hi = *(const LAS u32x2*)(vp + 32); w.x = lo.x; w.y = lo.y; w.z = hi.x; w.w = hi.y; const bf16x8_t vf = __builtin_bit_cast(bf16x8_t, w);
            ot[mb][0] = MFMA16(vf, pf[0], ot[mb][0]); ot[mb][1] = MFMA16(vf, pf[1], ot[mb][1]); } }
}
template <int MODE> __device__ __forceinline__ void at_softmax(f32x4 (&st)[4][2], f32x4 (&ot)[4][2], float (&m)[2], float (&l)[2], const bool (&rowok)[2], float cb, const LAS float* bias_h, int dist0  , int wlim) {
#pragma unroll
    for (int nb = 0; nb < 2; ++nb) { float mx = -1e30f;
#pragma unroll
        for (int mb = 0; mb < 4; ++mb)
#pragma unroll
            for (int i = 0; i < 4; ++i) { float s;
                if (MODE == 0) s = rowok[nb] ? st[mb][nb][i] + cb : -1e30f;
                else { const int dist = dist0 + 16 * nb - 16 * mb - i; const bool ok = rowok[nb] && dist >= 0 && dist < wlim; const int dd = dist < 0 ? 0 : (dist > 127 ? 127 : dist); const float bv = bias_h[dd]; s = ok ? st[mb][nb][i] + bv : -1e30f; }
                st[mb][nb][i] = s; mx = fmaxf(mx, s); }
        mx = fmaxf(mx, __shfl_xor(mx, 16)); mx = fmaxf(mx, __shfl_xor(mx, 32));
        const float mn = fmaxf(m[nb], mx), sc = __expf(m[nb] - mn); float ls = 0.f;
#pragma unroll
        for (int mb = 0; mb < 4; ++mb)
#pragma unroll
            for (int i = 0; i < 4; ++i) { const float s = st[mb][nb][i]; const float pe = __expf(s - mn); const float p = s > -1e29f ? pe : 0.f; st[mb][nb][i] = p; ls += p; }
        l[nb] = l[nb] * sc + ls; m[nb] = mn;
#pragma unroll
        for (int mb = 0; mb < 4; ++mb) ot[mb][nb] *= sc; }
}
template <bool ADD> __device__ __forceinline__ void at_finish(f32x4 (&ot)[4][2], float (&l)[2], const float (&gate)[2], LAS f32x4* park, int lane) {
#pragma unroll
    for (int nb = 0; nb < 2; ++nb) { float Ls = l[nb]; Ls += __shfl_xor(Ls, 16); Ls += __shfl_xor(Ls, 32); const float inv = Ls > 0.f ? gate[nb] / Ls : 0.f;
#pragma unroll
        for (int mb = 0; mb < 4; ++mb) { f32x4 v = ot[mb][nb] * inv; if (ADD) v += park[(mb * 2 + nb) * 64 + lane]; ot[mb][nb] = v; } }
}
__device__ __forceinline__ void at_park(const f32x4 (&ot)[4][2], LAS f32x4* park, int lane) {
#pragma unroll
    for (int nb = 0; nb < 2; ++nb)
#pragma unroll
        for (int mb = 0; mb < 4; ++mb) park[(mb * 2 + nb) * 64 + lane] = ot[mb][nb];
}
__device__ __forceinline__ void nsa_attn_prompt_phase(const Ctx& c) {
    const float* PJ = WSF(WC_PROJ); const float* gb = c.in[I_CGB]; bf16* OA = WSB(WC_OA);
    const bf16* KSB = WSB(WC_KSB); const bf16* VST = WSB(WC_VST); const bf16* KWB = WSB(WC_KWB); const bf16* VWT = WSB(WC_VWT); const bf16* KCB = WSB(WC_KCB); const bf16* VCT = WSB(WC_VCT);
    __syncthreads();
    { LAS float* bt = (LAS float*)(c.lds + AT_BIAS);
      for (int i = c.tid; i < 16 * 128; i += 512) { const int h = i >> 7, d = i & 127; bt[i] = c.in[I_T5][(int)T5_LUT[d] * 16 + h]; } }
    __syncthreads();
    for (int u = blockIdx.x; u < 1024; u += c.G) {
        LAS unsigned char* L = c.lds; asm volatile("" : "+v"(L));
        int tid = c.tid; asm volatile("" : "+v"(tid));
        const int lane = tid & 63, fr = lane & 15, rq = lane >> 4, w = c.wave, hg = w >> 1, tq0 = (w & 1) * 32;
        const int bg = (u & 255) >> 4, r16 = u & 15, k4 = u >> 8, qb = k4 == 0 ? r16 : (k4 == 1 ? 31 - r16 : (k4 == 2 ? 32 + r16 : 63 - r16)), b = bg >> 2, g = bg & 3, h = g * 4 + hg;
        const LAS float* bias_h = (const LAS float*)(L + AT_BIAS) + h * 128; const float cb = bias_h[127];
        LAS float* PS = (LAS float*)(L + AT_PS); LAS unsigned long long* SEL = (LAS unsigned long long*)(L + AT_SEL);
        bf16x8_t qf[2][2]; float gate_c[2], gate_s[2], gate_w[2]; size_t row[2];
#pragma unroll
        for (int nb = 0; nb < 2; ++nb) { row[nb] = (size_t)b * SEQ + 64 * qb + tq0 + 16 * nb + fr; const float* qr = PJ + row[nb] * NCIN;
#pragma unroll
            for (int s = 0; s < 2; ++s) { const f32x4 a = *(const f32x4*)(qr + h * 64 + 32 * s + 8 * rq) * 0.125f, bq = *(const f32x4*)(qr + h * 64 + 32 * s + 8 * rq + 4) * 0.125f;
                u32x4 wv; wv.x = pk2(a.x, a.y); wv.y = pk2(a.z, a.w); wv.z = pk2(bq.x, bq.y); wv.w = pk2(bq.z, bq.w); qf[nb][s] = __builtin_bit_cast(bf16x8_t, wv); }
            gate_c[nb] = sigmoid_f(qr[2560 + h] + gb[h]); gate_s[nb] = sigmoid_f(qr[2576 + h] + gb[16 + h]); gate_w[nb] = sigmoid_f(qr[2592 + h] + gb[32 + h]); }
        f32x4 ot[4][2], st[4][2]; float m[2], l[2]; bool rowok[2] = {true, true};
        LAS f32x4* park = (LAS f32x4*)(L + AT_PS) + w * 512;
#pragma unroll
        for (int mb = 0; mb < 4; ++mb) { ot[mb][0] = (f32x4){0.f, 0.f, 0.f, 0.f}; ot[mb][1] = (f32x4){0.f, 0.f, 0.f, 0.f}; }
        const int tl0 = 64 * qb + tq0 + fr;
        { __syncthreads();
          const AtRegs r0 = at_load(KCB + (size_t)bg * 128 * 64, VCT + (size_t)bg * 64 * 128, 128, tid), r1 = at_load(KCB + ((size_t)bg * 128 + 64) * 64, VCT + (size_t)bg * 64 * 128 + 64, 128, tid);
          at_store(L, 0, r0, tid); at_store(L, 1, r1, tid);
          __syncthreads();
          float cm[2] = {-1e30f, -1e30f}, cl[2] = {0.f, 0.f};
#pragma unroll
          for (int cc = 0; cc < 2; ++cc) { at_qk(L, cc, qf, st, fr, rq);
#pragma unroll
              for (int nb = 0; nb < 2; ++nb) { float mx = -1e30f; const int t = tl0 + 16 * nb;
#pragma unroll
                  for (int mb = 0; mb < 4; ++mb)
#pragma unroll
                      for (int i = 0; i < 4; ++i) { const int n = 64 * cc + 16 * mb + 4 * rq + i, dist = t - (32 * n + 31);
                          const float bv = bias_h[dist < 0 ? 0 : (dist > 127 ? 127 : dist)]; const float sv = dist >= 0 ? st[mb][nb][i] + bv : -1e30f; st[mb][nb][i] = sv; mx = fmaxf(mx, sv); }
                  mx = fmaxf(mx, __shfl_xor(mx, 16)); mx = fmaxf(mx, __shfl_xor(mx, 32));
                  const float mn = fmaxf(cm[nb], mx); float ls = 0.f;
#pragma unroll
                  for (int mb = 0; mb < 4; ++mb)
#pragma unroll
                      for (int i = 0; i < 4; ++i) { const float pe = __expf(st[mb][nb][i] - mn); ls += st[mb][nb][i] > -1e29f ? pe : 0.f; }
                  cl[nb] = cl[nb] * __expf(cm[nb] - mn) + ls; cm[nb] = mn; } }
          float cinv[2];
#pragma unroll
          for (int nb = 0; nb < 2; ++nb) { float ls = cl[nb]; ls += __shfl_xor(ls, 16); ls += __shfl_xor(ls, 32); cinv[nb] = ls > 0.f ? 1.f / ls : 0.f; l[nb] = ls > 0.f ? 0.25f : 0.f; }
#pragma unroll
          for (int cc = 0; cc < 2; ++cc) { at_qk(L, cc, qf, st, fr, rq);
#pragma unroll
              for (int nb = 0; nb < 2; ++nb) { const int t = tl0 + 16 * nb; LAS float* psr = PS + ((hg * 64 + tq0 + 16 * nb + fr) * 64 + 2 * rq) + 32 * cc;
#pragma unroll
                  for (int mb = 0; mb < 4; ++mb) {
#pragma unroll
                      for (int i = 0; i < 4; ++i) { const int n = 64 * cc + 16 * mb + 4 * rq + i, dist = t - (32 * n + 31);
                          const float bv = bias_h[dist < 0 ? 0 : (dist > 127 ? 127 : dist)]; const float pe = __expf(fminf(st[mb][nb][i] + bv - cm[nb], 0.f)) * cinv[nb]; st[mb][nb][i] = dist >= 0 ? pe : 0.f; }
                      *(LAS f32x2*)(psr + 8 * mb) = (f32x2){st[mb][nb][0] + st[mb][nb][1], st[mb][nb][2] + st[mb][nb][3]}; } }
              at_pv(L, cc, st, ot, fr, rq); }
          at_finish<false>(ot, l, gate_c, park, lane);
        }
        __syncthreads();
        { for (int i8 = 0; i8 < 8; ++i8) { const int tq = 8 * w + i8; unsigned long long sel;
              if (qb <= 15) sel = (2ull << qb) - 1ull;
              else { const float ps = (PS[(0 * 64 + tq) * 64 + lane] + PS[(1 * 64 + tq) * 64 + lane]) + (PS[(2 * 64 + tq) * 64 + lane] + PS[(3 * 64 + tq) * 64 + lane]);
                  const bool forced = (lane == 0) || (lane == qb) || (lane == qb - 1); const float sc = forced ? 100.f : (lane > qb ? -1.f : ps); int cnt = 0;
#pragma unroll 4
                  for (int k = 0; k < 64; ++k) { const float sk = readlane_f(sc, k); cnt += (sk > sc || (sk == sc && k < lane)) ? 1 : 0; }
                  sel = __ballot(cnt < 16) & ((2ull << qb) - 1ull); }
              if (lane == 0) SEL[tq] = sel; } }
        __syncthreads();
        unsigned long long selm[2], uni;
        { selm[0] = SEL[tq0 + fr]; selm[1] = SEL[tq0 + 16 + fr]; unsigned long long a = SEL[lane];
#pragma unroll
          for (int o = 1; o < 64; o <<= 1) a |= __shfl_xor(a, o);
          uni = a; }
        at_park(ot, park, lane);
#pragma unroll
        for (int mb = 0; mb < 4; ++mb) { ot[mb][0] = (f32x4){0.f, 0.f, 0.f, 0.f}; ot[mb][1] = (f32x4){0.f, 0.f, 0.f, 0.f}; }
        m[0] = m[1] = -1e30f; l[0] = l[1] = 0.f;
        { unsigned long long todo = __builtin_amdgcn_readfirstlane((unsigned)uni) | ((unsigned long long)__builtin_amdgcn_readfirstlane((unsigned)(uni >> 32)) << 32);
          int j = __builtin_ctzll(todo), buf = 0;
          AtRegs rg = at_load(KSB + ((size_t)bg * SEQ + 64 * j) * 64, VST + (size_t)bg * 64 * SEQ + 64 * j, SEQ, tid);
          for (;;) { at_store(L, buf, rg, tid); todo &= todo - 1ull; const bool more = todo != 0ull; const int jn = more ? __builtin_ctzll(todo) : 0;
              __syncthreads();
              if (more) rg = at_load(KSB + ((size_t)bg * SEQ + 64 * jn) * 64, VST + (size_t)bg * 64 * SEQ + 64 * jn, SEQ, tid);
              at_qk(L, buf, qf, st, fr, rq);
              rowok[0] = (selm[0] >> j) & 1ull; rowok[1] = (selm[1] >> j) & 1ull;
              if (j + 3 <= qb) at_softmax<0>(st, ot, m, l, rowok, cb, bias_h, 0, 0); else at_softmax<1>(st, ot, m, l, rowok, cb, bias_h, tl0 - (64 * j + 4 * rq), 1 << 30);
              at_pv(L, buf, st, ot, fr, rq);
              if (!more) break; j = jn; buf ^= 1; }
          at_finish<true>(ot, l, gate_s, park, lane); at_park(ot, park, lane); }
        __syncthreads();
#pragma unroll
        for (int mb = 0; mb < 4; ++mb) { ot[mb][0] = (f32x4){0.f, 0.f, 0.f, 0.f}; ot[mb][1] = (f32x4){0.f, 0.f, 0.f, 0.f}; }
        m[0] = m[1] = -1e30f; l[0] = l[1] = 0.f; rowok[0] = rowok[1] = true;
        { int j = qb >= 8 ? qb - 8 : 0, buf = 0;
          AtRegs rg = at_load(KWB + ((size_t)bg * SEQ + 64 * j) * 64, VWT + (size_t)bg * 64 * SEQ + 64 * j, SEQ, tid);
          for (;;) { at_store(L, buf, rg, tid); const bool more = j < qb; const int jn = j + 1;
              __syncthreads();
              if (more) rg = at_load(KWB + ((size_t)bg * SEQ + 64 * jn) * 64, VWT + (size_t)bg * 64 * SEQ + 64 * jn, SEQ, tid);
              at_qk(L, buf, qf, st, fr, rq);
              if (j + 3 <= qb && j + 8 > qb) at_softmax<0>(st, ot, m, l, rowok, cb, bias_h, 0, 0); else at_softmax<1>(st, ot, m, l, rowok, cb, bias_h, tl0 - (64 * j + 4 * rq), 512);
              at_pv(L, buf, st, ot, fr, rq);
              if (!more) break; j = jn; buf ^= 1; }
          at_finish<true>(ot, l, gate_w, park, lane); }
#pragma unroll
        for (int nb = 0; nb < 2; ++nb)
#pragma unroll
            for (int mb = 0; mb < 4; ++mb) { u32x2 wv; wv.x = pk2(ot[mb][nb].x, ot[mb][nb].y); wv.y = pk2(ot[mb][nb].z, ot[mb][nb].w); *(u32x2*)(OA + row[nb] * 1024 + h * 64 + 16 * mb + 4 * rq) = wv; }
    }
}
constexpr int PH_PER_SUB = 9, N_PHASES = 2 + 12 * PH_PER_SUB;
struct Args { const float* in[N_IN]; float* out; unsigned char* ws; int ph_lo, ph_hi, bli, pad; };
__host__ __device__ inline bool phase_exists(int ph) {
    if (ph < 2) return true; const int r = ph - 2, sub3 = r / PH_PER_SUB, slot = r % PH_PER_SUB, L = sub3 / 3, s = sub3 % 3, kind = (L == 1) ? 1 : (L == 2 ? 2 : 0);
    if (slot == 0 || slot == 5 || slot == 6) return true;
    if (slot == 7) return s == 2;
    if (slot == 8) return false;
    if (s != 1) return false;
    if (kind == 0) return slot <= 2; if (kind == 1) return slot <= 3; return true;
}

#ifndef PROBE
#define PROBE 0
#endif
#define TW(cls, ...) do { __VA_ARGS__; if (PROBE == (cls)) { __VA_ARGS__; } } while (0)
#define IN(k) (lo <= (k) && (k) < hi)
#define SEAM(k) do { if (IN(k) && (k) + 1 < hi) xcd_barrier(bar); } while (0)
template <int L, int S> __device__ __forceinline__ void run_sub(const Ctx& c, const XcdBarrier& bar, const int lo, const int hi) {
    constexpr int kind = (L == 1) ? 1 : (L == 2 ? 2 : 0), ia = (L == 3) ? 1 : 0, base = 2 + (3 * L + S) * PH_PER_SUB;
    LAS unsigned char* ring = c.lds;
    if (IN(base)) {
        if constexpr (S != 1) { constexpr int j = S >> 1; pg8::Gemm g{S == 0 ? WSB(WS_XNB) : WSB(WS_XN), WSB(WS_WUP + (size_t)(2 * L + j) * SZ_WUP), M, 5632, 1024}; pg8::StaticOrder So; So.init(M, 5632, c.G, (int)blockIdx.x);
            pg8::EpiGate E{WSB(WS_H), DFF}; TW(1, pg8::gemm_phase<pg8::EpiGate, pg8::StaticOrder, true, true>(ring, g, So, E)); }
        else if constexpr (kind == 0) { pg8::Gemm g{WSB(WS_XN), WSB(WS_WAIN + (size_t)ia * SZ_WAIN), M, 4096, 1024}; pg8::StaticOrder So; So.init(M, 4096, c.G, (int)blockIdx.x);
            pg8::EpiAin E{WSB(WA_U), WSF(WA_V)}; TW(1, pg8::gemm_phase<pg8::EpiAin, pg8::StaticOrder, true, true>(ring, g, So, E)); }
        else { constexpr int N = kind == 1 ? NBIN : NCIN; pg8::Gemm g{WSB(WS_XN), kind == 1 ? WSB(WS_WBIN) : WSB(WS_WCIN), M, N, 1024}; pg8::StaticOrder So; So.init(M, N, c.G, (int)blockIdx.x);
            pg8::EpiF32 E{WSF(WS_MIX), N}; TW(1, pg8::gemm_phase<pg8::EpiF32, pg8::StaticOrder, true, true>(ring, g, So, E)); }
    } SEAM(base);
    if constexpr (S == 1) {
        if (IN(base + 1)) { if constexpr (kind == 0) TW(3, a_stats_phase(c, ia)); else if constexpr (kind == 1) TW(3, gdn_prep_phase(c)); else TW(3, nsa_prep_phase(c)); } SEAM(base + 1);
        if (IN(base + 2)) { if constexpr (kind == 0) TW(3, a_sgu_phase(c, ia)); else if constexpr (kind == 1) TW(3, gdn_scan_phase(c));
            else {
                { pg8::Gemm g{WSB(WC_ACMP), WSB(WS_WC1), CMP_ROWS, 256, 2048}; pg8::StaticOrder So; So.init(CMP_ROWS, 256, c.G, (int)blockIdx.x);
                  pg8::EpiCmp E{WSB(WC_HC)}; TW(1, pg8::gemm_phase<pg8::EpiCmp, pg8::StaticOrder, true, true>(ring, g, So, E)); }
                { pg8::Gemm g{WSB(WC_ACMP) + (size_t)CMP_ROWS * 2048, WSB(WS_WC1 + SZ_WC1), CMP_ROWS, 256, 2048}; pg8::StaticOrder So; So.init(CMP_ROWS, 256, c.G, (int)((blockIdx.x + 128u) % (unsigned)c.G));
                  pg8::EpiCmp E{WSB(WC_HC) + (size_t)CMP_ROWS * 256}; TW(1, pg8::gemm_phase<pg8::EpiCmp, pg8::StaticOrder, true, true>(ring, g, So, E)); } } } SEAM(base + 2);
        if constexpr (kind != 0) { if (IN(base + 3)) { if constexpr (kind == 1) TW(3, gdn_post_phase(c)); else TW(3, nsa_cmp2_phase(c)); } SEAM(base + 3); }
        if constexpr (kind == 2) { if (IN(base + 4)) TW(2, nsa_attn_prompt_phase(c); nsa_attn_phase(c, 65536)); SEAM(base + 4); }
    }
    if (IN(base + 5)) {
        const bf16* A; const bf16* Bt; int K; float sc;
        if constexpr (S != 1) { A = WSB(WS_H); Bt = WSB(WS_WDN + (size_t)(2 * L + (S >> 1)) * SZ_WDN); K = DFF; sc = 0.5f; }
        else if constexpr (kind == 0) { A = WSB(WA_US); Bt = WSB(WS_WAOUT + (size_t)ia * SZ_WAOUT); K = 2048; sc = 1.f; }
        else if constexpr (kind == 1) { A = WSB(WB_OG); Bt = WSB(WS_WBOUT); K = 1024; sc = 1.f; }
        else { A = WSB(WC_OA); Bt = WSB(WS_WCOUT); K = 1024; sc = 1.f; }
        pg8::Gemm g{A, Bt, M, 1024, K}; pg8::StaticOrder So; So.init(M, 1024, c.G, (int)blockIdx.x);
        pg8::EpiResid E{WSF(WS_X), WSF(WS_PRE), ALPHA, sc}; TW(1, pg8::gemm_phase<pg8::EpiResid, pg8::StaticOrder, true, true>(ring, g, So, E));
    } SEAM(base + 5);
    if (IN(base + 6)) { TW(3, ln_phase(c, c.in[I_LNG] + (size_t)(3 * L + S) * 1024, c.in[I_LNB] + (size_t)(3 * L + S) * 1024)); } SEAM(base + 6);
    if constexpr (S == 2) { if (IN(base + 7)) { pg8::Gemm g{WSB(WS_XN), WSB(WS_WG + (size_t)L * SZ_WG), M, 1024, 1024}; pg8::StaticOrder So; So.init(M, 1024, c.G, (int)blockIdx.x);
            pg8::EpiPle E{WSF(WS_X), WSF(WS_PP) + (size_t)L * M * 1024, WSB(WS_XNB), L == 3 ? c.out : nullptr}; pg8::gemm_phase<pg8::EpiPle, pg8::StaticOrder, true, true>(ring, g, So, E); } SEAM(base + 7); }
}
template <int l> __device__ __forceinline__ void ple_proj(const Ctx& c) {
    pg8::Gemm g{WSB(WS_PBF) + (size_t)l * M * 256, WSB(WS_WP + l * SZ_WP), M, 1024, 256}; pg8::StaticOrder So; So.init(M, 1024, c.G, (int)blockIdx.x);
    pg8::EpiF32 E{WSF(WS_PP) + (size_t)l * M * 1024, 1024}; TW(1, pg8::gemm_phase<pg8::EpiF32, pg8::StaticOrder, true, true>(c.lds, g, So, E));
}
__global__ void __launch_bounds__(NWAVES * 64, 2) fwd(Args args) {
    extern __shared__ __attribute__((aligned(16))) unsigned char lds_raw[];
    Ctx c; c.lds = (LAS unsigned char*)lds_raw; c.ws = args.ws; c.out = args.out; c.in = args.in;
    c.tid = threadIdx.x; c.lane = c.tid & 63; c.wave = __builtin_amdgcn_readfirstlane(c.tid >> 6); c.G = gridDim.x; c.gw = blockIdx.x * NWAVES + c.wave; c.NGW = c.G * NWAVES;
    volatile LAS unsigned* MISC = (volatile LAS unsigned*)(c.lds + MISC_OFF);
    for (int u = c.tid; u < 128; u += NWAVES * 64) MISC[u] = 0u;
    __syncthreads();
    unsigned* ctl = (unsigned*)c.ws;
    XcdBarrier bar = xcd_barrier_post(ctl + CW_BAR + args.bli * XCD_BAR_WORDS, MISC + 8);
    const int lo = args.ph_lo, hi = args.ph_hi;
    if (IN(0)) { TW(3, prologue_phase(c)); } SEAM(0);
    if (IN(1)) { ple_proj<0>(c); ple_proj<1>(c); ple_proj<2>(c); ple_proj<3>(c); } SEAM(1);
    run_sub<0, 0>(c, bar, lo, hi); run_sub<0, 1>(c, bar, lo, hi); run_sub<0, 2>(c, bar, lo, hi);
    run_sub<1, 0>(c, bar, lo, hi); run_sub<1, 1>(c, bar, lo, hi); run_sub<1, 2>(c, bar, lo, hi);
    run_sub<2, 0>(c, bar, lo, hi); run_sub<2, 1>(c, bar, lo, hi); run_sub<2, 2>(c, bar, lo, hi);
    run_sub<3, 0>(c, bar, lo, hi); run_sub<3, 1>(c, bar, lo, hi); run_sub<3, 2>(c, bar, lo, hi);
}
#undef IN
#undef SEAM

#ifndef ONE_LAUNCH
#define ONE_LAUNCH 1
#endif
extern "C" void kernel_launch(void* const* d_in, const int* in_sizes, int n_in, void* d_out, int out_size, void* d_ws, size_t ws_size, hipStream_t stream) {
    static int grid = 0;
    if (grid == 0) {
        if (n_in != N_IN || (size_t)out_size != O_END || ws_size < WS_END) { fprintf(stderr, "kernel_launch: unexpected problem: n_in %d out %d ws %zu (need %zu)\n", n_in, out_size, ws_size, (size_t)WS_END); grid = -1; return; }
        int dev = 0, cus = 0, per_cu = 0;
        if (hipGetDevice(&dev) != hipSuccess || hipDeviceGetAttribute(&cus, hipDeviceAttributeMultiprocessorCount, dev) != hipSuccess) { grid = -1; return; }
        if (hipFuncSetAttribute((const void*)fwd, hipFuncAttributeMaxDynamicSharedMemorySize, LDS_BYTES) != hipSuccess) { fprintf(stderr, "kernel_launch: hipFuncSetAttribute failed\n"); grid = -1; return; }
        if (hipOccupancyMaxActiveBlocksPerMultiprocessor(&per_cu, (const void*)fwd, NWAVES * 64, LDS_BYTES) != hipSuccess || per_cu < 1) fprintf(stderr, "kernel_launch: occupancy query says %d\n", per_cu);
        (void)hipGetLastError();
        grid = cus;
    }
    if (grid < 0) return;
    (void)hipMemsetAsync(d_ws, 0, CTL_BYTES, stream);
    Args a{};
    for (int i = 0; i < N_IN; ++i) a.in[i] = (const float*)d_in[i];
    a.out = (float*)d_out; a.ws = (unsigned char*)d_ws; a.pad = 0;
#if ONE_LAUNCH
    a.ph_lo = 0; a.ph_hi = N_PHASES; a.bli = 0;
    hipLaunchKernelGGL(fwd, dim3(grid), dim3(NWAVES * 64), LDS_BYTES, stream, a);
#else
    for (int ph = 0; ph < N_PHASES; ++ph) { if (!phase_exists(ph)) continue; a.ph_lo = ph; a.ph_hi = ph + 1; a.bli = 0;
        hipLaunchKernelGGL(fwd, dim3(grid), dim3(NWAVES * 64), LDS_BYTES, stream, a); }
#endif
}
```

```cpp
#include <hip/hip_runtime.h>
#include <cstdio>
#include <cstdint>
namespace pg8 {
#define PG8_LAS __attribute__((address_space(3)))
typedef unsigned short bf16_t;
typedef short bf16x8 __attribute__((ext_vector_type(8)));
typedef float f32x4 __attribute__((ext_vector_type(4)));
typedef unsigned u32x4 __attribute__((ext_vector_type(4)));
constexpr int BM = 256, BK = 64, HALF = 128, HTB = HALF * BK * 2  , STAGE_BYTES = 8 * HTB, NXCD = 8, WGM = 8;

__host__ __device__ __forceinline__ int lds_byte(int r, int c) { const int st = (r >> 4) * 2 + (c >> 5), rr = r & 15, cc = c & 31, ob = rr * 64 + cc * 2; return st * 1024 + (ob ^ (((ob >> 9) & 1) << 5)); }
__host__ __device__ __forceinline__ void stage_rc(int b, int& R, int& C) { const int st = b / 1024, sb = b % 1024, swz = sb ^ (((sb >> 9) & 1) << 5); R = (st >> 1) * 16 + swz / 64; C = (st & 1) * 32 + (swz % 64) / 2; }
__host__ __device__ __forceinline__ int perm32(int rho) { const int n = rho >> 4, i = rho & 15; return 8 * (i >> 2) + 4 * n + (i & 3); }

struct Unit { int pm, pn; };
struct Gemm { const bf16_t* A; const bf16_t* Bt; int M, N, K; };

struct StaticOrder {
    int nM, nN, nwg, G, c;
    __host__ __device__ void init(int M, int N, int G_, int c_) { nM = M / BM; nN = N / BM; nwg = nM * nN; G = G_; c = c_; }
    __host__ __device__ bool next(int i, Unit& u) const {
        const long L = (long)i * G + c; if (L >= nwg) return false;
        int wgid = (int)L; { const int q = nwg / NXCD, r = nwg % NXCD, xcd = wgid % NXCD, off = wgid / NXCD; wgid = (xcd < r ? xcd * (q + 1) : r * (q + 1) + (xcd - r) * q) + off; }
        const int nig = WGM * nN, gid = wgid / nig, fm = gid * WGM, gsz = (nM - fm) < WGM ? (nM - fm) : WGM;
        u.pm = fm + ((wgid % nig) % gsz); u.pn = (wgid % nig) / gsz; return true;
    }
    __device__ __forceinline__ void a_ready(const Unit&) const {}
    __device__ __forceinline__ void done(const Unit&) const {}
};

__device__ __forceinline__ unsigned cvt_pk_bf16(float lo, float hi) { unsigned r; asm volatile("v_cvt_pk_bf16_f32 %0, %1, %2" : "=v"(r) : "v"(lo), "v"(hi)); return r; }
typedef unsigned u32x2 __attribute__((ext_vector_type(2)));
__device__ __forceinline__ float fast_sigmoid(float x) { return __frcp_rn(1.0f + __expf(-x)); }
__device__ __forceinline__ float silu_f(float x) { return x * fast_sigmoid(x); }
__device__ __forceinline__ float gelu_tanh_f(float x) { const float y = 1.5957691216057308f * (x + 0.044715f * x * x * x); return x * fast_sigmoid(y); }
__device__ __forceinline__ u32x2 pack4(f32x4 v) { u32x2 w; w.x = cvt_pk_bf16(v[0], v[1]); w.y = cvt_pk_bf16(v[2], v[3]); return w; }

struct EpiGate {
    static constexpr bool PERM = false, AFTER_DRAIN = false;
    bf16_t* H; int ldh;
    __device__ __forceinline__ void operator()(const f32x4 (&acc)[2][2][4][2], const Unit& u, int wr, int wc, int fr, int fq) const {
        const int row0 = u.pm * BM + wr * 64 + fr, col0 = u.pn * HALF + wc * 32 + 4 * fq;
#pragma unroll
        for (int ai = 0; ai < 2; ++ai)
#pragma unroll
            for (int m = 0; m < 4; ++m) { bf16_t* rowp = H + (size_t)(row0 + ai * HALF + m * 16) * ldh + col0;
#pragma unroll
                for (int n = 0; n < 2; ++n) { const f32x4 a = acc[ai][0][m][n], b = acc[ai][1][m][n]; f32x4 h;
#pragma unroll
                    for (int j = 0; j < 4; ++j) h[j] = silu_f(a[j]) * b[j];
                    *(u32x2*)(rowp + n * 16) = pack4(h); } }
    }
};
struct EpiResid {
    static constexpr bool PERM = false, AFTER_DRAIN = false;
    const float* X; float* PRE; float alpha, s;
    __device__ __forceinline__ void operator()(const f32x4 (&acc)[2][2][4][2], const Unit& u, int wr, int wc, int fr, int fq) const {
        const int row0 = u.pm * BM + wr * 64 + fr, col0 = u.pn * BM + wc * 32 + 4 * fq;
#pragma unroll
        for (int ai = 0; ai < 2; ++ai)
#pragma unroll
            for (int m = 0; m < 4; ++m) { const size_t off = (size_t)(row0 + ai * HALF + m * 16) * 1024 + col0;
#pragma unroll
                for (int bj = 0; bj < 2; ++bj)
#pragma unroll
                    for (int n = 0; n < 2; ++n) { const f32x4 x = *(const f32x4*)(X + off + bj * HALF + n * 16); *(f32x4*)(PRE + off + bj * HALF + n * 16) = x * alpha + acc[ai][bj][m][n] * s; } }
    }
};
struct EpiF32 {
    static constexpr bool PERM = false, AFTER_DRAIN = false;
    float* C; int ldc;
    __device__ __forceinline__ void operator()(const f32x4 (&acc)[2][2][4][2], const Unit& u, int wr, int wc, int fr, int fq) const {
        const int row0 = u.pm * BM + wr * 64 + fr, col0 = u.pn * BM + wc * 32 + 4 * fq;
#pragma unroll
        for (int ai = 0; ai < 2; ++ai)
#pragma unroll
            for (int m = 0; m < 4; ++m) { float* rowp = C + (size_t)(row0 + ai * HALF + m * 16) * ldc + col0;
#pragma unroll
                for (int bj = 0; bj < 2; ++bj)
#pragma unroll
                    for (int n = 0; n < 2; ++n) *(f32x4*)(rowp + bj * HALF + n * 16) = acc[ai][bj][m][n]; }
    }
};
struct EpiPle {
    static constexpr bool PERM = false, AFTER_DRAIN = false;
    float* X; const float* P; bf16_t* XN; float* OUT;
    __device__ __forceinline__ void operator()(const f32x4 (&acc)[2][2][4][2], const Unit& u, int wr, int wc, int fr, int fq) const {
        const int row0 = u.pm * BM + wr * 64 + fr, col0 = u.pn * BM + wc * 32 + 4 * fq;
#pragma unroll
        for (int ai = 0; ai < 2; ++ai)
#pragma unroll
            for (int m = 0; m < 4; ++m) { const size_t off = (size_t)(row0 + ai * HALF + m * 16) * 1024 + col0;
#pragma unroll
                for (int bj = 0; bj < 2; ++bj)
#pragma unroll
                    for (int n = 0; n < 2; ++n) { const size_t o = off + bj * HALF + n * 16; const f32x4 x = *(const f32x4*)(X + o), p = *(const f32x4*)(P + o), a = acc[ai][bj][m][n]; f32x4 y;
#pragma unroll
                        for (int j = 0; j < 4; ++j) y[j] = x[j] + fast_sigmoid(a[j]) * p[j];
                        *(f32x4*)(X + o) = y; *(u32x2*)(XN + o) = pack4(y); if (OUT) *(f32x4*)(OUT + o) = y; } }
    }
};
struct EpiAin {
    static constexpr bool PERM = false, AFTER_DRAIN = false;
    bf16_t* U; float* V;
    __device__ __forceinline__ void operator()(const f32x4 (&acc)[2][2][4][2], const Unit& u, int wr, int wc, int fr, int fq) const {
        const int row0 = u.pm * BM + wr * 64 + fr; const bool isu = u.pn < 8; const int col0 = (isu ? u.pn : u.pn - 8) * BM + wc * 32 + 4 * fq;
#pragma unroll
        for (int ai = 0; ai < 2; ++ai)
#pragma unroll
            for (int m = 0; m < 4; ++m) { const size_t off = (size_t)(row0 + ai * HALF + m * 16) * 2048 + col0;
#pragma unroll
                for (int bj = 0; bj < 2; ++bj)
#pragma unroll
                    for (int n = 0; n < 2; ++n) { const f32x4 a = acc[ai][bj][m][n]; f32x4 y;
#pragma unroll
                        for (int j = 0; j < 4; ++j) y[j] = gelu_tanh_f(a[j]);
                        if (isu) *(u32x2*)(U + off + bj * HALF + n * 16) = pack4(y); else *(f32x4*)(V + off + bj * HALF + n * 16) = y; } }
    }
};
struct EpiCmp {
    static constexpr bool PERM = false, AFTER_DRAIN = false;
    bf16_t* HC;
    __device__ __forceinline__ void operator()(const f32x4 (&acc)[2][2][4][2], const Unit& u, int wr, int wc, int fr, int fq) const {
        const int row0 = u.pm * BM + wr * 64 + fr, col0 = u.pn * BM + wc * 32 + 4 * fq;
#pragma unroll
        for (int ai = 0; ai < 2; ++ai)
#pragma unroll
            for (int m = 0; m < 4; ++m) { bf16_t* rowp = HC + (size_t)(row0 + ai * HALF + m * 16) * 256 + col0;
#pragma unroll
                for (int bj = 0; bj < 2; ++bj)
#pragma unroll
                    for (int n = 0; n < 2; ++n) { const f32x4 a = acc[ai][bj][m][n]; f32x4 y;
#pragma unroll
                        for (int j = 0; j < 4; ++j) y[j] = gelu_tanh_f(a[j]);
                        *(u32x2*)(rowp + bj * HALF + n * 16) = pack4(y); } }
    }
};
template <class Epi, class Sched, bool ALIGN_EPI = false, bool SP2 = false>
__device__ __forceinline__ void gemm_phase(PG8_LAS unsigned char* lds, const Gemm g, const Sched& S, const Epi& E) {
    const int tid = threadIdx.x, wid = __builtin_amdgcn_readfirstlane(tid >> 6), lane = tid & 63, wr = wid >> 2, wc = wid & 3, fr = lane & 15, fq = lane >> 4;
    const int K = g.K, nt = K / BK;
    unsigned voffA[2], voffB[2];
#pragma unroll
    for (int i = 0; i < 2; ++i) { int R, C; stage_rc(tid * 16 + i * 8192, R, C); const int Rb = Epi::PERM ? ((R & ~31) + perm32(R & 31)) : R;
        voffA[i] = (unsigned)(R * K + C) * 2u; voffB[i] = (unsigned)(Rb * K + C) * 2u; }
    const size_t kstep = (size_t)(BK * 2);
    const size_t hstep = (size_t)HALF * K * 2;
    const size_t tstep = 2 * hstep;
    const unsigned ldsw = (unsigned)wid * 1024u;
    const int aoff = lds_byte(wr * 64 + fr, fq * 8), boff = lds_byte(wc * 32 + fr, fq * 8);
#define PG8_SA(b, h) (((b) * 2 + (h)) * HTB)
#define PG8_SB(b, h) ((4 + (b) * 2 + (h)) * HTB)
#define PG8_STAGE(bufoff, gbase, voff) do { _Pragma("unroll") for (int _i = 0; _i < 2; ++_i) \
        __builtin_amdgcn_global_load_lds((const unsigned*)((const char*)(gbase) + (voff)[_i]), (PG8_LAS unsigned*)(lds + (bufoff) + ldsw + _i * 8192), 16, 0, 0); } while (0)
#define PG8_LDA(dst, b, h) do { _Pragma("unroll") for (int m = 0; m < 4; ++m) _Pragma("unroll") for (int k = 0; k < 2; ++k) dst[m][k] = *(const PG8_LAS bf16x8*)(lds + PG8_SA(b, h) + aoff + m * 2048 + k * 1024); } while (0)
#define PG8_LDB(dst, b, h) do { _Pragma("unroll") for (int n = 0; n < 2; ++n) _Pragma("unroll") for (int k = 0; k < 2; ++k) dst[n][k] = *(const PG8_LAS bf16x8*)(lds + PG8_SB(b, h) + boff + n * 2048 + k * 1024); } while (0)
#define PG8_MMA(ai, bj, At, Bt) do { __builtin_amdgcn_s_setprio(1); _Pragma("unroll") for (int m = 0; m < 4; ++m) _Pragma("unroll") for (int n = 0; n < 2; ++n) _Pragma("unroll") for (int k = 0; k < 2; ++k) \
        acc[ai][bj][m][n] = __builtin_amdgcn_mfma_f32_16x16x32_bf16(Bt[n][k], At[m][k], acc[ai][bj][m][n], 0, 0, 0); __builtin_amdgcn_s_setprio(0); } while (0)
#define PG8_WAIT_V(n) asm volatile("s_waitcnt vmcnt(" #n ")" ::: "memory")
#define PG8_WAIT_L(n) asm volatile("s_waitcnt lgkmcnt(" #n ")" ::: "memory")
#define PG8_BAR __builtin_amdgcn_s_barrier()
#define PG8_SCHED __builtin_amdgcn_sched_barrier(0)
    Unit cur, nxt; int ui = 0;
    if (!S.next(0, cur)) return;
    f32x4 acc[2][2][4][2];
#pragma unroll
    for (int a = 0; a < 2; ++a)
#pragma unroll
        for (int b = 0; b < 2; ++b)
#pragma unroll
            for (int m = 0; m < 4; ++m)
#pragma unroll
                for (int n = 0; n < 2; ++n) acc[a][b][m][n] = (f32x4){0.f, 0.f, 0.f, 0.f};
    bf16x8 At[4][2], B0[2][2], B1[2][2];
    const char* cA = (const char*)g.A + (size_t)cur.pm * tstep; const char* cB = (const char*)g.Bt + (size_t)cur.pn * tstep;
    S.a_ready(cur);
    if constexpr (SP2) {
        PG8_STAGE(PG8_SB(0, 0), cB, voffB); PG8_STAGE(PG8_SB(0, 1), cB + hstep, voffB); PG8_STAGE(PG8_SA(0, 0), cA, voffA); PG8_STAGE(PG8_SA(0, 1), cA + hstep, voffA);
        if (wr == 1) PG8_BAR;
        PG8_WAIT_V(2); PG8_BAR;
        PG8_STAGE(PG8_SB(1, 0), cB + kstep, voffB); PG8_STAGE(PG8_SA(1, 0), cA + kstep, voffA); PG8_STAGE(PG8_SB(1, 1), cB + hstep + kstep, voffB);
        PG8_WAIT_V(6); PG8_BAR;
    } else {
        PG8_STAGE(PG8_SB(0, 0), cB, voffB); PG8_STAGE(PG8_SA(0, 0), cA, voffA); PG8_STAGE(PG8_SB(0, 1), cB + hstep, voffB); PG8_STAGE(PG8_SA(0, 1), cA + hstep, voffA);
        if (wr == 1) PG8_BAR;
        PG8_WAIT_V(4); PG8_BAR;
        PG8_STAGE(PG8_SB(1, 0), cB + kstep, voffB); PG8_STAGE(PG8_SA(1, 0), cA + kstep, voffA); PG8_STAGE(PG8_SB(1, 1), cB + hstep + kstep, voffB);
        PG8_WAIT_V(6); PG8_BAR;
    }
    for (;;) {
        const bool has_next = S.next(ui + 1, nxt);
        const char* nA = has_next ? (const char*)g.A + (size_t)nxt.pm * tstep : cA; const char* nB = has_next ? (const char*)g.Bt + (size_t)nxt.pn * tstep : cB;
        for (int t = 0; t < nt; t += 2) {
            const bool last = (t == nt - 2);
            const char* a1 = cA + (size_t)(t + 1) * kstep;
            const char* a2 = last ? nA : cA + (size_t)(t + 2) * kstep; const char* b2 = last ? nB : cB + (size_t)(t + 2) * kstep;
            const char* a3 = a2 + kstep; const char* b3 = b2 + kstep;
            if (last && has_next) S.a_ready(nxt);
            if constexpr (SP2) {
            PG8_LDB(B0, 0, 0); PG8_LDB(B1, 0, 1); PG8_SCHED; PG8_LDA(At, 0, 0); PG8_STAGE(PG8_SA(1, 1), a1 + hstep, voffA);
            PG8_WAIT_V(8); PG8_WAIT_L(0); PG8_BAR; PG8_MMA(0, 0, At, B0); PG8_MMA(0, 1, At, B1); PG8_BAR; PG8_SCHED;
            PG8_LDA(At, 0, 1); PG8_STAGE(PG8_SB(0, 0), b2, voffB); PG8_STAGE(PG8_SB(0, 1), b2 + hstep, voffB); PG8_STAGE(PG8_SA(0, 0), a2, voffA);
            PG8_WAIT_V(8); PG8_WAIT_L(0); PG8_BAR; PG8_MMA(1, 0, At, B0); PG8_MMA(1, 1, At, B1); PG8_BAR; PG8_SCHED;
            PG8_LDB(B0, 1, 0); PG8_LDB(B1, 1, 1); PG8_SCHED; PG8_LDA(At, 1, 0); PG8_STAGE(PG8_SA(0, 1), a2 + hstep, voffA);
            PG8_WAIT_V(8); PG8_WAIT_L(0); PG8_BAR; PG8_MMA(0, 0, At, B0); PG8_MMA(0, 1, At, B1); PG8_BAR; PG8_SCHED;
            PG8_LDA(At, 1, 1); PG8_STAGE(PG8_SB(1, 0), b3, voffB); PG8_STAGE(PG8_SB(1, 1), b3 + hstep, voffB); PG8_STAGE(PG8_SA(1, 0), a3, voffA);
            PG8_WAIT_V(8); PG8_WAIT_L(0); PG8_BAR; PG8_MMA(1, 0, At, B0); PG8_MMA(1, 1, At, B1); PG8_BAR; PG8_SCHED;
            } else {
            PG8_LDB(B0, 0, 0); PG8_SCHED; PG8_LDA(At, 0, 0); PG8_STAGE(PG8_SA(1, 1), a1 + hstep, voffA);
            PG8_WAIT_L(8); PG8_BAR; PG8_WAIT_L(0); PG8_MMA(0, 0, At, B0); PG8_BAR; PG8_SCHED;
            PG8_LDB(B1, 0, 1); PG8_STAGE(PG8_SB(0, 0), b2, voffB);
            PG8_BAR; PG8_WAIT_L(0); PG8_MMA(0, 1, At, B1); PG8_BAR;
            PG8_LDA(At, 0, 1); PG8_STAGE(PG8_SA(0, 0), a2, voffA);
            PG8_BAR; PG8_WAIT_L(0); PG8_MMA(1, 0, At, B0); PG8_BAR; PG8_SCHED;
            PG8_STAGE(PG8_SB(0, 1), b2 + hstep, voffB);
            PG8_WAIT_V(6); PG8_BAR; PG8_MMA(1, 1, At, B1); PG8_BAR;
            PG8_LDB(B0, 1, 0); PG8_SCHED; PG8_LDA(At, 1, 0); PG8_STAGE(PG8_SA(0, 1), a2 + hstep, voffA);
            PG8_WAIT_L(8); PG8_BAR; PG8_WAIT_L(0); PG8_MMA(0, 0, At, B0); PG8_BAR; PG8_SCHED;
            PG8_LDB(B1, 1, 1); PG8_STAGE(PG8_SB(1, 0), b3, voffB);
            PG8_BAR; PG8_WAIT_L(0); PG8_MMA(0, 1, At, B1); PG8_BAR;
            PG8_LDA(At, 1, 1); PG8_STAGE(PG8_SA(1, 0), a3, voffA);
            PG8_BAR; PG8_WAIT_L(0); PG8_MMA(1, 0, At, B0); PG8_BAR; PG8_SCHED;
            PG8_STAGE(PG8_SB(1, 1), b3 + hstep, voffB);
            PG8_WAIT_V(6); PG8_BAR; PG8_MMA(1, 1, At, B1); PG8_BAR;
            }
        }
        if constexpr (ALIGN_EPI) { if (wr == 0) PG8_BAR; }
        if constexpr (!Epi::AFTER_DRAIN) { E(acc, cur, wr, wc, fr, fq); S.done(cur); }
        if (!has_next) break;
#pragma unroll
        for (int a = 0; a < 2; ++a)
#pragma unroll
            for (int b = 0; b < 2; ++b)
#pragma unroll
                for (int m = 0; m < 4; ++m)
#pragma unroll
                    for (int n = 0; n < 2; ++n) acc[a][b][m][n] = (f32x4){0.f, 0.f, 0.f, 0.f};
        cur = nxt; cA = nA; cB = nB; ++ui;
        if constexpr (ALIGN_EPI) { if (wr == 1) PG8_BAR; }
    }
    PG8_WAIT_V(0);
    if constexpr (!ALIGN_EPI) { if (wr == 0) PG8_BAR; }
    PG8_BAR;
    if constexpr (Epi::AFTER_DRAIN) { E.fused(acc, cur, wr, wc, fr, fq, lds, wid, lane); S.done(cur); }
#undef PG8_SA
#undef PG8_SB
#undef PG8_STAGE
#undef PG8_LDA
#undef PG8_LDB
#undef PG8_MMA
#undef PG8_WAIT_V
#undef PG8_WAIT_L
#undef PG8_BAR
#undef PG8_SCHED
}
}
constexpr int NWAVES = 8;
constexpr int MP = 16384, MS = 512, M = 16896, D = 1024, DFF = 2816, PLE = 256, SEQ = 4096, NB = 4, DB = 128, DSQ = 4;
constexpr int NBIN = 4352, NBIN_REAL = 4112, NCIN = 2816, NCIN_REAL = 2608;
constexpr int CMP_ROWS = 34816;
constexpr float ALPHA = 1.681792830507429f, LN_EPS = 1e-5f, NORM_EPS = 1e-6f;
constexpr size_t O_YP = 0, O_YS = 16777216, O_AV = 17301504, O_GSP = 19398656, O_GCP = 19922944, O_GSS = 19959808, O_GCS = 36737024,
                 O_KVP = 37916672, O_WINP = 54693888, O_KVS = 55742464, O_WINS = 56266752, O_END = 56528896;
constexpr size_t CTL_BYTES = 1u << 20;
constexpr size_t SZ_WUP = (size_t)5632 * 1024 * 2, SZ_WDN = (size_t)1024 * 2816 * 2, SZ_WG = (size_t)1024 * 1024 * 2, SZ_WP = (size_t)1024 * 256 * 2,
                 SZ_WAIN = (size_t)4096 * 1024 * 2, SZ_WAOUT = (size_t)1024 * 2048 * 2, SZ_WBIN = (size_t)NBIN * 1024 * 2, SZ_WCIN = (size_t)NCIN * 1024 * 2, SZ_WC1 = (size_t)256 * 2048 * 2;
constexpr size_t WS_WUP = CTL_BYTES, WS_WDN = WS_WUP + 8 * SZ_WUP, WS_WG = WS_WDN + 8 * SZ_WDN, WS_WP = WS_WG + 4 * SZ_WG, WS_WAIN = WS_WP + 4 * SZ_WP, WS_WAOUT = WS_WAIN + 2 * SZ_WAIN,
                 WS_WBIN = WS_WAOUT + 2 * SZ_WAOUT, WS_WBOUT = WS_WBIN + SZ_WBIN, WS_WCIN = WS_WBOUT + SZ_WG, WS_WCOUT = WS_WCIN + SZ_WCIN, WS_WC1 = WS_WCOUT + SZ_WG;
constexpr size_t WS_X = WS_WC1 + 2 * SZ_WC1;
constexpr size_t WS_XN = WS_X + (size_t)M * 1024 * 4;
constexpr size_t WS_XNB = WS_XN + (size_t)M * 1024 * 2;
constexpr size_t WS_PRE = WS_XNB + (size_t)M * 1024 * 2;
constexpr size_t WS_H = WS_PRE + (size_t)M * 1024 * 4;
constexpr size_t WS_PBF = WS_H + (size_t)M * 2816 * 2;
constexpr size_t WS_PP = WS_PBF + (size_t)4 * M * 256 * 2;
constexpr size_t WS_MIX = WS_PP + (size_t)4 * M * 1024 * 4;
constexpr size_t WA_U = WS_MIX, WA_V = WA_U + (size_t)M * 2048 * 2, WA_US = WA_V + (size_t)M * 2048 * 4, WA_ST = WA_US + (size_t)M * 2048 * 2, WA_END = WA_ST + (size_t)M * 8;
constexpr size_t GUNITS = 2048;
constexpr size_t WB_PROJ = WS_MIX, WB_W = WB_PROJ + (size_t)M * NBIN * 4, WB_U = WB_W + GUNITS * 64 * 128 * 4, WB_QG = WB_U + GUNITS * 64 * 128 * 4, WB_KD = WB_QG + GUNITS * 64 * 128 * 4,
                 WB_QK = WB_KD + GUNITS * 64 * 128 * 4, WB_EG = WB_QK + GUNITS * 64 * 64 * 4, WB_O = WB_EG + 65536, WB_OG = WB_O + (size_t)M * 1024 * 4, WB_END = WB_OG + (size_t)M * 1024 * 2;
constexpr size_t WC_PROJ = WS_MIX, WC_ACMP = WC_PROJ + (size_t)M * NCIN * 4, WC_HC = WC_ACMP + (size_t)2 * CMP_ROWS * 2048 * 2, WC_KCV = WC_HC + (size_t)2 * CMP_ROWS * 256 * 2,
                 WC_OA = WC_KCV + (size_t)2 * CMP_ROWS * 64 * 4, WC_KSB = WC_OA + (size_t)M * 1024 * 2, WC_VST = WC_KSB + (size_t)16 * SEQ * 64 * 2, WC_KWB = WC_VST + (size_t)16 * SEQ * 64 * 2, WC_VWT = WC_KWB + (size_t)16 * SEQ * 64 * 2,
                 WC_KCB = WC_VWT + (size_t)16 * SEQ * 64 * 2, WC_VCT = WC_KCB + (size_t)16 * 128 * 64 * 2, WC_END = WC_VCT + (size_t)16 * 128 * 64 * 2;
constexpr size_t WS_END = (WB_END > WC_END ? (WB_END > WA_END ? WB_END : WA_END) : (WC_END > WA_END ? WC_END : WA_END));
static_assert(WS_X % 256 == 0 && WS_MIX % 256 == 0 && WB_W % 256 == 0 && WC_ACMP % 256 == 0, "alignment");
constexpr int CW_TMO = 0, CW_BAR = 4096;
constexpr int LDS_BYTES = 147456, MISC_OFF = LDS_BYTES - 512;

#define GAS __attribute__((address_space(1)))
#define LAS __attribute__((address_space(3)))
typedef unsigned short bf16;
typedef float f32x4 __attribute__((ext_vector_type(4)));
typedef float f32x2 __attribute__((ext_vector_type(2)));
typedef unsigned u32x2 __attribute__((ext_vector_type(2)));
typedef unsigned u32x4 __attribute__((ext_vector_type(4)));
#define LDS_WAIT() asm volatile("s_waitcnt lgkmcnt(0)" ::: "memory")
__device__ __forceinline__ unsigned f2bf(float f) { unsigned u = __builtin_bit_cast(unsigned, f); return (u + 0x7fffu + ((u >> 16) & 1u)) >> 16; }
__device__ __forceinline__ unsigned pk2(float lo, float hi) { return f2bf(lo) | (f2bf(hi) << 16); }
__device__ __forceinline__ float bf2f(bf16 b) { return __builtin_bit_cast(float, ((unsigned)b) << 16); }
__device__ __forceinline__ float wave_sum(float v) {
#pragma unroll
    for (int o = 1; o < 64; o <<= 1) v += __shfl_xor(v, o);
    return v;
}
__device__ __forceinline__ float wave_max(float v) {
#pragma unroll
    for (int o = 1; o < 64; o <<= 1) v = fmaxf(v, __shfl_xor(v, o));
    return v;
}
__device__ __forceinline__ float sigmoid_f(float x) { return 1.0f / (1.0f + __expf(-x)); }
__device__ __forceinline__ float siluf(float x) { return x * sigmoid_f(x); }
__device__ __forceinline__ float readlane_f(float v, int k) { return __builtin_bit_cast(float, __builtin_amdgcn_readlane(__builtin_bit_cast(int, v), k)); }
typedef short bf16x8_t __attribute__((ext_vector_type(8)));
#define MFMA16(a, b, cc) __builtin_amdgcn_mfma_f32_16x16x32_bf16((a), (b), (cc), 0, 0, 0)
#define XB_TMO      128
#define XB_XCNT(j)  (256  + 64 * (j))
#define XB_XSUB(j)  (1280 + 64 * (j))
#define XB_XGEN(j)  (2304 + 64 * (j))
#define XB_TOP      3328
#define XB_TOPGEN   3392
#define XCD_BAR_WORDS 3456
#define XB_SPIN_CAP (1u << 18)

__device__ __forceinline__ unsigned xb_ld(unsigned* p)              { return __hip_atomic_load(p, __ATOMIC_RELAXED, __HIP_MEMORY_SCOPE_AGENT); }
__device__ __forceinline__ unsigned xb_add(unsigned* p, unsigned v) { return __hip_atomic_fetch_add(p, v, __ATOMIC_RELAXED, __HIP_MEMORY_SCOPE_AGENT); }
__device__ __forceinline__ unsigned xb_xcc_id() { return (unsigned)__builtin_amdgcn_s_getreg((3 << 11) | 20) & 0xFu; }
#define XB_SPIN(cond, bar) do { unsigned _sp = 0; while (cond) { __builtin_amdgcn_s_sleep(1); \
    if ((++_sp & 255u) == 0u) { if (xb_ld(&(bar)[XB_TMO])) break; if (_sp > XB_SPIN_CAP) { atomicAdd(&(bar)[XB_TMO], 1u); break; } } } } while (0)

struct XcdBarrier {
    unsigned* bar; unsigned x;
    volatile LAS unsigned* st;
};

__device__ __forceinline__ XcdBarrier xcd_barrier_post(unsigned* bar, volatile LAS unsigned* st) {
    XcdBarrier b; b.bar = bar; b.x = xb_xcc_id(); b.st = st;
    if (threadIdx.x == 0) (void)xb_add(&bar[XB_XCNT(b.x)], 1u);
    return b;
}
__device__ __forceinline__ void xcd_barrier_complete(unsigned* bar, unsigned x, unsigned& nloc, unsigned& nx) {
    const unsigned G = gridDim.x * gridDim.y * gridDim.z;
    unsigned sum, cnt, mine, sp = 0u;
    for (;;) {
        sum = 0u; cnt = 0u; mine = 0u;
#pragma unroll
        for (unsigned j = 0; j < 16; ++j) { const unsigned c = xb_ld(&bar[XB_XCNT(j)]); sum += c; cnt += (c > 0u) ? 1u : 0u; mine = (j == x) ? c : mine; }
        if (sum == G) break;
        __builtin_amdgcn_s_sleep(1);
        if ((++sp & 255u) == 0u) { if (xb_ld(&bar[XB_TMO])) break; if (sp > XB_SPIN_CAP) { atomicAdd(&bar[XB_TMO], 1u); break; } }
    }
    nloc = mine > 0u ? mine : 1u; nx = cnt > 0u ? cnt : 1u;
}

__device__ __forceinline__ void xcd_barrier(const XcdBarrier& b) {
    asm volatile("s_waitcnt vmcnt(0)" ::: "memory");
    __syncthreads();
    if (threadIdx.x == 0) {
        unsigned* bar = b.bar;
        __builtin_amdgcn_s_waitcnt(0);
        unsigned nloc = b.st[0], nx = b.st[1];
        if (nloc == 0u) { xcd_barrier_complete(bar, b.x, nloc, nx); b.st[0] = nloc; b.st[1] = nx; }
        const unsigned old = xb_add(&bar[XB_XSUB(b.x)], 1u);
        const unsigned gen = old / nloc;
        if (old + 1u == (gen + 1u) * nloc) {
            __builtin_amdgcn_fence(__ATOMIC_RELEASE, "agent");
            asm volatile("s_waitcnt vmcnt(0)" ::: "memory");
            const unsigned og = xb_add(&bar[XB_TOP], 1u);
            const unsigned tg = og / nx;
            if (og + 1u == (tg + 1u) * nx) xb_add(&bar[XB_TOPGEN], 1u);
            else XB_SPIN(xb_ld(&bar[XB_TOPGEN]) == tg, bar);
            __builtin_amdgcn_fence(__ATOMIC_ACQUIRE, "agent");
            xb_add(&bar[XB_XGEN(b.x)], 1u);
            asm volatile("s_waitcnt vmcnt(0)" ::: "memory");
        } else {
            XB_SPIN(xb_ld(&bar[XB_XGEN(b.x)]) == gen, bar);
            __builtin_amdgcn_fence(__ATOMIC_ACQUIRE, "agent");
            asm volatile("s_waitcnt vmcnt(0)" ::: "memory");
        }
    }
    __syncthreads();
}
enum { I_XP = 0, I_XS, I_GS, I_GCONV, I_CKV, I_CWIN, I_PT, I_PP, I_PS, I_LNG, I_LNB, I_WUP, I_WDN, I_WG, I_WPJ, I_AWIN, I_ALNG, I_ALNB, I_AWS, I_ABS, I_AWOUT,
       I_BWIN, I_BCONV, I_BALOG, I_BDT, I_BNG, I_BWOUT, I_CWIN_W, I_CGB, I_CPE, I_CW1, I_CW2, I_CWOUT, I_T5, N_IN };
struct Ctx {
    LAS unsigned char* lds; unsigned char* ws; float* out; const float* const* in;
    int tid, lane, wave, G, gw, NGW;
};
#define WSF(off) ((float*)(c.ws + (off)))
#define WSB(off) ((bf16*)(c.ws + (off)))

__device__ __forceinline__ void tr_item(const float* W, int K, int N, bf16* WT, int mode, LAS float* scr, int item, int lane) {
    const int nblk = (N + 31) >> 5, kb = item / nblk, nb = item - kb * nblk, k0 = 64 * kb, n0 = 32 * nb;
    const int nn = n0 + (lane & 31); const bool ok = nn < N;
#pragma unroll 8
    for (int i = 0; i < 32; ++i) { const int kk = 2 * i + (lane >> 5); scr[kk * 33 + (lane & 31)] = ok ? W[(size_t)(k0 + kk) * N + nn] : 0.f; }
    LDS_WAIT(); asm volatile("" ::: "memory");
    const int cch = lane & 7;
#pragma unroll
    for (int j = 0; j < 4; ++j) { const int nl = (lane >> 3) + 8 * j, n = n0 + nl; const LAS float* s = scr + (8 * cch) * 33 + nl;
        if (n < N) { u32x4 o; o.x = pk2(s[0 * 33], s[1 * 33]); o.y = pk2(s[2 * 33], s[3 * 33]); o.z = pk2(s[4 * 33], s[5 * 33]); o.w = pk2(s[6 * 33], s[7 * 33]);
            int drow = n; if (mode == 1) { const int half = n >= DFF ? 1 : 0, idx = n - half * DFF; drow = (idx >> 7) * 256 + half * 128 + (idx & 127); }
            *(u32x4*)(WT + (size_t)drow * K + k0 + 8 * cch) = o; } }
    LDS_WAIT(); asm volatile("" ::: "memory");
}
__device__ __forceinline__ void prologue_phase(const Ctx& c) {
    LAS float* scr = (LAS float*)(c.lds + c.wave * 16384);
    constexpr int IT_UP = 16 * 176, IT_DN = 44 * 32, IT_G = 16 * 32, IT_P = 4 * 32, IT_AIN = 16 * 128, IT_AOUT = 32 * 32, IT_BIN = 16 * 129, IT_CIN = 16 * 82, IT_C1 = 32 * 8;
    constexpr int NIT = 8 * IT_UP + 8 * IT_DN + 4 * IT_G + 4 * IT_P + 2 * IT_AIN + 2 * IT_AOUT + IT_BIN + IT_G + IT_CIN + IT_G + 2 * IT_C1;
    for (int it = c.gw; it < NIT; it += c.NGW) {
        int r = it, mi;
        if (r < 8 * IT_UP) { mi = r / IT_UP; tr_item(c.in[I_WUP] + (size_t)mi * 1024 * 5632, 1024, 5632, WSB(WS_WUP + mi * SZ_WUP), 1, scr, r - mi * IT_UP, c.lane); continue; } r -= 8 * IT_UP;
        if (r < 8 * IT_DN) { mi = r / IT_DN; tr_item(c.in[I_WDN] + (size_t)mi * 2816 * 1024, 2816, 1024, WSB(WS_WDN + mi * SZ_WDN), 0, scr, r - mi * IT_DN, c.lane); continue; } r -= 8 * IT_DN;
        if (r < 4 * IT_G) { mi = r / IT_G; tr_item(c.in[I_WG] + (size_t)mi * 1024 * 1024, 1024, 1024, WSB(WS_WG + mi * SZ_WG), 0, scr, r - mi * IT_G, c.lane); continue; } r -= 4 * IT_G;
        if (r < 4 * IT_P) { mi = r / IT_P; tr_item(c.in[I_WPJ] + (size_t)mi * 256 * 1024, 256, 1024, WSB(WS_WP + mi * SZ_WP), 0, scr, r - mi * IT_P, c.lane); continue; } r -= 4 * IT_P;
        if (r < 2 * IT_AIN) { mi = r / IT_AIN; tr_item(c.in[I_AWIN] + (size_t)mi * 1024 * 4096, 1024, 4096, WSB(WS_WAIN + mi * SZ_WAIN), 0, scr, r - mi * IT_AIN, c.lane); continue; } r -= 2 * IT_AIN;
        if (r < 2 * IT_AOUT) { mi = r / IT_AOUT; tr_item(c.in[I_AWOUT] + (size_t)mi * 2048 * 1024, 2048, 1024, WSB(WS_WAOUT + mi * SZ_WAOUT), 0, scr, r - mi * IT_AOUT, c.lane); continue; } r -= 2 * IT_AOUT;
        if (r < IT_BIN) { tr_item(c.in[I_BWIN], 1024, NBIN_REAL, WSB(WS_WBIN), 0, scr, r, c.lane); continue; } r -= IT_BIN;
        if (r < IT_G) { tr_item(c.in[I_BWOUT], 1024, 1024, WSB(WS_WBOUT), 0, scr, r, c.lane); continue; } r -= IT_G;
        if (r < IT_CIN) { tr_item(c.in[I_CWIN_W], 1024, NCIN_REAL, WSB(WS_WCIN), 0, scr, r, c.lane); continue; } r -= IT_CIN;
        if (r < IT_G) { tr_item(c.in[I_CWOUT], 1024, 1024, WSB(WS_WCOUT), 0, scr, r, c.lane); continue; } r -= IT_G;
        mi = r / IT_C1; tr_item(c.in[I_CW1] + (size_t)mi * 2048 * 256, 2048, 256, WSB(WS_WC1 + mi * SZ_WC1), 0, scr, r - mi * IT_C1, c.lane);
    }
    for (int r = c.gw; r < (NBIN - NBIN_REAL) + (NCIN - NCIN_REAL); r += c.NGW) {
        bf16* row = r < (NBIN - NBIN_REAL) ? WSB(WS_WBIN) + (size_t)(NBIN_REAL + r) * 1024 : WSB(WS_WCIN) + (size_t)(NCIN_REAL + r - (NBIN - NBIN_REAL)) * 1024;
        const u32x4 z = {0u, 0u, 0u, 0u}; *(u32x4*)(row + c.lane * 8) = z; *(u32x4*)(row + 512 + c.lane * 8) = z; }
    for (int row = c.gw; row < M; row += c.NGW) {
        const float* src = row < MP ? c.in[I_XP] + (size_t)row * 1024 : c.in[I_XS] + (size_t)(row - MP) * 1024;
        float* xd = WSF(WS_X) + (size_t)row * 1024; bf16* xn = WSB(WS_XNB) + (size_t)row * 1024;
#pragma unroll
        for (int j = 0; j < 4; ++j) { const f32x4 v = *((const f32x4*)src + c.lane + 64 * j); *((f32x4*)xd + c.lane + 64 * j) = v; u32x2 w; w.x = pk2(v.x, v.y); w.y = pk2(v.z, v.w); *((u32x2*)xn + c.lane + 64 * j) = w; }
    }
    for (int r = c.gw; r < 4 * M; r += c.NGW) {
        const int l = r / M, row = r - l * M;
        const float* src = row < MP ? c.in[I_PP] + ((size_t)l * MP + row) * 256 : c.in[I_PS] + ((size_t)l * MS + (row - MP)) * 256;
        const f32x4 v = *((const f32x4*)src + c.lane); u32x2 w; w.x = pk2(v.x, v.y); w.y = pk2(v.z, v.w); *((u32x2*)(WSB(WS_PBF) + (size_t)r * 256) + c.lane) = w;
    }
}
__device__ __forceinline__ void ln_phase(const Ctx& c, const float* g, const float* b) {
    f32x4 gv[4], bv[4];
#pragma unroll
    for (int j = 0; j < 4; ++j) { gv[j] = *((const f32x4*)g + c.lane + 64 * j); bv[j] = *((const f32x4*)b + c.lane + 64 * j); }
    for (int row = c.gw; row < M; row += c.NGW) {
        const f32x4* p = (const f32x4*)(WSF(WS_PRE) + (size_t)row * 1024) + c.lane;
        f32x4 v[4]; float s = 0.f;
#pragma unroll
        for (int j = 0; j < 4; ++j) { v[j] = p[64 * j]; s += (v[j].x + v[j].y) + (v[j].z + v[j].w); }
        const float mean = wave_sum(s) * (1.f / 1024.f); float s2 = 0.f;
#pragma unroll
        for (int j = 0; j < 4; ++j) { v[j] = v[j] - mean; s2 += (v[j].x * v[j].x + v[j].y * v[j].y) + (v[j].z * v[j].z + v[j].w * v[j].w); }
        const float rstd = 1.f / sqrtf(wave_sum(s2) * (1.f / 1024.f) + LN_EPS);
        float* xd = WSF(WS_X) + (size_t)row * 1024; bf16* xn = WSB(WS_XN) + (size_t)row * 1024;
#pragma unroll
        for (int j = 0; j < 4; ++j) { const f32x4 y = v[j] * rstd * gv[j] + bv[j]; *((f32x4*)xd + c.lane + 64 * j) = y; u32x2 w; w.x = pk2(y.x, y.y); w.y = pk2(y.z, y.w); *((u32x2*)xn + c.lane + 64 * j) = w; }
    }
}
__device__ __forceinline__ void a_stats_phase(const Ctx& c, int ia) {
    const float* lg = c.in[I_ALNG] + ia * 2048; const float* lb = c.in[I_ALNB] + ia * 2048;
    for (int row = c.gw; row < M; row += c.NGW) {
        const f32x4* p = (const f32x4*)(WSF(WA_V) + (size_t)row * 2048) + c.lane;
        f32x4 v[8]; float s = 0.f;
#pragma unroll
        for (int j = 0; j < 8; ++j) { v[j] = p[64 * j]; s += (v[j].x + v[j].y) + (v[j].z + v[j].w); }
        const float mean = wave_sum(s) * (1.f / 2048.f); float s2 = 0.f;
#pragma unroll
        for (int j = 0; j < 8; ++j) { v[j] = v[j] - mean; s2 += (v[j].x * v[j].x + v[j].y * v[j].y) + (v[j].z * v[j].z + v[j].w * v[j].w); }
        const float rstd = 1.f / sqrtf(wave_sum(s2) * (1.f / 2048.f) + LN_EPS);
        if (c.lane == 0) { WSF(WA_ST)[2 * row] = mean; WSF(WA_ST)[2 * row + 1] = rstd; }
        if (row >= MP) { float* o = c.out + O_AV + ((size_t)ia * MS + (row - MP)) * 2048;
#pragma unroll
            for (int j = 0; j < 8; ++j) { const f32x4 gg = *((const f32x4*)lg + c.lane + 64 * j), bb = *((const f32x4*)lb + c.lane + 64 * j); *((f32x4*)o + c.lane + 64 * j) = v[j] * rstd * gg + bb; } }
    }
}
__device__ __forceinline__ void a_sgu_phase(const Ctx& c, int ia) {
    LAS float* vn = (LAS float*)c.lds;
    LAS float* wT = vn + 128 * 128;
    const float* ws = c.in[I_AWS] + (size_t)ia * 16 * 128 * 128; const float* bs = c.in[I_ABS] + ia * 16 * 128;
    const float* lg = c.in[I_ALNG] + ia * 2048; const float* lb = c.in[I_ALNB] + ia * 2048;
    const float* V = WSF(WA_V); const float* ST = WSF(WA_ST); const bf16* U = WSB(WA_U); bf16* US = WSB(WA_US);
    for (int unit = blockIdx.x; unit < 2048 + DB; unit += c.G) {
        if (unit < 2048) {
            const int g = unit & 15, n = (unit >> 4) & 31, b = unit >> 9, rowbase = b * SEQ + n * 128;
            __syncthreads();
            for (int idx = c.tid; idx < 4096; idx += 512) { const int s = idx >> 5, c4 = idx & 31, row = rowbase + s;
                const f32x4 v = *(const f32x4*)(V + (size_t)row * 2048 + g * 128 + c4 * 4); const float mean = ST[2 * row], rstd = ST[2 * row + 1];
                const f32x4 gg = *(const f32x4*)(lg + g * 128 + c4 * 4), bb = *(const f32x4*)(lb + g * 128 + c4 * 4);
                *(LAS f32x4*)(vn + s * 128 + c4 * 4) = (v - mean) * rstd * gg + bb; }
            for (int idx = c.tid; idx < 4096; idx += 512) { const int t = idx >> 5, s4 = idx & 31; const f32x4 w = *(const f32x4*)(ws + ((size_t)g * 128 + t) * 128 + s4 * 4); const int pt = (t & 3) * 32 + (t >> 2);
#pragma unroll
                for (int k = 0; k < 4; ++k) { const int s = 4 * s4 + k; wT[s * 128 + pt] = (s <= t) ? w[k] : 0.f; } }
            __syncthreads();
            const int d = c.tid & 127, tq = c.tid >> 7;
            float acc[32];
#pragma unroll
            for (int i = 0; i < 32; ++i) acc[i] = 0.f;
            for (int s = 0; s < 128; ++s) { const float v = vn[s * 128 + d];
#pragma unroll
                for (int i4 = 0; i4 < 8; ++i4) { const f32x4 w4 = *(const LAS f32x4*)(wT + s * 128 + tq * 32 + 4 * i4);
                    acc[4 * i4 + 0] += w4.x * v; acc[4 * i4 + 1] += w4.y * v; acc[4 * i4 + 2] += w4.z * v; acc[4 * i4 + 3] += w4.w * v; } }
#pragma unroll
            for (int i = 0; i < 32; ++i) { const int t = tq + 4 * i; const size_t o = (size_t)(rowbase + t) * 2048 + g * 128 + d;
                US[o] = (bf16)f2bf((acc[i] + bs[g * 128 + t]) * bf2f(U[o])); }
        } else {
            const int sb = unit - 2048, c0 = c.tid * 4, g = c0 >> 7;
            const f32x4 gg = *(const f32x4*)(lg + c0), bb = *(const f32x4*)(lb + c0);
            f32x4 vnr[4];
#pragma unroll
            for (int t = 0; t < 4; ++t) { const int row = MP + 4 * sb + t; const f32x4 v = *(const f32x4*)(V + (size_t)row * 2048 + c0); vnr[t] = (v - ST[2 * row]) * ST[2 * row + 1] * gg + bb; }
#pragma unroll
            for (int t = 0; t < 4; ++t) { const int row = MP + 4 * sb + t; f32x4 sv = {0.f, 0.f, 0.f, 0.f};
#pragma unroll
                for (int s = 0; s <= t; ++s) sv += vnr[s] * ws[((size_t)g * 128 + t) * 128 + s];
                sv += bs[g * 128 + t];
                const u32x2 uu = *(const u32x2*)(U + (size_t)row * 2048 + c0);
                f32x4 y; y.x = sv.x * bf2f((bf16)(uu.x & 0xffff)); y.y = sv.y * bf2f((bf16)(uu.x >> 16)); y.z = sv.z * bf2f((bf16)(uu.y & 0xffff)); y.w = sv.w * bf2f((bf16)(uu.y >> 16));
                u32x2 w; w.x = pk2(y.x, y.y); w.y = pk2(y.z, y.w); *(u32x2*)(US + (size_t)row * 2048 + c0) = w; }
        }
    }
}
__device__ __forceinline__ void gdn_prep_phase(const Ctx& c) {
    const float* PJ = WSF(WB_PROJ); const float* cw = c.in[I_BCONV]; const float* alog = c.in[I_BALOG]; const float* dtb = c.in[I_BDT];
    bf16* GW = WSB(WB_W); float* GUT = WSF(WB_U); bf16* GQG = WSB(WB_QG); bf16* GKDT = WSB(WB_KD); bf16* GQK = WSB(WB_QK); float* GEG = WSF(WB_EG);
    for (int unit = blockIdx.x; unit < 2048 + 1024; unit += c.G) {
        __syncthreads();
        LAS float* lb = (LAS float*)c.lds; asm volatile("" : "+v"(lb));
        LAS float* kf = lb; LAS float* vf = kf + 64 * 129; LAS float* Am = vf + 64 * 129; LAS float* gc = Am + 64 * 64; LAS float* bt = gc + 64;
        LAS bf16* kb = (LAS bf16*)(bt + 64); LAS bf16* qb = kb + 64 * 136;
        if (unit < 2048) {
            const int ci = unit & 63, h = (unit >> 6) & 7, b = unit >> 9, rb = b * SEQ + ci * 64;
            if (c.tid < 64) { const size_t row = rb + c.tid; const float bl = PJ[row * NBIN + 4096 + h], al = PJ[row * NBIN + 4104 + h];
                const float x = al + dtb[h]; const float sp = x > 20.f ? x : log1pf(expf(x)); float g = -expf(alog[h]) * sp;
#pragma unroll
                for (int o = 1; o < 64; o <<= 1) { const float t = __shfl_up(g, o); if (c.lane >= o) g += t; }
                gc[c.tid] = g; bt[c.tid] = sigmoid_f(bl); }
            __syncthreads();
#pragma unroll 1
            for (int i = 0; i < 8; ++i) { const int tk = c.wave * 8 + i, tabs = ci * 64 + tk; const size_t row = rb + tk;
#pragma unroll
                for (int part = 0; part < 3; ++part) { const int ch = part * 1024 + h * 128 + 2 * c.lane; float a0 = 0.f, a1 = 0.f;
#pragma unroll
                    for (int j = 0; j < 4; ++j) { if (tabs - 3 + j >= 0) { const f32x2 x = *(const f32x2*)(PJ + (row - 3 + j) * NBIN + ch); const f32x2 w = *(const f32x2*)(cw + j * 3072 + ch); a0 += x.x * w.x; a1 += x.y * w.y; } }
                    a0 = siluf(a0); a1 = siluf(a1);
                    if (part < 2) { const float ss = wave_sum(a0 * a0 + a1 * a1); const float sc = (1.f / sqrtf(ss + NORM_EPS)) * (part == 0 ? 0.08838834764831845f : 1.f); a0 *= sc; a1 *= sc; }
                    if (part == 0) { *(LAS unsigned*)(qb + tk * 136 + 2 * c.lane) = pk2(a0, a1); const float eg = expf(gc[tk]); *(unsigned*)(GQG + (size_t)unit * 8192 + tk * 128 + 2 * c.lane) = pk2(a0 * eg, a1 * eg); }
                    else if (part == 1) { *(LAS unsigned*)(kb + tk * 136 + 2 * c.lane) = pk2(a0, a1); kf[tk * 129 + 2 * c.lane] = a0; kf[tk * 129 + 2 * c.lane + 1] = a1; }
                    else { vf[tk * 129 + 2 * c.lane] = a0; vf[tk * 129 + 2 * c.lane + 1] = a1; } } }
            __syncthreads();
            { const int fr = c.lane & 15, rq = c.lane >> 4;
#pragma unroll 1
              for (int bi = c.wave; bi < 16; bi += 8) {
                  const int mbj = bi < 10 ? (bi == 0 ? 0 : bi == 1 ? 0 : bi == 2 ? 1 : bi == 3 ? 0 : bi == 4 ? 1 : bi == 5 ? 2 : bi == 6 ? 0 : bi == 7 ? 1 : bi == 8 ? 2 : 3) : (bi == 10 ? 1 : bi == 11 ? 2 : bi == 12 ? 3 : bi == 13 ? 2 : bi == 14 ? 3 : 3);
                  const int nbi = bi < 10 ? (bi == 0 ? 0 : bi <= 2 ? 1 : bi <= 5 ? 2 : 3) : (bi <= 12 ? 0 : bi <= 14 ? 1 : 2);
                  const int i = 16 * nbi + fr, j0 = 16 * mbj + 4 * rq;
                  f32x4 akk = {0.f, 0.f, 0.f, 0.f}, aqk = {0.f, 0.f, 0.f, 0.f};
                  if (bi < 10) {
#pragma unroll
                      for (int ks = 0; ks < 4; ++ks) { const bf16x8_t xk = *(const LAS bf16x8_t*)(kb + (16 * mbj + fr) * 136 + 32 * ks + 8 * rq), yk = *(const LAS bf16x8_t*)(kb + i * 136 + 32 * ks + 8 * rq), yq = *(const LAS bf16x8_t*)(qb + i * 136 + 32 * ks + 8 * rq);
                          akk = MFMA16(xk, yk, akk); aqk = MFMA16(xk, yq, aqk); } }
                  const float gi = gc[i], bi_ = bt[i]; f32x4 av, qv;
#pragma unroll
                  for (int r = 0; r < 4; ++r) { const int j = j0 + r; const float dec = (i >= j) ? expf(gi - gc[j]) : 0.f; av[r] = (i > j) ? bi_ * akk[r] * dec : 0.f; qv[r] = (i >= j) ? aqk[r] * dec : 0.f; }
                  *(LAS f32x4*)(Am + i * 64 + j0) = av; u32x2 wv; wv.x = pk2(qv[0], qv[1]); wv.y = pk2(qv[2], qv[3]); *(u32x2*)(GQK + ((size_t)unit * 64 + i) * 64 + j0) = wv; } }
            __syncthreads();
            if (c.tid < 256) { const bool isw = c.tid >= 128; const int cc = c.tid & 127; float x[64];
#pragma unroll
                for (int i = 0; i < 64; ++i) x[i] = 0.f;
#pragma unroll
                for (int i = 0; i < 64; ++i) { float r = isw ? kf[i * 129 + cc] * bt[i] * expf(gc[i]) : vf[i * 129 + cc] * bt[i];
#pragma unroll
                    for (int j4 = 0; j4 < (i + 3) / 4; ++j4) { const f32x4 a4 = *(const LAS f32x4*)(Am + i * 64 + 4 * j4); r -= (a4.x * x[4 * j4] + a4.y * x[4 * j4 + 1]) + (a4.z * x[4 * j4 + 2] + a4.w * x[4 * j4 + 3]); }
                    x[i] = r; if (isw) GW[((size_t)unit * 64 + i) * 128 + cc] = (bf16)f2bf(r); }
                if (!isw) { float* dst = GUT + ((size_t)unit * 128 + cc) * 64;
#pragma unroll
                    for (int k = 0; k < 16; ++k) *(f32x4*)(dst + 4 * k) = (f32x4){x[4 * k], x[4 * k + 1], x[4 * k + 2], x[4 * k + 3]}; } }
            for (int idx = c.tid; idx < 1024; idx += 512) { const int dk = idx & 127, ch = idx >> 7; const float gl = gc[63]; unsigned e[4];
#pragma unroll
                for (int k = 0; k < 4; ++k) { const int c0 = 8 * ch + 2 * k; e[k] = pk2(kf[c0 * 129 + dk] * expf(gl - gc[c0]), kf[(c0 + 1) * 129 + dk] * expf(gl - gc[c0 + 1])); }
                *(u32x4*)(GKDT + (size_t)unit * 8192 + dk * 64 + 8 * ch) = (u32x4){e[0], e[1], e[2], e[3]}; }
            if (c.tid == 0) GEG[unit] = expf(gc[63]);
        } else {
            const int su = unit - 2048, h = su & 7, b = su >> 3;
            LAS float* q4 = lb; LAS float* k4 = q4 + 512; LAS float* v4 = k4 + 512; LAS float* red = v4 + 512; LAS float* o4 = red + 512; LAS float* g4 = o4 + 512; LAS float* b4 = g4 + 4;
            const float* cst = c.in[I_GCONV] + (size_t)b * 3 * 3072;
            { const int t = c.tid >> 7, chl = c.tid & 127;
#pragma unroll
              for (int part = 0; part < 3; ++part) { const int ch = part * 1024 + h * 128 + chl; float a = 0.f;
#pragma unroll
                  for (int j = 0; j < 4; ++j) { const int mm = t + j; const float x = mm < 3 ? cst[mm * 3072 + ch] : PJ[(size_t)(MP + 4 * b + mm - 3) * NBIN + ch]; a += x * cw[j * 3072 + ch]; }
                  (part == 0 ? q4 : (part == 1 ? k4 : v4))[t * 128 + chl] = siluf(a); }
              if (c.tid < 4) { const size_t row = MP + 4 * b + c.tid; const float bl = PJ[row * NBIN + 4096 + h], al = PJ[row * NBIN + 4104 + h];
                  const float x = al + dtb[h]; const float sp = x > 20.f ? x : log1pf(expf(x)); g4[c.tid] = -expf(alog[h]) * sp; b4[c.tid] = sigmoid_f(bl); } }
            __syncthreads();
            { const int t = c.tid >> 7, chl = c.tid & 127; float sq = 0.f, sk = 0.f;
              for (int d = 0; d < 128; ++d) { const float a = q4[t * 128 + d], bb = k4[t * 128 + d]; sq += a * a; sk += bb * bb; }
              const float qv = q4[t * 128 + chl] * (1.f / sqrtf(sq + NORM_EPS)) * 0.08838834764831845f, kv = k4[t * 128 + chl] * (1.f / sqrtf(sk + NORM_EPS));
              __syncthreads();
              q4[t * 128 + chl] = qv; k4[t * 128 + chl] = kv; }
            __syncthreads();
            const int dv = c.tid & 127, part = c.tid >> 7;
            float S[32];
            const float* S0 = c.in[I_GS] + (((size_t)b * 8 + h) * 128 + part * 32) * 128 + dv;
#pragma unroll
            for (int i = 0; i < 32; ++i) S[i] = S0[(size_t)i * 128];
#pragma unroll 1
            for (int t = 0; t < 4; ++t) { const float a = expf(g4[t]); float p = 0.f;
#pragma unroll
                for (int i = 0; i < 32; ++i) p += k4[t * 128 + part * 32 + i] * S[i];
                red[part * 128 + dv] = p; __syncthreads();
                const float kS = (red[dv] + red[128 + dv]) + (red[256 + dv] + red[384 + dv]); const float vnew = b4[t] * (v4[t * 128 + dv] - a * kS); float po = 0.f;
#pragma unroll
                for (int i = 0; i < 32; ++i) { S[i] = a * S[i] + k4[t * 128 + part * 32 + i] * vnew; po += q4[t * 128 + part * 32 + i] * S[i]; }
                __syncthreads(); red[part * 128 + dv] = po; __syncthreads();
                if (part == 0) o4[t * 128 + dv] = (red[dv] + red[128 + dv]) + (red[256 + dv] + red[384 + dv]);
                __syncthreads(); }
            float* So = c.out + O_GSS + (((size_t)b * 8 + h) * 128 + part * 32) * 128 + dv;
#pragma unroll
            for (int i = 0; i < 32; ++i) So[(size_t)i * 128] = S[i];
            { const int t = c.tid >> 7; float ms = 0.f;
              for (int d = 0; d < 128; ++d) { const float o = o4[t * 128 + d]; ms += o * o; }
              const size_t row = MP + 4 * b + t; const float z = PJ[row * NBIN + 3072 + h * 128 + dv];
              const float y = o4[t * 128 + dv] * (1.f / sqrtf(ms * (1.f / 128.f) + NORM_EPS)) * c.in[I_BNG][dv] * siluf(z);
              WSB(WB_OG)[row * 1024 + h * 128 + dv] = (bf16)f2bf(y); }
        }
    }
    for (size_t idx = (size_t)blockIdx.x * 512 + c.tid; idx < 36864 + 1179648; idx += (size_t)c.G * 512) {
        if (idx < 36864) { const int b = (int)(idx / 9216), r = (int)(idx % 9216), j = r / 3072, ch = r % 3072; c.out[O_GCP + idx] = PJ[((size_t)b * SEQ + SEQ - 3 + j) * NBIN + ch]; }
        else { const size_t k = idx - 36864; const int b = (int)(k / 9216), r = (int)(k % 9216), j = r / 3072, ch = r % 3072; c.out[O_GCS + k] = PJ[((size_t)MP + 4 * b + 1 + j) * NBIN + ch]; }
    }
}
struct ScanFr { bf16x8_t a4[4], b2[2], kd[2]; f32x4 u; float eg; };
__device__ __forceinline__ void scan_load(ScanFr& f, const bf16* GW, const bf16* GQG, const bf16* GKDT, const bf16* GQK, const float* GUT, const float* GEG, size_t pu, int w, int fr, int rq, int dvs) {
    const int mb = w & 3; const bf16* a = (w < 4 ? GW : GQG) + pu * 8192 + (16 * mb + fr) * 128 + 8 * rq;
#pragma unroll
    for (int ks = 0; ks < 4; ++ks) f.a4[ks] = *(const bf16x8_t*)(a + 32 * ks);
    const bf16* q = GQK + pu * 4096 + (16 * mb + fr) * 64 + 8 * rq; f.b2[0] = *(const bf16x8_t*)q; f.b2[1] = *(const bf16x8_t*)(q + 32);
    const bf16* k = GKDT + pu * 8192 + (16 * w + fr) * 64 + 8 * rq; f.kd[0] = *(const bf16x8_t*)k; f.kd[1] = *(const bf16x8_t*)(k + 32);
    f.u = *(const f32x4*)(GUT + (pu * 128 + dvs * 16 + fr) * 64 + 16 * mb + 4 * rq); f.eg = GEG[pu];
}
__device__ __forceinline__ void gdn_scan_phase(const Ctx& c) {
    const bf16* GW = WSB(WB_W); const float* GUT = WSF(WB_U); const bf16* GQG = WSB(WB_QG); const bf16* GKDT = WSB(WB_KD); const bf16* GQK = WSB(WB_QK); const float* GEG = WSF(WB_EG);
    float* GO = WSF(WB_O);
    for (int uu = blockIdx.x; uu < 256; uu += c.G) {
        LAS unsigned char* L = c.lds; asm volatile("" : "+v"(L));
        LAS bf16* ST = (LAS bf16*)L; LAS bf16* VNT = ST + 16 * 136;
        const int bh = (uu & 7) * 4 + (uu >> 6), dvs = (uu >> 3) & 7, b = bh >> 3, h = bh & 7;
        const int w = c.wave, fr = c.lane & 15, rq = c.lane >> 4, mb = w & 3;
        __syncthreads();
        for (int i = c.tid; i < 16 * 136 / 2; i += 512) ((LAS unsigned*)ST)[i] = 0u;
        f32x4 Sacc = {0.f, 0.f, 0.f, 0.f};
        ScanFr cur, nxt; scan_load(cur, GW, GQG, GKDT, GQK, GUT, GEG, (size_t)bh * 64, w, fr, rq, dvs);
        for (int ci = 0; ci < 64; ++ci) {
            const size_t pu = (size_t)bh * 64 + ci;
            if (ci < 63) scan_load(nxt, GW, GQG, GKDT, GQK, GUT, GEG, pu + 1, w, fr, rq, dvs);
            __syncthreads();
            f32x4 acc = {0.f, 0.f, 0.f, 0.f};
#pragma unroll
            for (int ks = 0; ks < 4; ++ks) { const bf16x8_t y = *(const LAS bf16x8_t*)(ST + fr * 136 + 32 * ks + 8 * rq); acc = MFMA16(cur.a4[ks], y, acc); }
            if (w < 4) { const f32x4 vn = cur.u - acc; u32x2 wv; wv.x = pk2(vn[0], vn[1]); wv.y = pk2(vn[2], vn[3]); *(LAS u32x2*)(VNT + fr * 72 + 16 * mb + 4 * rq) = wv; }
            __syncthreads();
            const bf16x8_t y0 = *(const LAS bf16x8_t*)(VNT + fr * 72 + 8 * rq), y1 = *(const LAS bf16x8_t*)(VNT + fr * 72 + 32 + 8 * rq);
            if (w >= 4) { acc = MFMA16(cur.b2[0], y0, acc); acc = MFMA16(cur.b2[1], y1, acc);
                float* o = GO + ((size_t)b * SEQ + ci * 64 + 16 * mb + 4 * rq) * 1024 + h * 128 + dvs * 16 + fr;
#pragma unroll
                for (int i = 0; i < 4; ++i) o[(size_t)i * 1024] = acc[i]; }
            Sacc *= cur.eg; Sacc = MFMA16(cur.kd[0], y0, Sacc); Sacc = MFMA16(cur.kd[1], y1, Sacc);
            { u32x2 wv; wv.x = pk2(Sacc[0], Sacc[1]); wv.y = pk2(Sacc[2], Sacc[3]); *(LAS u32x2*)(ST + fr * 136 + 16 * w + 4 * rq) = wv; }
            cur = nxt;
        }
#pragma unroll
        for (int i = 0; i < 4; ++i) c.out[O_GSP + (((size_t)b * 8 + h) * 128 + 16 * w + 4 * rq + i) * 128 + dvs * 16 + fr] = Sacc[i];
    }
}
__device__ __forceinline__ void gdn_post_phase(const Ctx& c) {
    const float* GO = WSF(WB_O); const float* PJ = WSF(WB_PROJ); const float* ng = c.in[I_BNG];
    for (int row = c.gw; row < MP; row += c.NGW) {
        const f32x4* p = (const f32x4*)(GO + (size_t)row * 1024 + c.lane * 16); f32x4 v[4]; float s = 0.f;
#pragma unroll
        for (int j = 0; j < 4; ++j) { v[j] = p[j]; s += (v[j].x * v[j].x + v[j].y * v[j].y) + (v[j].z * v[j].z + v[j].w * v[j].w); }
        s += __shfl_xor(s, 1); s += __shfl_xor(s, 2); s += __shfl_xor(s, 4);
        const float r = 1.f / sqrtf(s * (1.f / 128.f) + NORM_EPS);
        const f32x4* zp = (const f32x4*)(PJ + (size_t)row * NBIN + 3072 + c.lane * 16); const f32x4* gp = (const f32x4*)(ng + (c.lane & 7) * 16);
        u32x2* op = (u32x2*)(WSB(WB_OG) + (size_t)row * 1024 + c.lane * 16);
#pragma unroll
        for (int j = 0; j < 4; ++j) { const f32x4 z = zp[j], g = gp[j]; f32x4 y; y.x = v[j].x * r * g.x * siluf(z.x); y.y = v[j].y * r * g.y * siluf(z.y); y.z = v[j].z * r * g.z * siluf(z.z); y.w = v[j].w * r * g.w * siluf(z.w);
            u32x2 w; w.x = pk2(y.x, y.y); w.y = pk2(y.z, y.w); op[j] = w; }
    }
}
__device__ const unsigned char T5_LUT[128] = {0, 1, 2, 3, 4, 5, 6, 7, 8, 9, 10, 11, 12, 13, 14, 15, 16, 16, 16, 17, 17, 18, 18, 18, 19, 19, 19, 20, 20, 20, 20, 21, 21, 21, 21, 22, 22, 22, 22, 22, 23, 23, 23, 23, 23, 23, 24, 24, 24, 24, 24, 24, 25, 25, 25, 25, 25, 25, 25, 26, 26, 26, 26, 26, 26, 26, 26, 27, 27, 27, 27, 27, 27, 27, 27, 27, 27, 28, 28, 28, 28, 28, 28, 28, 28, 28, 28, 29, 29, 29, 29, 29, 29, 29, 29, 29, 29, 29, 29, 30, 30, 30, 30, 30, 30, 30, 30, 30, 30, 30, 30, 30, 30, 31, 31, 31, 31, 31, 31, 31, 31, 31, 31, 31, 31, 31, 31, 31};
__device__ __forceinline__ void nsa_prep_phase(const Ctx& c) {
    const float* PJ = WSF(WC_PROJ);
    for (size_t i4 = (size_t)blockIdx.x * 512 + c.tid; i4 < (size_t)M * 256; i4 += (size_t)c.G * 512) { const size_t row = i4 >> 8; const int c4 = (int)(i4 & 255);
        const f32x4 v = *(const f32x4*)(PJ + row * NCIN + 1024 + c4 * 4);
        if (row < MP) *(f32x4*)(c.out + O_KVP + row * 1024 + c4 * 4) = v; else *(f32x4*)(c.out + O_KVS + (row - MP) * 1024 + c4 * 4) = v; }
    for (size_t i4 = (size_t)blockIdx.x * 512 + c.tid; i4 < (size_t)(2048 + MS) * 128; i4 += (size_t)c.G * 512) { const size_t r = i4 >> 7; const int c4 = (int)(i4 & 127);
        const size_t row = r < 2048 ? (r >> 9) * SEQ + (SEQ - 512) + (r & 511) : MP + (r - 2048);
        const f32x4 v = *(const f32x4*)(PJ + row * NCIN + 2048 + c4 * 4);
        if (r < 2048) *(f32x4*)(c.out + O_WINP + r * 512 + c4 * 4) = v; else *(f32x4*)(c.out + O_WINS + (r - 2048) * 512 + c4 * 4) = v; }
    { LAS bf16* vt = (LAS bf16*)c.lds;
      bf16* KSB = WSB(WC_KSB); bf16* VST = WSB(WC_VST); bf16* KWB = WSB(WC_KWB); bf16* VWT = WSB(WC_VWT);
      for (int u = blockIdx.x; u < 256; u += c.G) { const int b = u >> 6, tb = u & 63; const size_t row0 = (size_t)b * SEQ + 64 * tb;
          __syncthreads();
          for (int idx = c.tid; idx < 64 * 256; idx += 512) { const int t = idx >> 8, q = idx & 255, sect = q >> 6, c4 = q & 63;
              const f32x4 v = *(const f32x4*)(PJ + (row0 + t) * NCIN + 1536 + sect * 256 + c4 * 4); u32x2 w; w.x = pk2(v.x, v.y); w.y = pk2(v.z, v.w);
              const int g = c4 >> 4, d = (c4 & 15) * 4;
              if (sect == 0) *(u32x2*)(KSB + (((size_t)(b * 4 + g) * SEQ + 64 * tb + t) * 64 + d)) = w;
              else if (sect == 2) *(u32x2*)(KWB + (((size_t)(b * 4 + g) * SEQ + 64 * tb + t) * 64 + d)) = w;
              else *(LAS u32x2*)(vt + t * 520 + (sect == 1 ? 0 : 256) + c4 * 4) = w; }
          __syncthreads();
          for (int idx = c.tid; idx < 512 * 8; idx += 512) { const int col = idx >> 3, ch = idx & 7; unsigned short e[8];
#pragma unroll
              for (int k = 0; k < 8; ++k) e[k] = vt[(8 * ch + k) * 520 + col];
              u32x4 w; w.x = e[0] | ((unsigned)e[1] << 16); w.y = e[2] | ((unsigned)e[3] << 16); w.z = e[4] | ((unsigned)e[5] << 16); w.w = e[6] | ((unsigned)e[7] << 16);
              const int cc = col & 255, g = cc >> 6, d = cc & 63; bf16* dst = (col < 256 ? VST : VWT) + ((size_t)(b * 4 + g) * 64 + d) * SEQ + 64 * tb + 8 * ch;
              *(u32x4*)dst = w; } }
      __syncthreads(); }
    bf16* AC = WSB(WC_ACMP); const float* pe = c.in[I_CPE]; const int* pt = (const int*)c.in[I_PT]; const float* ckv = c.in[I_CKV];
    for (int R = c.gw; R < 2 * CMP_ROWS; R += c.NGW) {
        const int which = R >= CMP_ROWS ? 1 : 0, r = R - which * CMP_ROWS;
        const float* src; size_t lstride;
        if (r < 2048) { const int g = r & 3, n = (r >> 2) & 127, b = r >> 9; src = PJ + ((size_t)b * SEQ + 32 * n) * NCIN + 1024 + which * 256 + g * 64; lstride = NCIN; }
        else { const int q = r - 2048, g = q & 3, n = (q >> 2) & 63, b = q >> 8; const int page = pt[b * 16 + (n >> 2)];
            src = ckv + (((size_t)page * 128 + (n & 3) * 32) * 16 + which * 4 + g) * 64; lstride = 1024; }
#pragma unroll
        for (int k = 0; k < 8; ++k) { const int idx = c.lane + 64 * k, l = idx >> 4, d4 = idx & 15;
            const f32x4 v = *(const f32x4*)(src + (size_t)l * lstride + d4 * 4) + *(const f32x4*)(pe + (which * 32 + l) * 64 + d4 * 4);
            u32x2 w; w.x = pk2(v.x, v.y); w.y = pk2(v.z, v.w); *(u32x2*)(AC + (size_t)R * 2048 + l * 64 + d4 * 4) = w; }
    }
}
__device__ __forceinline__ void nsa_cmp2_phase(const Ctx& c) {
    LAS float* w2 = (LAS float*)c.lds;
    __syncthreads();
    for (int i = c.tid; i < 2 * 256 * 64 / 4; i += 512) *(LAS f32x4*)(w2 + 4 * i) = *((const f32x4*)c.in[I_CW2] + i);
    __syncthreads();
    const bf16* HC = WSB(WC_HC); float* KCV = WSF(WC_KCV);
    for (int R = c.gw; R < 2 * CMP_ROWS; R += c.NGW) {
        const LAS float* w = w2 + (R >= CMP_ROWS ? 256 * 64 : 0) + c.lane; const u32x4* hp = (const u32x4*)(HC + (size_t)R * 256); float a = 0.f;
#pragma unroll 4
        for (int k8 = 0; k8 < 32; ++k8) { const u32x4 hv = hp[k8]; const unsigned hw[4] = {hv.x, hv.y, hv.z, hv.w};
#pragma unroll
            for (int j = 0; j < 4; ++j) { a += bf2f((bf16)(hw[j] & 0xffff)) * w[(8 * k8 + 2 * j) * 64]; a += bf2f((bf16)(hw[j] >> 16)) * w[(8 * k8 + 2 * j + 1) * 64]; } }
        KCV[(size_t)R * 64 + c.lane] = a;
        { const int which = R >= CMP_ROWS ? 1 : 0, r = R - which * CMP_ROWS;
          if (r < 2048) { const int g = r & 3, n = (r >> 2) & 127, b = r >> 9; if (which == 0) WSB(WC_KCB)[((size_t)(b * 4 + g) * 128 + n) * 64 + c.lane] = (bf16)f2bf(a); else WSB(WC_VCT)[((size_t)(b * 4 + g) * 64 + c.lane) * 128 + n] = (bf16)f2bf(a); } }
    }
}
struct AttSt { float m[4], l[4]; f32x4 o[4]; };
__device__ __forceinline__ void att_reset(AttSt& s) {
#pragma unroll
    for (int h = 0; h < 4; ++h) { s.m[h] = -1e30f; s.l[h] = 0.f; s.o[h] = (f32x4){0.f, 0.f, 0.f, 0.f}; } }
__device__ __forceinline__ void att_scores(const LAS float* qs, const LAS float* tabl, const float* kptr, bool valid, int dist, int g, float (&s)[4]) {
    const f32x4* kp = (const f32x4*)kptr;
    s[0] = s[1] = s[2] = s[3] = 0.f;
#pragma unroll 1
    for (int c4 = 0; c4 < 4; ++c4) {
        f32x4 kv[4];
#pragma unroll
        for (int u = 0; u < 4; ++u) kv[u] = kp[c4 * 4 + u];
#pragma unroll
        for (int u = 0; u < 4; ++u)
#pragma unroll
            for (int h = 0; h < 4; ++h) { const f32x4 q = *(const LAS f32x4*)(qs + h * 64 + (c4 * 4 + u) * 4); s[h] += (q.x * kv[u].x + q.y * kv[u].y) + (q.z * kv[u].z + q.w * kv[u].w); } }
    const int dd = dist < 0 ? 0 : dist; const int bk = dd < 128 ? (int)T5_LUT[dd] : 31;
    const f32x4 bias = *(const LAS f32x4*)(tabl + bk * 16 + g * 4);
#pragma unroll
    for (int h = 0; h < 4; ++h) s[h] = valid ? s[h] + bias[h] : -1e30f;
}
__device__ __forceinline__ void att_pv(AttSt& st, LAS f32x4* P, LAS unsigned long long* R, const float (&p)[4], const float* rowp, int voff, int lane) {
    P[lane] = (f32x4){p[0], p[1], p[2], p[3]}; R[lane] = (unsigned long long)rowp;
    LDS_WAIT();
#pragma unroll 8
    for (int i = 0; i < 16; ++i) { const int key = 4 * i + (lane >> 4); const f32x4 p4 = P[key]; const float* rp = (const float*)R[key];
        const f32x4 v = *(const f32x4*)(rp + voff + (lane & 15) * 4);
        st.o[0] += v * p4.x; st.o[1] += v * p4.y; st.o[2] += v * p4.z; st.o[3] += v * p4.w; }
    LDS_WAIT();
}
__device__ __forceinline__ void att_block(AttSt& st, const LAS float* qs, const LAS float* tabl, LAS f32x4* P, LAS unsigned long long* R, const float* kptr, const float* safe, bool valid, int dist, int voff, int g, int lane) {
    const float* rowp = valid ? kptr : safe; float s[4], p[4];
    att_scores(qs, tabl, rowp, valid, dist, g, s);
#pragma unroll
    for (int h = 0; h < 4; ++h) { const float mx = wave_max(s[h]), mn = fmaxf(st.m[h], mx), sc = __expf(st.m[h] - mn); p[h] = valid ? __expf(s[h] - mn) : 0.f;
        st.l[h] = st.l[h] * sc + wave_sum(p[h]); st.o[h] *= sc; st.m[h] = mn; }
    att_pv(st, P, R, p, rowp, voff, lane);
}
__device__ __forceinline__ void att_finish(AttSt& st, const float (&gate)[4], f32x4 (&acc)[4]) {
#pragma unroll
    for (int h = 0; h < 4; ++h) { f32x4 o = st.o[h];
#pragma unroll
        for (int k = 0; k < 4; ++k) { o[k] += __shfl_xor(o[k], 16); o[k] += __shfl_xor(o[k], 32); }
        const float inv = st.l[h] > 0.f ? gate[h] / st.l[h] : 0.f; acc[h] += o * inv; }
}
__device__ __forceinline__ void nsa_attn_phase(const Ctx& c, const int item0) {
    LAS float* tabl = (LAS float*)c.lds;
    LAS float* qs = tabl + 512 + c.wave * 768;
    LAS f32x4* P = (LAS f32x4*)(qs + 256); LAS unsigned long long* R = (LAS unsigned long long*)(qs + 512); LAS float* pcs = qs + 640;
    __syncthreads();
    for (int i = c.tid; i < 512; i += 512) tabl[i] = c.in[I_T5][i];
    __syncthreads();
    const float* PJ = WSF(WC_PROJ); const float* KCV = WSF(WC_KCV); const float* gb = c.in[I_CGB]; const int* pt = (const int*)c.in[I_PT]; const float* ckv = c.in[I_CKV]; const float* cwin = c.in[I_CWIN];
    bf16* OA = WSB(WC_OA);
    for (int item = item0 + c.gw; item < 65536 + 2048; item += c.NGW) {
        int lane = c.lane; asm volatile("" : "+v"(lane));
        const bool smp = item >= 65536; int b, g, t, qpos, ncmp, nslc; size_t row;
        if (!smp) { g = item & 3; b = (item >> 2) & 3; t = item >> 4; qpos = t; row = (size_t)b * SEQ + t; ncmp = 128; nslc = 64; }
        else { const int q = item - 65536; g = q & 3; t = (q >> 2) & 3; b = q >> 4; qpos = 2048 + t; row = (size_t)MP + 4 * b + t; ncmp = 64; nslc = 33; }
        const float* qrow = PJ + row * NCIN;
        { const f32x4 qv = *(const f32x4*)(qrow + g * 256 + lane * 4); *(LAS f32x4*)(qs + lane * 4) = qv * 0.125f; }
        float gv = 0.f; if (lane < 12) { const int gi = (lane >> 2) * 16 + g * 4 + (lane & 3); gv = sigmoid_f(qrow[2560 + gi] + gb[gi]); }
        float gate_c[4], gate_s[4], gate_w[4];
#pragma unroll
        for (int h = 0; h < 4; ++h) { gate_c[h] = readlane_f(gv, h); gate_s[h] = readlane_f(gv, 4 + h); gate_w[h] = readlane_f(gv, 8 + h); }
        LDS_WAIT();
        f32x4 acc[4];
#pragma unroll
        for (int h = 0; h < 4; ++h) acc[h] = (f32x4){0.f, 0.f, 0.f, 0.f};
        AttSt st;
        float ps;
        { const size_t kc0 = smp ? (size_t)2048 + ((size_t)b * 64) * 4 + g : ((size_t)b * 128) * 4 + g;
          const float* safe = KCV; float s0[4], s1[4];
          const int n0 = lane, n1 = lane + 64; const int d0 = qpos - (32 * n0 + 31), d1 = qpos - (32 * n1 + 31);
          const bool v0 = n0 < ncmp && d0 >= 0, v1 = n1 < ncmp && d1 >= 0;
          const float* k0p = v0 ? KCV + (kc0 + 4 * (size_t)n0) * 64 : safe; const float* k1p = v1 ? KCV + (kc0 + 4 * (size_t)n1) * 64 : safe;
          att_scores(qs, tabl, k0p, v0, d0, g, s0); att_scores(qs, tabl, k1p, v1, d1, g, s1);
          att_reset(st); float p0[4], p1[4], pc0 = 0.f, pc1 = 0.f;
#pragma unroll
          for (int h = 0; h < 4; ++h) { const float mx = wave_max(fmaxf(s0[h], s1[h])); p0[h] = v0 ? __expf(s0[h] - mx) : 0.f; p1[h] = v1 ? __expf(s1[h] - mx) : 0.f;
              const float l = wave_sum(p0[h] + p1[h]); const float inv = l > 0.f ? 1.f / l : 0.f; p0[h] *= inv; p1[h] *= inv; pc0 += p0[h]; pc1 += p1[h]; st.l[h] = l > 0.f ? 1.f : 0.f; }
          att_pv(st, P, R, p0, k0p, CMP_ROWS * 64, lane); att_pv(st, P, R, p1, k1p, CMP_ROWS * 64, lane);
          att_finish(st, gate_c, acc);
          pcs[lane] = pc0; pcs[64 + lane] = pc1; LDS_WAIT();
          ps = (2 * lane + 1 < ncmp) ? pcs[2 * lane] + pcs[2 * lane + 1] : 0.f; LDS_WAIT(); }
        const int jq = qpos >> 6; unsigned long long sel;
        { const bool forced = (lane == 0) || (lane == jq) || (lane == jq - 1);
          float sc = forced ? 100.f : (lane > jq ? -1.f : ps); if (lane >= nslc) sc = -__builtin_inff();
          int cnt = 0;
#pragma unroll 4
          for (int k = 0; k < 64; ++k) { const float sk = readlane_f(sc, k); cnt += (sk > sc || (sk == sc && k < lane)) ? 1 : 0; }
          sel = __ballot(cnt < 16); }
        att_reset(st);
        { const float* safe = qrow + 1536;
          unsigned long long todo = sel & (jq >= 63 ? ~0ull : ((1ull << (jq + 1)) - 1ull));
          while (todo) { const int j = __builtin_ctzll(todo); todo &= todo - 1ull;
              const int kpos = 64 * j + lane; const bool valid = kpos <= qpos; const float* kptr;
              if (!smp) kptr = PJ + ((size_t)b * SEQ + kpos) * NCIN + 1536 + g * 64;
              else if (j < 32) { const int page = pt[b * 16 + (j >> 1)]; kptr = ckv + (((size_t)page * 128 + (j & 1) * 64 + lane) * 16 + 8 + g) * 64; }
              else kptr = PJ + ((size_t)MP + 4 * b + (lane & 3)) * NCIN + 1536 + g * 64;
              att_block(st, qs, tabl, P, R, kptr, safe, valid, qpos - kpos, 256, g, lane); } }
        att_finish(st, gate_s, acc);
        att_reset(st);
        { const float* safe = qrow + 2048;
          for (int cb = 0; cb < 8; ++cb) { const int kpos = qpos - 511 + 64 * cb + lane; if (qpos - 511 + 64 * cb + 63 < 0) continue;
              const bool valid = kpos >= 0; const float* kptr;
              if (!smp) kptr = PJ + ((size_t)b * SEQ + (valid ? kpos : 0)) * NCIN + 2048 + g * 64;
              else if (kpos < 2048) kptr = cwin + (((size_t)b * 512 + (kpos - 1536)) * 2) * 256 + g * 64;
              else kptr = PJ + ((size_t)MP + 4 * b + (kpos - 2048)) * NCIN + 2048 + g * 64;
              att_block(st, qs, tabl, P, R, kptr, safe, valid, qpos - kpos, 256, g, lane); } }
        att_finish(st, gate_w, acc);
        if (lane < 16) {
#pragma unroll
            for (int h = 0; h < 4; ++h) { u32x2 w; w.x = pk2(acc[h].x, acc[h].y); w.y = pk2(acc[h].z, acc[h].w); *(u32x2*)(OA + row * 1024 + (g * 4 + h) * 64 + lane * 4) = w; } }
    }
}
constexpr int AT_ROWB = 144;
constexpr int AT_KB = 0, AT_VB = 2 * 64 * AT_ROWB, AT_PS = 4 * 64 * AT_ROWB, AT_SEL = AT_PS + 4 * 64 * 64 * 4, AT_BIAS = AT_SEL + 512, AT_END = AT_BIAS + 16 * 128 * 4;
static_assert(AT_END <= MISC_OFF, "attention LDS map");
struct AtRegs { u32x4 k, v; };
__device__ __forceinline__ AtRegs at_load(const bf16* kbase, const bf16* vbase, int vpitch, int tid) {
    AtRegs r; r.k = *(const u32x4*)(kbase + tid * 8); r.v = *(const u32x4*)(vbase + (size_t)(tid >> 3) * vpitch + (tid & 7) * 8); return r; }
__device__ __forceinline__ void at_store(LAS unsigned char* L, int buf, const AtRegs& r, int tid) {
    *(LAS u32x4*)(L + AT_KB + buf * 64 * AT_ROWB + (tid >> 3) * AT_ROWB + (tid & 7) * 16) = r.k; *(LAS u32x4*)(L + AT_VB + buf * 64 * AT_ROWB + (tid >> 3) * AT_ROWB + (tid & 7) * 16) = r.v; }
__device__ __forceinline__ void at_qk(LAS unsigned char* L, int buf, const bf16x8_t (&qf)[2][2], f32x4 (&st)[4][2], int fr, int rq) {
#pragma unroll
    for (int mb = 0; mb < 4; ++mb) { st[mb][0] = (f32x4){0.f, 0.f, 0.f, 0.f}; st[mb][1] = (f32x4){0.f, 0.f, 0.f, 0.f}; }
#pragma unroll
    for (int s = 0; s < 2; ++s)
#pragma unroll
        for (int mb = 0; mb < 4; ++mb) { const bf16x8_t kf = *(const LAS bf16x8_t*)(L + AT_KB + buf * 64 * AT_ROWB + (16 * mb + fr) * AT_ROWB + (32 * s + 8 * rq) * 2);
            st[mb][0] = MFMA16(kf, qf[0][s], st[mb][0]); st[mb][1] = MFMA16(kf, qf[1][s], st[mb][1]); }
}
__device__ __forceinline__ void at_pv(LAS unsigned char* L, int buf, const f32x4 (&st)[4][2], f32x4 (&ot)[4][2], int fr, int rq) {
#pragma unroll
    for (int s = 0; s < 2; ++s) { bf16x8_t pf[2];
#pragma unroll
        for (int nb = 0; nb < 2; ++nb) { u32x4 w; w.x = pk2(st[2 * s][nb].x, st[2 * s][nb].y); w.y = pk2(st[2 * s][nb].z, st[2 * s][nb].w); w.z = pk2(st[2 * s + 1][nb].x, st[2 * s + 1][nb].y); w.w = pk2(st[2 * s + 1][nb].z, st[2 * s + 1][nb].w);
            pf[nb] = __builtin_bit_cast(bf16x8_t, w); }
#pragma unroll
        for (int mb = 0; mb < 4; ++mb) { const LAS unsigned char* vp = L + AT_VB + buf * 64 * AT_ROWB + (16 * mb + fr) * AT_ROWB + (32 * s + 4 * rq) * 2;
            u32x4 w; const u32x2 lo = *(const LAS u32x2*)vp, hi = *(const LAS u32x2*)(vp + 32); w.x = lo.x; w.y = lo.y; w.z = hi.x; w.w = hi.y; const bf16x8_t vf = __builtin_bit_cast(bf16x8_t, w);
            ot[mb][0] = MFMA16(vf, pf[0], ot[mb][0]); ot[mb][1] = MFMA16(vf, pf[1], ot[mb][1]); } }
}
template <int MODE> __device__ __forceinline__ void at_softmax(f32x4 (&st)[4][2], f32x4 (&ot)[4][2], float (&m)[2], float (&l)[2], const bool (&rowok)[2], float cb, const LAS float* bias_h, int dist0  , int wlim) {
#pragma unroll
    for (int nb = 0; nb < 2; ++nb) { float mx = -1e30f;
#pragma unroll
        for (int mb = 0; mb < 4; ++mb)
#pragma unroll
            for (int i = 0; i < 4; ++i) { float s;
                if (MODE == 0) s = rowok[nb] ? st[mb][nb][i] + cb : -1e30f;
                else { const int dist = dist0 + 16 * nb - 16 * mb - i; const bool ok = rowok[nb] && dist >= 0 && dist < wlim; const int dd = dist < 0 ? 0 : (dist > 127 ? 127 : dist); const float bv = bias_h[dd]; s = ok ? st[mb][nb][i] + bv : -1e30f; }
                st[mb][nb][i] = s; mx = fmaxf(mx, s); }
        mx = fmaxf(mx, __shfl_xor(mx, 16)); mx = fmaxf(mx, __shfl_xor(mx, 32));
        const float mn = fmaxf(m[nb], mx), sc = __expf(m[nb] - mn); float ls = 0.f;
#pragma unroll
        for (int mb = 0; mb < 4; ++mb)
#pragma unroll
            for (int i = 0; i < 4; ++i) { const float s = st[mb][nb][i]; const float pe = __expf(s - mn); const float p = s > -1e29f ? pe : 0.f; st[mb][nb][i] = p; ls += p; }
        l[nb] = l[nb] * sc + ls; m[nb] = mn;
#pragma unroll
        for (int mb = 0; mb < 4; ++mb) ot[mb][nb] *= sc; }
}
template <bool ADD> __device__ __forceinline__ void at_finish(f32x4 (&ot)[4][2], float (&l)[2], const float (&gate)[2], LAS f32x4* park, int lane) {
#pragma unroll
    for (int nb = 0; nb < 2; ++nb) { float Ls = l[nb]; Ls += __shfl_xor(Ls, 16); Ls += __shfl_xor(Ls, 32); const float inv = Ls > 0.f ? gate[nb] / Ls : 0.f;
#pragma unroll
        for (int mb = 0; mb < 4; ++mb) { f32x4 v = ot[mb][nb] * inv; if (ADD) v += park[(mb * 2 + nb) * 64 + lane]; ot[mb][nb] = v; } }
}
__device__ __forceinline__ void at_park(const f32x4 (&ot)[4][2], LAS f32x4* park, int lane) {
#pragma unroll
    for (int nb = 0; nb < 2; ++nb)
#pragma unroll
        for (int mb = 0; mb < 4; ++mb) park[(mb * 2 + nb) * 64 + lane] = ot[mb][nb];
}
__device__ __forceinline__ void nsa_attn_prompt_phase(const Ctx& c) {
    const float* PJ = WSF(WC_PROJ); const float* gb = c.in[I_CGB]; bf16* OA = WSB(WC_OA);
    const bf16* KSB = WSB(WC_KSB); const bf16* VST = WSB(WC_VST); const bf16* KWB = WSB(WC_KWB); const bf16* VWT = WSB(WC_VWT); const bf16* KCB = WSB(WC_KCB); const bf16* VCT = WSB(WC_VCT);
    __syncthreads();
    { LAS float* bt = (LAS float*)(c.lds + AT_BIAS);
      for (int i = c.tid; i < 16 * 128; i += 512) { const int h = i >> 7, d = i & 127; bt[i] = c.in[I_T5][(int)T5_LUT[d] * 16 + h]; } }
    __syncthreads();
    for (int u = blockIdx.x; u < 1024; u += c.G) {
        LAS unsigned char* L = c.lds; asm volatile("" : "+v"(L));
        int tid = c.tid; asm volatile("" : "+v"(tid));
        const int lane = tid & 63, fr = lane & 15, rq = lane >> 4, w = c.wave, hg = w >> 1, tq0 = (w & 1) * 32;
        const int bg = (u & 255) >> 4, r16 = u & 15, k4 = u >> 8, qb = k4 == 0 ? r16 : (k4 == 1 ? 31 - r16 : (k4 == 2 ? 32 + r16 : 63 - r16)), b = bg >> 2, g = bg & 3, h = g * 4 + hg;
        const LAS float* bias_h = (const LAS float*)(L + AT_BIAS) + h * 128; const float cb = bias_h[127];
        LAS float* PS = (LAS float*)(L + AT_PS); LAS unsigned long long* SEL = (LAS unsigned long long*)(L + AT_SEL);
        bf16x8_t qf[2][2]; float gate_c[2], gate_s[2], gate_w[2]; size_t row[2];
#pragma unroll
        for (int nb = 0; nb < 2; ++nb) { row[nb] = (size_t)b * SEQ + 64 * qb + tq0 + 16 * nb + fr; const float* qr = PJ + row[nb] * NCIN;
#pragma unroll
            for (int s = 0; s < 2; ++s) { const f32x4 a = *(const f32x4*)(qr + h * 64 + 32 * s + 8 * rq) * 0.125f, bq = *(const f32x4*)(qr + h * 64 + 32 * s + 8 * rq + 4) * 0.125f;
                u32x4 wv; wv.x = pk2(a.x, a.y); wv.y = pk2(a.z, a.w); wv.z = pk2(bq.x, bq.y); wv.w = pk2(bq.z, bq.w); qf[nb][s] = __builtin_bit_cast(bf16x8_t, wv); }
            gate_c[nb] = sigmoid_f(qr[2560 + h] + gb[h]); gate_s[nb] = sigmoid_f(qr[2576 + h] + gb[16 + h]); gate_w[nb] = sigmoid_f(qr[2592 + h] + gb[32 + h]); }
        f32x4 ot[4][2], st[4][2]; float m[2], l[2]; bool rowok[2] = {true, true};
        LAS f32x4* park = (LAS f32x4*)(L + AT_PS) + w * 512;
#pragma unroll
        for (int mb = 0; mb < 4; ++mb) { ot[mb][0] = (f32x4){0.f, 0.f, 0.f, 0.f}; ot[mb][1] = (f32x4){0.f, 0.f, 0.f, 0.f}; }
        const int tl0 = 64 * qb + tq0 + fr;
        { __syncthreads();
          const AtRegs r0 = at_load(KCB + (size_t)bg * 128 * 64, VCT + (size_t)bg * 64 * 128, 128, tid), r1 = at_load(KCB + ((size_t)bg * 128 + 64) * 64, VCT + (size_t)bg * 64 * 128 + 64, 128, tid);
          at_store(L, 0, r0, tid); at_store(L, 1, r1, tid);
          __syncthreads();
          float cm[2] = {-1e30f, -1e30f}, cl[2] = {0.f, 0.f};
#pragma unroll
          for (int cc = 0; cc < 2; ++cc) { at_qk(L, cc, qf, st, fr, rq);
#pragma unroll
              for (int nb = 0; nb < 2; ++nb) { float mx = -1e30f; const int t = tl0 + 16 * nb;
#pragma unroll
                  for (int mb = 0; mb < 4; ++mb)
#pragma unroll
                      for (int i = 0; i < 4; ++i) { const int n = 64 * cc + 16 * mb + 4 * rq + i, dist = t - (32 * n + 31);
                          const float bv = bias_h[dist < 0 ? 0 : (dist > 127 ? 127 : dist)]; const float sv = dist >= 0 ? st[mb][nb][i] + bv : -1e30f; st[mb][nb][i] = sv; mx = fmaxf(mx, sv); }
                  mx = fmaxf(mx, __shfl_xor(mx, 16)); mx = fmaxf(mx, __shfl_xor(mx, 32));
                  const float mn = fmaxf(cm[nb], mx); float ls = 0.f;
#pragma unroll
                  for (int mb = 0; mb < 4; ++mb)
#pragma unroll
                      for (int i = 0; i < 4; ++i) { const float pe = __expf(st[mb][nb][i] - mn); ls += st[mb][nb][i] > -1e29f ? pe : 0.f; }
                  cl[nb] = cl[nb] * __expf(cm[nb] - mn) + ls; cm[nb] = mn; } }
          float cinv[2];
#pragma unroll
          for (int nb = 0; nb < 2; ++nb) { float ls = cl[nb]; ls += __shfl_xor(ls, 16); ls += __shfl_xor(ls, 32); cinv[nb] = ls > 0.f ? 1.f / ls : 0.f; l[nb] = ls > 0.f ? 0.25f : 0.f; }
#pragma unroll
          for (int cc = 0; cc < 2; ++cc) { at_qk(L, cc, qf, st, fr, rq);
#pragma unroll
              for (int nb = 0; nb < 2; ++nb) { const int t = tl0 + 16 * nb; LAS float* psr = PS + ((hg * 64 + tq0 + 16 * nb + fr) * 64 + 2 * rq) + 32 * cc;
#pragma unroll
                  for (int mb = 0; mb < 4; ++mb) {
#pragma unroll
                      for (int i = 0; i < 4; ++i) { const int n = 64 * cc + 16 * mb + 4 * rq + i, dist = t - (32 * n + 31);
                          const float bv = bias_h[dist < 0 ? 0 : (dist > 127 ? 127 : dist)]; const float pe = __expf(fminf(st[mb][nb][i] + bv - cm[nb], 0.f)) * cinv[nb]; st[mb][nb][i] = dist >= 0 ? pe : 0.f; }
                      *(LAS f32x2*)(psr + 8 * mb) = (f32x2){st[mb][nb][0] + st[mb][nb][1], st[mb][nb][2] + st[mb][nb][3]}; } }
              at_pv(L, cc, st, ot, fr, rq); }
          at_finish<false>(ot, l, gate_c, park, lane);
        }
        __syncthreads();
        { for (int i8 = 0; i8 < 8; ++i8) { const int tq = 8 * w + i8; unsigned long long sel;
              if (qb <= 15) sel = (2ull << qb) - 1ull;
              else { const float ps = (PS[(0 * 64 + tq) * 64 + lane] + PS[(1 * 64 + tq) * 64 + lane]) + (PS[(2 * 64 + tq) * 64 + lane] + PS[(3 * 64 + tq) * 64 + lane]);
                  const bool forced = (lane == 0) || (lane == qb) || (lane == qb - 1); const float sc = forced ? 100.f : (lane > qb ? -1.f : ps); int cnt = 0;
#pragma unroll 4
                  for (int k = 0; k < 64; ++k) { const float sk = readlane_f(sc, k); cnt += (sk > sc || (sk == sc && k < lane)) ? 1 : 0; }
                  sel = __ballot(cnt < 16) & ((2ull << qb) - 1ull); }
              if (lane == 0) SEL[tq] = sel; } }
        __syncthreads();
        unsigned long long selm[2], uni;
        { selm[0] = SEL[tq0 + fr]; selm[1] = SEL[tq0 + 16 + fr]; unsigned long long a = SEL[lane];
#pragma unroll
          for (int o = 1; o < 64; o <<= 1) a |= __shfl_xor(a, o);
          uni = a; }
        at_park(ot, park, lane);
#pragma unroll
        for (int mb = 0; mb < 4; ++mb) { ot[mb][0] = (f32x4){0.f, 0.f, 0.f, 0.f}; ot[mb][1] = (f32x4){0.f, 0.f, 0.f, 0.f}; }
        m[0] = m[1] = -1e30f; l[0] = l[1] = 0.f;
        { unsigned long long todo = __builtin_amdgcn_readfirstlane((unsigned)uni) | ((unsigned long long)__builtin_amdgcn_readfirstlane((unsigned)(uni >> 32)) << 32);
          int j = __builtin_ctzll(todo), buf = 0;
          AtRegs rg = at_load(KSB + ((size_t)bg * SEQ + 64 * j) * 64, VST + (size_t)bg * 64 * SEQ + 64 * j, SEQ, tid);
          for (;;) { at_store(L, buf, rg, tid); todo &= todo - 1ull; const bool more = todo != 0ull; const int jn = more ? __builtin_ctzll(todo) : 0;
              __syncthreads();
              if (more) rg = at_load(KSB + ((size_t)bg * SEQ + 64 * jn) * 64, VST + (size_t)bg * 64 * SEQ + 64 * jn, SEQ, tid);
              at_qk(L, buf, qf, st, fr, rq);
              rowok[0] = (selm[0] >> j) & 1ull; rowok[1] = (selm[1] >> j) & 1ull;
              if (j + 3 <= qb) at_softmax<0>(st, ot, m, l, rowok, cb, bias_h, 0, 0); else at_softmax<1>(st, ot, m, l, rowok, cb, bias_h, tl0 - (64 * j + 4 * rq), 1 << 30);
              at_pv(L, buf, st, ot, fr, rq);
              if (!more) break; j = jn; buf ^= 1; }
          at_finish<true>(ot, l, gate_s, park, lane); at_park(ot, park, lane); }
        __syncthreads();
#pragma unroll
        for (int mb = 0; mb < 4; ++mb) { ot[mb][0] = (f32x4){0.f, 0.f, 0.f, 0.f}; ot[mb][1] = (f32x4){0.f, 0.f, 0.f, 0.f}; }
        m[0] = m[1] = -1e30f; l[0] = l[1] = 0.f; rowok[0] = rowok[1] = true;
        { int j = qb >= 8 ? qb - 8 : 0, buf = 0;
          AtRegs rg = at_load(KWB + ((size_t)bg * SEQ + 64 * j) * 64, VWT + (size_t)bg * 64 * SEQ + 64 * j, SEQ, tid);
          for (;;) { at_store(L, buf, rg, tid); const bool more = j < qb; const int jn = j + 1;
              __syncthreads();
              if (more) rg = at_load(KWB + ((size_t)bg * SEQ + 64 * jn) * 64, VWT + (size_t)bg * 64 * SEQ + 64 * jn, SEQ, tid);
              at_qk(L, buf, qf, st, fr, rq);
              if (j + 3 <= qb && j + 8 > qb) at_softmax<0>(st, ot, m, l, rowok, cb, bias_h, 0, 0); else at_softmax<1>(st, ot, m, l, rowok, cb, bias_h, tl0 - (64 * j + 4 * rq), 512);
              at_pv(L, buf, st, ot, fr, rq);
              if (!more) break; j = jn; buf ^= 1; }
          at_finish<true>(ot, l, gate_w, park, lane); }
#pragma unroll
        for (int nb = 0; nb < 2; ++nb)
#pragma unroll
            for (int mb = 0; mb < 4; ++mb) { u32x2 wv; wv.x = pk2(ot[mb][nb].x, ot[mb][nb].y); wv.y = pk2(ot[mb][nb].z, ot[mb][nb].w); *(u32x2*)(OA + row[nb] * 1024 + h * 64 + 16 * mb + 4 * rq) = wv; }
    }
}
constexpr int PH_PER_SUB = 9, N_PHASES = 2 + 12 * PH_PER_SUB;
struct Args { const float* in[N_IN]; float* out; unsigned char* ws; int ph_lo, ph_hi, bli, pad; };
__host__ __device__ inline bool phase_exists(int ph) {
    if (ph < 2) return true; const int r = ph - 2, sub3 = r / PH_PER_SUB, slot = r % PH_PER_SUB, L = sub3 / 3, s = sub3 % 3, kind = (L == 1) ? 1 : (L == 2 ? 2 : 0);
    if (slot == 0 || slot == 5 || slot == 6) return true;
    if (slot == 7) return s == 2;
    if (slot == 8) return false;
    if (s != 1) return false;
    if (kind == 0) return slot <= 2; if (kind == 1) return slot <= 3; return true;
}

#ifndef PROBE
#define PROBE 0
#endif
#define TW(cls, ...) do { __VA_ARGS__; if (PROBE == (cls)) { __VA_ARGS__; } } while (0)
#define IN(k) (lo <= (k) && (k) < hi)
#define SEAM(k) do { if (IN(k) && (k) + 1 < hi) xcd_barrier(bar); } while (0)
template <int L, int S> __device__ __forceinline__ void run_sub(const Ctx& c, const XcdBarrier& bar, const int lo, const int hi) {
    constexpr int kind = (L == 1) ? 1 : (L == 2 ? 2 : 0), ia = (L == 3) ? 1 : 0, base = 2 + (3 * L + S) * PH_PER_SUB;
    LAS unsigned char* ring = c.lds;
    if (IN(base)) {
        if constexpr (S != 1) { constexpr int j = S >> 1; pg8::Gemm g{S == 0 ? WSB(WS_XNB) : WSB(WS_XN), WSB(WS_WUP + (size_t)(2 * L + j) * SZ_WUP), M, 5632, 1024}; pg8::StaticOrder So; So.init(M, 5632, c.G, (int)blockIdx.x);
            pg8::EpiGate E{WSB(WS_H), DFF}; TW(1, pg8::gemm_phase<pg8::EpiGate, pg8::StaticOrder, true, true>(ring, g, So, E)); }
        else if constexpr (kind == 0) { pg8::Gemm g{WSB(WS_XN), WSB(WS_WAIN + (size_t)ia * SZ_WAIN), M, 4096, 1024}; pg8::StaticOrder So; So.init(M, 4096, c.G, (int)blockIdx.x);
            pg8::EpiAin E{WSB(WA_U), WSF(WA_V)}; TW(1, pg8::gemm_phase<pg8::EpiAin, pg8::StaticOrder, true, true>(ring, g, So, E)); }
        else { constexpr int N = kind == 1 ? NBIN : NCIN; pg8::Gemm g{WSB(WS_XN), kind == 1 ? WSB(WS_WBIN) : WSB(WS_WCIN), M, N, 1024}; pg8::StaticOrder So; So.init(M, N, c.G, (int)blockIdx.x);
            pg8::EpiF32 E{WSF(WS_MIX), N}; TW(1, pg8::gemm_phase<pg8::EpiF32, pg8::StaticOrder, true, true>(ring, g, So, E)); }
    } SEAM(base);
    if constexpr (S == 1) {
        if (IN(base + 1)) { if constexpr (kind == 0) TW(3, a_stats_phase(c, ia)); else if constexpr (kind == 1) TW(3, gdn_prep_phase(c)); else TW(3, nsa_prep_phase(c)); } SEAM(base + 1);
        if (IN(base + 2)) { if constexpr (kind == 0) TW(3, a_sgu_phase(c, ia)); else if constexpr (kind == 1) TW(3, gdn_scan_phase(c));
            else {
                { pg8::Gemm g{WSB(WC_ACMP), WSB(WS_WC1), CMP_ROWS, 256, 2048}; pg8::StaticOrder So; So.init(CMP_ROWS, 256, c.G, (int)blockIdx.x);
                  pg8::EpiCmp E{WSB(WC_HC)}; TW(1, pg8::gemm_phase<pg8::EpiCmp, pg8::StaticOrder, true, true>(ring, g, So, E)); }
                { pg8::Gemm g{WSB(WC_ACMP) + (size_t)CMP_ROWS * 2048, WSB(WS_WC1 + SZ_WC1), CMP_ROWS, 256, 2048}; pg8::StaticOrder So; So.init(CMP_ROWS, 256, c.G, (int)((blockIdx.x + 128u) % (unsigned)c.G));
                  pg8::EpiCmp E{WSB(WC_HC) + (size_t)CMP_ROWS * 256}; TW(1, pg8::gemm_phase<pg8::EpiCmp, pg8::StaticOrder, true, true>(ring, g, So, E)); } } } SEAM(base + 2);
        if constexpr (kind != 0) { if (IN(base + 3)) { if constexpr (kind == 1) TW(3, gdn_post_phase(c)); else TW(3, nsa_cmp2_phase(c)); } SEAM(base + 3); }
        if constexpr (kind == 2) { if (IN(base + 4)) TW(2, nsa_attn_prompt_phase(c); nsa_attn_phase(c, 65536)); SEAM(base + 4); }
    }
    if (IN(base + 5)) {
        const bf16* A; const bf16* Bt; int K; float sc;
        if constexpr (S != 1) { A = WSB(WS_H); Bt = WSB(WS_WDN + (size_t)(2 * L + (S >> 1)) * SZ_WDN); K = DFF; sc = 0.5f; }
        else if constexpr (kind == 0) { A = WSB(WA_US); Bt = WSB(WS_WAOUT + (size_t)ia * SZ_WAOUT); K = 2048; sc = 1.f; }
        else if constexpr (kind == 1) { A = WSB(WB_OG); Bt = WSB(WS_WBOUT); K = 1024; sc = 1.f; }
        else { A = WSB(WC_OA); Bt = WSB(WS_WCOUT); K = 1024; sc = 1.f; }
        pg8::Gemm g{A, Bt, M, 1024, K}; pg8::StaticOrder So; So.init(M, 1024, c.G, (int)blockIdx.x);
        pg8::EpiResid E{WSF(WS_X), WSF(WS_PRE), ALPHA, sc}; TW(1, pg8::gemm_phase<pg8::EpiResid, pg8::StaticOrder, true, true>(ring, g, So, E));
    } SEAM(base + 5);
    if (IN(base + 6)) { TW(3, ln_phase(c, c.in[I_LNG] + (size_t)(3 * L + S) * 1024, c.in[I_LNB] + (size_t)(3 * L + S) * 1024)); } SEAM(base + 6);
    if constexpr (S == 2) { if (IN(base + 7)) { pg8::Gemm g{WSB(WS_XN), WSB(WS_WG + (size_t)L * SZ_WG), M, 1024, 1024}; pg8::StaticOrder So; So.init(M, 1024, c.G, (int)blockIdx.x);
            pg8::EpiPle E{WSF(WS_X), WSF(WS_PP) + (size_t)L * M * 1024, WSB(WS_XNB), L == 3 ? c.out : nullptr}; pg8::gemm_phase<pg8::EpiPle, pg8::StaticOrder, true, true>(ring, g, So, E); } SEAM(base + 7); }
}
template <int l> __device__ __forceinline__ void ple_proj(const Ctx& c) {
    pg8::Gemm g{WSB(WS_PBF) + (size_t)l * M * 256, WSB(WS_WP + l * SZ_WP), M, 1024, 256}; pg8::StaticOrder So; So.init(M, 1024, c.G, (int)blockIdx.x);
    pg8::EpiF32 E{WSF(WS_PP) + (size_t)l * M * 1024, 1024}; TW(1, pg8::gemm_phase<pg8::EpiF32, pg8::StaticOrder, true, true>(c.lds, g, So, E));
}
__global__ void __launch_bounds__(NWAVES * 64, 2) fwd(Args args) {
    extern __shared__ __attribute__((aligned(16))) unsigned char lds_raw[];
    Ctx c; c.lds = (LAS unsigned char*)lds_raw; c.ws = args.ws; c.out = args.out; c.in = args.in;
    c.tid = threadIdx.x; c.lane = c.tid & 63; c.wave = __builtin_amdgcn_readfirstlane(c.tid >> 6); c.G = gridDim.x; c.gw = blockIdx.x * NWAVES + c.wave; c.NGW = c.G * NWAVES;
    volatile LAS unsigned* MISC = (volatile LAS unsigned*)(c.lds + MISC_OFF);
    for (int u = c.tid; u < 128; u += NWAVES * 64) MISC[u] = 0u;
    __syncthreads();
    unsigned* ctl = (unsigned*)c.ws;
    XcdBarrier bar = xcd_barrier_post(ctl + CW_BAR + args.bli * XCD_BAR_WORDS, MISC + 8);
    const int lo = args.ph_lo, hi = args.ph_hi;
    if (IN(0)) { TW(3, prologue_phase(c)); } SEAM(0);
    if (IN(1)) { ple_proj<0>(c); ple_proj<1>(c); ple_proj<2>(c); ple_proj<3>(c); } SEAM(1);
    run_sub<0, 0>(c, bar, lo, hi); run_sub<0, 1>(c, bar, lo, hi); run_sub<0, 2>(c, bar, lo, hi);
    run_sub<1, 0>(c, bar, lo, hi); run_sub<1, 1>(c, bar, lo, hi); run_sub<1, 2>(c, bar, lo, hi);
    run_sub<2, 0>(c, bar, lo, hi); run_sub<2, 1>(c, bar, lo, hi); run_sub<2, 2>(c, bar, lo, hi);
    run_sub<3, 0>(c, bar, lo, hi); run_sub<3, 1>(c, bar, lo, hi); run_sub<3, 2>(c, bar, lo, hi);
}
#undef IN
#undef SEAM

#ifndef ONE_LAUNCH
#define ONE_LAUNCH 1
#endif
extern "C" void kernel_launch(void* const* d_in, const int* in_sizes, int n_in, void* d_out, int out_size, void* d_ws, size_t ws_size, hipStream_t stream) {
    static int grid = 0;
    if (grid == 0) {
        if (n_in != N_IN || (size_t)out_size != O_END || ws_size < WS_END) { fprintf(stderr, "kernel_launch: unexpected problem: n_in %d out %d ws %zu (need %zu)\n", n_in, out_size, ws_size, (size_t)WS_END); grid = -1; return; }
        int dev = 0, cus = 0, per_cu = 0;
        if (hipGetDevice(&dev) != hipSuccess || hipDeviceGetAttribute(&cus, hipDeviceAttributeMultiprocessorCount, dev) != hipSuccess) { grid = -1; return; }
        if (hipFuncSetAttribute((const void*)fwd, hipFuncAttributeMaxDynamicSharedMemorySize, LDS_BYTES) != hipSuccess) { fprintf(stderr, "kernel_launch: hipFuncSetAttribute failed\n"); grid = -1; return; }
        if (hipOccupancyMaxActiveBlocksPerMultiprocessor(&per_cu, (const void*)fwd, NWAVES * 64, LDS_BYTES) != hipSuccess || per_cu < 1) fprintf(stderr, "kernel_launch: occupancy query says %d\n", per_cu);
        (void)hipGetLastError();
        grid = cus;
    }
    if (grid < 0) return;
    (void)hipMemsetAsync(d_ws, 0, CTL_BYTES, stream);
    Args a{};
    for (int i = 0; i < N_IN; ++i) a.in[i] = (const float*)d_in[i];
    a.out = (float*)d_out; a.ws = (unsigned char*)d_ws; a.pad = 0;
#if ONE_LAUNCH
    a.ph_lo = 0; a.ph_hi = N_PHASES; a.bli = 0;
    hipLaunchKernelGGL(fwd, dim3(grid), dim3(NWAVES * 64), LDS_BYTES, stream, a);
#else
    for (int ph = 0; ph < N_PHASES; ++ph) { if (!phase_exists(ph)) continue; a.ph_lo = ph; a.ph_hi = ph + 1; a.bli = 0;
        hipLaunchKernelGGL(fwd, dim3(grid), dim3(NWAVES * 64), LDS_BYTES, stream, a); }
#endif
}
```

```cpp
#include <hip/hip_runtime.h>
#include <cstdio>
#include <cstdint>
namespace pg8 {
#define PG8_LAS __attribute__((address_space(3)))
typedef unsigned short bf16_t;
typedef short bf16x8 __attribute__((ext_vector_type(8)));
typedef float f32x4 __attribute__((ext_vector_type(4)));
typedef unsigned u32x4 __attribute__((ext_vector_type(4)));
constexpr int BM = 256, BK = 64, HALF = 128, HTB = HALF * BK * 2  , STAGE_BYTES = 8 * HTB, NXCD = 8, WGM = 8;

__host__ __device__ __forceinline__ int lds_byte(int r, int c) { const int st = (r >> 4) * 2 + (c >> 5), rr = r & 15, cc = c & 31, ob = rr * 64 + cc * 2; return st * 1024 + (ob ^ (((ob >> 9) & 1) << 5)); }
__host__ __device__ __forceinline__ void stage_rc(int b, int& R, int& C) { const int st = b / 1024, sb = b % 1024, swz = sb ^ (((sb >> 9) & 1) << 5); R = (st >> 1) * 16 + swz / 64; C = (st & 1) * 32 + (swz % 64) / 2; }
__host__ __device__ __forceinline__ int perm32(int rho) { const int n = rho >> 4, i = rho & 15; return 8 * (i >> 2) + 4 * n + (i & 3); }

struct Unit { int pm, pn; };
struct Gemm { const bf16_t* A; const bf16_t* Bt; int M, N, K; };

struct StaticOrder {
    int nM, nN, nwg, G, c;
    __host__ __device__ void init(int M, int N, int G_, int c_) { nM = M / BM; nN = N / BM; nwg = nM * nN; G = G_; c = c_; }
    __host__ __device__ bool next(int i, Unit& u) const {
        const long L = (long)i * G + c; if (L >= nwg) return false;
        int wgid = (int)L; { const int q = nwg / NXCD, r = nwg % NXCD, xcd = wgid % NXCD, off = wgid / NXCD; wgid = (xcd < r ? xcd * (q + 1) : r * (q + 1) + (xcd - r) * q) + off; }
        const int nig = WGM * nN, gid = wgid / nig, fm = gid * WGM, gsz = (nM - fm) < WGM ? (nM - fm) : WGM;
        u.pm = fm + ((wgid % nig) % gsz); u.pn = (wgid % nig) / gsz; return true;
    }
    __device__ __forceinline__ void a_ready(const Unit&) const {}
    __device__ __forceinline__ void done(const Unit&) const {}
};

__device__ __forceinline__ unsigned cvt_pk_bf16(float lo, float hi) { unsigned r; asm volatile("v_cvt_pk_bf16_f32 %0, %1, %2" : "=v"(r) : "v"(lo), "v"(hi)); return r; }
typedef unsigned u32x2 __attribute__((ext_vector_type(2)));
__device__ __forceinline__ float fast_sigmoid(float x) { return __frcp_rn(1.0f + __expf(-x)); }
__device__ __forceinline__ float silu_f(float x) { return x * fast_sigmoid(x); }
__device__ __forceinline__ float gelu_tanh_f(float x) { const float y = 1.5957691216057308f * (x + 0.044715f * x * x * x); return x * fast_sigmoid(y); }
__device__ __forceinline__ u32x2 pack4(f32x4 v) { u32x2 w; w.x = cvt_pk_bf16(v[0], v[1]); w.y = cvt_pk_bf16(v[2], v[3]); return w; }

struct EpiGate {
    static constexpr bool PERM = false, AFTER_DRAIN = false;
    bf16_t* H; int ldh;
    __device__ __forceinline__ void operator()(const f32x4 (&acc)[2][2][4][2], const Unit& u, int wr, int wc, int fr, int fq) const {
        const int row0 = u.pm * BM + wr * 64 + fr, col0 = u.pn * HALF + wc * 32 + 4 * fq;
#pragma unroll
        for (int ai = 0; ai < 2; ++ai)
#pragma unroll
            for (int m = 0; m < 4; ++m) { bf16_t* rowp = H + (size_t)(row0 + ai * HALF + m * 16) * ldh + col0;
#pragma unroll
                for (int n = 0; n < 2; ++n) { const f32x4 a = acc[ai][0][m][n], b = acc[ai][1][m][n]; f32x4 h;
#pragma unroll
                    for (int j = 0; j < 4; ++j) h[j] = silu_f(a[j]) * b[j];
                    *(u32x2*)(rowp + n * 16) = pack4(h); } }
    }
};
struct EpiResid {
    static constexpr bool PERM = false, AFTER_DRAIN = false;
    const float* X; float* PRE; float alpha, s;
    __device__ __forceinline__ void operator()(const f32x4 (&acc)[2][2][4][2], const Unit& u, int wr, int wc, int fr, int fq) const {
        const int row0 = u.pm * BM + wr * 64 + fr, col0 = u.pn * BM + wc * 32 + 4 * fq;
#pragma unroll
        for (int ai = 0; ai < 2; ++ai)
#pragma unroll
            for (int m = 0; m < 4; ++m) { const size_t off = (size_t)(row0 + ai * HALF + m * 16) * 1024 + col0;
#pragma unroll
                for (int bj = 0; bj < 2; ++bj)
#pragma unroll
                    for (int n = 0; n < 2; ++n) { const f32x4 x = *(const f32x4*)(X + off + bj * HALF + n * 16); *(f32x4*)(PRE + off + bj * HALF + n * 16) = x * alpha + acc[ai][bj][m][n] * s; } }
    }
};
struct EpiF32 {
    static constexpr bool PERM = false, AFTER_DRAIN = false;
    float* C; int ldc;
    __device__ __forceinline__ void operator()(const f32x4 (&acc)[2][2][4][2], const Unit& u, int wr, int wc, int fr, int fq) const {
        const int row0 = u.pm * BM + wr * 64 + fr, col0 = u.pn * BM + wc * 32 + 4 * fq;
#pragma unroll
        for (int ai = 0; ai < 2; ++ai)
#pragma unroll
            for (int m = 0; m < 4; ++m) { float* rowp = C + (size_t)(row0 + ai * HALF + m * 16) * ldc + col0;
#pragma unroll
                for (int bj = 0; bj < 2; ++bj)
#pragma unroll
                    for (int n = 0; n < 2; ++n) *(f32x4*)(rowp + bj * HALF + n * 16) = acc[ai][bj][m][n]; }
    }
};
struct EpiPle {
    static constexpr bool PERM = false, AFTER_DRAIN = false;
    float* X; const float* P; bf16_t* XN; float* OUT;
    __device__ __forceinline__ void operator()(const f32x4 (&acc)[2][2][4][2], const Unit& u, int wr, int wc, int fr, int fq) const {
        const int row0 = u.pm * BM + wr * 64 + fr, col0 = u.pn * BM + wc * 32 + 4 * fq;
#pragma unroll
        for (int ai = 0; ai < 2; ++ai)
#pragma unroll
            for (int m = 0; m < 4; ++m) { const size_t off = (size_t)(row0 + ai * HALF + m * 16) * 1024 + col0;
#pragma unroll
                for (int bj = 0; bj < 2; ++bj)
#pragma unroll
                    for (int n = 0; n < 2; ++n) { const size_t o = off + bj * HALF + n * 16; const f32x4 x = *(const f32x4*)(X + o), p = *(const f32x4*)(P + o), a = acc[ai][bj][m][n]; f32x4 y;
#pragma unroll
                        for (int j = 0; j < 4; ++j) y[j] = x[j] + fast_sigmoid(a[j]) * p[j];
                        *(f32x4*)(X + o) = y; *(u32x2*)(XN + o) = pack4(y); if (OUT) *(f32x4*)(OUT + o) = y; } }
    }
};
struct EpiAin {
    static constexpr bool PERM = false, AFTER_DRAIN = false;
    bf16_t* U; float* V;
    __device__ __forceinline__ void operator()(const f32x4 (&acc)[2][2][4][2], const Unit& u, int wr, int wc, int fr, int fq) const {
        const int row0 = u.pm * BM + wr * 64 + fr; const bool isu = u.pn < 8; const int col0 = (isu ? u.pn : u.pn - 8) * BM + wc * 32 + 4 * fq;
#pragma unroll
        for (int ai = 0; ai < 2; ++ai)
#pragma unroll
            for (int m = 0; m < 4; ++m) { const size_t off = (size_t)(row0 + ai * HALF + m * 16) * 2048 + col0;
#pragma unroll
                for (int bj = 0; bj < 2; ++bj)
#pragma unroll
                    for (int n = 0; n < 2; ++n) { const f32x4 a = acc[ai][bj][m][n]; f32x4 y;
#pragma unroll
                        for (int j = 0; j < 4; ++j) y[j] = gelu_tanh_f(a[j]);
                        if (isu) *(u32x2*)(U + off + bj * HALF + n * 16) = pack4(y); else *(f32x4*)(V + off + bj * HALF + n * 16) = y; } }
    }
};
struct EpiCmp {
    static constexpr bool PERM = false, AFTER_DRAIN = false;
    bf16_t* HC;
    __device__ __forceinline__ void operator()(const f32x4 (&acc)[2][2][4][2], const Unit& u, int wr, int wc, int fr, int fq) const {
        const int row0 = u.pm * BM + wr * 64 + fr, col0 = u.pn * BM + wc * 32 + 4 * fq;
#pragma unroll
        for (int ai = 0; ai < 2; ++ai)
#pragma unroll
            for (int m = 0; m < 4; ++m) { bf16_t* rowp = HC + (size_t)(row0 + ai * HALF + m * 16) * 256 + col0;
#pragma unroll
                for (int bj = 0; bj < 2; ++bj)
#pragma unroll
                    for (int n = 0; n < 2; ++n) { const f32x4 a = acc[ai][bj][m][n]; f32x4 y;
#pragma unroll
                        for (int j = 0; j < 4; ++j) y[j] = gelu_tanh_f(a[j]);
                        *(u32x2*)(rowp + bj * HALF + n * 16) = pack4(y); } }
    }
};
template <class Epi, class Sched, bool ALIGN_EPI = false, bool SP2 = false>
__device__ __forceinline__ void gemm_phase(PG8_LAS unsigned char* lds, const Gemm g, const Sched& S, const Epi& E) {
    const int tid = threadIdx.x, wid = __builtin_amdgcn_readfirstlane(tid >> 6), lane = tid & 63, wr = wid >> 2, wc = wid & 3, fr = lane & 15, fq = lane >> 4;
    const int K = g.K, nt = K / BK;
    unsigned voffA[2], voffB[2];
#pragma unroll
    for (int i = 0; i < 2; ++i) { int R, C; stage_rc(tid * 16 + i * 8192, R, C); const int Rb = Epi::PERM ? ((R & ~31) + perm32(R & 31)) : R;
        voffA[i] = (unsigned)(R * K + C) * 2u; voffB[i] = (unsigned)(Rb * K + C) * 2u; }
    const size_t kstep = (size_t)(BK * 2);
    const size_t hstep = (size_t)HALF * K * 2;
    const size_t tstep = 2 * hstep;
    const unsigned ldsw = (unsigned)wid * 1024u;
    const int aoff = lds_byte(wr * 64 + fr, fq * 8), boff = lds_byte(wc * 32 + fr, fq * 8);
#define PG8_SA(b, h) (((b) * 2 + (h)) * HTB)
#define PG8_SB(b, h) ((4 + (b) * 2 + (h)) * HTB)
#define PG8_STAGE(bufoff, gbase, voff) do { _Pragma("unroll") for (int _i = 0; _i < 2; ++_i) \
        __builtin_amdgcn_global_load_lds((const unsigned*)((const char*)(gbase) + (voff)[_i]), (PG8_LAS unsigned*)(lds + (bufoff) + ldsw + _i * 8192), 16, 0, 0); } while (0)
#define PG8_LDA(dst, b, h) do { _Pragma("unroll") for (int m = 0; m < 4; ++m) _Pragma("unroll") for (int k = 0; k < 2; ++k) dst[m][k] = *(const PG8_LAS bf16x8*)(lds + PG8_SA(b, h) + aoff + m * 2048 + k * 1024); } while (0)
#define PG8_LDB(dst, b, h) do { _Pragma("unroll") for (int n = 0; n < 2; ++n) _Pragma("unroll") for (int k = 0; k < 2; ++k) dst[n][k] = *(const PG8_LAS bf16x8*)(lds + PG8_SB(b, h) + boff + n * 2048 + k * 1024); } while (0)
#define PG8_MMA(ai, bj, At, Bt) do { __builtin_amdgcn_s_setprio(1); _Pragma("unroll") for (int m = 0; m < 4; ++m) _Pragma("unroll") for (int n = 0; n < 2; ++n) _Pragma("unroll") for (int k = 0; k < 2; ++k) \
        acc[ai][bj][m][n] = __builtin_amdgcn_mfma_f32_16x16x32_bf16(Bt[n][k], At[m][k], acc[ai][bj][m][n], 0, 0, 0); __builtin_amdgcn_s_setprio(0); } while (0)
#define PG8_WAIT_V(n) asm volatile("s_waitcnt vmcnt(" #n ")" ::: "memory")
#define PG8_WAIT_L(n) asm volatile("s_waitcnt lgkmcnt(" #n ")" ::: "memory")
#define PG8_BAR __builtin_amdgcn_s_barrier()
#define PG8_SCHED __builtin_amdgcn_sched_barrier(0)
    Unit cur, nxt; int ui = 0;
    if (!S.next(0, cur)) return;
    f32x4 acc[2][2][4][2];
#pragma unroll
    for (int a = 0; a < 2; ++a)
#pragma unroll
        for (int b = 0; b < 2; ++b)
#pragma unroll
            for (int m = 0; m < 4; ++m)
#pragma unroll
                for (int n = 0; n < 2; ++n) acc[a][b][m][n] = (f32x4){0.f, 0.f, 0.f, 0.f};
    bf16x8 At[4][2], B0[2][2], B1[2][2];
    const char* cA = (const char*)g.A + (size_t)cur.pm * tstep; const char* cB = (const char*)g.Bt + (size_t)cur.pn * tstep;
    S.a_ready(cur);
    if constexpr (SP2) {
        PG8_STAGE(PG8_SB(0, 0), cB, voffB); PG8_STAGE(PG8_SB(0, 1), cB + hstep, voffB); PG8_STAGE(PG8_SA(0, 0), cA, voffA); PG8_STAGE(PG8_SA(0, 1), cA + hstep, voffA);
        if (wr == 1) PG8_BAR;
        PG8_WAIT_V(2); PG8_BAR;
        PG8_STAGE(PG8_SB(1, 0), cB + kstep, voffB); PG8_STAGE(PG8_SA(1, 0), cA + kstep, voffA); PG8_STAGE(PG8_SB(1, 1), cB + hstep + kstep, voffB);
        PG8_WAIT_V(6); PG8_BAR;
    } else {
        PG8_STAGE(PG8_SB(0, 0), cB, voffB); PG8_STAGE(PG8_SA(0, 0), cA, voffA); PG8_STAGE(PG8_SB(0, 1), cB + hstep, voffB); PG8_STAGE(PG8_SA(0, 1), cA + hstep, voffA);
        if (wr == 1) PG8_BAR;
        PG8_WAIT_V(4); PG8_BAR;
        PG8_STAGE(PG8_SB(1, 0), cB + kstep, voffB); PG8_STAGE(PG8_SA(1, 0), cA + kstep, voffA); PG8_STAGE(PG8_SB(1, 1), cB + hstep + kstep, voffB);
        PG8_WAIT_V(6); PG8_BAR;
    }
    for (;;) {
        const bool has_next = S.next(ui + 1, nxt);
        const char* nA = has_next ? (const char*)g.A + (size_t)nxt.pm * tstep : cA; const char* nB = has_next ? (const char*)g.Bt + (size_t)nxt.pn * tstep : cB;
        for (int t = 0; t < nt; t += 2) {
            const bool last = (t == nt - 2);
            const char* a1 = cA + (size_t)(t + 1) * kstep;
            const char* a2 = last ? nA : cA + (size_t)(t + 2) * kstep; const char* b2 = last ? nB : cB + (size_t)(t + 2) * kstep;
            const char* a3 = a2 + kstep; const char* b3 = b2 + kstep;
            if (last && has_next) S.a_ready(nxt);
            if constexpr (SP2) {
            PG8_LDB(B0, 0, 0); PG8_LDB(B1, 0, 1); PG8_SCHED; PG8_LDA(At, 0, 0); PG8_STAGE(PG8_SA(1, 1), a1 + hstep, voffA);
            PG8_WAIT_V(8); PG8_WAIT_L(0); PG8_BAR; PG8_MMA(0, 0, At, B0); PG8_MMA(0, 1, At, B1); PG8_BAR; PG8_SCHED;
            PG8_LDA(At, 0, 1); PG8_STAGE(PG8_SB(0, 0), b2, voffB); PG8_STAGE(PG8_SB(0, 1), b2 + hstep, voffB); PG8_STAGE(PG8_SA(0, 0), a2, voffA);
            PG8_WAIT_V(8); PG8_WAIT_L(0); PG8_BAR; PG8_MMA(1, 0, At, B0); PG8_MMA(1, 1, At, B1); PG8_BAR; PG8_SCHED;
            PG8_LDB(B0, 1, 0); PG8_LDB(B1, 1, 1); PG8_SCHED; PG8_LDA(At, 1, 0); PG8_STAGE(PG8_SA(0, 1), a2 + hstep, voffA);
            PG8_WAIT_V(8); PG8_WAIT_L(0); PG8_BAR; PG8_MMA(0, 0, At, B0); PG8_MMA(0, 1, At, B1); PG8_BAR; PG8_SCHED;
            PG8_LDA(At, 1, 1); PG8_STAGE(PG8_SB(1, 0), b3, voffB); PG8_STAGE(PG8_SB(1, 1), b3 + hstep, voffB); PG8_STAGE(PG8_SA(1, 0), a3, voffA);
            PG8_WAIT_V(8); PG8_WAIT_L(0); PG8_BAR; PG8_MMA(1, 0, At, B0); PG8_MMA(1, 1, At, B1); PG8_BAR; PG8_SCHED;
            } else {
            PG8_LDB(B0, 0, 0); PG8_SCHED; PG8_LDA(At, 0, 0); PG8_STAGE(PG8_SA(1, 1), a1 + hstep, voffA);
            PG8_WAIT_L(8); PG8_BAR; PG8_WAIT_L(0); PG8_MMA(0, 0, At, B0); PG8_BAR; PG8_SCHED;
            PG8_LDB(B1, 0, 1); PG8_STAGE(PG8_SB(0, 0), b2, voffB);
            PG8_BAR; PG8_WAIT_L(0); PG8_MMA(0, 1, At, B1); PG8_BAR;
            PG8_LDA(At, 0, 1); PG8_STAGE(PG8_SA(0, 0), a2, voffA);
            PG8_BAR; PG8_WAIT_L(0); PG8_MMA(1, 0, At, B0); PG8_BAR; PG8_SCHED;
            PG8_STAGE(PG8_SB(0, 1), b2 + hstep, voffB);
            PG8_WAIT_V(6); PG8_BAR; PG8_MMA(1, 1, At, B1); PG8_BAR;
            PG8_LDB(B0, 1, 0); PG8_SCHED; PG8_LDA(At, 1, 0); PG8_STAGE(PG8_SA(0, 1), a2 + hstep, voffA);
            PG8_WAIT_L(8); PG8_BAR; PG8_WAIT_L(0); PG8_MMA(0, 0, At, B0); PG8_BAR; PG8_SCHED;
            PG8_LDB(B1, 1, 1); PG8_STAGE(PG8_SB(1, 0), b3, voffB);
            PG8_BAR; PG8_WAIT_L(0); PG8_MMA(0, 1, At, B1); PG8_BAR;
            PG8_LDA(At, 1, 1); PG8_STAGE(PG8_SA(1, 0), a3, voffA);
            PG8_BAR; PG8_WAIT_L(0); PG8_MMA(1, 0, At, B0); PG8_BAR; PG8_SCHED;
            PG8_STAGE(PG8_SB(1, 1), b3 + hstep, voffB);
            PG8_WAIT_V(6); PG8_BAR; PG8_MMA(1, 1, At, B1); PG8_BAR;
            }
        }
        if constexpr (ALIGN_EPI) { if (wr == 0) PG8_BAR; }
        if constexpr (!Epi::AFTER_DRAIN) { E(acc, cur, wr, wc, fr, fq); S.done(cur); }
        if (!has_next) break;
#pragma unroll
        for (int a = 0; a < 2; ++a)
#pragma unroll
            for (int b = 0; b < 2; ++b)
#pragma unroll
                for (int m = 0; m < 4; ++m)
#pragma unroll
                    for (int n = 0; n < 2; ++n) acc[a][b][m][n] = (f32x4){0.f, 0.f, 0.f, 0.f};
        cur = nxt; cA = nA; cB = nB; ++ui;
        if constexpr (ALIGN_EPI) { if (wr == 1) PG8_BAR; }
    }
    PG8_WAIT_V(0);
    if constexpr (!ALIGN_EPI) { if (wr == 0) PG8_BAR; }
    PG8_BAR;
    if constexpr (Epi::AFTER_DRAIN) { E.fused(acc, cur, wr, wc, fr, fq, lds, wid, lane); S.done(cur); }
#undef PG8_SA
#undef PG8_SB
#undef PG8_STAGE
#undef PG8_LDA
#undef PG8_LDB
#undef PG8_MMA
#undef PG8_WAIT_V
#undef PG8_WAIT_L
#undef PG8_BAR
#undef PG8_SCHED
}
}
constexpr int NWAVES = 8;
constexpr int MP = 16384, MS = 512, M = 16896, D = 1024, DFF = 2816, PLE = 256, SEQ = 4096, NB = 4, DB = 128, DSQ = 4;
constexpr int NBIN = 4352, NBIN_REAL = 4112, NCIN = 2816, NCIN_REAL = 2608;
constexpr int CMP_ROWS = 34816;
constexpr float ALPHA = 1.681792830507429f, LN_EPS = 1e-5f, NORM_EPS = 1e-6f;
constexpr size_t O_YP = 0, O_YS = 16777216, O_AV = 17301504, O_GSP = 19398656, O_GCP = 19922944, O_GSS = 19959808, O_GCS = 36737024,
                 O_KVP = 37916672, O_WINP = 54693888, O_KVS = 55742464, O_WINS = 56266752, O_END = 56528896;
constexpr size_t CTL_BYTES = 1u << 20;
constexpr size_t SZ_WUP = (size_t)5632 * 1024 * 2, SZ_WDN = (size_t)1024 * 2816 * 2, SZ_WG = (size_t)1024 * 1024 * 2, SZ_WP = (size_t)1024 * 256 * 2,
                 SZ_WAIN = (size_t)4096 * 1024 * 2, SZ_WAOUT = (size_t)1024 * 2048 * 2, SZ_WBIN = (size_t)NBIN * 1024 * 2, SZ_WCIN = (size_t)NCIN * 1024 * 2, SZ_WC1 = (size_t)256 * 2048 * 2;
constexpr size_t WS_WUP = CTL_BYTES, WS_WDN = WS_WUP + 8 * SZ_WUP, WS_WG = WS_WDN + 8 * SZ_WDN, WS_WP = WS_WG + 4 * SZ_WG, WS_WAIN = WS_WP + 4 * SZ_WP, WS_WAOUT = WS_WAIN + 2 * SZ_WAIN,
                 WS_WBIN = WS_WAOUT + 2 * SZ_WAOUT, WS_WBOUT = WS_WBIN + SZ_WBIN, WS_WCIN = WS_WBOUT + SZ_WG, WS_WCOUT = WS_WCIN + SZ_WCIN, WS_WC1 = WS_WCOUT + SZ_WG;
constexpr size_t WS_WSM = WS_WC1 + 2 * SZ_WC1;
constexpr size_t WS_X = WS_WSM + (size_t)2 * 16 * 128 * 128 * 2;
constexpr size_t WS_XN = WS_X + (size_t)M * 1024 * 4;
constexpr size_t WS_XNB = WS_XN + (size_t)M * 1024 * 2;
constexpr size_t WS_PRE = WS_XNB + (size_t)M * 1024 * 2;
constexpr size_t WS_H = WS_PRE + (size_t)M * 1024 * 4;
constexpr size_t WS_PBF = WS_H + (size_t)M * 2816 * 2;
constexpr size_t WS_PP = WS_PBF + (size_t)4 * M * 256 * 2;
constexpr size_t WS_MIX = WS_PP + (size_t)4 * M * 1024 * 4;
constexpr size_t WA_U = WS_MIX, WA_V = WA_U + (size_t)M * 2048 * 2, WA_US = WA_V + (size_t)M * 2048 * 4, WA_ST = WA_US + (size_t)M * 2048 * 2, WA_END = WA_ST + (size_t)M * 8;
constexpr size_t GUNITS = 2048;
constexpr size_t WB_PROJ = WS_MIX, WB_W = WB_PROJ + (size_t)M * NBIN * 4, WB_U = WB_W + GUNITS * 64 * 128 * 4, WB_QG = WB_U + GUNITS * 64 * 128 * 4, WB_KD = WB_QG + GUNITS * 64 * 128 * 4,
                 WB_QK = WB_KD + GUNITS * 64 * 128 * 4, WB_EG = WB_QK + GUNITS * 64 * 64 * 4, WB_O = WB_EG + 65536, WB_OG = WB_O + (size_t)M * 1024 * 4, WB_END = WB_OG + (size_t)M * 1024 * 2;
constexpr size_t WC_PROJ = WS_MIX, WC_ACMP = WC_PROJ + (size_t)M * NCIN * 4, WC_HC = WC_ACMP + (size_t)2 * CMP_ROWS * 2048 * 2, WC_KCV = WC_HC + (size_t)2 * CMP_ROWS * 256 * 2,
                 WC_OA = WC_KCV + (size_t)2 * CMP_ROWS * 64 * 4, WC_KSB = WC_OA + (size_t)M * 1024 * 2, WC_VST = WC_KSB + (size_t)16 * SEQ * 64 * 2, WC_KWB = WC_VST + (size_t)16 * SEQ * 64 * 2, WC_VWT = WC_KWB + (size_t)16 * SEQ * 64 * 2,
                 WC_KCB = WC_VWT + (size_t)16 * SEQ * 64 * 2, WC_VCT = WC_KCB + (size_t)16 * 128 * 64 * 2, WC_END = WC_VCT + (size_t)16 * 128 * 64 * 2;
constexpr size_t WS_END = (WB_END > WC_END ? (WB_END > WA_END ? WB_END : WA_END) : (WC_END > WA_END ? WC_END : WA_END));
static_assert(WS_X % 256 == 0 && WS_MIX % 256 == 0 && WB_W % 256 == 0 && WC_ACMP % 256 == 0, "alignment");
constexpr int CW_TMO = 0, CW_BAR = 4096;
constexpr int LDS_BYTES = 147456, MISC_OFF = LDS_BYTES - 512;

#define GAS __attribute__((address_space(1)))
#define LAS __attribute__((address_space(3)))
typedef unsigned short bf16;
typedef float f32x4 __attribute__((ext_vector_type(4)));
typedef float f32x2 __attribute__((ext_vector_type(2)));
typedef unsigned u32x2 __attribute__((ext_vector_type(2)));
typedef unsigned u32x4 __attribute__((ext_vector_type(4)));
#define LDS_WAIT() asm volatile("s_waitcnt lgkmcnt(0)" ::: "memory")
__device__ __forceinline__ unsigned f2bf(float f) { unsigned u = __builtin_bit_cast(unsigned, f); return (u + 0x7fffu + ((u >> 16) & 1u)) >> 16; }
typedef __bf16 hwbf16x2_t __attribute__((ext_vector_type(2)));
__device__ __forceinline__ unsigned pk2(float lo, float hi) { const f32x2 v = {lo, hi}; const hwbf16x2_t b = __builtin_convertvector(v, hwbf16x2_t); return __builtin_bit_cast(unsigned, b); }
__device__ __forceinline__ float bf2f(bf16 b) { return __builtin_bit_cast(float, ((unsigned)b) << 16); }
__device__ __forceinline__ float wave_sum(float v) {
#pragma unroll
    for (int o = 1; o < 64; o <<= 1) v += __shfl_xor(v, o);
    return v;
}
__device__ __forceinline__ float wave_max(float v) {
#pragma unroll
    for (int o = 1; o < 64; o <<= 1) v = fmaxf(v, __shfl_xor(v, o));
    return v;
}
__device__ __forceinline__ float sigmoid_f(float x) { return 1.0f / (1.0f + __expf(-x)); }
__device__ __forceinline__ float siluf(float x) { return x * sigmoid_f(x); }
__device__ __forceinline__ float readlane_f(float v, int k) { return __builtin_bit_cast(float, __builtin_amdgcn_readlane(__builtin_bit_cast(int, v), k)); }
typedef short bf16x8_t __attribute__((ext_vector_type(8)));
#define MFMA16(a, b, cc) __builtin_amdgcn_mfma_f32_16x16x32_bf16((a), (b), (cc), 0, 0, 0)
#define XB_TMO      128
#define XB_XCNT(j)  (256  + 64 * (j))
#define XB_XSUB(j)  (1280 + 64 * (j))
#define XB_XGEN(j)  (2304 + 64 * (j))
#define XB_TOP      3328
#define XB_TOPGEN   3392
#define XCD_BAR_WORDS 3456
#define XB_SPIN_CAP (1u << 18)

__device__ __forceinline__ unsigned xb_ld(unsigned* p)              { return __hip_atomic_load(p, __ATOMIC_RELAXED, __HIP_MEMORY_SCOPE_AGENT); }
__device__ __forceinline__ unsigned xb_add(unsigned* p, unsigned v) { return __hip_atomic_fetch_add(p, v, __ATOMIC_RELAXED, __HIP_MEMORY_SCOPE_AGENT); }
__device__ __forceinline__ unsigned xb_xcc_id() { return (unsigned)__builtin_amdgcn_s_getreg((3 << 11) | 20) & 0xFu; }
#define XB_SPIN(cond, bar) do { unsigned _sp = 0; while (cond) { __builtin_amdgcn_s_sleep(1); \
    if ((++_sp & 255u) == 0u) { if (xb_ld(&(bar)[XB_TMO])) break; if (_sp > XB_SPIN_CAP) { atomicAdd(&(bar)[XB_TMO], 1u); break; } } } } while (0)

struct XcdBarrier {
    unsigned* bar; unsigned x;
    volatile LAS unsigned* st;
};

__device__ __forceinline__ XcdBarrier xcd_barrier_post(unsigned* bar, volatile LAS unsigned* st) {
    XcdBarrier b; b.bar = bar; b.x = xb_xcc_id(); b.st = st;
    if (threadIdx.x == 0) (void)xb_add(&bar[XB_XCNT(b.x)], 1u);
    return b;
}
__device__ __forceinline__ void xcd_barrier_complete(unsigned* bar, unsigned x, unsigned& nloc, unsigned& nx) {
    const unsigned G = gridDim.x * gridDim.y * gridDim.z;
    unsigned sum, cnt, mine, sp = 0u;
    for (;;) {
        sum = 0u; cnt = 0u; mine = 0u;
#pragma unroll
        for (unsigned j = 0; j < 16; ++j) { const unsigned c = xb_ld(&bar[XB_XCNT(j)]); sum += c; cnt += (c > 0u) ? 1u : 0u; mine = (j == x) ? c : mine; }
        if (sum == G) break;
        __builtin_amdgcn_s_sleep(1);
        if ((++sp & 255u) == 0u) { if (xb_ld(&bar[XB_TMO])) break; if (sp > XB_SPIN_CAP) { atomicAdd(&bar[XB_TMO], 1u); break; } }
    }
    nloc = mine > 0u ? mine : 1u; nx = cnt > 0u ? cnt : 1u;
}

__device__ __forceinline__ void xcd_barrier(const XcdBarrier& b) {
    asm volatile("s_waitcnt vmcnt(0)" ::: "memory");
    __syncthreads();
    if (threadIdx.x == 0) {
        unsigned* bar = b.bar;
        __builtin_amdgcn_s_waitcnt(0);
        unsigned nloc = b.st[0], nx = b.st[1];
        if (nloc == 0u) { xcd_barrier_complete(bar, b.x, nloc, nx); b.st[0] = nloc; b.st[1] = nx; }
        const unsigned old = xb_add(&bar[XB_XSUB(b.x)], 1u);
        const unsigned gen = old / nloc;
        if (old + 1u == (gen + 1u) * nloc) {
            __builtin_amdgcn_fence(__ATOMIC_RELEASE, "agent");
            asm volatile("s_waitcnt vmcnt(0)" ::: "memory");
            const unsigned og = xb_add(&bar[XB_TOP], 1u);
            const unsigned tg = og / nx;
            if (og + 1u == (tg + 1u) * nx) xb_add(&bar[XB_TOPGEN], 1u);
            else XB_SPIN(xb_ld(&bar[XB_TOPGEN]) == tg, bar);
            __builtin_amdgcn_fence(__ATOMIC_ACQUIRE, "agent");
            xb_add(&bar[XB_XGEN(b.x)], 1u);
            asm volatile("s_waitcnt vmcnt(0)" ::: "memory");
        } else {
            XB_SPIN(xb_ld(&bar[XB_XGEN(b.x)]) == gen, bar);
            __builtin_amdgcn_fence(__ATOMIC_ACQUIRE, "agent");
            asm volatile("s_waitcnt vmcnt(0)" ::: "memory");
        }
    }
    __syncthreads();
}
enum { I_XP = 0, I_XS, I_GS, I_GCONV, I_CKV, I_CWIN, I_PT, I_PP, I_PS, I_LNG, I_LNB, I_WUP, I_WDN, I_WG, I_WPJ, I_AWIN, I_ALNG, I_ALNB, I_AWS, I_ABS, I_AWOUT,
       I_BWIN, I_BCONV, I_BALOG, I_BDT, I_BNG, I_BWOUT, I_CWIN_W, I_CGB, I_CPE, I_CW1, I_CW2, I_CWOUT, I_T5, N_IN };
struct Ctx {
    LAS unsigned char* lds; unsigned char* ws; float* out; const float* const* in;
    int tid, lane, wave, G, gw, NGW;
};
#define WSF(off) ((float*)(c.ws + (off)))
#define WSB(off) ((bf16*)(c.ws + (off)))

__device__ __forceinline__ void tr_item(const float* W, int K, int N, bf16* WT, int mode, LAS float* scr, int item, int lane) {
    const int nblk = (N + 31) >> 5, kb = item / nblk, nb = item - kb * nblk, k0 = 64 * kb, n0 = 32 * nb;
    const int nn = n0 + (lane & 31); const bool ok = nn < N;
#pragma unroll 8
    for (int i = 0; i < 32; ++i) { const int kk = 2 * i + (lane >> 5); scr[kk * 33 + (lane & 31)] = ok ? W[(size_t)(k0 + kk) * N + nn] : 0.f; }
    LDS_WAIT(); asm volatile("" ::: "memory");
    const int cch = lane & 7;
#pragma unroll
    for (int j = 0; j < 4; ++j) { const int nl = (lane >> 3) + 8 * j, n = n0 + nl; const LAS float* s = scr + (8 * cch) * 33 + nl;
        if (n < N) { u32x4 o; o.x = pk2(s[0 * 33], s[1 * 33]); o.y = pk2(s[2 * 33], s[3 * 33]); o.z = pk2(s[4 * 33], s[5 * 33]); o.w = pk2(s[6 * 33], s[7 * 33]);
            int drow = n; if (mode == 1) { const int half = n >= DFF ? 1 : 0, idx = n - half * DFF; drow = (idx >> 7) * 256 + half * 128 + (idx & 127); }
            *(u32x4*)(WT + (size_t)drow * K + k0 + 8 * cch) = o; } }
    LDS_WAIT(); asm volatile("" ::: "memory");
}
__device__ __forceinline__ void prologue_phase(const Ctx& c) {
    LAS float* scr = (LAS float*)(c.lds + c.wave * 16384);
    constexpr int IT_UP = 16 * 176, IT_DN = 44 * 32, IT_G = 16 * 32, IT_P = 4 * 32, IT_AIN = 16 * 128, IT_AOUT = 32 * 32, IT_BIN = 16 * 129, IT_CIN = 16 * 82, IT_C1 = 32 * 8;
    constexpr int NIT = 8 * IT_UP + 8 * IT_DN + 4 * IT_G + 4 * IT_P + 2 * IT_AIN + 2 * IT_AOUT + IT_BIN + IT_G + IT_CIN + IT_G + 2 * IT_C1;
    for (int it = c.gw; it < NIT; it += c.NGW) {
        int r = it, mi;
        if (r < 8 * IT_UP) { mi = r / IT_UP; tr_item(c.in[I_WUP] + (size_t)mi * 1024 * 5632, 1024, 5632, WSB(WS_WUP + mi * SZ_WUP), 1, scr, r - mi * IT_UP, c.lane); continue; } r -= 8 * IT_UP;
        if (r < 8 * IT_DN) { mi = r / IT_DN; tr_item(c.in[I_WDN] + (size_t)mi * 2816 * 1024, 2816, 1024, WSB(WS_WDN + mi * SZ_WDN), 0, scr, r - mi * IT_DN, c.lane); continue; } r -= 8 * IT_DN;
        if (r < 4 * IT_G) { mi = r / IT_G; tr_item(c.in[I_WG] + (size_t)mi * 1024 * 1024, 1024, 1024, WSB(WS_WG + mi * SZ_WG), 0, scr, r - mi * IT_G, c.lane); continue; } r -= 4 * IT_G;
        if (r < 4 * IT_P) { mi = r / IT_P; tr_item(c.in[I_WPJ] + (size_t)mi * 256 * 1024, 256, 1024, WSB(WS_WP + mi * SZ_WP), 0, scr, r - mi * IT_P, c.lane); continue; } r -= 4 * IT_P;
        if (r < 2 * IT_AIN) { mi = r / IT_AIN; tr_item(c.in[I_AWIN] + (size_t)mi * 1024 * 4096, 1024, 4096, WSB(WS_WAIN + mi * SZ_WAIN), 0, scr, r - mi * IT_AIN, c.lane); continue; } r -= 2 * IT_AIN;
        if (r < 2 * IT_AOUT) { mi = r / IT_AOUT; tr_item(c.in[I_AWOUT] + (size_t)mi * 2048 * 1024, 2048, 1024, WSB(WS_WAOUT + mi * SZ_WAOUT), 0, scr, r - mi * IT_AOUT, c.lane); continue; } r -= 2 * IT_AOUT;
        if (r < IT_BIN) { tr_item(c.in[I_BWIN], 1024, NBIN_REAL, WSB(WS_WBIN), 0, scr, r, c.lane); continue; } r -= IT_BIN;
        if (r < IT_G) { tr_item(c.in[I_BWOUT], 1024, 1024, WSB(WS_WBOUT), 0, scr, r, c.lane); continue; } r -= IT_G;
        if (r < IT_CIN) { tr_item(c.in[I_CWIN_W], 1024, NCIN_REAL, WSB(WS_WCIN), 0, scr, r, c.lane); continue; } r -= IT_CIN;
        if (r < IT_G) { tr_item(c.in[I_CWOUT], 1024, 1024, WSB(WS_WCOUT), 0, scr, r, c.lane); continue; } r -= IT_G;
        mi = r / IT_C1; tr_item(c.in[I_CW1] + (size_t)mi * 2048 * 256, 2048, 256, WSB(WS_WC1 + mi * SZ_WC1), 0, scr, r - mi * IT_C1, c.lane);
    }
    for (int i4 = c.gw * 64 + c.lane; i4 < 2 * 16 * 128 * 128 / 4; i4 += c.NGW * 64) { const int t = (i4 >> 5) & 127, s0 = (i4 & 31) * 4; const f32x4 w = *((const f32x4*)c.in[I_AWS] + i4);
        u32x2 o; o.x = pk2(s0 <= t ? w.x : 0.f, s0 + 1 <= t ? w.y : 0.f); o.y = pk2(s0 + 2 <= t ? w.z : 0.f, s0 + 3 <= t ? w.w : 0.f); *((u32x2*)WSB(WS_WSM) + i4) = o; }
    for (int r = c.gw; r < (NBIN - NBIN_REAL) + (NCIN - NCIN_REAL); r += c.NGW) {
        bf16* row = r < (NBIN - NBIN_REAL) ? WSB(WS_WBIN) + (size_t)(NBIN_REAL + r) * 1024 : WSB(WS_WCIN) + (size_t)(NCIN_REAL + r - (NBIN - NBIN_REAL)) * 1024;
        const u32x4 z = {0u, 0u, 0u, 0u}; *(u32x4*)(row + c.lane * 8) = z; *(u32x4*)(row + 512 + c.lane * 8) = z; }
    for (int row = c.gw; row < M; row += c.NGW) {
        const float* src = row < MP ? c.in[I_XP] + (size_t)row * 1024 : c.in[I_XS] + (size_t)(row - MP) * 1024;
        float* xd = WSF(WS_X) + (size_t)row * 1024; bf16* xn = WSB(WS_XNB) + (size_t)row * 1024;
#pragma unroll
        for (int j = 0; j < 4; ++j) { const f32x4 v = *((const f32x4*)src + c.lane + 64 * j); *((f32x4*)xd + c.lane + 64 * j) = v; u32x2 w; w.x = pk2(v.x, v.y); w.y = pk2(v.z, v.w); *((u32x2*)xn + c.lane + 64 * j) = w; }
    }
    for (int r = c.gw; r < 4 * M; r += c.NGW) {
        const int l = r / M, row = r - l * M;
        const float* src = row < MP ? c.in[I_PP] + ((size_t)l * MP + row) * 256 : c.in[I_PS] + ((size_t)l * MS + (row - MP)) * 256;
        const f32x4 v = *((const f32x4*)src + c.lane); u32x2 w; w.x = pk2(v.x, v.y); w.y = pk2(v.z, v.w); *((u32x2*)(WSB(WS_PBF) + (size_t)r * 256) + c.lane) = w;
    }
}
__device__ __forceinline__ void ln_phase(const Ctx& c, const float* g, const float* b) {
    f32x4 gv[4], bv[4];
#pragma unroll
    for (int j = 0; j < 4; ++j) { gv[j] = *((const f32x4*)g + c.lane + 64 * j); bv[j] = *((const f32x4*)b + c.lane + 64 * j); }
    for (int row = c.gw; row < M; row += c.NGW) {
        const f32x4* p = (const f32x4*)(WSF(WS_PRE) + (size_t)row * 1024) + c.lane;
        f32x4 v[4]; float s = 0.f;
#pragma unroll
        for (int j = 0; j < 4; ++j) { v[j] = p[64 * j]; s += (v[j].x + v[j].y) + (v[j].z + v[j].w); }
        const float mean = wave_sum(s) * (1.f / 1024.f); float s2 = 0.f;
#pragma unroll
        for (int j = 0; j < 4; ++j) { v[j] = v[j] - mean; s2 += (v[j].x * v[j].x + v[j].y * v[j].y) + (v[j].z * v[j].z + v[j].w * v[j].w); }
        const float rstd = 1.f / sqrtf(wave_sum(s2) * (1.f / 1024.f) + LN_EPS);
        float* xd = WSF(WS_X) + (size_t)row * 1024; bf16* xn = WSB(WS_XN) + (size_t)row * 1024;
#pragma unroll
        for (int j = 0; j < 4; ++j) { const f32x4 y = v[j] * rstd * gv[j] + bv[j]; *((f32x4*)xd + c.lane + 64 * j) = y; u32x2 w; w.x = pk2(y.x, y.y); w.y = pk2(y.z, y.w); *((u32x2*)xn + c.lane + 64 * j) = w; }
    }
}
__device__ __forceinline__ void a_stats_phase(const Ctx& c, int ia) {
    const float* lg = c.in[I_ALNG] + ia * 2048; const float* lb = c.in[I_ALNB] + ia * 2048;
    for (int row = c.gw; row < M; row += c.NGW) {
        const f32x4* p = (const f32x4*)(WSF(WA_V) + (size_t)row * 2048) + c.lane;
        f32x4 v[8]; float s = 0.f;
#pragma unroll
        for (int j = 0; j < 8; ++j) { v[j] = p[64 * j]; s += (v[j].x + v[j].y) + (v[j].z + v[j].w); }
        const float mean = wave_sum(s) * (1.f / 2048.f); float s2 = 0.f;
#pragma unroll
        for (int j = 0; j < 8; ++j) { v[j] = v[j] - mean; s2 += (v[j].x * v[j].x + v[j].y * v[j].y) + (v[j].z * v[j].z + v[j].w * v[j].w); }
        const float rstd = 1.f / sqrtf(wave_sum(s2) * (1.f / 2048.f) + LN_EPS);
        if (c.lane == 0) { WSF(WA_ST)[2 * row] = mean; WSF(WA_ST)[2 * row + 1] = rstd; }
        if (row >= MP) { float* o = c.out + O_AV + ((size_t)ia * MS + (row - MP)) * 2048;
#pragma unroll
            for (int j = 0; j < 8; ++j) { const f32x4 gg = *((const f32x4*)lg + c.lane + 64 * j), bb = *((const f32x4*)lb + c.lane + 64 * j); *((f32x4*)o + c.lane + 64 * j) = v[j] * rstd * gg + bb; } }
    }
}
__device__ __forceinline__ void a_sgu_phase(const Ctx& c, int ia) {
    const float* ws = c.in[I_AWS] + (size_t)ia * 16 * 128 * 128; const float* bs = c.in[I_ABS] + ia * 16 * 128; const bf16* wsm = WSB(WS_WSM) + (size_t)ia * 16 * 128 * 128;
    const float* lg = c.in[I_ALNG] + ia * 2048; const float* lb = c.in[I_ALNB] + ia * 2048;
    const float* V = WSF(WA_V); const float* ST = WSF(WA_ST); const bf16* U = WSB(WA_U); bf16* US = WSB(WA_US);
    for (int unit = blockIdx.x; unit < 2048 + DB; unit += c.G) {
        if (unit < 2048) {
            LAS bf16* vt = (LAS bf16*)c.lds; asm volatile("" : "+v"(vt));
            const int g = unit & 15, n = (unit >> 4) & 31, b = unit >> 9, rowbase = b * SEQ + n * 128;
            const int w = c.wave, fr = c.lane & 15, rq = c.lane >> 4, ta = w >> 1, dh = w & 1;
            bf16x8_t wf0[2], wf1[4];
            { const bf16* w0 = wsm + ((size_t)g * 128 + 16 * ta + fr) * 128 + 8 * rq; const bf16* w1 = wsm + ((size_t)g * 128 + 16 * (7 - ta) + fr) * 128 + 8 * rq;
#pragma unroll
              for (int ks = 0; ks < 2; ++ks) wf0[ks] = *(const bf16x8_t*)(w0 + 32 * ks);
#pragma unroll
              for (int ks = 0; ks < 4; ++ks) wf1[ks] = *(const bf16x8_t*)(w1 + 32 * ks); }
            __syncthreads();
            { const int d = c.tid & 127, sp = c.tid >> 7; const float gg = lg[g * 128 + d], bb = lb[g * 128 + d];
#pragma unroll 4
              for (int k = 0; k < 16; ++k) { const int s = 2 * (sp + 4 * k); const size_t r0 = rowbase + s;
                  const float v0 = (V[r0 * 2048 + g * 128 + d] - ST[2 * r0]) * ST[2 * r0 + 1] * gg + bb, v1 = (V[(r0 + 1) * 2048 + g * 128 + d] - ST[2 * r0 + 2]) * ST[2 * r0 + 3] * gg + bb;
                  *(LAS unsigned*)(vt + d * 132 + s) = pk2(v0, v1); } }
            __syncthreads();
            f32x4 acc[2][4];
#pragma unroll
            for (int e = 0; e < 2; ++e)
#pragma unroll
                for (int mb = 0; mb < 4; ++mb) acc[e][mb] = (f32x4){0.f, 0.f, 0.f, 0.f};
#pragma unroll
            for (int ks = 0; ks < 4; ++ks) {
#pragma unroll
                for (int mb = 0; mb < 4; ++mb) { const LAS bf16* xp = vt + (16 * (4 * dh + mb) + fr) * 132 + 32 * ks + 8 * rq; const u32x2 lo = *(const LAS u32x2*)xp, hi = *(const LAS u32x2*)(xp + 4);
                    const bf16x8_t xf = __builtin_bit_cast(bf16x8_t, (u32x4){lo.x, lo.y, hi.x, hi.y});
                    if (ks < 2) { if (2 * ks <= ta) acc[0][mb] = MFMA16(xf, wf0[ks < 2 ? ks : 0], acc[0][mb]); }
                    if (2 * ks <= 7 - ta) acc[1][mb] = MFMA16(xf, wf1[ks], acc[1][mb]); } }
#pragma unroll
            for (int e = 0; e < 2; ++e) { const int t = 16 * (e ? 7 - ta : ta) + fr; const float bias = bs[g * 128 + t]; const size_t o = (size_t)(rowbase + t) * 2048 + g * 128 + 64 * dh + 4 * rq;
#pragma unroll
                for (int mb = 0; mb < 4; ++mb) { const u32x2 uu = *(const u32x2*)(U + o + 16 * mb); const f32x4 sv = acc[e][mb] + bias;
                    u32x2 wv; wv.x = pk2(sv.x * bf2f((bf16)(uu.x & 0xffff)), sv.y * bf2f((bf16)(uu.x >> 16))); wv.y = pk2(sv.z * bf2f((bf16)(uu.y & 0xffff)), sv.w * bf2f((bf16)(uu.y >> 16)));
                    *(u32x2*)(US + o + 16 * mb) = wv; } }
        } else {
            const int sb = unit - 2048, c0 = c.tid * 4, g = c0 >> 7;
            const f32x4 gg = *(const f32x4*)(lg + c0), bb = *(const f32x4*)(lb + c0);
            f32x4 vnr[4];
#pragma unroll
            for (int t = 0; t < 4; ++t) { const int row = MP + 4 * sb + t; const f32x4 v = *(const f32x4*)(V + (size_t)row * 2048 + c0); vnr[t] = (v - ST[2 * row]) * ST[2 * row + 1] * gg + bb; }
#pragma unroll
            for (int t = 0; t < 4; ++t) { const int row = MP + 4 * sb + t; f32x4 sv = {0.f, 0.f, 0.f, 0.f};
#pragma unroll
                for (int s = 0; s <= t; ++s) sv += vnr[s] * ws[((size_t)g * 128 + t) * 128 + s];
                sv += bs[g * 128 + t];
                const u32x2 uu = *(const u32x2*)(U + (size_t)row * 2048 + c0);
                f32x4 y; y.x = sv.x * bf2f((bf16)(uu.x & 0xffff)); y.y = sv.y * bf2f((bf16)(uu.x >> 16)); y.z = sv.z * bf2f((bf16)(uu.y & 0xffff)); y.w = sv.w * bf2f((bf16)(uu.y >> 16));
                u32x2 w; w.x = pk2(y.x, y.y); w.y = pk2(y.z, y.w); *(u32x2*)(US + (size_t)row * 2048 + c0) = w; }
        }
    }
}
__device__ __forceinline__ void gdn_prep_phase(const Ctx& c) {
    const float* PJ = WSF(WB_PROJ); const float* cw = c.in[I_BCONV]; const float* alog = c.in[I_BALOG]; const float* dtb = c.in[I_BDT];
    bf16* GW = WSB(WB_W); float* GUT = WSF(WB_U); bf16* GQG = WSB(WB_QG); bf16* GKDT = WSB(WB_KD); bf16* GQK = WSB(WB_QK); float* GEG = WSF(WB_EG);
    for (int unit = blockIdx.x; unit < 2048 + 1024; unit += c.G) {
        __syncthreads();
        LAS float* lb = (LAS float*)c.lds; asm volatile("" : "+v"(lb));
        LAS float* kf = lb; LAS float* vf = kf + 64 * 129; LAS float* Am = vf + 64 * 129; LAS float* gc = Am + 64 * 64; LAS float* bt = gc + 64;
        LAS bf16* kb = (LAS bf16*)(bt + 64); LAS bf16* qb = kb + 64 * 136;
        if (unit < 2048) {
            const int ci = unit & 63, h = (unit >> 6) & 7, b = unit >> 9, rb = b * SEQ + ci * 64;
            if (c.tid < 64) { const size_t row = rb + c.tid; const float bl = PJ[row * NBIN + 4096 + h], al = PJ[row * NBIN + 4104 + h];
                const float x = al + dtb[h]; const float sp = x > 20.f ? x : log1pf(expf(x)); float g = -expf(alog[h]) * sp;
#pragma unroll
                for (int o = 1; o < 64; o <<= 1) { const float t = __shfl_up(g, o); if (c.lane >= o) g += t; }
                gc[c.tid] = g; bt[c.tid] = sigmoid_f(bl); }
            __syncthreads();
            { const int tk0 = c.wave * 8, tabs0 = ci * 64 + tk0; const size_t row0 = rb + tk0;
              f32x2 xr[3][11], wv[3][4];
#pragma unroll
              for (int part = 0; part < 3; ++part) { const int ch = part * 1024 + h * 128 + 2 * c.lane;
#pragma unroll
                  for (int j = 0; j < 4; ++j) wv[part][j] = *(const f32x2*)(cw + j * 3072 + ch);
#pragma unroll
                  for (int r = 0; r < 11; ++r) xr[part][r] = (tabs0 - 3 + r >= 0) ? *(const f32x2*)(PJ + (row0 + r - 3) * NBIN + ch) : (f32x2){0.f, 0.f}; }
#pragma unroll
              for (int i = 0; i < 8; ++i) { const int tk = tk0 + i;
#pragma unroll
                  for (int part = 0; part < 3; ++part) { float a0 = 0.f, a1 = 0.f;
#pragma unroll
                      for (int j = 0; j < 4; ++j) { a0 += xr[part][i + j].x * wv[part][j].x; a1 += xr[part][i + j].y * wv[part][j].y; }
                      a0 = siluf(a0); a1 = siluf(a1);
                      if (part < 2) { const float ss = wave_sum(a0 * a0 + a1 * a1); const float sc = (1.f / sqrtf(ss + NORM_EPS)) * (part == 0 ? 0.08838834764831845f : 1.f); a0 *= sc; a1 *= sc; }
                      if (part == 0) { *(LAS unsigned*)(qb + tk * 136 + 2 * c.lane) = pk2(a0, a1); const float eg = expf(gc[tk]); *(unsigned*)(GQG + (size_t)unit * 8192 + tk * 128 + 2 * c.lane) = pk2(a0 * eg, a1 * eg); }
                      else if (part == 1) { *(LAS unsigned*)(kb + tk * 136 + 2 * c.lane) = pk2(a0, a1); kf[tk * 129 + 2 * c.lane] = a0; kf[tk * 129 + 2 * c.lane + 1] = a1; }
                      else { vf[tk * 129 + 2 * c.lane] = a0; vf[tk * 129 + 2 * c.lane + 1] = a1; } } } }
            __syncthreads();
            { const int fr = c.lane & 15, rq = c.lane >> 4;
#pragma unroll 1
              for (int bi = c.wave; bi < 16; bi += 8) {
                  const int mbj = bi < 10 ? (bi == 0 ? 0 : bi == 1 ? 0 : bi == 2 ? 1 : bi == 3 ? 0 : bi == 4 ? 1 : bi == 5 ? 2 : bi == 6 ? 0 : bi == 7 ? 1 : bi == 8 ? 2 : 3) : (bi == 10 ? 1 : bi == 11 ? 2 : bi == 12 ? 3 : bi == 13 ? 2 : bi == 14 ? 3 : 3);
                  const int nbi = bi < 10 ? (bi == 0 ? 0 : bi <= 2 ? 1 : bi <= 5 ? 2 : 3) : (bi <= 12 ? 0 : bi <= 14 ? 1 : 2);
                  const int i = 16 * nbi + fr, j0 = 16 * mbj + 4 * rq;
                  f32x4 akk = {0.f, 0.f, 0.f, 0.f}, aqk = {0.f, 0.f, 0.f, 0.f};
                  if (bi < 10) {
#pragma unroll
                      for (int ks = 0; ks < 4; ++ks) { const bf16x8_t xk = *(const LAS bf16x8_t*)(kb + (16 * mbj + fr) * 136 + 32 * ks + 8 * rq), yk = *(const LAS bf16x8_t*)(kb + i * 136 + 32 * ks + 8 * rq), yq = *(const LAS bf16x8_t*)(qb + i * 136 + 32 * ks + 8 * rq);
                          akk = MFMA16(xk, yk, akk); aqk = MFMA16(xk, yq, aqk); } }
                  const float gi = gc[i], bi_ = bt[i]; f32x4 av, qv;
#pragma unroll
                  for (int r = 0; r < 4; ++r) { const int j = j0 + r; const float dec = (i >= j) ? expf(gi - gc[j]) : 0.f; av[r] = (i > j) ? bi_ * akk[r] * dec : 0.f; qv[r] = (i >= j) ? aqk[r] * dec : 0.f; }
                  *(LAS f32x4*)(Am + i * 64 + j0) = av; u32x2 wv; wv.x = pk2(qv[0], qv[1]); wv.y = pk2(qv[2], qv[3]); *(u32x2*)(GQK + ((size_t)unit * 64 + i) * 64 + j0) = wv; } }
            __syncthreads();
            if (c.tid < 256) { const bool isw = c.tid >= 128; const int cc = c.tid & 127; float x[64];
#pragma unroll
                for (int i = 0; i < 64; ++i) x[i] = 0.f;
#pragma unroll
                for (int i = 0; i < 64; ++i) { float r = isw ? kf[i * 129 + cc] * bt[i] * expf(gc[i]) : vf[i * 129 + cc] * bt[i];
#pragma unroll
                    for (int j4 = 0; j4 < (i + 3) / 4; ++j4) { const f32x4 a4 = *(const LAS f32x4*)(Am + i * 64 + 4 * j4); r -= (a4.x * x[4 * j4] + a4.y * x[4 * j4 + 1]) + (a4.z * x[4 * j4 + 2] + a4.w * x[4 * j4 + 3]); }
                    x[i] = r; if (isw) GW[((size_t)unit * 64 + i) * 128 + cc] = (bf16)f2bf(r); }
                if (!isw) { float* dst = GUT + ((size_t)unit * 128 + cc) * 64;
#pragma unroll
                    for (int k = 0; k < 16; ++k) *(f32x4*)(dst + 4 * k) = (f32x4){x[4 * k], x[4 * k + 1], x[4 * k + 2], x[4 * k + 3]}; } }
            for (int idx = c.tid; idx < 1024; idx += 512) { const int dk = idx & 127, ch = idx >> 7; const float gl = gc[63]; unsigned e[4];
#pragma unroll
                for (int k = 0; k < 4; ++k) { const int c0 = 8 * ch + 2 * k; e[k] = pk2(kf[c0 * 129 + dk] * expf(gl - gc[c0]), kf[(c0 + 1) * 129 + dk] * expf(gl - gc[c0 + 1])); }
                *(u32x4*)(GKDT + (size_t)unit * 8192 + dk * 64 + 8 * ch) = (u32x4){e[0], e[1], e[2], e[3]}; }
            if (c.tid == 0) GEG[unit] = expf(gc[63]);
        } else {
            const int su = unit - 2048, h = su & 7, b = su >> 3;
            LAS float* q4 = lb; LAS float* k4 = q4 + 512; LAS float* v4 = k4 + 512; LAS float* red = v4 + 512; LAS float* o4 = red + 512; LAS float* g4 = o4 + 512; LAS float* b4 = g4 + 4;
            const float* cst = c.in[I_GCONV] + (size_t)b * 3 * 3072;
            { const int t = c.tid >> 7, chl = c.tid & 127;
#pragma unroll
              for (int part = 0; part < 3; ++part) { const int ch = part * 1024 + h * 128 + chl; float a = 0.f;
#pragma unroll
                  for (int j = 0; j < 4; ++j) { const int mm = t + j; const float x = mm < 3 ? cst[mm * 3072 + ch] : PJ[(size_t)(MP + 4 * b + mm - 3) * NBIN + ch]; a += x * cw[j * 3072 + ch]; }
                  (part == 0 ? q4 : (part == 1 ? k4 : v4))[t * 128 + chl] = siluf(a); }
              if (c.tid < 4) { const size_t row = MP + 4 * b + c.tid; const float bl = PJ[row * NBIN + 4096 + h], al = PJ[row * NBIN + 4104 + h];
                  const float x = al + dtb[h]; const float sp = x > 20.f ? x : log1pf(expf(x)); g4[c.tid] = -expf(alog[h]) * sp; b4[c.tid] = sigmoid_f(bl); } }
            __syncthreads();
            { const int t = c.tid >> 7, chl = c.tid & 127; float sq = 0.f, sk = 0.f;
              for (int d = 0; d < 128; ++d) { const float a = q4[t * 128 + d], bb = k4[t * 128 + d]; sq += a * a; sk += bb * bb; }
              const float qv = q4[t * 128 + chl] * (1.f / sqrtf(sq + NORM_EPS)) * 0.08838834764831845f, kv = k4[t * 128 + chl] * (1.f / sqrtf(sk + NORM_EPS));
              __syncthreads();
              q4[t * 128 + chl] = qv; k4[t * 128 + chl] = kv; }
            __syncthreads();
            const int dv = c.tid & 127, part = c.tid >> 7;
            float S[32];
            const float* S0 = c.in[I_GS] + (((size_t)b * 8 + h) * 128 + part * 32) * 128 + dv;
#pragma unroll
            for (int i = 0; i < 32; ++i) S[i] = S0[(size_t)i * 128];
#pragma unroll 1
            for (int t = 0; t < 4; ++t) { const float a = expf(g4[t]); float p = 0.f;
#pragma unroll
                for (int i = 0; i < 32; ++i) p += k4[t * 128 + part * 32 + i] * S[i];
                red[part * 128 + dv] = p; __syncthreads();
                const float kS = (red[dv] + red[128 + dv]) + (red[256 + dv] + red[384 + dv]); const float vnew = b4[t] * (v4[t * 128 + dv] - a * kS); float po = 0.f;
#pragma unroll
                for (int i = 0; i < 32; ++i) { S[i] = a * S[i] + k4[t * 128 + part * 32 + i] * vnew; po += q4[t * 128 + part * 32 + i] * S[i]; }
                __syncthreads(); red[part * 128 + dv] = po; __syncthreads();
                if (part == 0) o4[t * 128 + dv] = (red[dv] + red[128 + dv]) + (red[256 + dv] + red[384 + dv]);
                __syncthreads(); }
            float* So = c.out + O_GSS + (((size_t)b * 8 + h) * 128 + part * 32) * 128 + dv;
#pragma unroll
            for (int i = 0; i < 32; ++i) So[(size_t)i * 128] = S[i];
            { const int t = c.tid >> 7; float ms = 0.f;
              for (int d = 0; d < 128; ++d) { const float o = o4[t * 128 + d]; ms += o * o; }
              const size_t row = MP + 4 * b + t; const float z = PJ[row * NBIN + 3072 + h * 128 + dv];
              const float y = o4[t * 128 + dv] * (1.f / sqrtf(ms * (1.f / 128.f) + NORM_EPS)) * c.in[I_BNG][dv] * siluf(z);
              WSB(WB_OG)[row * 1024 + h * 128 + dv] = (bf16)f2bf(y); }
        }
    }
    for (size_t idx = (size_t)blockIdx.x * 512 + c.tid; idx < 36864 + 1179648; idx += (size_t)c.G * 512) {
        if (idx < 36864) { const int b = (int)(idx / 9216), r = (int)(idx % 9216), j = r / 3072, ch = r % 3072; c.out[O_GCP + idx] = PJ[((size_t)b * SEQ + SEQ - 3 + j) * NBIN + ch]; }
        else { const size_t k = idx - 36864; const int b = (int)(k / 9216), r = (int)(k % 9216), j = r / 3072, ch = r % 3072; c.out[O_GCS + k] = PJ[((size_t)MP + 4 * b + 1 + j) * NBIN + ch]; }
    }
}
struct ScanFr { bf16x8_t a4[4], b2[2], kd[2]; f32x4 u; float eg; };
__device__ __forceinline__ void scan_load(ScanFr& f, const bf16* GW, const bf16* GQG, const bf16* GKDT, const bf16* GQK, const float* GUT, const float* GEG, size_t pu, int w, int fr, int rq, int dvs) {
    const int mb = w & 3; const bf16* a = (w < 4 ? GW : GQG) + pu * 8192 + (16 * mb + fr) * 128 + 8 * rq;
#pragma unroll
    for (int ks = 0; ks < 4; ++ks) f.a4[ks] = *(const bf16x8_t*)(a + 32 * ks);
    const bf16* q = GQK + pu * 4096 + (16 * mb + fr) * 64 + 8 * rq; f.b2[0] = *(const bf16x8_t*)q; f.b2[1] = *(const bf16x8_t*)(q + 32);
    const bf16* k = GKDT + pu * 8192 + (16 * w + fr) * 64 + 8 * rq; f.kd[0] = *(const bf16x8_t*)k; f.kd[1] = *(const bf16x8_t*)(k + 32);
    f.u = *(const f32x4*)(GUT + (pu * 128 + dvs * 16 + fr) * 64 + 16 * mb + 4 * rq); f.eg = GEG[pu];
}
__device__ __forceinline__ void gdn_scan_phase(const Ctx& c) {
    const bf16* GW = WSB(WB_W); const float* GUT = WSF(WB_U); const bf16* GQG = WSB(WB_QG); const bf16* GKDT = WSB(WB_KD); const bf16* GQK = WSB(WB_QK); const float* GEG = WSF(WB_EG);
    float* GO = WSF(WB_O);
    for (int uu = blockIdx.x; uu < 256; uu += c.G) {
        LAS unsigned char* L = c.lds; asm volatile("" : "+v"(L));
        LAS bf16* ST = (LAS bf16*)L; LAS bf16* VNT = ST + 16 * 136;
        const int bh = (uu & 7) * 4 + (uu >> 6), dvs = (uu >> 3) & 7, b = bh >> 3, h = bh & 7;
        const int w = c.wave, fr = c.lane & 15, rq = c.lane >> 4, mb = w & 3;
        __syncthreads();
        for (int i = c.tid; i < 16 * 136 / 2; i += 512) ((LAS unsigned*)ST)[i] = 0u;
        f32x4 Sacc = {0.f, 0.f, 0.f, 0.f};
        ScanFr cur, nxt; scan_load(cur, GW, GQG, GKDT, GQK, GUT, GEG, (size_t)bh * 64, w, fr, rq, dvs);
        for (int ci = 0; ci < 64; ++ci) {
            const size_t pu = (size_t)bh * 64 + ci;
            if (ci < 63) scan_load(nxt, GW, GQG, GKDT, GQK, GUT, GEG, pu + 1, w, fr, rq, dvs);
            __syncthreads();
            f32x4 acc = {0.f, 0.f, 0.f, 0.f};
#pragma unroll
            for (int ks = 0; ks < 4; ++ks) { const bf16x8_t y = *(const LAS bf16x8_t*)(ST + fr * 136 + 32 * ks + 8 * rq); acc = MFMA16(cur.a4[ks], y, acc); }
            if (w < 4) { const f32x4 vn = cur.u - acc; u32x2 wv; wv.x = pk2(vn[0], vn[1]); wv.y = pk2(vn[2], vn[3]); *(LAS u32x2*)(VNT + fr * 72 + 16 * mb + 4 * rq) = wv; }
            __syncthreads();
            const bf16x8_t y0 = *(const LAS bf16x8_t*)(VNT + fr * 72 + 8 * rq), y1 = *(const LAS bf16x8_t*)(VNT + fr * 72 + 32 + 8 * rq);
            if (w >= 4) { acc = MFMA16(cur.b2[0], y0, acc); acc = MFMA16(cur.b2[1], y1, acc);
                float* o = GO + ((size_t)b * SEQ + ci * 64 + 16 * mb + 4 * rq) * 1024 + h * 128 + dvs * 16 + fr;
#pragma unroll
                for (int i = 0; i < 4; ++i) o[(size_t)i * 1024] = acc[i]; }
            Sacc *= cur.eg; Sacc = MFMA16(cur.kd[0], y0, Sacc); Sacc = MFMA16(cur.kd[1], y1, Sacc);
            { u32x2 wv; wv.x = pk2(Sacc[0], Sacc[1]); wv.y = pk2(Sacc[2], Sacc[3]); *(LAS u32x2*)(ST + fr * 136 + 16 * w + 4 * rq) = wv; }
            cur = nxt;
        }
#pragma unroll
        for (int i = 0; i < 4; ++i) c.out[O_GSP + (((size_t)b * 8 + h) * 128 + 16 * w + 4 * rq + i) * 128 + dvs * 16 + fr] = Sacc[i];
    }
}
__device__ __forceinline__ void gdn_post_phase(const Ctx& c) {
    const float* GO = WSF(WB_O); const float* PJ = WSF(WB_PROJ); const float* ng = c.in[I_BNG];
    for (int row = c.gw; row < MP; row += c.NGW) {
        const f32x4* p = (const f32x4*)(GO + (size_t)row * 1024 + c.lane * 16); f32x4 v[4]; float s = 0.f;
#pragma unroll
        for (int j = 0; j < 4; ++j) { v[j] = p[j]; s += (v[j].x * v[j].x + v[j].y * v[j].y) + (v[j].z * v[j].z + v[j].w * v[j].w); }
        s += __shfl_xor(s, 1); s += __shfl_xor(s, 2); s += __shfl_xor(s, 4);
        const float r = 1.f / sqrtf(s * (1.f / 128.f) + NORM_EPS);
        const f32x4* zp = (const f32x4*)(PJ + (size_t)row * NBIN + 3072 + c.lane * 16); const f32x4* gp = (const f32x4*)(ng + (c.lane & 7) * 16);
        u32x2* op = (u32x2*)(WSB(WB_OG) + (size_t)row * 1024 + c.lane * 16);
#pragma unroll
        for (int j = 0; j < 4; ++j) { const f32x4 z = zp[j], g = gp[j]; f32x4 y; y.x = v[j].x * r * g.x * siluf(z.x); y.y = v[j].y * r * g.y * siluf(z.y); y.z = v[j].z * r * g.z * siluf(z.z); y.w = v[j].w * r * g.w * siluf(z.w);
            u32x2 w; w.x = pk2(y.x, y.y); w.y = pk2(y.z, y.w); op[j] = w; }
    }
}
__device__ const unsigned char T5_LUT[128] = {0, 1, 2, 3, 4, 5, 6, 7, 8, 9, 10, 11, 12, 13, 14, 15, 16, 16, 16, 17, 17, 18, 18, 18, 19, 19, 19, 20, 20, 20, 20, 21, 21, 21, 21, 22, 22, 22, 22, 22, 23, 23, 23, 23, 23, 23, 24, 24, 24, 24, 24, 24, 25, 25, 25, 25, 25, 25, 25, 26, 26, 26, 26, 26, 26, 26, 26, 27, 27, 27, 27, 27, 27, 27, 27, 27, 27, 28, 28, 28, 28, 28, 28, 28, 28, 28, 28, 29, 29, 29, 29, 29, 29, 29, 29, 29, 29, 29, 29, 30, 30, 30, 30, 30, 30, 30, 30, 30, 30, 30, 30, 30, 30, 31, 31, 31, 31, 31, 31, 31, 31, 31, 31, 31, 31, 31, 31, 31};
__device__ __forceinline__ void nsa_prep_phase(const Ctx& c) {
    const float* PJ = WSF(WC_PROJ);
    for (size_t i4 = (size_t)blockIdx.x * 512 + c.tid; i4 < (size_t)M * 256; i4 += (size_t)c.G * 512) { const size_t row = i4 >> 8; const int c4 = (int)(i4 & 255);
        const f32x4 v = *(const f32x4*)(PJ + row * NCIN + 1024 + c4 * 4);
        if (row < MP) *(f32x4*)(c.out + O_KVP + row * 1024 + c4 * 4) = v; else *(f32x4*)(c.out + O_KVS + (row - MP) * 1024 + c4 * 4) = v; }
    for (size_t i4 = (size_t)blockIdx.x * 512 + c.tid; i4 < (size_t)(2048 + MS) * 128; i4 += (size_t)c.G * 512) { const size_t r = i4 >> 7; const int c4 = (int)(i4 & 127);
        const size_t row = r < 2048 ? (r >> 9) * SEQ + (SEQ - 512) + (r & 511) : MP + (r - 2048);
        const f32x4 v = *(const f32x4*)(PJ + row * NCIN + 2048 + c4 * 4);
        if (r < 2048) *(f32x4*)(c.out + O_WINP + r * 512 + c4 * 4) = v; else *(f32x4*)(c.out + O_WINS + (r - 2048) * 512 + c4 * 4) = v; }
    { LAS bf16* vt = (LAS bf16*)c.lds;
      bf16* KSB = WSB(WC_KSB); bf16* VST = WSB(WC_VST); bf16* KWB = WSB(WC_KWB); bf16* VWT = WSB(WC_VWT);
      for (int u = blockIdx.x; u < 256; u += c.G) { const int b = u >> 6, tb = u & 63; const size_t row0 = (size_t)b * SEQ + 64 * tb;
          __syncthreads();
          for (int idx = c.tid; idx < 64 * 256; idx += 512) { const int t = idx >> 8, q = idx & 255, sect = q >> 6, c4 = q & 63;
              const f32x4 v = *(const f32x4*)(PJ + (row0 + t) * NCIN + 1536 + sect * 256 + c4 * 4); u32x2 w; w.x = pk2(v.x, v.y); w.y = pk2(v.z, v.w);
              const int g = c4 >> 4, d = (c4 & 15) * 4;
              if (sect == 0) *(u32x2*)(KSB + (((size_t)(b * 4 + g) * SEQ + 64 * tb + t) * 64 + d)) = w;
              else if (sect == 2) *(u32x2*)(KWB + (((size_t)(b * 4 + g) * SEQ + 64 * tb + t) * 64 + d)) = w;
              else *(LAS u32x2*)(vt + t * 520 + (sect == 1 ? 0 : 256) + c4 * 4) = w; }
          __syncthreads();
          for (int idx = c.tid; idx < 512 * 8; idx += 512) { const int col = idx >> 3, ch = idx & 7; unsigned short e[8];
#pragma unroll
              for (int k = 0; k < 8; ++k) e[k] = vt[(8 * ch + k) * 520 + col];
              u32x4 w; w.x = e[0] | ((unsigned)e[1] << 16); w.y = e[2] | ((unsigned)e[3] << 16); w.z = e[4] | ((unsigned)e[5] << 16); w.w = e[6] | ((unsigned)e[7] << 16);
              const int cc = col & 255, g = cc >> 6, d = cc & 63; bf16* dst = (col < 256 ? VST : VWT) + ((size_t)(b * 4 + g) * 64 + d) * SEQ + 64 * tb + 8 * ch;
              *(u32x4*)dst = w; } }
      __syncthreads(); }
    bf16* AC = WSB(WC_ACMP); const float* pe = c.in[I_CPE]; const int* pt = (const int*)c.in[I_PT]; const float* ckv = c.in[I_CKV];
    for (int R = c.gw; R < 2 * CMP_ROWS; R += c.NGW) {
        const int which = R >= CMP_ROWS ? 1 : 0, r = R - which * CMP_ROWS;
        const float* src; size_t lstride;
        if (r < 2048) { const int g = r & 3, n = (r >> 2) & 127, b = r >> 9; src = PJ + ((size_t)b * SEQ + 32 * n) * NCIN + 1024 + which * 256 + g * 64; lstride = NCIN; }
        else { const int q = r - 2048, g = q & 3, n = (q >> 2) & 63, b = q >> 8; const int page = pt[b * 16 + (n >> 2)];
            src = ckv + (((size_t)page * 128 + (n & 3) * 32) * 16 + which * 4 + g) * 64; lstride = 1024; }
#pragma unroll
        for (int k = 0; k < 8; ++k) { const int idx = c.lane + 64 * k, l = idx >> 4, d4 = idx & 15;
            const f32x4 v = *(const f32x4*)(src + (size_t)l * lstride + d4 * 4) + *(const f32x4*)(pe + (which * 32 + l) * 64 + d4 * 4);
            u32x2 w; w.x = pk2(v.x, v.y); w.y = pk2(v.z, v.w); *(u32x2*)(AC + (size_t)R * 2048 + l * 64 + d4 * 4) = w; }
    }
}
__device__ __forceinline__ void nsa_cmp2_phase(const Ctx& c) {
    LAS float* w2 = (LAS float*)c.lds;
    __syncthreads();
    for (int i = c.tid; i < 2 * 256 * 64 / 4; i += 512) *(LAS f32x4*)(w2 + 4 * i) = *((const f32x4*)c.in[I_CW2] + i);
    __syncthreads();
    const bf16* HC = WSB(WC_HC); float* KCV = WSF(WC_KCV);
    for (int R = c.gw; R < 2 * CMP_ROWS; R += c.NGW) {
        const LAS float* w = w2 + (R >= CMP_ROWS ? 256 * 64 : 0) + c.lane; const u32x4* hp = (const u32x4*)(HC + (size_t)R * 256); float a = 0.f;
#pragma unroll 4
        for (int k8 = 0; k8 < 32; ++k8) { const u32x4 hv = hp[k8]; const unsigned hw[4] = {hv.x, hv.y, hv.z, hv.w};
#pragma unroll
            for (int j = 0; j < 4; ++j) { a += bf2f((bf16)(hw[j] & 0xffff)) * w[(8 * k8 + 2 * j) * 64]; a += bf2f((bf16)(hw[j] >> 16)) * w[(8 * k8 + 2 * j + 1) * 64]; } }
        KCV[(size_t)R * 64 + c.lane] = a;
        { const int which = R >= CMP_ROWS ? 1 : 0, r = R - which * CMP_ROWS;
          if (r < 2048) { const int g = r & 3, n = (r >> 2) & 127, b = r >> 9; if (which == 0) WSB(WC_KCB)[((size_t)(b * 4 + g) * 128 + n) * 64 + c.lane] = (bf16)f2bf(a); else WSB(WC_VCT)[((size_t)(b * 4 + g) * 64 + c.lane) * 128 + n] = (bf16)f2bf(a); } }
    }
}
struct AttSt { float m[4], l[4]; f32x4 o[4]; };
__device__ __forceinline__ void att_reset(AttSt& s) {
#pragma unroll
    for (int h = 0; h < 4; ++h) { s.m[h] = -1e30f; s.l[h] = 0.f; s.o[h] = (f32x4){0.f, 0.f, 0.f, 0.f}; } }
__device__ __forceinline__ void att_scores(const LAS float* qs, const LAS float* tabl, const float* kptr, bool valid, int dist, int g, float (&s)[4]) {
    const f32x4* kp = (const f32x4*)kptr;
    s[0] = s[1] = s[2] = s[3] = 0.f;
#pragma unroll 1
    for (int c4 = 0; c4 < 4; ++c4) {
        f32x4 kv[4];
#pragma unroll
        for (int u = 0; u < 4; ++u) kv[u] = kp[c4 * 4 + u];
#pragma unroll
        for (int u = 0; u < 4; ++u)
#pragma unroll
            for (int h = 0; h < 4; ++h) { const f32x4 q = *(const LAS f32x4*)(qs + h * 64 + (c4 * 4 + u) * 4); s[h] += (q.x * kv[u].x + q.y * kv[u].y) + (q.z * kv[u].z + q.w * kv[u].w); } }
    const int dd = dist < 0 ? 0 : dist; const int bk = dd < 128 ? (int)T5_LUT[dd] : 31;
    const f32x4 bias = *(const LAS f32x4*)(tabl + bk * 16 + g * 4);
#pragma unroll
    for (int h = 0; h < 4; ++h) s[h] = valid ? s[h] + bias[h] : -1e30f;
}
__device__ __forceinline__ void att_pv(AttSt& st, LAS f32x4* P, LAS unsigned long long* R, const float (&p)[4], const float* rowp, int voff, int lane) {
    P[lane] = (f32x4){p[0], p[1], p[2], p[3]}; R[lane] = (unsigned long long)rowp;
    LDS_WAIT();
#pragma unroll 8
    for (int i = 0; i < 16; ++i) { const int key = 4 * i + (lane >> 4); const f32x4 p4 = P[key]; const float* rp = (const float*)R[key];
        const f32x4 v = *(const f32x4*)(rp + voff + (lane & 15) * 4);
        st.o[0] += v * p4.x; st.o[1] += v * p4.y; st.o[2] += v * p4.z; st.o[3] += v * p4.w; }
    LDS_WAIT();
}
__device__ __forceinline__ void att_block(AttSt& st, const LAS float* qs, const LAS float* tabl, LAS f32x4* P, LAS unsigned long long* R, const float* kptr, const float* safe, bool valid, int dist, int voff, int g, int lane) {
    const float* rowp = valid ? kptr : safe; float s[4], p[4];
    att_scores(qs, tabl, rowp, valid, dist, g, s);
#pragma unroll
    for (int h = 0; h < 4; ++h) { const float mx = wave_max(s[h]), mn = fmaxf(st.m[h], mx), sc = __expf(st.m[h] - mn); p[h] = valid ? __expf(s[h] - mn) : 0.f;
        st.l[h] = st.l[h] * sc + wave_sum(p[h]); st.o[h] *= sc; st.m[h] = mn; }
    att_pv(st, P, R, p, rowp, voff, lane);
}
__device__ __forceinline__ void att_finish(AttSt& st, const float (&gate)[4], f32x4 (&acc)[4]) {
#pragma unroll
    for (int h = 0; h < 4; ++h) { f32x4 o = st.o[h];
#pragma unroll
        for (int k = 0; k < 4; ++k) { o[k] += __shfl_xor(o[k], 16); o[k] += __shfl_xor(o[k], 32); }
        const float inv = st.l[h] > 0.f ? gate[h] / st.l[h] : 0.f; acc[h] += o * inv; }
}
__device__ __forceinline__ void nsa_attn_phase(const Ctx& c, const int item0) {
    LAS float* tabl = (LAS float*)c.lds;
    LAS float* qs = tabl + 512 + c.wave * 768;
    LAS f32x4* P = (LAS f32x4*)(qs + 256); LAS unsigned long long* R = (LAS unsigned long long*)(qs + 512); LAS float* pcs = qs + 640;
    __syncthreads();
    for (int i = c.tid; i < 512; i += 512) tabl[i] = c.in[I_T5][i];
    __syncthreads();
    const float* PJ = WSF(WC_PROJ); const float* KCV = WSF(WC_KCV); const float* gb = c.in[I_CGB]; const int* pt = (const int*)c.in[I_PT]; const float* ckv = c.in[I_CKV]; const float* cwin = c.in[I_CWIN];
    bf16* OA = WSB(WC_OA);
    for (int item = item0 + c.gw; item < 65536 + 2048; item += c.NGW) {
        int lane = c.lane; asm volatile("" : "+v"(lane));
        const bool smp = item >= 65536; int b, g, t, qpos, ncmp, nslc; size_t row;
        if (!smp) { g = item & 3; b = (item >> 2) & 3; t = item >> 4; qpos = t; row = (size_t)b * SEQ + t; ncmp = 128; nslc = 64; }
        else { const int q = item - 65536; g = q & 3; t = (q >> 2) & 3; b = q >> 4; qpos = 2048 + t; row = (size_t)MP + 4 * b + t; ncmp = 64; nslc = 33; }
        const float* qrow = PJ + row * NCIN;
        { const f32x4 qv = *(const f32x4*)(qrow + g * 256 + lane * 4); *(LAS f32x4*)(qs + lane * 4) = qv * 0.125f; }
        float gv = 0.f; if (lane < 12) { const int gi = (lane >> 2) * 16 + g * 4 + (lane & 3); gv = sigmoid_f(qrow[2560 + gi] + gb[gi]); }
        float gate_c[4], gate_s[4], gate_w[4];
#pragma unroll
        for (int h = 0; h < 4; ++h) { gate_c[h] = readlane_f(gv, h); gate_s[h] = readlane_f(gv, 4 + h); gate_w[h] = readlane_f(gv, 8 + h); }
        LDS_WAIT();
        f32x4 acc[4];
#pragma unroll
        for (int h = 0; h < 4; ++h) acc[h] = (f32x4){0.f, 0.f, 0.f, 0.f};
        AttSt st;
        float ps;
        { const size_t kc0 = smp ? (size_t)2048 + ((size_t)b * 64) * 4 + g : ((size_t)b * 128) * 4 + g;
          const float* safe = KCV; float s0[4], s1[4];
          const int n0 = lane, n1 = lane + 64; const int d0 = qpos - (32 * n0 + 31), d1 = qpos - (32 * n1 + 31);
          const bool v0 = n0 < ncmp && d0 >= 0, v1 = n1 < ncmp && d1 >= 0;
          const float* k0p = v0 ? KCV + (kc0 + 4 * (size_t)n0) * 64 : safe; const float* k1p = v1 ? KCV + (kc0 + 4 * (size_t)n1) * 64 : safe;
          att_scores(qs, tabl, k0p, v0, d0, g, s0); att_scores(qs, tabl, k1p, v1, d1, g, s1);
          att_reset(st); float p0[4], p1[4], pc0 = 0.f, pc1 = 0.f;
#pragma unroll
          for (int h = 0; h < 4; ++h) { const float mx = wave_max(fmaxf(s0[h], s1[h])); p0[h] = v0 ? __expf(s0[h] - mx) : 0.f; p1[h] = v1 ? __expf(s1[h] - mx) : 0.f;
              const float l = wave_sum(p0[h] + p1[h]); const float inv = l > 0.f ? 1.f / l : 0.f; p0[h] *= inv; p1[h] *= inv; pc0 += p0[h]; pc1 += p1[h]; st.l[h] = l > 0.f ? 1.f : 0.f; }
          att_pv(st, P, R, p0, k0p, CMP_ROWS * 64, lane); att_pv(st, P, R, p1, k1p, CMP_ROWS * 64, lane);
          att_finish(st, gate_c, acc);
          pcs[lane] = pc0; pcs[64 + lane] = pc1; LDS_WAIT();
          ps = (2 * lane + 1 < ncmp) ? pcs[2 * lane] + pcs[2 * lane + 1] : 0.f; LDS_WAIT(); }
        const int jq = qpos >> 6; unsigned long long sel;
        { const bool forced = (lane == 0) || (lane == jq) || (lane == jq - 1);
          float sc = forced ? 100.f : (lane > jq ? -1.f : ps); if (lane >= nslc) sc = -__builtin_inff();
          int cnt = 0;
#pragma unroll 4
          for (int k = 0; k < 64; ++k) { const float sk = readlane_f(sc, k); cnt += (sk > sc || (sk == sc && k < lane)) ? 1 : 0; }
          sel = __ballot(cnt < 16); }
        att_reset(st);
        { const float* safe = qrow + 1536;
          unsigned long long todo = sel & (jq >= 63 ? ~0ull : ((1ull << (jq + 1)) - 1ull));
          while (todo) { const int j = __builtin_ctzll(todo); todo &= todo - 1ull;
              const int kpos = 64 * j + lane; const bool valid = kpos <= qpos; const float* kptr;
              if (!smp) kptr = PJ + ((size_t)b * SEQ + kpos) * NCIN + 1536 + g * 64;
              else if (j < 32) { const int page = pt[b * 16 + (j >> 1)]; kptr = ckv + (((size_t)page * 128 + (j & 1) * 64 + lane) * 16 + 8 + g) * 64; }
              else kptr = PJ + ((size_t)MP + 4 * b + (lane & 3)) * NCIN + 1536 + g * 64;
              att_block(st, qs, tabl, P, R, kptr, safe, valid, qpos - kpos, 256, g, lane); } }
        att_finish(st, gate_s, acc);
        att_reset(st);
        { const float* safe = qrow + 2048;
          for (int cb = 0; cb < 8; ++cb) { const int kpos = qpos - 511 + 64 * cb + lane; if (qpos - 511 + 64 * cb + 63 < 0) continue;
              const bool valid = kpos >= 0; const float* kptr;
              if (!smp) kptr = PJ + ((size_t)b * SEQ + (valid ? kpos : 0)) * NCIN + 2048 + g * 64;
              else if (kpos < 2048) kptr = cwin + (((size_t)b * 512 + (kpos - 1536)) * 2) * 256 + g * 64;
              else kptr = PJ + ((size_t)MP + 4 * b + (kpos - 2048)) * NCIN + 2048 + g * 64;
              att_block(st, qs, tabl, P, R, kptr, safe, valid, qpos - kpos, 256, g, lane); } }
        att_finish(st, gate_w, acc);
        if (lane < 16) {
#pragma unroll
            for (int h = 0; h < 4; ++h) { u32x2 w; w.x = pk2(acc[h].x, acc[h].y); w.y = pk2(acc[h].z, acc[h].w); *(u32x2*)(OA + row * 1024 + (g * 4 + h) * 64 + lane * 4) = w; } }
    }
}
constexpr int AT_ROWB = 144;
constexpr int AT_KB = 0, AT_VB = 2 * 64 * AT_ROWB, AT_PS = 4 * 64 * AT_ROWB, AT_SEL = AT_PS + 4 * 64 * 64 * 4, AT_BIAS = AT_SEL + 512, AT_END = AT_BIAS + 16 * 128 * 4;
static_assert(AT_END <= MISC_OFF, "attention LDS map");
struct AtRegs { u32x4 k, v; };
__device__ __forceinline__ AtRegs at_load(const bf16* kbase, const bf16* vbase, int vpitch, int tid) {
    AtRegs r; r.k = *(const u32x4*)(kbase + tid * 8); r.v = *(const u32x4*)(vbase + (size_t)(tid >> 3) * vpitch + (tid & 7) * 8); return r; }
__device__ __forceinline__ void at_store(LAS unsigned char* L, int buf, const AtRegs& r, int tid) {
    *(LAS u32x4*)(L + AT_KB + buf * 64 * AT_ROWB + (tid >> 3) * AT_ROWB + (tid & 7) * 16) = r.k; *(LAS u32x4*)(L + AT_VB + buf * 64 * AT_ROWB + (tid >> 3) * AT_ROWB + (tid & 7) * 16) = r.v; }
__device__ __forceinline__ void at_qk(LAS unsigned char* L, int buf, const bf16x8_t (&qf)[2][2], f32x4 (&st)[4][2], int fr, int rq) {
#pragma unroll
    for (int mb = 0; mb < 4; ++mb) { st[mb][0] = (f32x4){0.f, 0.f, 0.f, 0.f}; st[mb][1] = (f32x4){0.f, 0.f, 0.f, 0.f}; }
#pragma unroll
    for (int s = 0; s < 2; ++s)
#pragma unroll
        for (int mb = 0; mb < 4; ++mb) { const bf16x8_t kf = *(const LAS bf16x8_t*)(L + AT_KB + buf * 64 * AT_ROWB + (16 * mb + fr) * AT_ROWB + (32 * s + 8 * rq) * 2);
            st[mb][0] = MFMA16(kf, qf[0][s], st[mb][0]); st[mb][1] = MFMA16(kf, qf[1][s], st[mb][1]); }
}
__device__ __forceinline__ void at_pv(LAS unsigned char* L, int buf, const f32x4 (&st)[4][2], f32x4 (&ot)[4][2], int fr, int rq) {
#pragma unroll
    for (int s = 0; s < 2; ++s) { bf16x8_t pf[2];
#pragma unroll
        for (int nb = 0; nb < 2; ++nb) { u32x4 w; w.x = pk2(st[2 * s][nb].x, st[2 * s][nb].y); w.y = pk2(st[2 * s][nb].z, st[2 * s][nb].w); w.z = pk2(st[2 * s + 1][nb].x, st[2 * s + 1][nb].y); w.w = pk2(st[2 * s + 1][nb].z, st[2 * s + 1][nb].w);
            pf[nb] = __builtin_bit_cast(bf16x8_t, w); }
#pragma unroll
        for (int mb = 0; mb < 4; ++mb) { const LAS unsigned char* vp = L + AT_VB + buf * 64 * AT_ROWB + (16 * mb + fr) * AT_ROWB + (32 * s + 4 * rq) * 2;
            u32x4 w; const u32x2 lo = *(const LAS u32x2*)vp, hi = *(const LAS u32x2*)(vp + 32); w.x = lo.x; w.y = lo.y; w.z = hi.x; w.w = hi.y; const bf16x8_t vf = __builtin_bit_cast(bf16x8_t, w);
            ot[mb][0] = MFMA16(vf, pf[0], ot[mb][0]); ot[mb][1] = MFMA16(vf, pf[1], ot[mb][1]); } }
}
template <int MODE> __device__ __forceinline__ void at_softmax(f32x4 (&st)[4][2], f32x4 (&ot)[4][2], float (&m)[2], float (&l)[2], const bool (&rowok)[2], float cb, const LAS float* bias_h, int dist0  , int wlim) {
#pragma unroll
    for (int nb = 0; nb < 2; ++nb) { float mx = -1e30f;
#pragma unroll
        for (int mb = 0; mb < 4; ++mb)
#pragma unroll
            for (int i = 0; i < 4; ++i) { float s;
                if (MODE == 0) s = rowok[nb] ? st[mb][nb][i] + cb : -1e30f;
                else { const int dist = dist0 + 16 * nb - 16 * mb - i; const bool ok = rowok[nb] && dist >= 0 && dist < wlim; const int dd = dist < 0 ? 0 : (dist > 127 ? 127 : dist); const float bv = bias_h[dd]; s = ok ? st[mb][nb][i] + bv : -1e30f; }
                st[mb][nb][i] = s; mx = fmaxf(mx, s); }
        mx = fmaxf(mx, __shfl_xor(mx, 16)); mx = fmaxf(mx, __shfl_xor(mx, 32));
        const float mn = fmaxf(m[nb], mx), sc = __expf(m[nb] - mn); float ls = 0.f;
#pragma unroll
        for (int mb = 0; mb < 4; ++mb)
#pragma unroll
            for (int i = 0; i < 4; ++i) { const float s = st[mb][nb][i]; const float pe = __expf(s - mn); const float p = s > -1e29f ? pe : 0.f; st[mb][nb][i] = p; ls += p; }
        l[nb] = l[nb] * sc + ls; m[nb] = mn;
#pragma unroll
        for (int mb = 0; mb < 4; ++mb) ot[mb][nb] *= sc; }
}
template <bool ADD> __device__ __forceinline__ void at_finish(f32x4 (&ot)[4][2], float (&l)[2], const float (&gate)[2], LAS f32x4* park, int lane) {
#pragma unroll
    for (int nb = 0; nb < 2; ++nb) { float Ls = l[nb]; Ls += __shfl_xor(Ls, 16); Ls += __shfl_xor(Ls, 32); const float inv = Ls > 0.f ? gate[nb] / Ls : 0.f;
#pragma unroll
        for (int mb = 0; mb < 4; ++mb) { f32x4 v = ot[mb][nb] * inv; if (ADD) v += park[(mb * 2 + nb) * 64 + lane]; ot[mb][nb] = v; } }
}
__device__ __forceinline__ void at_park(const f32x4 (&ot)[4][2], LAS f32x4* park, int lane) {
#pragma unroll
    for (int nb = 0; nb < 2; ++nb)
#pragma unroll
        for (int mb = 0; mb < 4; ++mb) park[(mb * 2 + nb) * 64 + lane] = ot[mb][nb];
}
__device__ __forceinline__ void nsa_attn_prompt_phase(const Ctx& c) {
    const float* PJ = WSF(WC_PROJ); const float* gb = c.in[I_CGB]; bf16* OA = WSB(WC_OA);
    const bf16* KSB = WSB(WC_KSB); const bf16* VST = WSB(WC_VST); const bf16* KWB = WSB(WC_KWB); const bf16* VWT = WSB(WC_VWT); const bf16* KCB = WSB(WC_KCB); const bf16* VCT = WSB(WC_VCT);
    __syncthreads();
    { LAS float* bt = (LAS float*)(c.lds + AT_BIAS);
      for (int i = c.tid; i < 16 * 128; i += 512) { const int h = i >> 7, d = i & 127; bt[i] = c.in[I_T5][(int)T5_LUT[d] * 16 + h]; } }
    __syncthreads();
    for (int u = blockIdx.x; u < 1024; u += c.G) {
        LAS unsigned char* L = c.lds; asm volatile("" : "+v"(L));
        int tid = c.tid; asm volatile("" : "+v"(tid));
        const int lane = tid & 63, fr = lane & 15, rq = lane >> 4, w = c.wave, hg = w >> 1, tq0 = (w & 1) * 32;
        const int bg = (u & 255) >> 4, r16 = u & 15, k4 = u >> 8, qb = k4 == 0 ? r16 : (k4 == 1 ? 31 - r16 : (k4 == 2 ? 32 + r16 : 63 - r16)), b = bg >> 2, g = bg & 3, h = g * 4 + hg;
        const LAS float* bias_h = (const LAS float*)(L + AT_BIAS) + h * 128; const float cb = bias_h[127];
        LAS float* PS = (LAS float*)(L + AT_PS); LAS unsigned long long* SEL = (LAS unsigned long long*)(L + AT_SEL);
        bf16x8_t qf[2][2]; float gate_c[2], gate_s[2], gate_w[2]; size_t row[2];
#pragma unroll
        for (int nb = 0; nb < 2; ++nb) { row[nb] = (size_t)b * SEQ + 64 * qb + tq0 + 16 * nb + fr; const float* qr = PJ + row[nb] * NCIN;
#pragma unroll
            for (int s = 0; s < 2; ++s) { const f32x4 a = *(const f32x4*)(qr + h * 64 + 32 * s + 8 * rq) * 0.125f, bq = *(const f32x4*)(qr + h * 64 + 32 * s + 8 * rq + 4) * 0.125f;
                u32x4 wv; wv.x = pk2(a.x, a.y); wv.y = pk2(a.z, a.w); wv.z = pk2(bq.x, bq.y); wv.w = pk2(bq.z, bq.w); qf[nb][s] = __builtin_bit_cast(bf16x8_t, wv); }
            gate_c[nb] = sigmoid_f(qr[2560 + h] + gb[h]); gate_s[nb] = sigmoid_f(qr[2576 + h] + gb[16 + h]); gate_w[nb] = sigmoid_f(qr[2592 + h] + gb[32 + h]); }
        f32x4 ot[4][2], st[4][2]; float m[2], l[2]; bool rowok[2] = {true, true};
        LAS f32x4* park = (LAS f32x4*)(L + AT_PS) + w * 512;
#pragma unroll
        for (int mb = 0; mb < 4; ++mb) { ot[mb][0] = (f32x4){0.f, 0.f, 0.f, 0.f}; ot[mb][1] = (f32x4){0.f, 0.f, 0.f, 0.f}; }
        const int tl0 = 64 * qb + tq0 + fr;
        { __syncthreads();
          const AtRegs r0 = at_load(KCB + (size_t)bg * 128 * 64, VCT + (size_t)bg * 64 * 128, 128, tid), r1 = at_load(KCB + ((size_t)bg * 128 + 64) * 64, VCT + (size_t)bg * 64 * 128 + 64, 128, tid);
          at_store(L, 0, r0, tid); at_store(L, 1, r1, tid);
          __syncthreads();
          float cm[2] = {-1e30f, -1e30f}, cl[2] = {0.f, 0.f};
#pragma unroll
          for (int cc = 0; cc < 2; ++cc) { at_qk(L, cc, qf, st, fr, rq);
#pragma unroll
              for (int nb = 0; nb < 2; ++nb) { float mx = -1e30f; const int t = tl0 + 16 * nb;
#pragma unroll
                  for (int mb = 0; mb < 4; ++mb)
#pragma unroll
                      for (int i = 0; i < 4; ++i) { const int n = 64 * cc + 16 * mb + 4 * rq + i, dist = t - (32 * n + 31);
                          const float bv = bias_h[dist < 0 ? 0 : (dist > 127 ? 127 : dist)]; const float sv = dist >= 0 ? st[mb][nb][i] + bv : -1e30f; st[mb][nb][i] = sv; mx = fmaxf(mx, sv); }
                  mx = fmaxf(mx, __shfl_xor(mx, 16)); mx = fmaxf(mx, __shfl_xor(mx, 32));
                  const float mn = fmaxf(cm[nb], mx); float ls = 0.f;
#pragma unroll
                  for (int mb = 0; mb < 4; ++mb)
#pragma unroll
                      for (int i = 0; i < 4; ++i) { const float pe = __expf(st[mb][nb][i] - mn); ls += st[mb][nb][i] > -1e29f ? pe : 0.f; }
                  cl[nb] = cl[nb] * __expf(cm[nb] - mn) + ls; cm[nb] = mn; } }
          float cinv[2];
#pragma unroll
          for (int nb = 0; nb < 2; ++nb) { float ls = cl[nb]; ls += __shfl_xor(ls, 16); ls += __shfl_xor(ls, 32); cinv[nb] = ls > 0.f ? 1.f / ls : 0.f; l[nb] = ls > 0.f ? 0.25f : 0.f; }
#pragma unroll
          for (int cc = 0; cc < 2; ++cc) { at_qk(L, cc, qf, st, fr, rq);
#pragma unroll
              for (int nb = 0; nb < 2; ++nb) { const int t = tl0 + 16 * nb; LAS float* psr = PS + ((hg * 64 + tq0 + 16 * nb + fr) * 64 + 2 * rq) + 32 * cc;
#pragma unroll
                  for (int mb = 0; mb < 4; ++mb) {
#pragma unroll
                      for (int i = 0; i < 4; ++i) { const int n = 64 * cc + 16 * mb + 4 * rq + i, dist = t - (32 * n + 31);
                          const float bv = bias_h[dist < 0 ? 0 : (dist > 127 ? 127 : dist)]; const float pe = __expf(fminf(st[mb][nb][i] + bv - cm[nb], 0.f)) * cinv[nb]; st[mb][nb][i] = dist >= 0 ? pe : 0.f; }
                      *(LAS f32x2*)(psr + 8 * mb) = (f32x2){st[mb][nb][0] + st[mb][nb][1], st[mb][nb][2] + st[mb][nb][3]}; } }
              at_pv(L, cc, st, ot, fr, rq); }
          at_finish<false>(ot, l, gate_c, park, lane);
        }
        __syncthreads();
        { for (int i8 = 0; i8 < 8; ++i8) { const int tq = 8 * w + i8; unsigned long long sel;
              if (qb <= 15) sel = (2ull << qb) - 1ull;
              else { const float ps = (PS[(0 * 64 + tq) * 64 + lane] + PS[(1 * 64 + tq) * 64 + lane]) + (PS[(2 * 64 + tq) * 64 + lane] + PS[(3 * 64 + tq) * 64 + lane]);
                  const bool forced = (lane == 0) || (lane == qb) || (lane == qb - 1); const float sc = forced ? 100.f : (lane > qb ? -1.f : ps); int cnt = 0;
#pragma unroll 4
                  for (int k = 0; k < 64; ++k) { const float sk = readlane_f(sc, k); cnt += (sk > sc || (sk == sc && k < lane)) ? 1 : 0; }
                  sel = __ballot(cnt < 16) & ((2ull << qb) - 1ull); }
              if (lane == 0) SEL[tq] = sel; } }
        __syncthreads();
        unsigned long long selm[2], uni;
        { selm[0] = SEL[tq0 + fr]; selm[1] = SEL[tq0 + 16 + fr]; unsigned long long a = SEL[lane];
#pragma unroll
          for (int o = 1; o < 64; o <<= 1) a |= __shfl_xor(a, o);
          uni = a; }
        at_park(ot, park, lane);
#pragma unroll
        for (int mb = 0; mb < 4; ++mb) { ot[mb][0] = (f32x4){0.f, 0.f, 0.f, 0.f}; ot[mb][1] = (f32x4){0.f, 0.f, 0.f, 0.f}; }
        m[0] = m[1] = -1e30f; l[0] = l[1] = 0.f;
        { unsigned long long todo = __builtin_amdgcn_readfirstlane((unsigned)uni) | ((unsigned long long)__builtin_amdgcn_readfirstlane((unsigned)(uni >> 32)) << 32);
          int j = __builtin_ctzll(todo), buf = 0;
          AtRegs rg = at_load(KSB + ((size_t)bg * SEQ + 64 * j) * 64, VST + (size_t)bg * 64 * SEQ + 64 * j, SEQ, tid);
          for (;;) { at_store(L, buf, rg, tid); todo &= todo - 1ull; const bool more = todo != 0ull; const int jn = more ? __builtin_ctzll(todo) : 0;
              __syncthreads();
              if (more) rg = at_load(KSB + ((size_t)bg * SEQ + 64 * jn) * 64, VST + (size_t)bg * 64 * SEQ + 64 * jn, SEQ, tid);
              at_qk(L, buf, qf, st, fr, rq);
              rowok[0] = (selm[0] >> j) & 1ull; rowok[1] = (selm[1] >> j) & 1ull;
              if (j + 3 <= qb) at_softmax<0>(st, ot, m, l, rowok, cb, bias_h, 0, 0); else at_softmax<1>(st, ot, m, l, rowok, cb, bias_h, tl0 - (64 * j + 4 * rq), 1 << 30);
              at_pv(L, buf, st, ot, fr, rq);
              if (!more) break; j = jn; buf ^= 1; }
          at_finish<true>(ot, l, gate_s, park, lane); at_park(ot, park, lane); }
        __syncthreads();
#pragma unroll
        for (int mb = 0; mb < 4; ++mb) { ot[mb][0] = (f32x4){0.f, 0.f, 0.f, 0.f}; ot[mb][1] = (f32x4){0.f, 0.f, 0.f, 0.f}; }
        m[0] = m[1] = -1e30f; l[0] = l[1] = 0.f; rowok[0] = rowok[1] = true;
        { int j = qb >= 8 ? qb - 8 : 0, buf = 0;
          AtRegs rg = at_load(KWB + ((size_t)bg * SEQ + 64 * j) * 64, VWT + (size_t)bg * 64 * SEQ + 64 * j, SEQ, tid);
          for (;;) { at_store(L, buf, rg, tid); const bool more = j < qb; const int jn = j + 1;
              __syncthreads();
              if (more) rg = at_load(KWB + ((size_t)bg * SEQ + 64 * jn) * 64, VWT + (size_t)bg * 64 * SEQ + 64 * jn, SEQ, tid);
              at_qk(L, buf, qf, st, fr, rq);
              if (j + 3 <= qb && j + 8 > qb) at_softmax<0>(st, ot, m, l, rowok, cb, bias_h, 0, 0); else at_softmax<1>(st, ot, m, l, rowok, cb, bias_h, tl0 - (64 * j + 4 * rq), 512);
              at_pv(L, buf, st, ot, fr, rq);
              if (!more) break; j = jn; buf ^= 1; }
          at_finish<true>(ot, l, gate_w, park, lane); }
#pragma unroll
        for (int nb = 0; nb < 2; ++nb)
#pragma unroll
            for (int mb = 0; mb < 4; ++mb) { u32x2 wv; wv.x = pk2(ot[mb][nb].x, ot[mb][nb].y); wv.y = pk2(ot[mb][nb].z, ot[mb][nb].w); *(u32x2*)(OA + row[nb] * 1024 + h * 64 + 16 * mb + 4 * rq) = wv; }
    }
}
constexpr int PH_PER_SUB = 9, N_PHASES = 2 + 12 * PH_PER_SUB;
struct Args { const float* in[N_IN]; float* out; unsigned char* ws; int ph_lo, ph_hi, bli, pad; };
__host__ __device__ inline bool phase_exists(int ph) {
    if (ph < 2) return true; const int r = ph - 2, sub3 = r / PH_PER_SUB, slot = r % PH_PER_SUB, L = sub3 / 3, s = sub3 % 3, kind = (L == 1) ? 1 : (L == 2 ? 2 : 0);
    if (slot == 0 || slot == 5 || slot == 6) return true;
    if (slot == 7) return s == 2;
    if (slot == 8) return false;
    if (s != 1) return false;
    if (kind == 0) return slot <= 2; if (kind == 1) return slot <= 3; return true;
}

#ifndef PROBE
#define PROBE 0
#endif
#define TW(cls, ...) do { __VA_ARGS__; if (PROBE == (cls)) { __VA_ARGS__; } } while (0)
#define IN(k) (lo <= (k) && (k) < hi)
#define SEAM(k) do { if (IN(k) && (k) + 1 < hi) xcd_barrier(bar); } while (0)
template <int L, int S> __device__ __forceinline__ void run_sub(const Ctx& c, const XcdBarrier& bar, const int lo, const int hi) {
    constexpr int kind = (L == 1) ? 1 : (L == 2 ? 2 : 0), ia = (L == 3) ? 1 : 0, base = 2 + (3 * L + S) * PH_PER_SUB;
    LAS unsigned char* ring = c.lds;
    if (IN(base)) {
        if constexpr (S != 1) { constexpr int j = S >> 1; pg8::Gemm g{S == 0 ? WSB(WS_XNB) : WSB(WS_XN), WSB(WS_WUP + (size_t)(2 * L + j) * SZ_WUP), M, 5632, 1024}; pg8::StaticOrder So; So.init(M, 5632, c.G, (int)blockIdx.x);
            pg8::EpiGate E{WSB(WS_H), DFF}; TW(1, pg8::gemm_phase<pg8::EpiGate, pg8::StaticOrder, true, true>(ring, g, So, E)); }
        else if constexpr (kind == 0) { pg8::Gemm g{WSB(WS_XN), WSB(WS_WAIN + (size_t)ia * SZ_WAIN), M, 4096, 1024}; pg8::StaticOrder So; So.init(M, 4096, c.G, (int)blockIdx.x);
            pg8::EpiAin E{WSB(WA_U), WSF(WA_V)}; TW(1, pg8::gemm_phase<pg8::EpiAin, pg8::StaticOrder, true, true>(ring, g, So, E)); }
        else { constexpr int N = kind == 1 ? NBIN : NCIN; pg8::Gemm g{WSB(WS_XN), kind == 1 ? WSB(WS_WBIN) : WSB(WS_WCIN), M, N, 1024}; pg8::StaticOrder So; So.init(M, N, c.G, (int)blockIdx.x);
            pg8::EpiF32 E{WSF(WS_MIX), N}; TW(1, pg8::gemm_phase<pg8::EpiF32, pg8::StaticOrder, true, true>(ring, g, So, E)); }
    } SEAM(base);
    if constexpr (S == 1) {
        if (IN(base + 1)) { if constexpr (kind == 0) TW(4, a_stats_phase(c, ia)); else if constexpr (kind == 1) TW(6, gdn_prep_phase(c)); else TW(9, nsa_prep_phase(c)); } SEAM(base + 1);
        if (IN(base + 2)) { if constexpr (kind == 0) TW(5, a_sgu_phase(c, ia)); else if constexpr (kind == 1) TW(7, gdn_scan_phase(c));
            else {
                { pg8::Gemm g{WSB(WC_ACMP), WSB(WS_WC1), CMP_ROWS, 256, 2048}; pg8::StaticOrder So; So.init(CMP_ROWS, 256, c.G, (int)blockIdx.x);
                  pg8::EpiCmp E{WSB(WC_HC)}; TW(1, pg8::gemm_phase<pg8::EpiCmp, pg8::StaticOrder, true, true>(ring, g, So, E)); }
                { pg8::Gemm g{WSB(WC_ACMP) + (size_t)CMP_ROWS * 2048, WSB(WS_WC1 + SZ_WC1), CMP_ROWS, 256, 2048}; pg8::StaticOrder So; So.init(CMP_ROWS, 256, c.G, (int)((blockIdx.x + 128u) % (unsigned)c.G));
                  pg8::EpiCmp E{WSB(WC_HC) + (size_t)CMP_ROWS * 256}; TW(1, pg8::gemm_phase<pg8::EpiCmp, pg8::StaticOrder, true, true>(ring, g, So, E)); } } } SEAM(base + 2);
        if constexpr (kind != 0) { if (IN(base + 3)) { if constexpr (kind == 1) TW(8, gdn_post_phase(c)); else TW(10, nsa_cmp2_phase(c)); } SEAM(base + 3); }
        if constexpr (kind == 2) { if (IN(base + 4)) TW(11, nsa_attn_prompt_phase(c)); TW(12, nsa_attn_phase(c, 65536)); SEAM(base + 4); }
    }
    if (IN(base + 5)) {
        const bf16* A; const bf16* Bt; int K; float sc;
        if constexpr (S != 1) { A = WSB(WS_H); Bt = WSB(WS_WDN + (size_t)(2 * L + (S >> 1)) * SZ_WDN); K = DFF; sc = 0.5f; }
        else if constexpr (kind == 0) { A = WSB(WA_US); Bt = WSB(WS_WAOUT + (size_t)ia * SZ_WAOUT); K = 2048; sc = 1.f; }
        else if constexpr (kind == 1) { A = WSB(WB_OG); Bt = WSB(WS_WBOUT); K = 1024; sc = 1.f; }
        else { A = WSB(WC_OA); Bt = WSB(WS_WCOUT); K = 1024; sc = 1.f; }
        pg8::Gemm g{A, Bt, M, 1024, K}; pg8::StaticOrder So; So.init(M, 1024, c.G, (int)blockIdx.x);
        pg8::EpiResid E{WSF(WS_X), WSF(WS_PRE), ALPHA, sc}; TW(1, pg8::gemm_phase<pg8::EpiResid, pg8::StaticOrder, true, true>(ring, g, So, E));
    } SEAM(base + 5);
    if (IN(base + 6)) { TW(3, ln_phase(c, c.in[I_LNG] + (size_t)(3 * L + S) * 1024, c.in[I_LNB] + (size_t)(3 * L + S) * 1024)); } SEAM(base + 6);
    if constexpr (S == 2) { if (IN(base + 7)) { pg8::Gemm g{WSB(WS_XN), WSB(WS_WG + (size_t)L * SZ_WG), M, 1024, 1024}; pg8::StaticOrder So; So.init(M, 1024, c.G, (int)blockIdx.x);
            pg8::EpiPle E{WSF(WS_X), WSF(WS_PP) + (size_t)L * M * 1024, WSB(WS_XNB), L == 3 ? c.out : nullptr}; pg8::gemm_phase<pg8::EpiPle, pg8::StaticOrder, true, true>(ring, g, So, E); } SEAM(base + 7); }
}
template <int l> __device__ __forceinline__ void ple_proj(const Ctx& c) {
    pg8::Gemm g{WSB(WS_PBF) + (size_t)l * M * 256, WSB(WS_WP + l * SZ_WP), M, 1024, 256}; pg8::StaticOrder So; So.init(M, 1024, c.G, (int)blockIdx.x);
    pg8::EpiF32 E{WSF(WS_PP) + (size_t)l * M * 1024, 1024}; TW(1, pg8::gemm_phase<pg8::EpiF32, pg8::StaticOrder, true, true>(c.lds, g, So, E));
}
__global__ void __launch_bounds__(NWAVES * 64, 2) fwd(Args args) {
    extern __shared__ __attribute__((aligned(16))) unsigned char lds_raw[];
    Ctx c; c.lds = (LAS unsigned char*)lds_raw; c.ws = args.ws; c.out = args.out; c.in = args.in;
    c.tid = threadIdx.x; c.lane = c.tid & 63; c.wave = __builtin_amdgcn_readfirstlane(c.tid >> 6); c.G = gridDim.x; c.gw = blockIdx.x * NWAVES + c.wave; c.NGW = c.G * NWAVES;
    volatile LAS unsigned* MISC = (volatile LAS unsigned*)(c.lds + MISC_OFF);
    for (int u = c.tid; u < 128; u += NWAVES * 64) MISC[u] = 0u;
    __syncthreads();
    unsigned* ctl = (unsigned*)c.ws;
    XcdBarrier bar = xcd_barrier_post(ctl + CW_BAR + args.bli * XCD_BAR_WORDS, MISC + 8);
    const int lo = args.ph_lo, hi = args.ph_hi;
    if (IN(0)) { TW(13, prologue_phase(c)); } SEAM(0);
    if (IN(1)) { ple_proj<0>(c); ple_proj<1>(c); ple_proj<2>(c); ple_proj<3>(c); } SEAM(1);
    run_sub<0, 0>(c, bar, lo, hi); run_sub<0, 1>(c, bar, lo, hi); run_sub<0, 2>(c, bar, lo, hi);
    run_sub<1, 0>(c, bar, lo, hi); run_sub<1, 1>(c, bar, lo, hi); run_sub<1, 2>(c, bar, lo, hi);
    run_sub<2, 0>(c, bar, lo, hi); run_sub<2, 1>(c, bar, lo, hi); run_sub<2, 2>(c, bar, lo, hi);
    run_sub<3, 0>(c, bar, lo, hi); run_sub<3, 1>(c, bar, lo, hi); run_sub<3, 2>(c, bar, lo, hi);
}
#undef IN
#undef SEAM

#ifndef ONE_LAUNCH
#define ONE_LAUNCH 1
#endif
extern "C" void kernel_launch(void* const* d_in, const int* in_sizes, int n_in, void* d_out, int out_size, void* d_ws, size_t ws_size, hipStream_t stream) {
    static int grid = 0;
    if (grid == 0) {
        if (n_in != N_IN || (size_t)out_size != O_END || ws_size < WS_END) { fprintf(stderr, "kernel_launch: unexpected problem: n_in %d out %d ws %zu (need %zu)\n", n_in, out_size, ws_size, (size_t)WS_END); grid = -1; return; }
        int dev = 0, cus = 0, per_cu = 0;
        if (hipGetDevice(&dev) != hipSuccess || hipDeviceGetAttribute(&cus, hipDeviceAttributeMultiprocessorCount, dev) != hipSuccess) { grid = -1; return; }
        if (hipFuncSetAttribute((const void*)fwd, hipFuncAttributeMaxDynamicSharedMemorySize, LDS_BYTES) != hipSuccess) { fprintf(stderr, "kernel_launch: hipFuncSetAttribute failed\n"); grid = -1; return; }
        if (hipOccupancyMaxActiveBlocksPerMultiprocessor(&per_cu, (const void*)fwd, NWAVES * 64, LDS_BYTES) != hipSuccess || per_cu < 1) fprintf(stderr, "kernel_launch: occupancy query says %d\n", per_cu);
        (void)hipGetLastError();
        grid = cus;
    }
    if (grid < 0) return;
    (void)hipMemsetAsync(d_ws, 0, CTL_BYTES, stream);
    Args a{};
    for (int i = 0; i < N_IN; ++i) a.in[i] = (const float*)d_in[i];
    a.out = (float*)d_out; a.ws = (unsigned char*)d_ws; a.pad = 0;
#if ONE_LAUNCH
    a.ph_lo = 0; a.ph_hi = N_PHASES; a.bli = 0;
    hipLaunchKernelGGL(fwd, dim3(grid), dim3(NWAVES * 64), LDS_BYTES, stream, a);
#else
    for (int ph = 0; ph < N_PHASES; ++ph) { if (!phase_exists(ph)) continue; a.ph_lo = ph; a.ph_hi = ph + 1; a.bli = 0;
        hipLaunchKernelGGL(fwd, dim3(grid), dim3(NWAVES * 64), LDS_BYTES, stream, a); }
#endif
}
```

```cpp
#include <hip/hip_runtime.h>
#include <cstdio>
#include <cstdint>
namespace pg8 {
#define PG8_LAS __attribute__((address_space(3)))
typedef unsigned short bf16_t;
typedef short bf16x8 __attribute__((ext_vector_type(8)));
typedef float f32x4 __attribute__((ext_vector_type(4)));
typedef unsigned u32x4 __attribute__((ext_vector_type(4)));
constexpr int BM = 256, BK = 64, HALF = 128, HTB = HALF * BK * 2  , STAGE_BYTES = 8 * HTB, NXCD = 8, WGM = 8;

__host__ __device__ __forceinline__ int lds_byte(int r, int c) { const int st = (r >> 4) * 2 + (c >> 5), rr = r & 15, cc = c & 31, ob = rr * 64 + cc * 2; return st * 1024 + (ob ^ (((ob >> 9) & 1) << 5)); }
__host__ __device__ __forceinline__ void stage_rc(int b, int& R, int& C) { const int st = b / 1024, sb = b % 1024, swz = sb ^ (((sb >> 9) & 1) << 5); R = (st >> 1) * 16 + swz / 64; C = (st & 1) * 32 + (swz % 64) / 2; }
__host__ __device__ __forceinline__ int perm32(int rho) { const int n = rho >> 4, i = rho & 15; return 8 * (i >> 2) + 4 * n + (i & 3); }

struct Unit { int pm, pn, ko; };
struct Gemm { const bf16_t* A; const bf16_t* Bt; int M, N, K, ld; };

struct StaticOrder {
    int nM, nN, nwg, G, c;
    __host__ __device__ void init(int M, int N, int G_, int c_) { nM = M / BM; nN = N / BM; nwg = nM * nN; G = G_; c = c_; }
    __host__ __device__ bool next(int i, Unit& u) const {
        const long L = (long)i * G + c; if (L >= nwg) return false;
        int wgid = (int)L; { const int q = nwg / NXCD, r = nwg % NXCD, xcd = wgid % NXCD, off = wgid / NXCD; wgid = (xcd < r ? xcd * (q + 1) : r * (q + 1) + (xcd - r) * q) + off; }
        const int nig = WGM * nN, gid = wgid / nig, fm = gid * WGM, gsz = (nM - fm) < WGM ? (nM - fm) : WGM;
        u.pm = fm + ((wgid % nig) % gsz); u.pn = (wgid % nig) / gsz; u.ko = 0; return true;
    }
    __device__ __forceinline__ void a_ready(const Unit&) const {}
    __device__ __forceinline__ void done(const Unit&) const {}
};

__device__ __forceinline__ unsigned cvt_pk_bf16(float lo, float hi) { unsigned r; asm volatile("v_cvt_pk_bf16_f32 %0, %1, %2" : "=v"(r) : "v"(lo), "v"(hi)); return r; }
typedef unsigned u32x2 __attribute__((ext_vector_type(2)));
__device__ __forceinline__ float fast_sigmoid(float x) { return __frcp_rn(1.0f + __expf(-x)); }
__device__ __forceinline__ float silu_f(float x) { return x * fast_sigmoid(x); }
__device__ __forceinline__ float gelu_tanh_f(float x) { const float y = 1.5957691216057308f * (x + 0.044715f * x * x * x); return x * fast_sigmoid(y); }
__device__ __forceinline__ u32x2 pack4(f32x4 v) { u32x2 w; w.x = cvt_pk_bf16(v[0], v[1]); w.y = cvt_pk_bf16(v[2], v[3]); return w; }

struct EpiGate {
    static constexpr bool PERM = false, AFTER_DRAIN = false;
    bf16_t* H; int ldh;
    __device__ __forceinline__ void operator()(const f32x4 (&acc)[2][2][4][2], const Unit& u, int wr, int wc, int fr, int fq) const {
        const int row0 = u.pm * BM + wr * 64 + fr, col0 = u.pn * HALF + wc * 32 + 4 * fq;
#pragma unroll
        for (int ai = 0; ai < 2; ++ai)
#pragma unroll
            for (int m = 0; m < 4; ++m) { bf16_t* rowp = H + (size_t)(row0 + ai * HALF + m * 16) * ldh + col0;
#pragma unroll
                for (int n = 0; n < 2; ++n) { const f32x4 a = acc[ai][0][m][n], b = acc[ai][1][m][n]; f32x4 h;
#pragma unroll
                    for (int j = 0; j < 4; ++j) h[j] = silu_f(a[j]) * b[j];
                    *(u32x2*)(rowp + n * 16) = pack4(h); } }
    }
};
struct EpiResid {
    static constexpr bool PERM = false, AFTER_DRAIN = false;
    const float* X; float* PRE; float alpha, s;
    __device__ __forceinline__ void operator()(const f32x4 (&acc)[2][2][4][2], const Unit& u, int wr, int wc, int fr, int fq) const {
        const int row0 = u.pm * BM + wr * 64 + fr, col0 = u.pn * BM + wc * 32 + 4 * fq;
#pragma unroll
        for (int ai = 0; ai < 2; ++ai)
#pragma unroll
            for (int m = 0; m < 4; ++m) { const size_t off = (size_t)(row0 + ai * HALF + m * 16) * 1024 + col0;
#pragma unroll
                for (int bj = 0; bj < 2; ++bj)
#pragma unroll
                    for (int n = 0; n < 2; ++n) { const f32x4 x = *(const f32x4*)(X + off + bj * HALF + n * 16); *(f32x4*)(PRE + off + bj * HALF + n * 16) = x * alpha + acc[ai][bj][m][n] * s; } }
    }
};
struct EpiF32 {
    static constexpr bool PERM = false, AFTER_DRAIN = false;
    float* C; int ldc;
    __device__ __forceinline__ void operator()(const f32x4 (&acc)[2][2][4][2], const Unit& u, int wr, int wc, int fr, int fq) const {
        const int row0 = u.pm * BM + wr * 64 + fr, col0 = u.pn * BM + wc * 32 + 4 * fq;
#pragma unroll
        for (int ai = 0; ai < 2; ++ai)
#pragma unroll
            for (int m = 0; m < 4; ++m) { float* rowp = C + (size_t)(row0 + ai * HALF + m * 16) * ldc + col0;
#pragma unroll
                for (int bj = 0; bj < 2; ++bj)
#pragma unroll
                    for (int n = 0; n < 2; ++n) *(f32x4*)(rowp + bj * HALF + n * 16) = acc[ai][bj][m][n]; }
    }
};
struct EpiPle {
    static constexpr bool PERM = false, AFTER_DRAIN = false;
    float* X; const float* P; bf16_t* XN; float* OUT;
    __device__ __forceinline__ void operator()(const f32x4 (&acc)[2][2][4][2], const Unit& u, int wr, int wc, int fr, int fq) const {
        const int row0 = u.pm * BM + wr * 64 + fr, col0 = u.pn * BM + wc * 32 + 4 * fq;
#pragma unroll
        for (int ai = 0; ai < 2; ++ai)
#pragma unroll
            for (int m = 0; m < 4; ++m) { const size_t off = (size_t)(row0 + ai * HALF + m * 16) * 1024 + col0;
#pragma unroll
                for (int bj = 0; bj < 2; ++bj)
#pragma unroll
                    for (int n = 0; n < 2; ++n) { const size_t o = off + bj * HALF + n * 16; const f32x4 x = *(const f32x4*)(X + o), p = *(const f32x4*)(P + o), a = acc[ai][bj][m][n]; f32x4 y;
#pragma unroll
                        for (int j = 0; j < 4; ++j) y[j] = x[j] + fast_sigmoid(a[j]) * p[j];
                        *(f32x4*)(X + o) = y; *(u32x2*)(XN + o) = pack4(y); if (OUT) *(f32x4*)(OUT + o) = y; } }
    }
};
struct EpiAin {
    static constexpr bool PERM = false, AFTER_DRAIN = false;
    bf16_t* U; float* V;
    __device__ __forceinline__ void operator()(const f32x4 (&acc)[2][2][4][2], const Unit& u, int wr, int wc, int fr, int fq) const {
        const int row0 = u.pm * BM + wr * 64 + fr; const bool isu = u.pn < 8; const int col0 = (isu ? u.pn : u.pn - 8) * BM + wc * 32 + 4 * fq;
#pragma unroll
        for (int ai = 0; ai < 2; ++ai)
#pragma unroll
            for (int m = 0; m < 4; ++m) { const size_t off = (size_t)(row0 + ai * HALF + m * 16) * 2048 + col0;
#pragma unroll
                for (int bj = 0; bj < 2; ++bj)
#pragma unroll
                    for (int n = 0; n < 2; ++n) { const f32x4 a = acc[ai][bj][m][n]; f32x4 y;
#pragma unroll
                        for (int j = 0; j < 4; ++j) y[j] = gelu_tanh_f(a[j]);
                        if (isu) *(u32x2*)(U + off + bj * HALF + n * 16) = pack4(y); else *(f32x4*)(V + off + bj * HALF + n * 16) = y; } }
    }
};
struct EpiCmp {
    static constexpr bool PERM = false, AFTER_DRAIN = false;
    bf16_t* HC;
    __device__ __forceinline__ void operator()(const f32x4 (&acc)[2][2][4][2], const Unit& u, int wr, int wc, int fr, int fq) const {
        const int row0 = u.pm * BM + wr * 64 + fr, col0 = u.pn * BM + wc * 32 + 4 * fq;
#pragma unroll
        for (int ai = 0; ai < 2; ++ai)
#pragma unroll
            for (int m = 0; m < 4; ++m) { bf16_t* rowp = HC + (size_t)(row0 + ai * HALF + m * 16) * 256 + col0;
#pragma unroll
                for (int bj = 0; bj < 2; ++bj)
#pragma unroll
                    for (int n = 0; n < 2; ++n) { const f32x4 a = acc[ai][bj][m][n]; f32x4 y;
#pragma unroll
                        for (int j = 0; j < 4; ++j) y[j] = gelu_tanh_f(a[j]);
                        *(u32x2*)(rowp + bj * HALF + n * 16) = pack4(y); } }
    }
};

struct SplitOrder {
    int nM, nN, nsplit, ksplit, G, c;
    __device__ __forceinline__ bool next(int i, Unit& u) const { const int L = i * G + c, nt = nM * nN; if (L >= nsplit * nt) return false; const int sp = L / nt, t = L - sp * nt; u.pm = t / nN; u.pn = t - u.pm * nN; u.ko = sp * ksplit; return true; }
    __device__ __forceinline__ void a_ready(const Unit&) const {}
    __device__ __forceinline__ void done(const Unit&) const {}
};
struct EpiSlab {
    static constexpr bool PERM = false, AFTER_DRAIN = false;
    float* S; int ksplit; size_t slab;
    __device__ __forceinline__ void operator()(const f32x4 (&acc)[2][2][4][2], const Unit& u, int wr, int wc, int fr, int fq) const {
        const int row0 = u.pm * BM + wr * 64 + fr, col0 = u.pn * BM + wc * 32 + 4 * fq; float* base = S + (size_t)(u.ko / ksplit) * slab;
#pragma unroll
        for (int ai = 0; ai < 2; ++ai)
#pragma unroll
            for (int m = 0; m < 4; ++m) { float* rowp = base + (size_t)(row0 + ai * HALF + m * 16) * 1024 + col0;
#pragma unroll
                for (int bj = 0; bj < 2; ++bj)
#pragma unroll
                    for (int n = 0; n < 2; ++n) *(f32x4*)(rowp + bj * HALF + n * 16) = acc[ai][bj][m][n]; }
    }
};
template <class Epi, class Sched, bool ALIGN_EPI = false, bool SP2 = false>
__device__ __forceinline__ void gemm_phase(PG8_LAS unsigned char* lds, const Gemm g, const Sched& S, const Epi& E) {
    const int tid = threadIdx.x, wid = __builtin_amdgcn_readfirstlane(tid >> 6), lane = tid & 63, wr = wid >> 2, wc = wid & 3, fr = lane & 15, fq = lane >> 4;
    const int K = g.K, LD = g.ld ? g.ld : g.K, nt = K / BK;
    unsigned voffA[2], voffB[2];
#pragma unroll
    for (int i = 0; i < 2; ++i) { int R, C; stage_rc(tid * 16 + i * 8192, R, C); const int Rb = Epi::PERM ? ((R & ~31) + perm32(R & 31)) : R;
        voffA[i] = (unsigned)(R * LD + C) * 2u; voffB[i] = (unsigned)(Rb * LD + C) * 2u; }
    const size_t kstep = (size_t)(BK * 2);
    const size_t hstep = (size_t)HALF * LD * 2;
    const size_t tstep = 2 * hstep;
    const unsigned ldsw = (unsigned)wid * 1024u;
    const int aoff = lds_byte(wr * 64 + fr, fq * 8), boff = lds_byte(wc * 32 + fr, fq * 8);
#define PG8_SA(b, h) (((b) * 2 + (h)) * HTB)
#define PG8_SB(b, h) ((4 + (b) * 2 + (h)) * HTB)
#define PG8_STAGE(bufoff, gbase, voff) do { _Pragma("unroll") for (int _i = 0; _i < 2; ++_i) \
        __builtin_amdgcn_global_load_lds((const unsigned*)((const char*)(gbase) + (voff)[_i]), (PG8_LAS unsigned*)(lds + (bufoff) + ldsw + _i * 8192), 16, 0, 0); } while (0)
#define PG8_LDA(dst, b, h) do { _Pragma("unroll") for (int m = 0; m < 4; ++m) _Pragma("unroll") for (int k = 0; k < 2; ++k) dst[m][k] = *(const PG8_LAS bf16x8*)(lds + PG8_SA(b, h) + aoff + m * 2048 + k * 1024); } while (0)
#define PG8_LDB(dst, b, h) do { _Pragma("unroll") for (int n = 0; n < 2; ++n) _Pragma("unroll") for (int k = 0; k < 2; ++k) dst[n][k] = *(const PG8_LAS bf16x8*)(lds + PG8_SB(b, h) + boff + n * 2048 + k * 1024); } while (0)
#define PG8_MMA(ai, bj, At, Bt) do { __builtin_amdgcn_s_setprio(1); _Pragma("unroll") for (int m = 0; m < 4; ++m) _Pragma("unroll") for (int n = 0; n < 2; ++n) _Pragma("unroll") for (int k = 0; k < 2; ++k) \
        acc[ai][bj][m][n] = __builtin_amdgcn_mfma_f32_16x16x32_bf16(Bt[n][k], At[m][k], acc[ai][bj][m][n], 0, 0, 0); __builtin_amdgcn_s_setprio(0); } while (0)
#define PG8_WAIT_V(n) asm volatile("s_waitcnt vmcnt(" #n ")" ::: "memory")
#define PG8_WAIT_L(n) asm volatile("s_waitcnt lgkmcnt(" #n ")" ::: "memory")
#define PG8_BAR __builtin_amdgcn_s_barrier()
#define PG8_SCHED __builtin_amdgcn_sched_barrier(0)
    Unit cur, nxt; int ui = 0;
    if (!S.next(0, cur)) return;
    f32x4 acc[2][2][4][2];
#pragma unroll
    for (int a = 0; a < 2; ++a)
#pragma unroll
        for (int b = 0; b < 2; ++b)
#pragma unroll
            for (int m = 0; m < 4; ++m)
#pragma unroll
                for (int n = 0; n < 2; ++n) acc[a][b][m][n] = (f32x4){0.f, 0.f, 0.f, 0.f};
    bf16x8 At[4][2], B0[2][2], B1[2][2];
    const char* cA = (const char*)g.A + (size_t)cur.pm * tstep + (size_t)cur.ko * 2; const char* cB = (const char*)g.Bt + (size_t)cur.pn * tstep + (size_t)cur.ko * 2;
    S.a_ready(cur);
    if constexpr (SP2) {
        PG8_STAGE(PG8_SB(0, 0), cB, voffB); PG8_STAGE(PG8_SB(0, 1), cB + hstep, voffB); PG8_STAGE(PG8_SA(0, 0), cA, voffA); PG8_STAGE(PG8_SA(0, 1), cA + hstep, voffA);
        if (wr == 1) PG8_BAR;
        PG8_WAIT_V(2); PG8_BAR;
        PG8_STAGE(PG8_SB(1, 0), cB + kstep, voffB); PG8_STAGE(PG8_SA(1, 0), cA + kstep, voffA); PG8_STAGE(PG8_SB(1, 1), cB + hstep + kstep, voffB);
        PG8_WAIT_V(6); PG8_BAR;
    } else {
        PG8_STAGE(PG8_SB(0, 0), cB, voffB); PG8_STAGE(PG8_SA(0, 0), cA, voffA); PG8_STAGE(PG8_SB(0, 1), cB + hstep, voffB); PG8_STAGE(PG8_SA(0, 1), cA + hstep, voffA);
        if (wr == 1) PG8_BAR;
        PG8_WAIT_V(4); PG8_BAR;
        PG8_STAGE(PG8_SB(1, 0), cB + kstep, voffB); PG8_STAGE(PG8_SA(1, 0), cA + kstep, voffA); PG8_STAGE(PG8_SB(1, 1), cB + hstep + kstep, voffB);
        PG8_WAIT_V(6); PG8_BAR;
    }
    for (;;) {
        const bool has_next = S.next(ui + 1, nxt);
        const char* nA = has_next ? (const char*)g.A + (size_t)nxt.pm * tstep + (size_t)nxt.ko * 2 : cA; const char* nB = has_next ? (const char*)g.Bt + (size_t)nxt.pn * tstep + (size_t)nxt.ko * 2 : cB;
        for (int t = 0; t < nt; t += 2) {
            const bool last = (t == nt - 2);
            const char* a1 = cA + (size_t)(t + 1) * kstep;
            const char* a2 = last ? nA : cA + (size_t)(t + 2) * kstep; const char* b2 = last ? nB : cB + (size_t)(t + 2) * kstep;
            const char* a3 = a2 + kstep; const char* b3 = b2 + kstep;
            if (last && has_next) S.a_ready(nxt);
            if constexpr (SP2) {
            PG8_LDB(B0, 0, 0); PG8_LDB(B1, 0, 1); PG8_SCHED; PG8_LDA(At, 0, 0); PG8_STAGE(PG8_SA(1, 1), a1 + hstep, voffA);
            PG8_WAIT_V(8); PG8_WAIT_L(0); PG8_BAR; PG8_MMA(0, 0, At, B0); PG8_MMA(0, 1, At, B1); PG8_BAR; PG8_SCHED;
            PG8_LDA(At, 0, 1); PG8_STAGE(PG8_SB(0, 0), b2, voffB); PG8_STAGE(PG8_SB(0, 1), b2 + hstep, voffB); PG8_STAGE(PG8_SA(0, 0), a2, voffA);
            PG8_WAIT_V(8); PG8_WAIT_L(0); PG8_BAR; PG8_MMA(1, 0, At, B0); PG8_MMA(1, 1, At, B1); PG8_BAR; PG8_SCHED;
            PG8_LDB(B0, 1, 0); PG8_LDB(B1, 1, 1); PG8_SCHED; PG8_LDA(At, 1, 0); PG8_STAGE(PG8_SA(0, 1), a2 + hstep, voffA);
            PG8_WAIT_V(8); PG8_WAIT_L(0); PG8_BAR; PG8_MMA(0, 0, At, B0); PG8_MMA(0, 1, At, B1); PG8_BAR; PG8_SCHED;
            PG8_LDA(At, 1, 1); PG8_STAGE(PG8_SB(1, 0), b3, voffB); PG8_STAGE(PG8_SB(1, 1), b3 + hstep, voffB); PG8_STAGE(PG8_SA(1, 0), a3, voffA);
            PG8_WAIT_V(8); PG8_WAIT_L(0); PG8_BAR; PG8_MMA(1, 0, At, B0); PG8_MMA(1, 1, At, B1); PG8_BAR; PG8_SCHED;
            } else {
            PG8_LDB(B0, 0, 0); PG8_SCHED; PG8_LDA(At, 0, 0); PG8_STAGE(PG8_SA(1, 1), a1 + hstep, voffA);
            PG8_WAIT_L(8); PG8_BAR; PG8_WAIT_L(0); PG8_MMA(0, 0, At, B0); PG8_BAR; PG8_SCHED;
            PG8_LDB(B1, 0, 1); PG8_STAGE(PG8_SB(0, 0), b2, voffB);
            PG8_BAR; PG8_WAIT_L(0); PG8_MMA(0, 1, At, B1); PG8_BAR;
            PG8_LDA(At, 0, 1); PG8_STAGE(PG8_SA(0, 0), a2, voffA);
            PG8_BAR; PG8_WAIT_L(0); PG8_MMA(1, 0, At, B0); PG8_BAR; PG8_SCHED;
            PG8_STAGE(PG8_SB(0, 1), b2 + hstep, voffB);
            PG8_WAIT_V(6); PG8_BAR; PG8_MMA(1, 1, At, B1); PG8_BAR;
            PG8_LDB(B0, 1, 0); PG8_SCHED; PG8_LDA(At, 1, 0); PG8_STAGE(PG8_SA(0, 1), a2 + hstep, voffA);
            PG8_WAIT_L(8); PG8_BAR; PG8_WAIT_L(0); PG8_MMA(0, 0, At, B0); PG8_BAR; PG8_SCHED;
            PG8_LDB(B1, 1, 1); PG8_STAGE(PG8_SB(1, 0), b3, voffB);
            PG8_BAR; PG8_WAIT_L(0); PG8_MMA(0, 1, At, B1); PG8_BAR;
            PG8_LDA(At, 1, 1); PG8_STAGE(PG8_SA(1, 0), a3, voffA);
            PG8_BAR; PG8_WAIT_L(0); PG8_MMA(1, 0, At, B0); PG8_BAR; PG8_SCHED;
            PG8_STAGE(PG8_SB(1, 1), b3 + hstep, voffB);
            PG8_WAIT_V(6); PG8_BAR; PG8_MMA(1, 1, At, B1); PG8_BAR;
            }
        }
        if constexpr (ALIGN_EPI) { if (wr == 0) PG8_BAR; }
        if constexpr (!Epi::AFTER_DRAIN) { E(acc, cur, wr, wc, fr, fq); S.done(cur); }
        if (!has_next) break;
#pragma unroll
        for (int a = 0; a < 2; ++a)
#pragma unroll
            for (int b = 0; b < 2; ++b)
#pragma unroll
                for (int m = 0; m < 4; ++m)
#pragma unroll
                    for (int n = 0; n < 2; ++n) acc[a][b][m][n] = (f32x4){0.f, 0.f, 0.f, 0.f};
        cur = nxt; cA = nA; cB = nB; ++ui;
        if constexpr (ALIGN_EPI) { if (wr == 1) PG8_BAR; }
    }
    PG8_WAIT_V(0);
    if constexpr (!ALIGN_EPI) { if (wr == 0) PG8_BAR; }
    PG8_BAR;
    if constexpr (Epi::AFTER_DRAIN) { E.fused(acc, cur, wr, wc, fr, fq, lds, wid, lane); S.done(cur); }
#undef PG8_SA
#undef PG8_SB
#undef PG8_STAGE
#undef PG8_LDA
#undef PG8_LDB
#undef PG8_MMA
#undef PG8_WAIT_V
#undef PG8_WAIT_L
#undef PG8_BAR
#undef PG8_SCHED
}
}
constexpr int NWAVES = 8;
constexpr int MP = 16384, MS = 512, M = 16896, D = 1024, DFF = 2816, PLE = 256, SEQ = 4096, NB = 4, DB = 128, DSQ = 4;
constexpr int NBIN = 4352, NBIN_REAL = 4112, NCIN = 2816, NCIN_REAL = 2608;
constexpr int CMP_ROWS = 34816;
constexpr float ALPHA = 1.681792830507429f, LN_EPS = 1e-5f, NORM_EPS = 1e-6f;
constexpr size_t O_YP = 0, O_YS = 16777216, O_AV = 17301504, O_GSP = 19398656, O_GCP = 19922944, O_GSS = 19959808, O_GCS = 36737024,
                 O_KVP = 37916672, O_WINP = 54693888, O_KVS = 55742464, O_WINS = 56266752, O_END = 56528896;
constexpr size_t CTL_BYTES = 1u << 20;
constexpr size_t SZ_WUP = (size_t)5632 * 1024 * 2, SZ_WDN = (size_t)1024 * 2816 * 2, SZ_WG = (size_t)1024 * 1024 * 2, SZ_WP = (size_t)1024 * 256 * 2,
                 SZ_WAIN = (size_t)4096 * 1024 * 2, SZ_WAOUT = (size_t)1024 * 2048 * 2, SZ_WBIN = (size_t)NBIN * 1024 * 2, SZ_WCIN = (size_t)NCIN * 1024 * 2, SZ_WC1 = (size_t)256 * 2048 * 2;
constexpr size_t WS_WUP = CTL_BYTES, WS_WDN = WS_WUP + 8 * SZ_WUP, WS_WG = WS_WDN + 8 * SZ_WDN, WS_WP = WS_WG + 4 * SZ_WG, WS_WAIN = WS_WP + 4 * SZ_WP, WS_WAOUT = WS_WAIN + 2 * SZ_WAIN,
                 WS_WBIN = WS_WAOUT + 2 * SZ_WAOUT, WS_WBOUT = WS_WBIN + SZ_WBIN, WS_WCIN = WS_WBOUT + SZ_WG, WS_WCOUT = WS_WCIN + SZ_WCIN, WS_WC1 = WS_WCOUT + SZ_WG;
constexpr size_t WS_WSM = WS_WC1 + 2 * SZ_WC1;
constexpr size_t WS_X = WS_WSM + (size_t)2 * 16 * 128 * 128 * 2;
constexpr size_t WS_XN = WS_X + (size_t)M * 1024 * 4;
constexpr size_t WS_XNB = WS_XN + (size_t)M * 1024 * 2;
constexpr size_t WS_PRE = WS_XNB + (size_t)M * 1024 * 2;
constexpr size_t WS_H = WS_PRE + (size_t)M * 1024 * 4;
constexpr size_t WS_PBF = WS_H + (size_t)M * 2816 * 2;
constexpr size_t WS_PP = WS_PBF + (size_t)4 * M * 256 * 2;
constexpr size_t WS_SLAB = WS_PP + (size_t)4 * M * 1024 * 4;
constexpr size_t WS_MIX = WS_SLAB + (size_t)11 * MS * 1024 * 4;
constexpr size_t WA_U = WS_MIX, WA_V = WA_U + (size_t)M * 2048 * 2, WA_US = WA_V + (size_t)M * 2048 * 4, WA_ST = WA_US + (size_t)M * 2048 * 2, WA_END = WA_ST + (size_t)M * 8;
constexpr size_t GUNITS = 2048;
constexpr size_t WB_PROJ = WS_MIX, WB_W = WB_PROJ + (size_t)M * NBIN * 4, WB_U = WB_W + GUNITS * 64 * 128 * 4, WB_QG = WB_U + GUNITS * 64 * 128 * 4, WB_KD = WB_QG + GUNITS * 64 * 128 * 4,
                 WB_QK = WB_KD + GUNITS * 64 * 128 * 4, WB_EG = WB_QK + GUNITS * 64 * 64 * 4, WB_O = WB_EG + 65536, WB_OG = WB_O + (size_t)M * 1024 * 4, WB_END = WB_OG + (size_t)M * 1024 * 2;
constexpr size_t WC_PROJ = WS_MIX, WC_ACMP = WC_PROJ + (size_t)M * NCIN * 4, WC_HC = WC_ACMP + (size_t)2 * CMP_ROWS * 2048 * 2, WC_KCV = WC_HC + (size_t)2 * CMP_ROWS * 256 * 2,
                 WC_OA = WC_KCV + (size_t)2 * CMP_ROWS * 64 * 4, WC_KSB = WC_OA + (size_t)M * 1024 * 2, WC_VST = WC_KSB + (size_t)16 * SEQ * 64 * 2, WC_KWB = WC_VST + (size_t)16 * SEQ * 64 * 2, WC_VWT = WC_KWB + (size_t)16 * SEQ * 64 * 2,
                 WC_KCB = WC_VWT + (size_t)16 * SEQ * 64 * 2, WC_VCT = WC_KCB + (size_t)16 * 128 * 64 * 2, WC_END = WC_VCT + (size_t)16 * 128 * 64 * 2;
constexpr size_t WS_END = (WB_END > WC_END ? (WB_END > WA_END ? WB_END : WA_END) : (WC_END > WA_END ? WC_END : WA_END));
static_assert(WS_X % 256 == 0 && WS_MIX % 256 == 0 && WB_W % 256 == 0 && WC_ACMP % 256 == 0, "alignment");
constexpr int CW_TMO = 0, CW_BAR = 4096;
constexpr int LDS_BYTES = 147456, MISC_OFF = LDS_BYTES - 512;

#define GAS __attribute__((address_space(1)))
#define LAS __attribute__((address_space(3)))
typedef unsigned short bf16;
typedef float f32x4 __attribute__((ext_vector_type(4)));
typedef float f32x2 __attribute__((ext_vector_type(2)));
typedef unsigned u32x2 __attribute__((ext_vector_type(2)));
typedef unsigned u32x4 __attribute__((ext_vector_type(4)));
#define LDS_WAIT() asm volatile("s_waitcnt lgkmcnt(0)" ::: "memory")
__device__ __forceinline__ unsigned f2bf(float f) { unsigned u = __builtin_bit_cast(unsigned, f); return (u + 0x7fffu + ((u >> 16) & 1u)) >> 16; }
typedef __bf16 hwbf16x2_t __attribute__((ext_vector_type(2)));
__device__ __forceinline__ unsigned pk2(float lo, float hi) { const f32x2 v = {lo, hi}; const hwbf16x2_t b = __builtin_convertvector(v, hwbf16x2_t); return __builtin_bit_cast(unsigned, b); }
__device__ __forceinline__ float bf2f(bf16 b) { return __builtin_bit_cast(float, ((unsigned)b) << 16); }
__device__ __forceinline__ float wave_sum(float v) {
#pragma unroll
    for (int o = 1; o < 64; o <<= 1) v += __shfl_xor(v, o);
    return v;
}
__device__ __forceinline__ float wave_max(float v) {
#pragma unroll
    for (int o = 1; o < 64; o <<= 1) v = fmaxf(v, __shfl_xor(v, o));
    return v;
}
__device__ __forceinline__ float sigmoid_f(float x) { return 1.0f / (1.0f + __expf(-x)); }
__device__ __forceinline__ float siluf(float x) { return x * sigmoid_f(x); }
__device__ __forceinline__ float readlane_f(float v, int k) { return __builtin_bit_cast(float, __builtin_amdgcn_readlane(__builtin_bit_cast(int, v), k)); }
typedef short bf16x8_t __attribute__((ext_vector_type(8)));
#define MFMA16(a, b, cc) __builtin_amdgcn_mfma_f32_16x16x32_bf16((a), (b), (cc), 0, 0, 0)
#define XB_TMO      128
#define XB_XCNT(j)  (256  + 64 * (j))
#define XB_XSUB(j)  (1280 + 64 * (j))
#define XB_XGEN(j)  (2304 + 64 * (j))
#define XB_TOP      3328
#define XB_TOPGEN   3392
#define XCD_BAR_WORDS 3456
#define XB_SPIN_CAP (1u << 18)

__device__ __forceinline__ unsigned xb_ld(unsigned* p)              { return __hip_atomic_load(p, __ATOMIC_RELAXED, __HIP_MEMORY_SCOPE_AGENT); }
__device__ __forceinline__ unsigned xb_add(unsigned* p, unsigned v) { return __hip_atomic_fetch_add(p, v, __ATOMIC_RELAXED, __HIP_MEMORY_SCOPE_AGENT); }
__device__ __forceinline__ unsigned xb_xcc_id() { return (unsigned)__builtin_amdgcn_s_getreg((3 << 11) | 20) & 0xFu; }
#define XB_SPIN(cond, bar) do { unsigned _sp = 0; while (cond) { __builtin_amdgcn_s_sleep(1); \
    if ((++_sp & 255u) == 0u) { if (xb_ld(&(bar)[XB_TMO])) break; if (_sp > XB_SPIN_CAP) { atomicAdd(&(bar)[XB_TMO], 1u); break; } } } } while (0)

struct XcdBarrier {
    unsigned* bar; unsigned x;
    volatile LAS unsigned* st;
};

__device__ __forceinline__ XcdBarrier xcd_barrier_post(unsigned* bar, volatile LAS unsigned* st) {
    XcdBarrier b; b.bar = bar; b.x = xb_xcc_id(); b.st = st;
    if (threadIdx.x == 0) (void)xb_add(&bar[XB_XCNT(b.x)], 1u);
    return b;
}
__device__ __forceinline__ void xcd_barrier_complete(unsigned* bar, unsigned x, unsigned& nloc, unsigned& nx) {
    const unsigned G = gridDim.x * gridDim.y * gridDim.z;
    unsigned sum, cnt, mine, sp = 0u;
    for (;;) {
        sum = 0u; cnt = 0u; mine = 0u;
#pragma unroll
        for (unsigned j = 0; j < 16; ++j) { const unsigned c = xb_ld(&bar[XB_XCNT(j)]); sum += c; cnt += (c > 0u) ? 1u : 0u; mine = (j == x) ? c : mine; }
        if (sum == G) break;
        __builtin_amdgcn_s_sleep(1);
        if ((++sp & 255u) == 0u) { if (xb_ld(&bar[XB_TMO])) break; if (sp > XB_SPIN_CAP) { atomicAdd(&bar[XB_TMO], 1u); break; } }
    }
    nloc = mine > 0u ? mine : 1u; nx = cnt > 0u ? cnt : 1u;
}

__device__ __forceinline__ void xcd_barrier(const XcdBarrier& b) {
    asm volatile("s_waitcnt vmcnt(0)" ::: "memory");
    __syncthreads();
    if (threadIdx.x == 0) {
        unsigned* bar = b.bar;
        __builtin_amdgcn_s_waitcnt(0);
        unsigned nloc = b.st[0], nx = b.st[1];
        if (nloc == 0u) { xcd_barrier_complete(bar, b.x, nloc, nx); b.st[0] = nloc; b.st[1] = nx; }
        const unsigned old = xb_add(&bar[XB_XSUB(b.x)], 1u);
        const unsigned gen = old / nloc;
        if (old + 1u == (gen + 1u) * nloc) {
            __builtin_amdgcn_fence(__ATOMIC_RELEASE, "agent");
            asm volatile("s_waitcnt vmcnt(0)" ::: "memory");
            const unsigned og = xb_add(&bar[XB_TOP], 1u);
            const unsigned tg = og / nx;
            if (og + 1u == (tg + 1u) * nx) xb_add(&bar[XB_TOPGEN], 1u);
            else XB_SPIN(xb_ld(&bar[XB_TOPGEN]) == tg, bar);
            __builtin_amdgcn_fence(__ATOMIC_ACQUIRE, "agent");
            xb_add(&bar[XB_XGEN(b.x)], 1u);
            asm volatile("s_waitcnt vmcnt(0)" ::: "memory");
        } else {
            XB_SPIN(xb_ld(&bar[XB_XGEN(b.x)]) == gen, bar);
            __builtin_amdgcn_fence(__ATOMIC_ACQUIRE, "agent");
            asm volatile("s_waitcnt vmcnt(0)" ::: "memory");
        }
    }
    __syncthreads();
}
enum { I_XP = 0, I_XS, I_GS, I_GCONV, I_CKV, I_CWIN, I_PT, I_PP, I_PS, I_LNG, I_LNB, I_WUP, I_WDN, I_WG, I_WPJ, I_AWIN, I_ALNG, I_ALNB, I_AWS, I_ABS, I_AWOUT,
       I_BWIN, I_BCONV, I_BALOG, I_BDT, I_BNG, I_BWOUT, I_CWIN_W, I_CGB, I_CPE, I_CW1, I_CW2, I_CWOUT, I_T5, N_IN };
struct Ctx {
    LAS unsigned char* lds; unsigned char* ws; float* out; const float* const* in;
    int tid, lane, wave, G, gw, NGW;
};
#define WSF(off) ((float*)(c.ws + (off)))
#define WSB(off) ((bf16*)(c.ws + (off)))

__device__ __forceinline__ void tr_item(const float* W, int K, int N, bf16* WT, int mode, LAS float* scr, int item, int lane) {
    const int nblk = (N + 31) >> 5, kb = item / nblk, nb = item - kb * nblk, k0 = 64 * kb, n0 = 32 * nb;
    const int nn = n0 + (lane & 31); const bool ok = nn < N;
#pragma unroll 8
    for (int i = 0; i < 32; ++i) { const int kk = 2 * i + (lane >> 5); scr[kk * 33 + (lane & 31)] = ok ? W[(size_t)(k0 + kk) * N + nn] : 0.f; }
    LDS_WAIT(); asm volatile("" ::: "memory");
    const int cch = lane & 7;
#pragma unroll
    for (int j = 0; j < 4; ++j) { const int nl = (lane >> 3) + 8 * j, n = n0 + nl; const LAS float* s = scr + (8 * cch) * 33 + nl;
        if (n < N) { u32x4 o; o.x = pk2(s[0 * 33], s[1 * 33]); o.y = pk2(s[2 * 33], s[3 * 33]); o.z = pk2(s[4 * 33], s[5 * 33]); o.w = pk2(s[6 * 33], s[7 * 33]);
            int drow = n; if (mode == 1) { const int half = n >= DFF ? 1 : 0, idx = n - half * DFF; drow = (idx >> 7) * 256 + half * 128 + (idx & 127); }
            *(u32x4*)(WT + (size_t)drow * K + k0 + 8 * cch) = o; } }
    LDS_WAIT(); asm volatile("" ::: "memory");
}
__device__ __forceinline__ void prologue_phase(const Ctx& c) {
    LAS float* scr = (LAS float*)(c.lds + c.wave * 16384);
    constexpr int IT_UP = 16 * 176, IT_DN = 44 * 32, IT_G = 16 * 32, IT_P = 4 * 32, IT_AIN = 16 * 128, IT_AOUT = 32 * 32, IT_BIN = 16 * 129, IT_CIN = 16 * 82, IT_C1 = 32 * 8;
    constexpr int NIT = 8 * IT_UP + 8 * IT_DN + 4 * IT_G + 4 * IT_P + 2 * IT_AIN + 2 * IT_AOUT + IT_BIN + IT_G + IT_CIN + IT_G + 2 * IT_C1;
    for (int it = c.gw; it < NIT; it += c.NGW) {
        int r = it, mi;
        if (r < 8 * IT_UP) { mi = r / IT_UP; tr_item(c.in[I_WUP] + (size_t)mi * 1024 * 5632, 1024, 5632, WSB(WS_WUP + mi * SZ_WUP), 1, scr, r - mi * IT_UP, c.lane); continue; } r -= 8 * IT_UP;
        if (r < 8 * IT_DN) { mi = r / IT_DN; tr_item(c.in[I_WDN] + (size_t)mi * 2816 * 1024, 2816, 1024, WSB(WS_WDN + mi * SZ_WDN), 0, scr, r - mi * IT_DN, c.lane); continue; } r -= 8 * IT_DN;
        if (r < 4 * IT_G) { mi = r / IT_G; tr_item(c.in[I_WG] + (size_t)mi * 1024 * 1024, 1024, 1024, WSB(WS_WG + mi * SZ_WG), 0, scr, r - mi * IT_G, c.lane); continue; } r -= 4 * IT_G;
        if (r < 4 * IT_P) { mi = r / IT_P; tr_item(c.in[I_WPJ] + (size_t)mi * 256 * 1024, 256, 1024, WSB(WS_WP + mi * SZ_WP), 0, scr, r - mi * IT_P, c.lane); continue; } r -= 4 * IT_P;
        if (r < 2 * IT_AIN) { mi = r / IT_AIN; tr_item(c.in[I_AWIN] + (size_t)mi * 1024 * 4096, 1024, 4096, WSB(WS_WAIN + mi * SZ_WAIN), 0, scr, r - mi * IT_AIN, c.lane); continue; } r -= 2 * IT_AIN;
        if (r < 2 * IT_AOUT) { mi = r / IT_AOUT; tr_item(c.in[I_AWOUT] + (size_t)mi * 2048 * 1024, 2048, 1024, WSB(WS_WAOUT + mi * SZ_WAOUT), 0, scr, r - mi * IT_AOUT, c.lane); continue; } r -= 2 * IT_AOUT;
        if (r < IT_BIN) { tr_item(c.in[I_BWIN], 1024, NBIN_REAL, WSB(WS_WBIN), 0, scr, r, c.lane); continue; } r -= IT_BIN;
        if (r < IT_G) { tr_item(c.in[I_BWOUT], 1024, 1024, WSB(WS_WBOUT), 0, scr, r, c.lane); continue; } r -= IT_G;
        if (r < IT_CIN) { tr_item(c.in[I_CWIN_W], 1024, NCIN_REAL, WSB(WS_WCIN), 0, scr, r, c.lane); continue; } r -= IT_CIN;
        if (r < IT_G) { tr_item(c.in[I_CWOUT], 1024, 1024, WSB(WS_WCOUT), 0, scr, r, c.lane); continue; } r -= IT_G;
        mi = r / IT_C1; tr_item(c.in[I_CW1] + (size_t)mi * 2048 * 256, 2048, 256, WSB(WS_WC1 + mi * SZ_WC1), 0, scr, r - mi * IT_C1, c.lane);
    }
    for (int i4 = c.gw * 64 + c.lane; i4 < 2 * 16 * 128 * 128 / 4; i4 += c.NGW * 64) { const int t = (i4 >> 5) & 127, s0 = (i4 & 31) * 4; const f32x4 w = *((const f32x4*)c.in[I_AWS] + i4);
        u32x2 o; o.x = pk2(s0 <= t ? w.x : 0.f, s0 + 1 <= t ? w.y : 0.f); o.y = pk2(s0 + 2 <= t ? w.z : 0.f, s0 + 3 <= t ? w.w : 0.f); *((u32x2*)WSB(WS_WSM) + i4) = o; }
    for (int r = c.gw; r < (NBIN - NBIN_REAL) + (NCIN - NCIN_REAL); r += c.NGW) {
        bf16* row = r < (NBIN - NBIN_REAL) ? WSB(WS_WBIN) + (size_t)(NBIN_REAL + r) * 1024 : WSB(WS_WCIN) + (size_t)(NCIN_REAL + r - (NBIN - NBIN_REAL)) * 1024;
        const u32x4 z = {0u, 0u, 0u, 0u}; *(u32x4*)(row + c.lane * 8) = z; *(u32x4*)(row + 512 + c.lane * 8) = z; }
    for (int row = c.gw; row < M; row += c.NGW) {
        const float* src = row < MP ? c.in[I_XP] + (size_t)row * 1024 : c.in[I_XS] + (size_t)(row - MP) * 1024;
        float* xd = WSF(WS_X) + (size_t)row * 1024; bf16* xn = WSB(WS_XNB) + (size_t)row * 1024;
#pragma unroll
        for (int j = 0; j < 4; ++j) { const f32x4 v = *((const f32x4*)src + c.lane + 64 * j); *((f32x4*)xd + c.lane + 64 * j) = v; u32x2 w; w.x = pk2(v.x, v.y); w.y = pk2(v.z, v.w); *((u32x2*)xn + c.lane + 64 * j) = w; }
    }
    for (int r = c.gw; r < 4 * M; r += c.NGW) {
        const int l = r / M, row = r - l * M;
        const float* src = row < MP ? c.in[I_PP] + ((size_t)l * MP + row) * 256 : c.in[I_PS] + ((size_t)l * MS + (row - MP)) * 256;
        const f32x4 v = *((const f32x4*)src + c.lane); u32x2 w; w.x = pk2(v.x, v.y); w.y = pk2(v.z, v.w); *((u32x2*)(WSB(WS_PBF) + (size_t)r * 256) + c.lane) = w;
    }
}
__device__ __forceinline__ void ln_phase(const Ctx& c, const float* g, const float* b, const int nsplit, const float sc) {
    f32x4 gv[4], bv[4];
#pragma unroll
    for (int j = 0; j < 4; ++j) { gv[j] = *((const f32x4*)g + c.lane + 64 * j); bv[j] = *((const f32x4*)b + c.lane + 64 * j); }
    for (int row = c.gw; row < M; row += c.NGW) {
        const f32x4* p = (const f32x4*)(WSF(WS_PRE) + (size_t)row * 1024) + c.lane;
        f32x4 v[4]; float s = 0.f;
        if (row < MP) {
#pragma unroll
            for (int j = 0; j < 4; ++j) v[j] = p[64 * j];
        } else {
            const f32x4* xq = (const f32x4*)(WSF(WS_X) + (size_t)row * 1024) + c.lane; const f32x4* sl = (const f32x4*)(WSF(WS_SLAB) + (size_t)(row - MP) * 1024) + c.lane;
#pragma unroll
            for (int j = 0; j < 4; ++j) { f32x4 a = {0.f, 0.f, 0.f, 0.f}; for (int k = 0; k < nsplit; ++k) a += sl[(size_t)k * (MS * 256) + 64 * j]; v[j] = xq[64 * j] * ALPHA + a * sc; }
        }
#pragma unroll
        for (int j = 0; j < 4; ++j) s += (v[j].x + v[j].y) + (v[j].z + v[j].w);
        const float mean = wave_sum(s) * (1.f / 1024.f); float s2 = 0.f;
#pragma unroll
        for (int j = 0; j < 4; ++j) { v[j] = v[j] - mean; s2 += (v[j].x * v[j].x + v[j].y * v[j].y) + (v[j].z * v[j].z + v[j].w * v[j].w); }
        const float rstd = 1.f / sqrtf(wave_sum(s2) * (1.f / 1024.f) + LN_EPS);
        float* xd = WSF(WS_X) + (size_t)row * 1024; bf16* xn = WSB(WS_XN) + (size_t)row * 1024;
#pragma unroll
        for (int j = 0; j < 4; ++j) { const f32x4 y = v[j] * rstd * gv[j] + bv[j]; *((f32x4*)xd + c.lane + 64 * j) = y; u32x2 w; w.x = pk2(y.x, y.y); w.y = pk2(y.z, y.w); *((u32x2*)xn + c.lane + 64 * j) = w; }
    }
}
__device__ __forceinline__ void a_stats_phase(const Ctx& c, int ia) {
    const float* lg = c.in[I_ALNG] + ia * 2048; const float* lb = c.in[I_ALNB] + ia * 2048;
    for (int row = c.gw; row < M; row += c.NGW) {
        const f32x4* p = (const f32x4*)(WSF(WA_V) + (size_t)row * 2048) + c.lane;
        f32x4 v[8]; float s = 0.f;
#pragma unroll
        for (int j = 0; j < 8; ++j) { v[j] = p[64 * j]; s += (v[j].x + v[j].y) + (v[j].z + v[j].w); }
        const float mean = wave_sum(s) * (1.f / 2048.f); float s2 = 0.f;
#pragma unroll
        for (int j = 0; j < 8; ++j) { v[j] = v[j] - mean; s2 += (v[j].x * v[j].x + v[j].y * v[j].y) + (v[j].z * v[j].z + v[j].w * v[j].w); }
        const float rstd = 1.f / sqrtf(wave_sum(s2) * (1.f / 2048.f) + LN_EPS);
        if (c.lane == 0) { WSF(WA_ST)[2 * row] = mean; WSF(WA_ST)[2 * row + 1] = rstd; }
        if (row >= MP) { float* o = c.out + O_AV + ((size_t)ia * MS + (row - MP)) * 2048;
#pragma unroll
            for (int j = 0; j < 8; ++j) { const f32x4 gg = *((const f32x4*)lg + c.lane + 64 * j), bb = *((const f32x4*)lb + c.lane + 64 * j); *((f32x4*)o + c.lane + 64 * j) = v[j] * rstd * gg + bb; } }
    }
}
__device__ __forceinline__ void a_sgu_phase(const Ctx& c, int ia) {
    const float* ws = c.in[I_AWS] + (size_t)ia * 16 * 128 * 128; const float* bs = c.in[I_ABS] + ia * 16 * 128; const bf16* wsm = WSB(WS_WSM) + (size_t)ia * 16 * 128 * 128;
    const float* lg = c.in[I_ALNG] + ia * 2048; const float* lb = c.in[I_ALNB] + ia * 2048;
    const float* V = WSF(WA_V); const float* ST = WSF(WA_ST); const bf16* U = WSB(WA_U); bf16* US = WSB(WA_US);
    for (int unit = blockIdx.x; unit < 2048 + DB; unit += c.G) {
        if (unit < 2048) {
            LAS bf16* vt = (LAS bf16*)c.lds; asm volatile("" : "+v"(vt));
            const int g = unit & 15, n = (unit >> 4) & 31, b = unit >> 9, rowbase = b * SEQ + n * 128;
            const int w = c.wave, fr = c.lane & 15, rq = c.lane >> 4, ta = w >> 1, dh = w & 1;
            bf16x8_t wf0[2], wf1[4];
            { const bf16* w0 = wsm + ((size_t)g * 128 + 16 * ta + fr) * 128 + 8 * rq; const bf16* w1 = wsm + ((size_t)g * 128 + 16 * (7 - ta) + fr) * 128 + 8 * rq;
#pragma unroll
              for (int ks = 0; ks < 2; ++ks) wf0[ks] = *(const bf16x8_t*)(w0 + 32 * ks);
#pragma unroll
              for (int ks = 0; ks < 4; ++ks) wf1[ks] = *(const bf16x8_t*)(w1 + 32 * ks); }
            __syncthreads();
            { const int d = c.tid & 127, sp = c.tid >> 7; const float gg = lg[g * 128 + d], bb = lb[g * 128 + d];
#pragma unroll 4
              for (int k = 0; k < 16; ++k) { const int s = 2 * (sp + 4 * k); const size_t r0 = rowbase + s;
                  const float v0 = (V[r0 * 2048 + g * 128 + d] - ST[2 * r0]) * ST[2 * r0 + 1] * gg + bb, v1 = (V[(r0 + 1) * 2048 + g * 128 + d] - ST[2 * r0 + 2]) * ST[2 * r0 + 3] * gg + bb;
                  *(LAS unsigned*)(vt + d * 132 + s) = pk2(v0, v1); } }
            __syncthreads();
            f32x4 acc[2][4];
#pragma unroll
            for (int e = 0; e < 2; ++e)
#pragma unroll
                for (int mb = 0; mb < 4; ++mb) acc[e][mb] = (f32x4){0.f, 0.f, 0.f, 0.f};
#pragma unroll
            for (int ks = 0; ks < 4; ++ks) {
#pragma unroll
                for (int mb = 0; mb < 4; ++mb) { const LAS bf16* xp = vt + (16 * (4 * dh + mb) + fr) * 132 + 32 * ks + 8 * rq; const u32x2 lo = *(const LAS u32x2*)xp, hi = *(const LAS u32x2*)(xp + 4);
                    const bf16x8_t xf = __builtin_bit_cast(bf16x8_t, (u32x4){lo.x, lo.y, hi.x, hi.y});
                    if (ks < 2) { if (2 * ks <= ta) acc[0][mb] = MFMA16(xf, wf0[ks < 2 ? ks : 0], acc[0][mb]); }
                    if (2 * ks <= 7 - ta) acc[1][mb] = MFMA16(xf, wf1[ks], acc[1][mb]); } }
#pragma unroll
            for (int e = 0; e < 2; ++e) { const int t = 16 * (e ? 7 - ta : ta) + fr; const float bias = bs[g * 128 + t]; const size_t o = (size_t)(rowbase + t) * 2048 + g * 128 + 64 * dh + 4 * rq;
#pragma unroll
                for (int mb = 0; mb < 4; ++mb) { const u32x2 uu = *(const u32x2*)(U + o + 16 * mb); const f32x4 sv = acc[e][mb] + bias;
                    u32x2 wv; wv.x = pk2(sv.x * bf2f((bf16)(uu.x & 0xffff)), sv.y * bf2f((bf16)(uu.x >> 16))); wv.y = pk2(sv.z * bf2f((bf16)(uu.y & 0xffff)), sv.w * bf2f((bf16)(uu.y >> 16)));
                    *(u32x2*)(US + o + 16 * mb) = wv; } }
        } else {
            const int sb = unit - 2048, c0 = c.tid * 4, g = c0 >> 7;
            const f32x4 gg = *(const f32x4*)(lg + c0), bb = *(const f32x4*)(lb + c0);
            f32x4 vnr[4];
#pragma unroll
            for (int t = 0; t < 4; ++t) { const int row = MP + 4 * sb + t; const f32x4 v = *(const f32x4*)(V + (size_t)row * 2048 + c0); vnr[t] = (v - ST[2 * row]) * ST[2 * row + 1] * gg + bb; }
#pragma unroll
            for (int t = 0; t < 4; ++t) { const int row = MP + 4 * sb + t; f32x4 sv = {0.f, 0.f, 0.f, 0.f};
#pragma unroll
                for (int s = 0; s <= t; ++s) sv += vnr[s] * ws[((size_t)g * 128 + t) * 128 + s];
                sv += bs[g * 128 + t];
                const u32x2 uu = *(const u32x2*)(U + (size_t)row * 2048 + c0);
                f32x4 y; y.x = sv.x * bf2f((bf16)(uu.x & 0xffff)); y.y = sv.y * bf2f((bf16)(uu.x >> 16)); y.z = sv.z * bf2f((bf16)(uu.y & 0xffff)); y.w = sv.w * bf2f((bf16)(uu.y >> 16));
                u32x2 w; w.x = pk2(y.x, y.y); w.y = pk2(y.z, y.w); *(u32x2*)(US + (size_t)row * 2048 + c0) = w; }
        }
    }
}
__device__ __forceinline__ void gdn_prep_phase(const Ctx& c) {
    const float* PJ = WSF(WB_PROJ); const float* cw = c.in[I_BCONV]; const float* alog = c.in[I_BALOG]; const float* dtb = c.in[I_BDT];
    bf16* GW = WSB(WB_W); float* GUT = WSF(WB_U); bf16* GQG = WSB(WB_QG); bf16* GKDT = WSB(WB_KD); bf16* GQK = WSB(WB_QK); float* GEG = WSF(WB_EG);
    for (int unit = blockIdx.x; unit < 2048 + 1024; unit += c.G) {
        __syncthreads();
        LAS float* lb = (LAS float*)c.lds; asm volatile("" : "+v"(lb));
        LAS float* kf = lb; LAS float* vf = kf + 64 * 129; LAS float* Am = vf + 64 * 129; LAS float* gc = Am + 64 * 64; LAS float* bt = gc + 64;
        LAS bf16* kb = (LAS bf16*)(bt + 64); LAS bf16* qb = kb + 64 * 136;
        if (unit < 2048) {
            const int ci = unit & 63, h = (unit >> 6) & 7, b = unit >> 9, rb = b * SEQ + ci * 64;
            if (c.tid < 64) { const size_t row = rb + c.tid; const float bl = PJ[row * NBIN + 4096 + h], al = PJ[row * NBIN + 4104 + h];
                const float x = al + dtb[h]; const float sp = x > 20.f ? x : log1pf(expf(x)); float g = -expf(alog[h]) * sp;
#pragma unroll
                for (int o = 1; o < 64; o <<= 1) { const float t = __shfl_up(g, o); if (c.lane >= o) g += t; }
                gc[c.tid] = g; bt[c.tid] = sigmoid_f(bl); }
            __syncthreads();
            { const int tk0 = c.wave * 8, tabs0 = ci * 64 + tk0; const size_t row0 = rb + tk0;
              f32x2 xr[3][11], wv[3][4];
#pragma unroll
              for (int part = 0; part < 3; ++part) { const int ch = part * 1024 + h * 128 + 2 * c.lane;
#pragma unroll
                  for (int j = 0; j < 4; ++j) wv[part][j] = *(const f32x2*)(cw + j * 3072 + ch);
#pragma unroll
                  for (int r = 0; r < 11; ++r) xr[part][r] = (tabs0 - 3 + r >= 0) ? *(const f32x2*)(PJ + (row0 + r - 3) * NBIN + ch) : (f32x2){0.f, 0.f}; }
#pragma unroll
              for (int i = 0; i < 8; ++i) { const int tk = tk0 + i;
#pragma unroll
                  for (int part = 0; part < 3; ++part) { float a0 = 0.f, a1 = 0.f;
#pragma unroll
                      for (int j = 0; j < 4; ++j) { a0 += xr[part][i + j].x * wv[part][j].x; a1 += xr[part][i + j].y * wv[part][j].y; }
                      a0 = siluf(a0); a1 = siluf(a1);
                      if (part < 2) { const float ss = wave_sum(a0 * a0 + a1 * a1); const float sc = (1.f / sqrtf(ss + NORM_EPS)) * (part == 0 ? 0.08838834764831845f : 1.f); a0 *= sc; a1 *= sc; }
                      if (part == 0) { *(LAS unsigned*)(qb + tk * 136 + 2 * c.lane) = pk2(a0, a1); const float eg = expf(gc[tk]); *(unsigned*)(GQG + (size_t)unit * 8192 + tk * 128 + 2 * c.lane) = pk2(a0 * eg, a1 * eg); }
                      else if (part == 1) { *(LAS unsigned*)(kb + tk * 136 + 2 * c.lane) = pk2(a0, a1); kf[tk * 129 + 2 * c.lane] = a0; kf[tk * 129 + 2 * c.lane + 1] = a1; }
                      else { vf[tk * 129 + 2 * c.lane] = a0; vf[tk * 129 + 2 * c.lane + 1] = a1; } } } }
            __syncthreads();
            { const int fr = c.lane & 15, rq = c.lane >> 4;
#pragma unroll 1
              for (int bi = c.wave; bi < 16; bi += 8) {
                  const int mbj = bi < 10 ? (bi == 0 ? 0 : bi == 1 ? 0 : bi == 2 ? 1 : bi == 3 ? 0 : bi == 4 ? 1 : bi == 5 ? 2 : bi == 6 ? 0 : bi == 7 ? 1 : bi == 8 ? 2 : 3) : (bi == 10 ? 1 : bi == 11 ? 2 : bi == 12 ? 3 : bi == 13 ? 2 : bi == 14 ? 3 : 3);
                  const int nbi = bi < 10 ? (bi == 0 ? 0 : bi <= 2 ? 1 : bi <= 5 ? 2 : 3) : (bi <= 12 ? 0 : bi <= 14 ? 1 : 2);
                  const int i = 16 * nbi + fr, j0 = 16 * mbj + 4 * rq;
                  f32x4 akk = {0.f, 0.f, 0.f, 0.f}, aqk = {0.f, 0.f, 0.f, 0.f};
                  if (bi < 10) {
#pragma unroll
                      for (int ks = 0; ks < 4; ++ks) { const bf16x8_t xk = *(const LAS bf16x8_t*)(kb + (16 * mbj + fr) * 136 + 32 * ks + 8 * rq), yk = *(const LAS bf16x8_t*)(kb + i * 136 + 32 * ks + 8 * rq), yq = *(const LAS bf16x8_t*)(qb + i * 136 + 32 * ks + 8 * rq);
                          akk = MFMA16(xk, yk, akk); aqk = MFMA16(xk, yq, aqk); } }
                  const float gi = gc[i], bi_ = bt[i]; f32x4 av, qv;
#pragma unroll
                  for (int r = 0; r < 4; ++r) { const int j = j0 + r; const float dec = (i >= j) ? expf(gi - gc[j]) : 0.f; av[r] = (i > j) ? bi_ * akk[r] * dec : 0.f; qv[r] = (i >= j) ? aqk[r] * dec : 0.f; }
                  *(LAS f32x4*)(Am + i * 64 + j0) = av; u32x2 wv; wv.x = pk2(qv[0], qv[1]); wv.y = pk2(qv[2], qv[3]); *(u32x2*)(GQK + ((size_t)unit * 64 + i) * 64 + j0) = wv; } }
            __syncthreads();
            if (c.tid < 256) { const bool isw = c.tid >= 128; const int cc = c.tid & 127; float x[64];
#pragma unroll
                for (int i = 0; i < 64; ++i) x[i] = 0.f;
#pragma unroll
                for (int i = 0; i < 64; ++i) { float r = isw ? kf[i * 129 + cc] * bt[i] * expf(gc[i]) : vf[i * 129 + cc] * bt[i];
#pragma unroll
                    for (int j4 = 0; j4 < (i + 3) / 4; ++j4) { const f32x4 a4 = *(const LAS f32x4*)(Am + i * 64 + 4 * j4); r -= (a4.x * x[4 * j4] + a4.y * x[4 * j4 + 1]) + (a4.z * x[4 * j4 + 2] + a4.w * x[4 * j4 + 3]); }
                    x[i] = r; if (isw) GW[((size_t)unit * 64 + i) * 128 + cc] = (bf16)f2bf(r); }
                if (!isw) { float* dst = GUT + ((size_t)unit * 128 + cc) * 64;
#pragma unroll
                    for (int k = 0; k < 16; ++k) *(f32x4*)(dst + 4 * k) = (f32x4){x[4 * k], x[4 * k + 1], x[4 * k + 2], x[4 * k + 3]}; } }
            for (int idx = c.tid; idx < 1024; idx += 512) { const int dk = idx & 127, ch = idx >> 7; const float gl = gc[63]; unsigned e[4];
#pragma unroll
                for (int k = 0; k < 4; ++k) { const int c0 = 8 * ch + 2 * k; e[k] = pk2(kf[c0 * 129 + dk] * expf(gl - gc[c0]), kf[(c0 + 1) * 129 + dk] * expf(gl - gc[c0 + 1])); }
                *(u32x4*)(GKDT + (size_t)unit * 8192 + dk * 64 + 8 * ch) = (u32x4){e[0], e[1], e[2], e[3]}; }
            if (c.tid == 0) GEG[unit] = expf(gc[63]);
        } else {
            const int su = unit - 2048, h = su & 7, b = su >> 3;
            LAS float* q4 = lb; LAS float* k4 = q4 + 512; LAS float* v4 = k4 + 512; LAS float* red = v4 + 512; LAS float* o4 = red + 512; LAS float* g4 = o4 + 512; LAS float* b4 = g4 + 4;
            const float* cst = c.in[I_GCONV] + (size_t)b * 3 * 3072;
            { const int t = c.tid >> 7, chl = c.tid & 127;
#pragma unroll
              for (int part = 0; part < 3; ++part) { const int ch = part * 1024 + h * 128 + chl; float a = 0.f;
#pragma unroll
                  for (int j = 0; j < 4; ++j) { const int mm = t + j; const float x = mm < 3 ? cst[mm * 3072 + ch] : PJ[(size_t)(MP + 4 * b + mm - 3) * NBIN + ch]; a += x * cw[j * 3072 + ch]; }
                  (part == 0 ? q4 : (part == 1 ? k4 : v4))[t * 128 + chl] = siluf(a); }
              if (c.tid < 4) { const size_t row = MP + 4 * b + c.tid; const float bl = PJ[row * NBIN + 4096 + h], al = PJ[row * NBIN + 4104 + h];
                  const float x = al + dtb[h]; const float sp = x > 20.f ? x : log1pf(expf(x)); g4[c.tid] = -expf(alog[h]) * sp; b4[c.tid] = sigmoid_f(bl); } }
            __syncthreads();
            { const int t = c.tid >> 7, chl = c.tid & 127; float sq = 0.f, sk = 0.f;
              for (int d = 0; d < 128; ++d) { const float a = q4[t * 128 + d], bb = k4[t * 128 + d]; sq += a * a; sk += bb * bb; }
              const float qv = q4[t * 128 + chl] * (1.f / sqrtf(sq + NORM_EPS)) * 0.08838834764831845f, kv = k4[t * 128 + chl] * (1.f / sqrtf(sk + NORM_EPS));
              __syncthreads();
              q4[t * 128 + chl] = qv; k4[t * 128 + chl] = kv; }
            __syncthreads();
            const int dv = c.tid & 127, part = c.tid >> 7;
            float S[32];
            const float* S0 = c.in[I_GS] + (((size_t)b * 8 + h) * 128 + part * 32) * 128 + dv;
#pragma unroll
            for (int i = 0; i < 32; ++i) S[i] = S0[(size_t)i * 128];
#pragma unroll 1
            for (int t = 0; t < 4; ++t) { const float a = expf(g4[t]); float p = 0.f;
#pragma unroll
                for (int i = 0; i < 32; ++i) p += k4[t * 128 + part * 32 + i] * S[i];
                red[part * 128 + dv] = p; __syncthreads();
                const float kS = (red[dv] + red[128 + dv]) + (red[256 + dv] + red[384 + dv]); const float vnew = b4[t] * (v4[t * 128 + dv] - a * kS); float po = 0.f;
#pragma unroll
                for (int i = 0; i < 32; ++i) { S[i] = a * S[i] + k4[t * 128 + part * 32 + i] * vnew; po += q4[t * 128 + part * 32 + i] * S[i]; }
                __syncthreads(); red[part * 128 + dv] = po; __syncthreads();
                if (part == 0) o4[t * 128 + dv] = (red[dv] + red[128 + dv]) + (red[256 + dv] + red[384 + dv]);
                __syncthreads(); }
            float* So = c.out + O_GSS + (((size_t)b * 8 + h) * 128 + part * 32) * 128 + dv;
#pragma unroll
            for (int i = 0; i < 32; ++i) So[(size_t)i * 128] = S[i];
            { const int t = c.tid >> 7; float ms = 0.f;
              for (int d = 0; d < 128; ++d) { const float o = o4[t * 128 + d]; ms += o * o; }
              const size_t row = MP + 4 * b + t; const float z = PJ[row * NBIN + 3072 + h * 128 + dv];
              const float y = o4[t * 128 + dv] * (1.f / sqrtf(ms * (1.f / 128.f) + NORM_EPS)) * c.in[I_BNG][dv] * siluf(z);
              WSB(WB_OG)[row * 1024 + h * 128 + dv] = (bf16)f2bf(y); }
        }
    }
    for (size_t idx = (size_t)blockIdx.x * 512 + c.tid; idx < 36864 + 1179648; idx += (size_t)c.G * 512) {
        if (idx < 36864) { const int b = (int)(idx / 9216), r = (int)(idx % 9216), j = r / 3072, ch = r % 3072; c.out[O_GCP + idx] = PJ[((size_t)b * SEQ + SEQ - 3 + j) * NBIN + ch]; }
        else { const size_t k = idx - 36864; const int b = (int)(k / 9216), r = (int)(k % 9216), j = r / 3072, ch = r % 3072; c.out[O_GCS + k] = PJ[((size_t)MP + 4 * b + 1 + j) * NBIN + ch]; }
    }
}
struct ScanFr { bf16x8_t a4[4], b2[2], kd[2]; f32x4 u; float eg; };
__device__ __forceinline__ void scan_load(ScanFr& f, const bf16* GW, const bf16* GQG, const bf16* GKDT, const bf16* GQK, const float* GUT, const float* GEG, size_t pu, int w, int fr, int rq, int dvs) {
    const int mb = w & 3; const bf16* a = (w < 4 ? GW : GQG) + pu * 8192 + (16 * mb + fr) * 128 + 8 * rq;
#pragma unroll
    for (int ks = 0; ks < 4; ++ks) f.a4[ks] = *(const bf16x8_t*)(a + 32 * ks);
    const bf16* q = GQK + pu * 4096 + (16 * mb + fr) * 64 + 8 * rq; f.b2[0] = *(const bf16x8_t*)q; f.b2[1] = *(const bf16x8_t*)(q + 32);
    const bf16* k = GKDT + pu * 8192 + (16 * w + fr) * 64 + 8 * rq; f.kd[0] = *(const bf16x8_t*)k; f.kd[1] = *(const bf16x8_t*)(k + 32);
    f.u = *(const f32x4*)(GUT + (pu * 128 + dvs * 16 + fr) * 64 + 16 * mb + 4 * rq); f.eg = GEG[pu];
}
__device__ __forceinline__ void gdn_scan_phase(const Ctx& c) {
    const bf16* GW = WSB(WB_W); const float* GUT = WSF(WB_U); const bf16* GQG = WSB(WB_QG); const bf16* GKDT = WSB(WB_KD); const bf16* GQK = WSB(WB_QK); const float* GEG = WSF(WB_EG);
    float* GO = WSF(WB_O);
    for (int uu = blockIdx.x; uu < 256; uu += c.G) {
        LAS unsigned char* L = c.lds; asm volatile("" : "+v"(L));
        LAS bf16* ST = (LAS bf16*)L; LAS bf16* VNT = ST + 16 * 136;
        const int bh = (uu & 7) * 4 + (uu >> 6), dvs = (uu >> 3) & 7, b = bh >> 3, h = bh & 7;
        const int w = c.wave, fr = c.lane & 15, rq = c.lane >> 4, mb = w & 3;
        __syncthreads();
        for (int i = c.tid; i < 16 * 136 / 2; i += 512) ((LAS unsigned*)ST)[i] = 0u;
        f32x4 Sacc = {0.f, 0.f, 0.f, 0.f};
        ScanFr cur, nxt; scan_load(cur, GW, GQG, GKDT, GQK, GUT, GEG, (size_t)bh * 64, w, fr, rq, dvs);
        for (int ci = 0; ci < 64; ++ci) {
            const size_t pu = (size_t)bh * 64 + ci;
            if (ci < 63) scan_load(nxt, GW, GQG, GKDT, GQK, GUT, GEG, pu + 1, w, fr, rq, dvs);
            __syncthreads();
            f32x4 acc = {0.f, 0.f, 0.f, 0.f};
#pragma unroll
            for (int ks = 0; ks < 4; ++ks) { const bf16x8_t y = *(const LAS bf16x8_t*)(ST + fr * 136 + 32 * ks + 8 * rq); acc = MFMA16(cur.a4[ks], y, acc); }
            if (w < 4) { const f32x4 vn = cur.u - acc; u32x2 wv; wv.x = pk2(vn[0], vn[1]); wv.y = pk2(vn[2], vn[3]); *(LAS u32x2*)(VNT + fr * 72 + 16 * mb + 4 * rq) = wv; }
            __syncthreads();
            const bf16x8_t y0 = *(const LAS bf16x8_t*)(VNT + fr * 72 + 8 * rq), y1 = *(const LAS bf16x8_t*)(VNT + fr * 72 + 32 + 8 * rq);
            if (w >= 4) { acc = MFMA16(cur.b2[0], y0, acc); acc = MFMA16(cur.b2[1], y1, acc);
                float* o = GO + ((size_t)b * SEQ + ci * 64 + 16 * mb + 4 * rq) * 1024 + h * 128 + dvs * 16 + fr;
#pragma unroll
                for (int i = 0; i < 4; ++i) o[(size_t)i * 1024] = acc[i]; }
            Sacc *= cur.eg; Sacc = MFMA16(cur.kd[0], y0, Sacc); Sacc = MFMA16(cur.kd[1], y1, Sacc);
            { u32x2 wv; wv.x = pk2(Sacc[0], Sacc[1]); wv.y = pk2(Sacc[2], Sacc[3]); *(LAS u32x2*)(ST + fr * 136 + 16 * w + 4 * rq) = wv; }
            cur = nxt;
        }
#pragma unroll
        for (int i = 0; i < 4; ++i) c.out[O_GSP + (((size_t)b * 8 + h) * 128 + 16 * w + 4 * rq + i) * 128 + dvs * 16 + fr] = Sacc[i];
    }
}
__device__ __forceinline__ void gdn_post_phase(const Ctx& c) {
    const float* GO = WSF(WB_O); const float* PJ = WSF(WB_PROJ); const float* ng = c.in[I_BNG];
    for (int row = c.gw; row < MP; row += c.NGW) {
        const f32x4* p = (const f32x4*)(GO + (size_t)row * 1024 + c.lane * 16); f32x4 v[4]; float s = 0.f;
#pragma unroll
        for (int j = 0; j < 4; ++j) { v[j] = p[j]; s += (v[j].x * v[j].x + v[j].y * v[j].y) + (v[j].z * v[j].z + v[j].w * v[j].w); }
        s += __shfl_xor(s, 1); s += __shfl_xor(s, 2); s += __shfl_xor(s, 4);
        const float r = 1.f / sqrtf(s * (1.f / 128.f) + NORM_EPS);
        const f32x4* zp = (const f32x4*)(PJ + (size_t)row * NBIN + 3072 + c.lane * 16); const f32x4* gp = (const f32x4*)(ng + (c.lane & 7) * 16);
        u32x2* op = (u32x2*)(WSB(WB_OG) + (size_t)row * 1024 + c.lane * 16);
#pragma unroll
        for (int j = 0; j < 4; ++j) { const f32x4 z = zp[j], g = gp[j]; f32x4 y; y.x = v[j].x * r * g.x * siluf(z.x); y.y = v[j].y * r * g.y * siluf(z.y); y.z = v[j].z * r * g.z * siluf(z.z); y.w = v[j].w * r * g.w * siluf(z.w);
            u32x2 w; w.x = pk2(y.x, y.y); w.y = pk2(y.z, y.w); op[j] = w; }
    }
}
__device__ const unsigned char T5_LUT[128] = {0, 1, 2, 3, 4, 5, 6, 7, 8, 9, 10, 11, 12, 13, 14, 15, 16, 16, 16, 17, 17, 18, 18, 18, 19, 19, 19, 20, 20, 20, 20, 21, 21, 21, 21, 22, 22, 22, 22, 22, 23, 23, 23, 23, 23, 23, 24, 24, 24, 24, 24, 24, 25, 25, 25, 25, 25, 25, 25, 26, 26, 26, 26, 26, 26, 26, 26, 27, 27, 27, 27, 27, 27, 27, 27, 27, 27, 28, 28, 28, 28, 28, 28, 28, 28, 28, 28, 29, 29, 29, 29, 29, 29, 29, 29, 29, 29, 29, 29, 30, 30, 30, 30, 30, 30, 30, 30, 30, 30, 30, 30, 30, 30, 31, 31, 31, 31, 31, 31, 31, 31, 31, 31, 31, 31, 31, 31, 31};
__device__ __forceinline__ void nsa_prep_phase(const Ctx& c) {
    const float* PJ = WSF(WC_PROJ);
    for (size_t i4 = (size_t)blockIdx.x * 512 + c.tid; i4 < (size_t)M * 256; i4 += (size_t)c.G * 512) { const size_t row = i4 >> 8; const int c4 = (int)(i4 & 255);
        const f32x4 v = *(const f32x4*)(PJ + row * NCIN + 1024 + c4 * 4);
        if (row < MP) *(f32x4*)(c.out + O_KVP + row * 1024 + c4 * 4) = v; else *(f32x4*)(c.out + O_KVS + (row - MP) * 1024 + c4 * 4) = v; }
    for (size_t i4 = (size_t)blockIdx.x * 512 + c.tid; i4 < (size_t)(2048 + MS) * 128; i4 += (size_t)c.G * 512) { const size_t r = i4 >> 7; const int c4 = (int)(i4 & 127);
        const size_t row = r < 2048 ? (r >> 9) * SEQ + (SEQ - 512) + (r & 511) : MP + (r - 2048);
        const f32x4 v = *(const f32x4*)(PJ + row * NCIN + 2048 + c4 * 4);
        if (r < 2048) *(f32x4*)(c.out + O_WINP + r * 512 + c4 * 4) = v; else *(f32x4*)(c.out + O_WINS + (r - 2048) * 512 + c4 * 4) = v; }
    { LAS bf16* vt = (LAS bf16*)c.lds;
      bf16* KSB = WSB(WC_KSB); bf16* VST = WSB(WC_VST); bf16* KWB = WSB(WC_KWB); bf16* VWT = WSB(WC_VWT);
      for (int u = blockIdx.x; u < 256; u += c.G) { const int b = u >> 6, tb = u & 63; const size_t row0 = (size_t)b * SEQ + 64 * tb;
          __syncthreads();
          for (int idx = c.tid; idx < 64 * 256; idx += 512) { const int t = idx >> 8, q = idx & 255, sect = q >> 6, c4 = q & 63;
              const f32x4 v = *(const f32x4*)(PJ + (row0 + t) * NCIN + 1536 + sect * 256 + c4 * 4); u32x2 w; w.x = pk2(v.x, v.y); w.y = pk2(v.z, v.w);
              const int g = c4 >> 4, d = (c4 & 15) * 4;
              if (sect == 0) *(u32x2*)(KSB + (((size_t)(b * 4 + g) * SEQ + 64 * tb + t) * 64 + d)) = w;
              else if (sect == 2) *(u32x2*)(KWB + (((size_t)(b * 4 + g) * SEQ + 64 * tb + t) * 64 + d)) = w;
              else *(LAS u32x2*)(vt + t * 520 + (sect == 1 ? 0 : 256) + c4 * 4) = w; }
          __syncthreads();
          for (int idx = c.tid; idx < 512 * 8; idx += 512) { const int col = idx >> 3, ch = idx & 7; unsigned short e[8];
#pragma unroll
              for (int k = 0; k < 8; ++k) e[k] = vt[(8 * ch + k) * 520 + col];
              u32x4 w; w.x = e[0] | ((unsigned)e[1] << 16); w.y = e[2] | ((unsigned)e[3] << 16); w.z = e[4] | ((unsigned)e[5] << 16); w.w = e[6] | ((unsigned)e[7] << 16);
              const int cc = col & 255, g = cc >> 6, d = cc & 63; bf16* dst = (col < 256 ? VST : VWT) + ((size_t)(b * 4 + g) * 64 + d) * SEQ + 64 * tb + 8 * ch;
              *(u32x4*)dst = w; } }
      __syncthreads(); }
    bf16* AC = WSB(WC_ACMP); const float* pe = c.in[I_CPE]; const int* pt = (const int*)c.in[I_PT]; const float* ckv = c.in[I_CKV];
    for (int R = c.gw; R < 2 * CMP_ROWS; R += c.NGW) {
        const int which = R >= CMP_ROWS ? 1 : 0, r = R - which * CMP_ROWS;
        const float* src; size_t lstride;
        if (r < 2048) { const int g = r & 3, n = (r >> 2) & 127, b = r >> 9; src = PJ + ((size_t)b * SEQ + 32 * n) * NCIN + 1024 + which * 256 + g * 64; lstride = NCIN; }
        else { const int q = r - 2048, g = q & 3, n = (q >> 2) & 63, b = q >> 8; const int page = pt[b * 16 + (n >> 2)];
            src = ckv + (((size_t)page * 128 + (n & 3) * 32) * 16 + which * 4 + g) * 64; lstride = 1024; }
#pragma unroll
        for (int k = 0; k < 8; ++k) { const int idx = c.lane + 64 * k, l = idx >> 4, d4 = idx & 15;
            const f32x4 v = *(const f32x4*)(src + (size_t)l * lstride + d4 * 4) + *(const f32x4*)(pe + (which * 32 + l) * 64 + d4 * 4);
            u32x2 w; w.x = pk2(v.x, v.y); w.y = pk2(v.z, v.w); *(u32x2*)(AC + (size_t)R * 2048 + l * 64 + d4 * 4) = w; }
    }
}
__device__ __forceinline__ void nsa_cmp2_phase(const Ctx& c) {
    LAS float* w2 = (LAS float*)c.lds;
    __syncthreads();
    for (int i = c.tid; i < 2 * 256 * 64 / 4; i += 512) *(LAS f32x4*)(w2 + 4 * i) = *((const f32x4*)c.in[I_CW2] + i);
    __syncthreads();
    const bf16* HC = WSB(WC_HC); float* KCV = WSF(WC_KCV);
    for (int R = c.gw; R < 2 * CMP_ROWS; R += c.NGW) {
        const LAS float* w = w2 + (R >= CMP_ROWS ? 256 * 64 : 0) + c.lane; const u32x4* hp = (const u32x4*)(HC + (size_t)R * 256); float a = 0.f;
#pragma unroll 4
        for (int k8 = 0; k8 < 32; ++k8) { const u32x4 hv = hp[k8]; const unsigned hw[4] = {hv.x, hv.y, hv.z, hv.w};
#pragma unroll
            for (int j = 0; j < 4; ++j) { a += bf2f((bf16)(hw[j] & 0xffff)) * w[(8 * k8 + 2 * j) * 64]; a += bf2f((bf16)(hw[j] >> 16)) * w[(8 * k8 + 2 * j + 1) * 64]; } }
        KCV[(size_t)R * 64 + c.lane] = a;
        { const int which = R >= CMP_ROWS ? 1 : 0, r = R - which * CMP_ROWS;
          if (r < 2048) { const int g = r & 3, n = (r >> 2) & 127, b = r >> 9; if (which == 0) WSB(WC_KCB)[((size_t)(b * 4 + g) * 128 + n) * 64 + c.lane] = (bf16)f2bf(a); else WSB(WC_VCT)[((size_t)(b * 4 + g) * 64 + c.lane) * 128 + n] = (bf16)f2bf(a); } }
    }
}
struct AttSt { float m[4], l[4]; f32x4 o[4]; };
__device__ __forceinline__ void att_reset(AttSt& s) {
#pragma unroll
    for (int h = 0; h < 4; ++h) { s.m[h] = -1e30f; s.l[h] = 0.f; s.o[h] = (f32x4){0.f, 0.f, 0.f, 0.f}; } }
__device__ __forceinline__ void att_scores(const LAS float* qs, const LAS float* tabl, const float* kptr, bool valid, int dist, int g, float (&s)[4]) {
    const f32x4* kp = (const f32x4*)kptr;
    s[0] = s[1] = s[2] = s[3] = 0.f;
#pragma unroll 1
    for (int c4 = 0; c4 < 4; ++c4) {
        f32x4 kv[4];
#pragma unroll
        for (int u = 0; u < 4; ++u) kv[u] = kp[c4 * 4 + u];
#pragma unroll
        for (int u = 0; u < 4; ++u)
#pragma unroll
            for (int h = 0; h < 4; ++h) { const f32x4 q = *(const LAS f32x4*)(qs + h * 64 + (c4 * 4 + u) * 4); s[h] += (q.x * kv[u].x + q.y * kv[u].y) + (q.z * kv[u].z + q.w * kv[u].w); } }
    const int dd = dist < 0 ? 0 : dist; const int bk = dd < 128 ? (int)T5_LUT[dd] : 31;
    const f32x4 bias = *(const LAS f32x4*)(tabl + bk * 16 + g * 4);
#pragma unroll
    for (int h = 0; h < 4; ++h) s[h] = valid ? s[h] + bias[h] : -1e30f;
}
__device__ __forceinline__ void att_pv(AttSt& st, LAS f32x4* P, LAS unsigned long long* R, const float (&p)[4], const float* rowp, int voff, int lane) {
    P[lane] = (f32x4){p[0], p[1], p[2], p[3]}; R[lane] = (unsigned long long)rowp;
    LDS_WAIT();
#pragma unroll 8
    for (int i = 0; i < 16; ++i) { const int key = 4 * i + (lane >> 4); const f32x4 p4 = P[key]; const float* rp = (const float*)R[key];
        const f32x4 v = *(const f32x4*)(rp + voff + (lane & 15) * 4);
        st.o[0] += v * p4.x; st.o[1] += v * p4.y; st.o[2] += v * p4.z; st.o[3] += v * p4.w; }
    LDS_WAIT();
}
__device__ __forceinline__ void att_block(AttSt& st, const LAS float* qs, const LAS float* tabl, LAS f32x4* P, LAS unsigned long long* R, const float* kptr, const float* safe, bool valid, int dist, int voff, int g, int lane) {
    const float* rowp = valid ? kptr : safe; float s[4], p[4];
    att_scores(qs, tabl, rowp, valid, dist, g, s);
#pragma unroll
    for (int h = 0; h < 4; ++h) { const float mx = wave_max(s[h]), mn = fmaxf(st.m[h], mx), sc = __expf(st.m[h] - mn); p[h] = valid ? __expf(s[h] - mn) : 0.f;
        st.l[h] = st.l[h] * sc + wave_sum(p[h]); st.o[h] *= sc; st.m[h] = mn; }
    att_pv(st, P, R, p, rowp, voff, lane);
}
__device__ __forceinline__ void att_finish(AttSt& st, const float (&gate)[4], f32x4 (&acc)[4]) {
#pragma unroll
    for (int h = 0; h < 4; ++h) { f32x4 o = st.o[h];
#pragma unroll
        for (int k = 0; k < 4; ++k) { o[k] += __shfl_xor(o[k], 16); o[k] += __shfl_xor(o[k], 32); }
        const float inv = st.l[h] > 0.f ? gate[h] / st.l[h] : 0.f; acc[h] += o * inv; }
}
__device__ __forceinline__ void nsa_attn_phase(const Ctx& c, const int item0) {
    LAS float* tabl = (LAS float*)c.lds;
    LAS float* qs = tabl + 512 + c.wave * 768;
    LAS f32x4* P = (LAS f32x4*)(qs + 256); LAS unsigned long long* R = (LAS unsigned long long*)(qs + 512); LAS float* pcs = qs + 640;
    __syncthreads();
    for (int i = c.tid; i < 512; i += 512) tabl[i] = c.in[I_T5][i];
    __syncthreads();
    const float* PJ = WSF(WC_PROJ); const float* KCV = WSF(WC_KCV); const float* gb = c.in[I_CGB]; const int* pt = (const int*)c.in[I_PT]; const float* ckv = c.in[I_CKV]; const float* cwin = c.in[I_CWIN];
    bf16* OA = WSB(WC_OA);
    for (int item = item0 + c.gw; item < 65536 + 2048; item += c.NGW) {
        int lane = c.lane; asm volatile("" : "+v"(lane));
        const bool smp = item >= 65536; int b, g, t, qpos, ncmp, nslc; size_t row;
        if (!smp) { g = item & 3; b = (item >> 2) & 3; t = item >> 4; qpos = t; row = (size_t)b * SEQ + t; ncmp = 128; nslc = 64; }
        else { const int q = item - 65536; g = q & 3; t = (q >> 2) & 3; b = q >> 4; qpos = 2048 + t; row = (size_t)MP + 4 * b + t; ncmp = 64; nslc = 33; }
        const float* qrow = PJ + row * NCIN;
        { const f32x4 qv = *(const f32x4*)(qrow + g * 256 + lane * 4); *(LAS f32x4*)(qs + lane * 4) = qv * 0.125f; }
        float gv = 0.f; if (lane < 12) { const int gi = (lane >> 2) * 16 + g * 4 + (lane & 3); gv = sigmoid_f(qrow[2560 + gi] + gb[gi]); }
        float gate_c[4], gate_s[4], gate_w[4];
#pragma unroll
        for (int h = 0; h < 4; ++h) { gate_c[h] = readlane_f(gv, h); gate_s[h] = readlane_f(gv, 4 + h); gate_w[h] = readlane_f(gv, 8 + h); }
        LDS_WAIT();
        f32x4 acc[4];
#pragma unroll
        for (int h = 0; h < 4; ++h) acc[h] = (f32x4){0.f, 0.f, 0.f, 0.f};
        AttSt st;
        float ps;
        { const size_t kc0 = smp ? (size_t)2048 + ((size_t)b * 64) * 4 + g : ((size_t)b * 128) * 4 + g;
          const float* safe = KCV; float s0[4], s1[4];
          const int n0 = lane, n1 = lane + 64; const int d0 = qpos - (32 * n0 + 31), d1 = qpos - (32 * n1 + 31);
          const bool v0 = n0 < ncmp && d0 >= 0, v1 = n1 < ncmp && d1 >= 0;
          const float* k0p = v0 ? KCV + (kc0 + 4 * (size_t)n0) * 64 : safe; const float* k1p = v1 ? KCV + (kc0 + 4 * (size_t)n1) * 64 : safe;
          att_scores(qs, tabl, k0p, v0, d0, g, s0); att_scores(qs, tabl, k1p, v1, d1, g, s1);
          att_reset(st); float p0[4], p1[4], pc0 = 0.f, pc1 = 0.f;
#pragma unroll
          for (int h = 0; h < 4; ++h) { const float mx = wave_max(fmaxf(s0[h], s1[h])); p0[h] = v0 ? __expf(s0[h] - mx) : 0.f; p1[h] = v1 ? __expf(s1[h] - mx) : 0.f;
              const float l = wave_sum(p0[h] + p1[h]); const float inv = l > 0.f ? 1.f / l : 0.f; p0[h] *= inv; p1[h] *= inv; pc0 += p0[h]; pc1 += p1[h]; st.l[h] = l > 0.f ? 1.f : 0.f; }
          att_pv(st, P, R, p0, k0p, CMP_ROWS * 64, lane); att_pv(st, P, R, p1, k1p, CMP_ROWS * 64, lane);
          att_finish(st, gate_c, acc);
          pcs[lane] = pc0; pcs[64 + lane] = pc1; LDS_WAIT();
          ps = (2 * lane + 1 < ncmp) ? pcs[2 * lane] + pcs[2 * lane + 1] : 0.f; LDS_WAIT(); }
        const int jq = qpos >> 6; unsigned long long sel;
        { const bool forced = (lane == 0) || (lane == jq) || (lane == jq - 1);
          float sc = forced ? 100.f : (lane > jq ? -1.f : ps); if (lane >= nslc) sc = -__builtin_inff();
          int cnt = 0;
#pragma unroll 4
          for (int k = 0; k < 64; ++k) { const float sk = readlane_f(sc, k); cnt += (sk > sc || (sk == sc && k < lane)) ? 1 : 0; }
          sel = __ballot(cnt < 16); }
        att_reset(st);
        { const float* safe = qrow + 1536;
          unsigned long long todo = sel & (jq >= 63 ? ~0ull : ((1ull << (jq + 1)) - 1ull));
          while (todo) { const int j = __builtin_ctzll(todo); todo &= todo - 1ull;
              const int kpos = 64 * j + lane; const bool valid = kpos <= qpos; const float* kptr;
              if (!smp) kptr = PJ + ((size_t)b * SEQ + kpos) * NCIN + 1536 + g * 64;
              else if (j < 32) { const int page = pt[b * 16 + (j >> 1)]; kptr = ckv + (((size_t)page * 128 + (j & 1) * 64 + lane) * 16 + 8 + g) * 64; }
              else kptr = PJ + ((size_t)MP + 4 * b + (lane & 3)) * NCIN + 1536 + g * 64;
              att_block(st, qs, tabl, P, R, kptr, safe, valid, qpos - kpos, 256, g, lane); } }
        att_finish(st, gate_s, acc);
        att_reset(st);
        { const float* safe = qrow + 2048;
          for (int cb = 0; cb < 8; ++cb) { const int kpos = qpos - 511 + 64 * cb + lane; if (qpos - 511 + 64 * cb + 63 < 0) continue;
              const bool valid = kpos >= 0; const float* kptr;
              if (!smp) kptr = PJ + ((size_t)b * SEQ + (valid ? kpos : 0)) * NCIN + 2048 + g * 64;
              else if (kpos < 2048) kptr = cwin + (((size_t)b * 512 + (kpos - 1536)) * 2) * 256 + g * 64;
              else kptr = PJ + ((size_t)MP + 4 * b + (kpos - 2048)) * NCIN + 2048 + g * 64;
              att_block(st, qs, tabl, P, R, kptr, safe, valid, qpos - kpos, 256, g, lane); } }
        att_finish(st, gate_w, acc);
        if (lane < 16) {
#pragma unroll
            for (int h = 0; h < 4; ++h) { u32x2 w; w.x = pk2(acc[h].x, acc[h].y); w.y = pk2(acc[h].z, acc[h].w); *(u32x2*)(OA + row * 1024 + (g * 4 + h) * 64 + lane * 4) = w; } }
    }
}
constexpr int AT_ROWB = 144;
constexpr int AT_KB = 0, AT_VB = 2 * 64 * AT_ROWB, AT_PS = 4 * 64 * AT_ROWB, AT_SEL = AT_PS + 4 * 64 * 64 * 4, AT_BIAS = AT_SEL + 512, AT_END = AT_BIAS + 16 * 128 * 4;
static_assert(AT_END <= MISC_OFF, "attention LDS map");
struct AtRegs { u32x4 k, v; };
__device__ __forceinline__ AtRegs at_load(const bf16* kbase, const bf16* vbase, int vpitch, int tid) {
    AtRegs r; r.k = *(const u32x4*)(kbase + tid * 8); r.v = *(const u32x4*)(vbase + (size_t)(tid >> 3) * vpitch + (tid & 7) * 8); return r; }
__device__ __forceinline__ void at_store(LAS unsigned char* L, int buf, const AtRegs& r, int tid) {
    *(LAS u32x4*)(L + AT_KB + buf * 64 * AT_ROWB + (tid >> 3) * AT_ROWB + (tid & 7) * 16) = r.k; *(LAS u32x4*)(L + AT_VB + buf * 64 * AT_ROWB + (tid >> 3) * AT_ROWB + (tid & 7) * 16) = r.v; }
__device__ __forceinline__ void at_qk(LAS unsigned char* L, int buf, const bf16x8_t (&qf)[2][2], f32x4 (&st)[4][2], int fr, int rq) {
#pragma unroll
    for (int mb = 0; mb < 4; ++mb) { st[mb][0] = (f32x4){0.f, 0.f, 0.f, 0.f}; st[mb][1] = (f32x4){0.f, 0.f, 0.f, 0.f}; }
#pragma unroll
    for (int s = 0; s < 2; ++s)
#pragma unroll
        for (int mb = 0; mb < 4; ++mb) { const bf16x8_t kf = *(const LAS bf16x8_t*)(L + AT_KB + buf * 64 * AT_ROWB + (16 * mb + fr) * AT_ROWB + (32 * s + 8 * rq) * 2);
            st[mb][0] = MFMA16(kf, qf[0][s], st[mb][0]); st[mb][1] = MFMA16(kf, qf[1][s], st[mb][1]); }
}
__device__ __forceinline__ void at_pv(LAS unsigned char* L, int buf, const f32x4 (&st)[4][2], f32x4 (&ot)[4][2], int fr, int rq) {
#pragma unroll
    for (int s = 0; s < 2; ++s) { bf16x8_t pf[2];
#pragma unroll
        for (int nb = 0; nb < 2; ++nb) { u32x4 w; w.x = pk2(st[2 * s][nb].x, st[2 * s][nb].y); w.y = pk2(st[2 * s][nb].z, st[2 * s][nb].w); w.z = pk2(st[2 * s + 1][nb].x, st[2 * s + 1][nb].y); w.w = pk2(st[2 * s + 1][nb].z, st[2 * s + 1][nb].w);
            pf[nb] = __builtin_bit_cast(bf16x8_t, w); }
#pragma unroll
        for (int mb = 0; mb < 4; ++mb) { const LAS unsigned char* vp = L + AT_VB + buf * 64 * AT_ROWB + (16 * mb + fr) * AT_ROWB + (32 * s + 4 * rq) * 2;
            u32x4 w; const u32x2 lo = *(const LAS u32x2*)vp, hi = *(const LAS u32x2*)(vp + 32); w.x = lo.x; w.y = lo.y; w.z = hi.x; w.w = hi.y; const bf16x8_t vf = __builtin_bit_cast(bf16x8_t, w);
            ot[mb][0] = MFMA16(vf, pf[0], ot[mb][0]); ot[mb][1] = MFMA16(vf, pf[1], ot[mb][1]); } }
}
template <int MODE> __device__ __forceinline__ void at_softmax(f32x4 (&st)[4][2], f32x4 (&ot)[4][2], float (&m)[2], float (&l)[2], const bool (&rowok)[2], float cb, const LAS float* bias_h, int dist0  , int wlim) {
#pragma unroll
    for (int nb = 0; nb < 2; ++nb) { float mx = -1e30f;
#pragma unroll
        for (int mb = 0; mb < 4; ++mb)
#pragma unroll
            for (int i = 0; i < 4; ++i) { float s;
                if (MODE == 0) s = rowok[nb] ? st[mb][nb][i] + cb : -1e30f;
                else { const int dist = dist0 + 16 * nb - 16 * mb - i; const bool ok = rowok[nb] && dist >= 0 && dist < wlim; const int dd = dist < 0 ? 0 : (dist > 127 ? 127 : dist); const float bv = bias_h[dd]; s = ok ? st[mb][nb][i] + bv : -1e30f; }
                st[mb][nb][i] = s; mx = fmaxf(mx, s); }
        mx = fmaxf(mx, __shfl_xor(mx, 16)); mx = fmaxf(mx, __shfl_xor(mx, 32));
        const float mn = fmaxf(m[nb], mx), sc = __expf(m[nb] - mn); float ls = 0.f;
#pragma unroll
        for (int mb = 0; mb < 4; ++mb)
#pragma unroll
            for (int i = 0; i < 4; ++i) { const float s = st[mb][nb][i]; const float pe = __expf(s - mn); const float p = s > -1e29f ? pe : 0.f; st[mb][nb][i] = p; ls += p; }
        l[nb] = l[nb] * sc + ls; m[nb] = mn;
#pragma unroll
        for (int mb = 0; mb < 4; ++mb) ot[mb][nb] *= sc; }
}
template <bool ADD> __device__ __forceinline__ void at_finish(f32x4 (&ot)[4][2], float (&l)[2], const float (&gate)[2], LAS f32x4* park, int lane) {
#pragma unroll
    for (int nb = 0; nb < 2; ++nb) { float Ls = l[nb]; Ls += __shfl_xor(Ls, 16); Ls += __shfl_xor(Ls, 32); const float inv = Ls > 0.f ? gate[nb] / Ls : 0.f;
#pragma unroll
        for (int mb = 0; mb < 4; ++mb) { f32x4 v = ot[mb][nb] * inv; if (ADD) v += park[(mb * 2 + nb) * 64 + lane]; ot[mb][nb] = v; } }
}
__device__ __forceinline__ void at_park(const f32x4 (&ot)[4][2], LAS f32x4* park, int lane) {
#pragma unroll
    for (int nb = 0; nb < 2; ++nb)
#pragma unroll
        for (int mb = 0; mb < 4; ++mb) park[(mb * 2 + nb) * 64 + lane] = ot[mb][nb];
}
__device__ __forceinline__ void nsa_attn_prompt_phase(const Ctx& c) {
    const float* PJ = WSF(WC_PROJ); const float* gb = c.in[I_CGB]; bf16* OA = WSB(WC_OA);
    const bf16* KSB = WSB(WC_KSB); const bf16* VST = WSB(WC_VST); const bf16* KWB = WSB(WC_KWB); const bf16* VWT = WSB(WC_VWT); const bf16* KCB = WSB(WC_KCB); const bf16* VCT = WSB(WC_VCT);
    __syncthreads();
    { LAS float* bt = (LAS float*)(c.lds + AT_BIAS);
      for (int i = c.tid; i < 16 * 128; i += 512) { const int h = i >> 7, d = i & 127; bt[i] = c.in[I_T5][(int)T5_LUT[d] * 16 + h]; } }
    __syncthreads();
    for (int u = blockIdx.x; u < 1024; u += c.G) {
        LAS unsigned char* L = c.lds; asm volatile("" : "+v"(L));
        int tid = c.tid; asm volatile("" : "+v"(tid));
        const int lane = tid & 63, fr = lane & 15, rq = lane >> 4, w = c.wave, hg = w >> 1, tq0 = (w & 1) * 32;
        const int bg = (u & 255) >> 4, r16 = u & 15, k4 = u >> 8, qb = k4 == 0 ? r16 : (k4 == 1 ? 31 - r16 : (k4 == 2 ? 32 + r16 : 63 - r16)), b = bg >> 2, g = bg & 3, h = g * 4 + hg;
        const LAS float* bias_h = (const LAS float*)(L + AT_BIAS) + h * 128; const float cb = bias_h[127];
        LAS float* PS = (LAS float*)(L + AT_PS); LAS unsigned long long* SEL = (LAS unsigned long long*)(L + AT_SEL);
        bf16x8_t qf[2][2]; float gate_c[2], gate_s[2], gate_w[2]; size_t row[2];
#pragma unroll
        for (int nb = 0; nb < 2; ++nb) { row[nb] = (size_t)b * SEQ + 64 * qb + tq0 + 16 * nb + fr; const float* qr = PJ + row[nb] * NCIN;
#pragma unroll
            for (int s = 0; s < 2; ++s) { const f32x4 a = *(const f32x4*)(qr + h * 64 + 32 * s + 8 * rq) * 0.125f, bq = *(const f32x4*)(qr + h * 64 + 32 * s + 8 * rq + 4) * 0.125f;
                u32x4 wv; wv.x = pk2(a.x, a.y); wv.y = pk2(a.z, a.w); wv.z = pk2(bq.x, bq.y); wv.w = pk2(bq.z, bq.w); qf[nb][s] = __builtin_bit_cast(bf16x8_t, wv); }
            gate_c[nb] = sigmoid_f(qr[2560 + h] + gb[h]); gate_s[nb] = sigmoid_f(qr[2576 + h] + gb[16 + h]); gate_w[nb] = sigmoid_f(qr[2592 + h] + gb[32 + h]); }
        f32x4 ot[4][2], st[4][2]; float m[2], l[2]; bool rowok[2] = {true, true};
        LAS f32x4* park = (LAS f32x4*)(L + AT_PS) + w * 512;
#pragma unroll
        for (int mb = 0; mb < 4; ++mb) { ot[mb][0] = (f32x4){0.f, 0.f, 0.f, 0.f}; ot[mb][1] = (f32x4){0.f, 0.f, 0.f, 0.f}; }
        const int tl0 = 64 * qb + tq0 + fr;
        { __syncthreads();
          const AtRegs r0 = at_load(KCB + (size_t)bg * 128 * 64, VCT + (size_t)bg * 64 * 128, 128, tid), r1 = at_load(KCB + ((size_t)bg * 128 + 64) * 64, VCT + (size_t)bg * 64 * 128 + 64, 128, tid);
          at_store(L, 0, r0, tid); at_store(L, 1, r1, tid);
          __syncthreads();
          float cm[2] = {-1e30f, -1e30f}, cl[2] = {0.f, 0.f};
#pragma unroll
          for (int cc = 0; cc < 2; ++cc) { at_qk(L, cc, qf, st, fr, rq);
#pragma unroll
              for (int nb = 0; nb < 2; ++nb) { float mx = -1e30f; const int t = tl0 + 16 * nb;
#pragma unroll
                  for (int mb = 0; mb < 4; ++mb)
#pragma unroll
                      for (int i = 0; i < 4; ++i) { const int n = 64 * cc + 16 * mb + 4 * rq + i, dist = t - (32 * n + 31);
                          const float bv = bias_h[dist < 0 ? 0 : (dist > 127 ? 127 : dist)]; const float sv = dist >= 0 ? st[mb][nb][i] + bv : -1e30f; st[mb][nb][i] = sv; mx = fmaxf(mx, sv); }
                  mx = fmaxf(mx, __shfl_xor(mx, 16)); mx = fmaxf(mx, __shfl_xor(mx, 32));
                  const float mn = fmaxf(cm[nb], mx); float ls = 0.f;
#pragma unroll
                  for (int mb = 0; mb < 4; ++mb)
#pragma unroll
                      for (int i = 0; i < 4; ++i) { const float pe = __expf(st[mb][nb][i] - mn); ls += st[mb][nb][i] > -1e29f ? pe : 0.f; }
                  cl[nb] = cl[nb] * __expf(cm[nb] - mn) + ls; cm[nb] = mn; } }
          float cinv[2];
#pragma unroll
          for (int nb = 0; nb < 2; ++nb) { float ls = cl[nb]; ls += __shfl_xor(ls, 16); ls += __shfl_xor(ls, 32); cinv[nb] = ls > 0.f ? 1.f / ls : 0.f; l[nb] = ls > 0.f ? 0.25f : 0.f; }
#pragma unroll
          for (int cc = 0; cc < 2; ++cc) { at_qk(L, cc, qf, st, fr, rq);
#pragma unroll
              for (int nb = 0; nb < 2; ++nb) { const int t = tl0 + 16 * nb; LAS float* psr = PS + ((hg * 64 + tq0 + 16 * nb + fr) * 64 + 2 * rq) + 32 * cc;
#pragma unroll
                  for (int mb = 0; mb < 4; ++mb) {
#pragma unroll
                      for (int i = 0; i < 4; ++i) { const int n = 64 * cc + 16 * mb + 4 * rq + i, dist = t - (32 * n + 31);
                          const float bv = bias_h[dist < 0 ? 0 : (dist > 127 ? 127 : dist)]; const float pe = __expf(fminf(st[mb][nb][i] + bv - cm[nb], 0.f)) * cinv[nb]; st[mb][nb][i] = dist >= 0 ? pe : 0.f; }
                      *(LAS f32x2*)(psr + 8 * mb) = (f32x2){st[mb][nb][0] + st[mb][nb][1], st[mb][nb][2] + st[mb][nb][3]}; } }
              at_pv(L, cc, st, ot, fr, rq); }
          at_finish<false>(ot, l, gate_c, park, lane);
        }
        __syncthreads();
        { for (int i8 = 0; i8 < 8; ++i8) { const int tq = 8 * w + i8; unsigned long long sel;
              if (qb <= 15) sel = (2ull << qb) - 1ull;
              else { const float ps = (PS[(0 * 64 + tq) * 64 + lane] + PS[(1 * 64 + tq) * 64 + lane]) + (PS[(2 * 64 + tq) * 64 + lane] + PS[(3 * 64 + tq) * 64 + lane]);
                  const bool forced = (lane == 0) || (lane == qb) || (lane == qb - 1); const float sc = forced ? 100.f : (lane > qb ? -1.f : ps); int cnt = 0;
#pragma unroll 4
                  for (int k = 0; k < 64; ++k) { const float sk = readlane_f(sc, k); cnt += (sk > sc || (sk == sc && k < lane)) ? 1 : 0; }
                  sel = __ballot(cnt < 16) & ((2ull << qb) - 1ull); }
              if (lane == 0) SEL[tq] = sel; } }
        __syncthreads();
        unsigned long long selm[2], uni;
        { selm[0] = SEL[tq0 + fr]; selm[1] = SEL[tq0 + 16 + fr]; unsigned long long a = SEL[lane];
#pragma unroll
          for (int o = 1; o < 64; o <<= 1) a |= __shfl_xor(a, o);
          uni = a; }
        at_park(ot, park, lane);
#pragma unroll
        for (int mb = 0; mb < 4; ++mb) { ot[mb][0] = (f32x4){0.f, 0.f, 0.f, 0.f}; ot[mb][1] = (f32x4){0.f, 0.f, 0.f, 0.f}; }
        m[0] = m[1] = -1e30f; l[0] = l[1] = 0.f;
        { unsigned long long todo = __builtin_amdgcn_readfirstlane((unsigned)uni) | ((unsigned long long)__builtin_amdgcn_readfirstlane((unsigned)(uni >> 32)) << 32);
          int j = __builtin_ctzll(todo), buf = 0;
          AtRegs rg = at_load(KSB + ((size_t)bg * SEQ + 64 * j) * 64, VST + (size_t)bg * 64 * SEQ + 64 * j, SEQ, tid);
          for (;;) { at_store(L, buf, rg, tid); todo &= todo - 1ull; const bool more = todo != 0ull; const int jn = more ? __builtin_ctzll(todo) : 0;
              __syncthreads();
              if (more) rg = at_load(KSB + ((size_t)bg * SEQ + 64 * jn) * 64, VST + (size_t)bg * 64 * SEQ + 64 * jn, SEQ, tid);
              at_qk(L, buf, qf, st, fr, rq);
              rowok[0] = (selm[0] >> j) & 1ull; rowok[1] = (selm[1] >> j) & 1ull;
              if (j + 3 <= qb) at_softmax<0>(st, ot, m, l, rowok, cb, bias_h, 0, 0); else at_softmax<1>(st, ot, m, l, rowok, cb, bias_h, tl0 - (64 * j + 4 * rq), 1 << 30);
              at_pv(L, buf, st, ot, fr, rq);
              if (!more) break; j = jn; buf ^= 1; }
          at_finish<true>(ot, l, gate_s, park, lane); at_park(ot, park, lane); }
        __syncthreads();
#pragma unroll
        for (int mb = 0; mb < 4; ++mb) { ot[mb][0] = (f32x4){0.f, 0.f, 0.f, 0.f}; ot[mb][1] = (f32x4){0.f, 0.f, 0.f, 0.f}; }
        m[0] = m[1] = -1e30f; l[0] = l[1] = 0.f; rowok[0] = rowok[1] = true;
        { int j = qb >= 8 ? qb - 8 : 0, buf = 0;
          AtRegs rg = at_load(KWB + ((size_t)bg * SEQ + 64 * j) * 64, VWT + (size_t)bg * 64 * SEQ + 64 * j, SEQ, tid);
          for (;;) { at_store(L, buf, rg, tid); const bool more = j < qb; const int jn = j + 1;
              __syncthreads();
              if (more) rg = at_load(KWB + ((size_t)bg * SEQ + 64 * jn) * 64, VWT + (size_t)bg * 64 * SEQ + 64 * jn, SEQ, tid);
              at_qk(L, buf, qf, st, fr, rq);
              if (j + 3 <= qb && j + 8 > qb) at_softmax<0>(st, ot, m, l, rowok, cb, bias_h, 0, 0); else at_softmax<1>(st, ot, m, l, rowok, cb, bias_h, tl0 - (64 * j + 4 * rq), 512);
              at_pv(L, buf, st, ot, fr, rq);
              if (!more) break; j = jn; buf ^= 1; }
          at_finish<true>(ot, l, gate_w, park, lane); }
#pragma unroll
        for (int nb = 0; nb < 2; ++nb)
#pragma unroll
            for (int mb = 0; mb < 4; ++mb) { u32x2 wv; wv.x = pk2(ot[mb][nb].x, ot[mb][nb].y); wv.y = pk2(ot[mb][nb].z, ot[mb][nb].w); *(u32x2*)(OA + row[nb] * 1024 + h * 64 + 16 * mb + 4 * rq) = wv; }
    }
}
constexpr int PH_PER_SUB = 9, N_PHASES = 2 + 12 * PH_PER_SUB;
struct Args { const float* in[N_IN]; float* out; unsigned char* ws; int ph_lo, ph_hi, bli, pad; };
__host__ __device__ inline bool phase_exists(int ph) {
    if (ph < 2) return true; const int r = ph - 2, sub3 = r / PH_PER_SUB, slot = r % PH_PER_SUB, L = sub3 / 3, s = sub3 % 3, kind = (L == 1) ? 1 : (L == 2 ? 2 : 0);
    if (slot == 0 || slot == 5 || slot == 6) return true;
    if (slot == 7) return s == 2;
    if (slot == 8) return false;
    if (s != 1) return false;
    if (kind == 0) return slot <= 2; if (kind == 1) return slot <= 3; return true;
}

#ifndef PROBE
#define PROBE 0
#endif
#define TW(cls, ...) do { __VA_ARGS__; if (PROBE == (cls)) { __VA_ARGS__; } } while (0)
#define IN(k) (lo <= (k) && (k) < hi)
#define SEAM(k) do { if (IN(k) && (k) + 1 < hi) xcd_barrier(bar); } while (0)
template <int L, int S> __device__ __forceinline__ void run_sub(const Ctx& c, const XcdBarrier& bar, const int lo, const int hi) {
    constexpr int kind = (L == 1) ? 1 : (L == 2 ? 2 : 0), ia = (L == 3) ? 1 : 0, base = 2 + (3 * L + S) * PH_PER_SUB;
    LAS unsigned char* ring = c.lds;
    if (IN(base)) {
        if constexpr (S != 1) { constexpr int j = S >> 1; pg8::Gemm g{S == 0 ? WSB(WS_XNB) : WSB(WS_XN), WSB(WS_WUP + (size_t)(2 * L + j) * SZ_WUP), M, 5632, 1024}; pg8::StaticOrder So; So.init(M, 5632, c.G, (int)blockIdx.x);
            pg8::EpiGate E{WSB(WS_H), DFF}; TW(1, pg8::gemm_phase<pg8::EpiGate, pg8::StaticOrder, true, true>(ring, g, So, E)); }
        else if constexpr (kind == 0) { pg8::Gemm g{WSB(WS_XN), WSB(WS_WAIN + (size_t)ia * SZ_WAIN), M, 4096, 1024}; pg8::StaticOrder So; So.init(M, 4096, c.G, (int)blockIdx.x);
            pg8::EpiAin E{WSB(WA_U), WSF(WA_V)}; TW(1, pg8::gemm_phase<pg8::EpiAin, pg8::StaticOrder, true, true>(ring, g, So, E)); }
        else { constexpr int N = kind == 1 ? NBIN : NCIN; pg8::Gemm g{WSB(WS_XN), kind == 1 ? WSB(WS_WBIN) : WSB(WS_WCIN), M, N, 1024}; pg8::StaticOrder So; So.init(M, N, c.G, (int)blockIdx.x);
            pg8::EpiF32 E{WSF(WS_MIX), N}; TW(1, pg8::gemm_phase<pg8::EpiF32, pg8::StaticOrder, true, true>(ring, g, So, E)); }
    } SEAM(base);
    if constexpr (S == 1) {
        if (IN(base + 1)) { if constexpr (kind == 0) TW(4, a_stats_phase(c, ia)); else if constexpr (kind == 1) TW(6, gdn_prep_phase(c)); else TW(9, nsa_prep_phase(c)); } SEAM(base + 1);
        if (IN(base + 2)) { if constexpr (kind == 0) TW(5, a_sgu_phase(c, ia)); else if constexpr (kind == 1) TW(7, gdn_scan_phase(c));
            else {
                { pg8::Gemm g{WSB(WC_ACMP), WSB(WS_WC1), CMP_ROWS, 256, 2048}; pg8::StaticOrder So; So.init(CMP_ROWS, 256, c.G, (int)blockIdx.x);
                  pg8::EpiCmp E{WSB(WC_HC)}; TW(1, pg8::gemm_phase<pg8::EpiCmp, pg8::StaticOrder, true, true>(ring, g, So, E)); }
                { pg8::Gemm g{WSB(WC_ACMP) + (size_t)CMP_ROWS * 2048, WSB(WS_WC1 + SZ_WC1), CMP_ROWS, 256, 2048}; pg8::StaticOrder So; So.init(CMP_ROWS, 256, c.G, (int)((blockIdx.x + 128u) % (unsigned)c.G));
                  pg8::EpiCmp E{WSB(WC_HC) + (size_t)CMP_ROWS * 256}; TW(1, pg8::gemm_phase<pg8::EpiCmp, pg8::StaticOrder, true, true>(ring, g, So, E)); } } } SEAM(base + 2);
        if constexpr (kind != 0) { if (IN(base + 3)) { if constexpr (kind == 1) TW(8, gdn_post_phase(c)); else TW(10, nsa_cmp2_phase(c)); } SEAM(base + 3); }
        if constexpr (kind == 2) { if (IN(base + 4)) TW(11, nsa_attn_prompt_phase(c)); TW(12, nsa_attn_phase(c, 65536)); SEAM(base + 4); }
    }
    constexpr int KOUT = (S != 1) ? DFF : (kind == 0 ? 2048 : 1024); constexpr float SCL = (S != 1) ? 0.5f : 1.f;
    if (IN(base + 5)) {
        const bf16* A; const bf16* Bt;
        if constexpr (S != 1) { A = WSB(WS_H); Bt = WSB(WS_WDN + (size_t)(2 * L + (S >> 1)) * SZ_WDN); }
        else if constexpr (kind == 0) { A = WSB(WA_US); Bt = WSB(WS_WAOUT + (size_t)ia * SZ_WAOUT); }
        else if constexpr (kind == 1) { A = WSB(WB_OG); Bt = WSB(WS_WBOUT); }
        else { A = WSB(WC_OA); Bt = WSB(WS_WCOUT); }
        { pg8::Gemm g{A, Bt, MP, 1024, KOUT, KOUT}; pg8::StaticOrder So; So.init(MP, 1024, c.G, (int)blockIdx.x);
          pg8::EpiResid E{WSF(WS_X), WSF(WS_PRE), ALPHA, SCL}; TW(1, pg8::gemm_phase<pg8::EpiResid, pg8::StaticOrder, true, true>(ring, g, So, E)); }
        { pg8::Gemm g{A + (size_t)MP * KOUT, Bt, MS, 1024, 256, KOUT}; pg8::SplitOrder So{2, 4, KOUT / 256, 256, c.G, (int)blockIdx.x};
          pg8::EpiSlab E{WSF(WS_SLAB), 256, (size_t)MS * 1024}; TW(1, pg8::gemm_phase<pg8::EpiSlab, pg8::SplitOrder, true, true>(ring, g, So, E)); }
    } SEAM(base + 5);
    if (IN(base + 6)) { TW(3, ln_phase(c, c.in[I_LNG] + (size_t)(3 * L + S) * 1024, c.in[I_LNB] + (size_t)(3 * L + S) * 1024, KOUT / 256, SCL)); } SEAM(base + 6);
    if constexpr (S == 2) { if (IN(base + 7)) { pg8::Gemm g{WSB(WS_XN), WSB(WS_WG + (size_t)L * SZ_WG), M, 1024, 1024}; pg8::StaticOrder So; So.init(M, 1024, c.G, (int)blockIdx.x);
            pg8::EpiPle E{WSF(WS_X), WSF(WS_PP) + (size_t)L * M * 1024, WSB(WS_XNB), L == 3 ? c.out : nullptr}; pg8::gemm_phase<pg8::EpiPle, pg8::StaticOrder, true, true>(ring, g, So, E); } SEAM(base + 7); }
}
template <int l> __device__ __forceinline__ void ple_proj(const Ctx& c) {
    pg8::Gemm g{WSB(WS_PBF) + (size_t)l * M * 256, WSB(WS_WP + l * SZ_WP), M, 1024, 256}; pg8::StaticOrder So; So.init(M, 1024, c.G, (int)blockIdx.x);
    pg8::EpiF32 E{WSF(WS_PP) + (size_t)l * M * 1024, 1024}; TW(1, pg8::gemm_phase<pg8::EpiF32, pg8::StaticOrder, true, true>(c.lds, g, So, E));
}
__global__ void __launch_bounds__(NWAVES * 64, 2) fwd(Args args) {
    extern __shared__ __attribute__((aligned(16))) unsigned char lds_raw[];
    Ctx c; c.lds = (LAS unsigned char*)lds_raw; c.ws = args.ws; c.out = args.out; c.in = args.in;
    c.tid = threadIdx.x; c.lane = c.tid & 63; c.wave = __builtin_amdgcn_readfirstlane(c.tid >> 6); c.G = gridDim.x; c.gw = blockIdx.x * NWAVES + c.wave; c.NGW = c.G * NWAVES;
    volatile LAS unsigned* MISC = (volatile LAS unsigned*)(c.lds + MISC_OFF);
    for (int u = c.tid; u < 128; u += NWAVES * 64) MISC[u] = 0u;
    __syncthreads();
    unsigned* ctl = (unsigned*)c.ws;
    XcdBarrier bar = xcd_barrier_post(ctl + CW_BAR + args.bli * XCD_BAR_WORDS, MISC + 8);
    const int lo = args.ph_lo, hi = args.ph_hi;
    if (IN(0)) { TW(13, prologue_phase(c)); } SEAM(0);
    if (IN(1)) { ple_proj<0>(c); ple_proj<1>(c); ple_proj<2>(c); ple_proj<3>(c); } SEAM(1);
    run_sub<0, 0>(c, bar, lo, hi); run_sub<0, 1>(c, bar, lo, hi); run_sub<0, 2>(c, bar, lo, hi);
    run_sub<1, 0>(c, bar, lo, hi); run_sub<1, 1>(c, bar, lo, hi); run_sub<1, 2>(c, bar, lo, hi);
    run_sub<2, 0>(c, bar, lo, hi); run_sub<2, 1>(c, bar, lo, hi); run_sub<2, 2>(c, bar, lo, hi);
    run_sub<3, 0>(c, bar, lo, hi); run_sub<3, 1>(c, bar, lo, hi); run_sub<3, 2>(c, bar, lo, hi);
}
#undef IN
#undef SEAM

#ifndef ONE_LAUNCH
#define ONE_LAUNCH 1
#endif
extern "C" void kernel_launch(void* const* d_in, const int* in_sizes, int n_in, void* d_out, int out_size, void* d_ws, size_t ws_size, hipStream_t stream) {
    static int grid = 0;
    if (grid == 0) {
        if (n_in != N_IN || (size_t)out_size != O_END || ws_size < WS_END) { fprintf(stderr, "kernel_launch: unexpected problem: n_in %d out %d ws %zu (need %zu)\n", n_in, out_size, ws_size, (size_t)WS_END); grid = -1; return; }
        int dev = 0, cus = 0, per_cu = 0;
        if (hipGetDevice(&dev) != hipSuccess || hipDeviceGetAttribute(&cus, hipDeviceAttributeMultiprocessorCount, dev) != hipSuccess) { grid = -1; return; }
        if (hipFuncSetAttribute((const void*)fwd, hipFuncAttributeMaxDynamicSharedMemorySize, LDS_BYTES) != hipSuccess) { fprintf(stderr, "kernel_launch: hipFuncSetAttribute failed\n"); grid = -1; return; }
        if (hipOccupancyMaxActiveBlocksPerMultiprocessor(&per_cu, (const void*)fwd, NWAVES * 64, LDS_BYTES) != hipSuccess || per_cu < 1) fprintf(stderr, "kernel_launch: occupancy query says %d\n", per_cu);
        (void)hipGetLastError();
        grid = cus;
    }
    if (grid < 0) return;
    (void)hipMemsetAsync(d_ws, 0, CTL_BYTES, stream);
    Args a{};
    for (int i = 0; i < N_IN; ++i) a.in[i] = (const float*)d_in[i];
    a.out = (float*)d_out; a.ws = (unsigned char*)d_ws; a.pad = 0;
#if ONE_LAUNCH
    a.ph_lo = 0; a.ph_hi = N_PHASES; a.bli = 0;
    hipLaunchKernelGGL(fwd, dim3(grid), dim3(NWAVES * 64), LDS_BYTES, stream, a);
#else
    for (int ph = 0; ph < N_PHASES; ++ph) { if (!phase_exists(ph)) continue; a.ph_lo = ph; a.ph_hi = ph + 1; a.bli = 0;
        hipLaunchKernelGGL(fwd, dim3(grid), dim3(NWAVES * 64), LDS_BYTES, stream, a); }
#endif
}
```

```cpp
#include <hip/hip_runtime.h>
#include <cstdio>
#include <cstdint>
namespace pg8 {
#define PG8_LAS __attribute__((address_space(3)))
typedef unsigned short bf16_t;
typedef short bf16x8 __attribute__((ext_vector_type(8)));
typedef float f32x4 __attribute__((ext_vector_type(4)));
typedef unsigned u32x4 __attribute__((ext_vector_type(4)));
constexpr int BM = 256, BK = 64, HALF = 128, HTB = HALF * BK * 2  , STAGE_BYTES = 8 * HTB, NXCD = 8, WGM = 8;

__host__ __device__ __forceinline__ int lds_byte(int r, int c) { const int st = (r >> 4) * 2 + (c >> 5), rr = r & 15, cc = c & 31, ob = rr * 64 + cc * 2; return st * 1024 + (ob ^ (((ob >> 9) & 1) << 5)); }
__host__ __device__ __forceinline__ void stage_rc(int b, int& R, int& C) { const int st = b / 1024, sb = b % 1024, swz = sb ^ (((sb >> 9) & 1) << 5); R = (st >> 1) * 16 + swz / 64; C = (st & 1) * 32 + (swz % 64) / 2; }
__host__ __device__ __forceinline__ int perm32(int rho) { const int n = rho >> 4, i = rho & 15; return 8 * (i >> 2) + 4 * n + (i & 3); }

struct Unit { int pm, pn, ko; };
struct Gemm { const bf16_t* A; const bf16_t* Bt; int M, N, K, ld; };

struct StaticOrder {
    int nM, nN, nwg, G, c;
    __host__ __device__ void init(int M, int N, int G_, int c_) { nM = M / BM; nN = N / BM; nwg = nM * nN; G = G_; c = c_; }
    __host__ __device__ bool next(int i, Unit& u) const {
        const long L = (long)i * G + c; if (L >= nwg) return false;
        int wgid = (int)L; { const int q = nwg / NXCD, r = nwg % NXCD, xcd = wgid % NXCD, off = wgid / NXCD; wgid = (xcd < r ? xcd * (q + 1) : r * (q + 1) + (xcd - r) * q) + off; }
        const int nig = WGM * nN, gid = wgid / nig, fm = gid * WGM, gsz = (nM - fm) < WGM ? (nM - fm) : WGM;
        u.pm = fm + ((wgid % nig) % gsz); u.pn = (wgid % nig) / gsz; u.ko = 0; return true;
    }
    __device__ __forceinline__ void a_ready(const Unit&) const {}
    __device__ __forceinline__ void done(const Unit&) const {}
};

__device__ __forceinline__ unsigned cvt_pk_bf16(float lo, float hi) { unsigned r; asm volatile("v_cvt_pk_bf16_f32 %0, %1, %2" : "=v"(r) : "v"(lo), "v"(hi)); return r; }
typedef unsigned u32x2 __attribute__((ext_vector_type(2)));
__device__ __forceinline__ float fast_sigmoid(float x) { return __frcp_rn(1.0f + __expf(-x)); }
__device__ __forceinline__ float silu_f(float x) { return x * fast_sigmoid(x); }
__device__ __forceinline__ float gelu_tanh_f(float x) { const float y = 1.5957691216057308f * (x + 0.044715f * x * x * x); return x * fast_sigmoid(y); }
__device__ __forceinline__ u32x2 pack4(f32x4 v) { u32x2 w; w.x = cvt_pk_bf16(v[0], v[1]); w.y = cvt_pk_bf16(v[2], v[3]); return w; }

struct EpiGate {
    static constexpr bool PERM = false, AFTER_DRAIN = false;
    bf16_t* H; int ldh;
    __device__ __forceinline__ void operator()(const f32x4 (&acc)[2][2][4][2], const Unit& u, int wr, int wc, int fr, int fq) const {
        const int row0 = u.pm * BM + wr * 64 + fr, col0 = u.pn * HALF + wc * 32 + 4 * fq;
#pragma unroll
        for (int ai = 0; ai < 2; ++ai)
#pragma unroll
            for (int m = 0; m < 4; ++m) { bf16_t* rowp = H + (size_t)(row0 + ai * HALF + m * 16) * ldh + col0;
#pragma unroll
                for (int n = 0; n < 2; ++n) { const f32x4 a = acc[ai][0][m][n], b = acc[ai][1][m][n]; f32x4 h;
#pragma unroll
                    for (int j = 0; j < 4; ++j) h[j] = silu_f(a[j]) * b[j];
                    *(u32x2*)(rowp + n * 16) = pack4(h); } }
    }
};
struct EpiResid {
    static constexpr bool PERM = false, AFTER_DRAIN = false;
    const float* X; float* PRE; float alpha, s;
    __device__ __forceinline__ void operator()(const f32x4 (&acc)[2][2][4][2], const Unit& u, int wr, int wc, int fr, int fq) const {
        const int row0 = u.pm * BM + wr * 64 + fr, col0 = u.pn * BM + wc * 32 + 4 * fq;
#pragma unroll
        for (int ai = 0; ai < 2; ++ai)
#pragma unroll
            for (int m = 0; m < 4; ++m) { const size_t off = (size_t)(row0 + ai * HALF + m * 16) * 1024 + col0;
#pragma unroll
                for (int bj = 0; bj < 2; ++bj)
#pragma unroll
                    for (int n = 0; n < 2; ++n) { const f32x4 x = *(const f32x4*)(X + off + bj * HALF + n * 16); *(f32x4*)(PRE + off + bj * HALF + n * 16) = x * alpha + acc[ai][bj][m][n] * s; } }
    }
};
struct EpiF32 {
    static constexpr bool PERM = false, AFTER_DRAIN = false;
    float* C; int ldc;
    __device__ __forceinline__ void operator()(const f32x4 (&acc)[2][2][4][2], const Unit& u, int wr, int wc, int fr, int fq) const {
        const int row0 = u.pm * BM + wr * 64 + fr, col0 = u.pn * BM + wc * 32 + 4 * fq;
#pragma unroll
        for (int ai = 0; ai < 2; ++ai)
#pragma unroll
            for (int m = 0; m < 4; ++m) { float* rowp = C + (size_t)(row0 + ai * HALF + m * 16) * ldc + col0;
#pragma unroll
                for (int bj = 0; bj < 2; ++bj)
#pragma unroll
                    for (int n = 0; n < 2; ++n) *(f32x4*)(rowp + bj * HALF + n * 16) = acc[ai][bj][m][n]; }
    }
};
struct EpiPle {
    static constexpr bool PERM = false, AFTER_DRAIN = false;
    float* X; const float* P; bf16_t* XN; float* OUT;
    __device__ __forceinline__ void operator()(const f32x4 (&acc)[2][2][4][2], const Unit& u, int wr, int wc, int fr, int fq) const {
        const int row0 = u.pm * BM + wr * 64 + fr, col0 = u.pn * BM + wc * 32 + 4 * fq;
#pragma unroll
        for (int ai = 0; ai < 2; ++ai)
#pragma unroll
            for (int m = 0; m < 4; ++m) { const size_t off = (size_t)(row0 + ai * HALF + m * 16) * 1024 + col0;
#pragma unroll
                for (int bj = 0; bj < 2; ++bj)
#pragma unroll
                    for (int n = 0; n < 2; ++n) { const size_t o = off + bj * HALF + n * 16; const f32x4 x = *(const f32x4*)(X + o), p = *(const f32x4*)(P + o), a = acc[ai][bj][m][n]; f32x4 y;
#pragma unroll
                        for (int j = 0; j < 4; ++j) y[j] = x[j] + fast_sigmoid(a[j]) * p[j];
                        *(f32x4*)(X + o) = y; *(u32x2*)(XN + o) = pack4(y); if (OUT) *(f32x4*)(OUT + o) = y; } }
    }
};
struct EpiAin {
    static constexpr bool PERM = false, AFTER_DRAIN = false;
    bf16_t* U; float* V;
    __device__ __forceinline__ void operator()(const f32x4 (&acc)[2][2][4][2], const Unit& u, int wr, int wc, int fr, int fq) const {
        const int row0 = u.pm * BM + wr * 64 + fr; const bool isu = u.pn < 8; const int col0 = (isu ? u.pn : u.pn - 8) * BM + wc * 32 + 4 * fq;
#pragma unroll
        for (int ai = 0; ai < 2; ++ai)
#pragma unroll
            for (int m = 0; m < 4; ++m) { const size_t off = (size_t)(row0 + ai * HALF + m * 16) * 2048 + col0;
#pragma unroll
                for (int bj = 0; bj < 2; ++bj)
#pragma unroll
                    for (int n = 0; n < 2; ++n) { const f32x4 a = acc[ai][bj][m][n]; f32x4 y;
#pragma unroll
                        for (int j = 0; j < 4; ++j) y[j] = gelu_tanh_f(a[j]);
                        if (isu) *(u32x2*)(U + off + bj * HALF + n * 16) = pack4(y); else *(f32x4*)(V + off + bj * HALF + n * 16) = y; } }
    }
};
struct EpiCmp {
    static constexpr bool PERM = false, AFTER_DRAIN = false;
    bf16_t* HC;
    __device__ __forceinline__ void operator()(const f32x4 (&acc)[2][2][4][2], const Unit& u, int wr, int wc, int fr, int fq) const {
        const int row0 = u.pm * BM + wr * 64 + fr, col0 = u.pn * BM + wc * 32 + 4 * fq;
#pragma unroll
        for (int ai = 0; ai < 2; ++ai)
#pragma unroll
            for (int m = 0; m < 4; ++m) { bf16_t* rowp = HC + (size_t)(row0 + ai * HALF + m * 16) * 256 + col0;
#pragma unroll
                for (int bj = 0; bj < 2; ++bj)
#pragma unroll
                    for (int n = 0; n < 2; ++n) { const f32x4 a = acc[ai][bj][m][n]; f32x4 y;
#pragma unroll
                        for (int j = 0; j < 4; ++j) y[j] = gelu_tanh_f(a[j]);
                        *(u32x2*)(rowp + bj * HALF + n * 16) = pack4(y); } }
    }
};

struct SplitOrder {
    int nM, nN, nsplit, ksplit, G, c;
    __device__ __forceinline__ bool next(int i, Unit& u) const { const int L = i * G + c, nt = nM * nN; if (L >= nsplit * nt) return false; const int sp = L / nt, t = L - sp * nt; u.pm = t / nN; u.pn = t - u.pm * nN; u.ko = sp * ksplit; return true; }
    __device__ __forceinline__ void a_ready(const Unit&) const {}
    __device__ __forceinline__ void done(const Unit&) const {}
};
struct EpiSlab {
    static constexpr bool PERM = false, AFTER_DRAIN = false;
    float* S; int ksplit; size_t slab;
    __device__ __forceinline__ void operator()(const f32x4 (&acc)[2][2][4][2], const Unit& u, int wr, int wc, int fr, int fq) const {
        const int row0 = u.pm * BM + wr * 64 + fr, col0 = u.pn * BM + wc * 32 + 4 * fq; float* base = S + (size_t)(u.ko / ksplit) * slab;
#pragma unroll
        for (int ai = 0; ai < 2; ++ai)
#pragma unroll
            for (int m = 0; m < 4; ++m) { float* rowp = base + (size_t)(row0 + ai * HALF + m * 16) * 1024 + col0;
#pragma unroll
                for (int bj = 0; bj < 2; ++bj)
#pragma unroll
                    for (int n = 0; n < 2; ++n) *(f32x4*)(rowp + bj * HALF + n * 16) = acc[ai][bj][m][n]; }
    }
};
template <class Epi, class Sched, bool ALIGN_EPI = false, bool SP2 = false>
__device__ __forceinline__ void gemm_phase(PG8_LAS unsigned char* lds, const Gemm g, const Sched& S, const Epi& E) {
    const int tid = threadIdx.x, wid = __builtin_amdgcn_readfirstlane(tid >> 6), lane = tid & 63, wr = wid >> 2, wc = wid & 3, fr = lane & 15, fq = lane >> 4;
    const int K = g.K, LD = g.ld ? g.ld : g.K, nt = K / BK;
    unsigned voffA[2], voffB[2];
#pragma unroll
    for (int i = 0; i < 2; ++i) { int R, C; stage_rc(tid * 16 + i * 8192, R, C); const int Rb = Epi::PERM ? ((R & ~31) + perm32(R & 31)) : R;
        voffA[i] = (unsigned)(R * LD + C) * 2u; voffB[i] = (unsigned)(Rb * LD + C) * 2u; }
    const size_t kstep = (size_t)(BK * 2);
    const size_t hstep = (size_t)HALF * LD * 2;
    const size_t tstep = 2 * hstep;
    const unsigned ldsw = (unsigned)wid * 1024u;
    const int aoff = lds_byte(wr * 64 + fr, fq * 8), boff = lds_byte(wc * 32 + fr, fq * 8);
#define PG8_SA(b, h) (((b) * 2 + (h)) * HTB)
#define PG8_SB(b, h) ((4 + (b) * 2 + (h)) * HTB)
#define PG8_STAGE(bufoff, gbase, voff) do { _Pragma("unroll") for (int _i = 0; _i < 2; ++_i) \
        __builtin_amdgcn_global_load_lds((const unsigned*)((const char*)(gbase) + (voff)[_i]), (PG8_LAS unsigned*)(lds + (bufoff) + ldsw + _i * 8192), 16, 0, 0); } while (0)
#define PG8_LDA(dst, b, h) do { _Pragma("unroll") for (int m = 0; m < 4; ++m) _Pragma("unroll") for (int k = 0; k < 2; ++k) dst[m][k] = *(const PG8_LAS bf16x8*)(lds + PG8_SA(b, h) + aoff + m * 2048 + k * 1024); } while (0)
#define PG8_LDB(dst, b, h) do { _Pragma("unroll") for (int n = 0; n < 2; ++n) _Pragma("unroll") for (int k = 0; k < 2; ++k) dst[n][k] = *(const PG8_LAS bf16x8*)(lds + PG8_SB(b, h) + boff + n * 2048 + k * 1024); } while (0)
#define PG8_MMA(ai, bj, At, Bt) do { __builtin_amdgcn_s_setprio(1); _Pragma("unroll") for (int m = 0; m < 4; ++m) _Pragma("unroll") for (int n = 0; n < 2; ++n) _Pragma("unroll") for (int k = 0; k < 2; ++k) \
        acc[ai][bj][m][n] = __builtin_amdgcn_mfma_f32_16x16x32_bf16(Bt[n][k], At[m][k], acc[ai][bj][m][n], 0, 0, 0); __builtin_amdgcn_s_setprio(0); } while (0)
#define PG8_WAIT_V(n) asm volatile("s_waitcnt vmcnt(" #n ")" ::: "memory")
#define PG8_WAIT_L(n) asm volatile("s_waitcnt lgkmcnt(" #n ")" ::: "memory")
#define PG8_BAR __builtin_amdgcn_s_barrier()
#define PG8_SCHED __builtin_amdgcn_sched_barrier(0)
    Unit cur, nxt; int ui = 0;
    if (!S.next(0, cur)) return;
    f32x4 acc[2][2][4][2];
#pragma unroll
    for (int a = 0; a < 2; ++a)
#pragma unroll
        for (int b = 0; b < 2; ++b)
#pragma unroll
            for (int m = 0; m < 4; ++m)
#pragma unroll
                for (int n = 0; n < 2; ++n) acc[a][b][m][n] = (f32x4){0.f, 0.f, 0.f, 0.f};
    bf16x8 At[4][2], B0[2][2], B1[2][2];
    const char* cA = (const char*)g.A + (size_t)cur.pm * tstep + (size_t)cur.ko * 2; const char* cB = (const char*)g.Bt + (size_t)cur.pn * tstep + (size_t)cur.ko * 2;
    S.a_ready(cur);
    if constexpr (SP2) {
        PG8_STAGE(PG8_SB(0, 0), cB, voffB); PG8_STAGE(PG8_SB(0, 1), cB + hstep, voffB); PG8_STAGE(PG8_SA(0, 0), cA, voffA); PG8_STAGE(PG8_SA(0, 1), cA + hstep, voffA);
        if (wr == 1) PG8_BAR;
        PG8_WAIT_V(2); PG8_BAR;
        PG8_STAGE(PG8_SB(1, 0), cB + kstep, voffB); PG8_STAGE(PG8_SA(1, 0), cA + kstep, voffA); PG8_STAGE(PG8_SB(1, 1), cB + hstep + kstep, voffB);
        PG8_WAIT_V(6); PG8_BAR;
    } else {
        PG8_STAGE(PG8_SB(0, 0), cB, voffB); PG8_STAGE(PG8_SA(0, 0), cA, voffA); PG8_STAGE(PG8_SB(0, 1), cB + hstep, voffB); PG8_STAGE(PG8_SA(0, 1), cA + hstep, voffA);
        if (wr == 1) PG8_BAR;
        PG8_WAIT_V(4); PG8_BAR;
        PG8_STAGE(PG8_SB(1, 0), cB + kstep, voffB); PG8_STAGE(PG8_SA(1, 0), cA + kstep, voffA); PG8_STAGE(PG8_SB(1, 1), cB + hstep + kstep, voffB);
        PG8_WAIT_V(6); PG8_BAR;
    }
    for (;;) {
        const bool has_next = S.next(ui + 1, nxt);
        const char* nA = has_next ? (const char*)g.A + (size_t)nxt.pm * tstep + (size_t)nxt.ko * 2 : cA; const char* nB = has_next ? (const char*)g.Bt + (size_t)nxt.pn * tstep + (size_t)nxt.ko * 2 : cB;
        for (int t = 0; t < nt; t += 2) {
            const bool last = (t == nt - 2);
            const char* a1 = cA + (size_t)(t + 1) * kstep;
            const char* a2 = last ? nA : cA + (size_t)(t + 2) * kstep; const char* b2 = last ? nB : cB + (size_t)(t + 2) * kstep;
            const char* a3 = a2 + kstep; const char* b3 = b2 + kstep;
            if (last && has_next) S.a_ready(nxt);
            if constexpr (SP2) {
            PG8_LDB(B0, 0, 0); PG8_LDB(B1, 0, 1); PG8_SCHED; PG8_LDA(At, 0, 0); PG8_STAGE(PG8_SA(1, 1), a1 + hstep, voffA);
            PG8_WAIT_V(8); PG8_WAIT_L(0); PG8_BAR; PG8_MMA(0, 0, At, B0); PG8_MMA(0, 1, At, B1); PG8_BAR; PG8_SCHED;
            PG8_LDA(At, 0, 1); PG8_STAGE(PG8_SB(0, 0), b2, voffB); PG8_STAGE(PG8_SB(0, 1), b2 + hstep, voffB); PG8_STAGE(PG8_SA(0, 0), a2, voffA);
            PG8_WAIT_V(8); PG8_WAIT_L(0); PG8_BAR; PG8_MMA(1, 0, At, B0); PG8_MMA(1, 1, At, B1); PG8_BAR; PG8_SCHED;
            PG8_LDB(B0, 1, 0); PG8_LDB(B1, 1, 1); PG8_SCHED; PG8_LDA(At, 1, 0); PG8_STAGE(PG8_SA(0, 1), a2 + hstep, voffA);
            PG8_WAIT_V(8); PG8_WAIT_L(0); PG8_BAR; PG8_MMA(0, 0, At, B0); PG8_MMA(0, 1, At, B1); PG8_BAR; PG8_SCHED;
            PG8_LDA(At, 1, 1); PG8_STAGE(PG8_SB(1, 0), b3, voffB); PG8_STAGE(PG8_SB(1, 1), b3 + hstep, voffB); PG8_STAGE(PG8_SA(1, 0), a3, voffA);
            PG8_WAIT_V(8); PG8_WAIT_L(0); PG8_BAR; PG8_MMA(1, 0, At, B0); PG8_MMA(1, 1, At, B1); PG8_BAR; PG8_SCHED;
            } else {
            PG8_LDB(B0, 0, 0); PG8_SCHED; PG8_LDA(At, 0, 0); PG8_STAGE(PG8_SA(1, 1), a1 + hstep, voffA);
            PG8_WAIT_L(8); PG8_BAR; PG8_WAIT_L(0); PG8_MMA(0, 0, At, B0); PG8_BAR; PG8_SCHED;
            PG8_LDB(B1, 0, 1); PG8_STAGE(PG8_SB(0, 0), b2, voffB);
            PG8_BAR; PG8_WAIT_L(0); PG8_MMA(0, 1, At, B1); PG8_BAR;
            PG8_LDA(At, 0, 1); PG8_STAGE(PG8_SA(0, 0), a2, voffA);
            PG8_BAR; PG8_WAIT_L(0); PG8_MMA(1, 0, At, B0); PG8_BAR; PG8_SCHED;
            PG8_STAGE(PG8_SB(0, 1), b2 + hstep, voffB);
            PG8_WAIT_V(6); PG8_BAR; PG8_MMA(1, 1, At, B1); PG8_BAR;
            PG8_LDB(B0, 1, 0); PG8_SCHED; PG8_LDA(At, 1, 0); PG8_STAGE(PG8_SA(0, 1), a2 + hstep, voffA);
            PG8_WAIT_L(8); PG8_BAR; PG8_WAIT_L(0); PG8_MMA(0, 0, At, B0); PG8_BAR; PG8_SCHED;
            PG8_LDB(B1, 1, 1); PG8_STAGE(PG8_SB(1, 0), b3, voffB);
            PG8_BAR; PG8_WAIT_L(0); PG8_MMA(0, 1, At, B1); PG8_BAR;
            PG8_LDA(At, 1, 1); PG8_STAGE(PG8_SA(1, 0), a3, voffA);
            PG8_BAR; PG8_WAIT_L(0); PG8_MMA(1, 0, At, B0); PG8_BAR; PG8_SCHED;
            PG8_STAGE(PG8_SB(1, 1), b3 + hstep, voffB);
            PG8_WAIT_V(6); PG8_BAR; PG8_MMA(1, 1, At, B1); PG8_BAR;
            }
        }
        if constexpr (ALIGN_EPI) { if (wr == 0) PG8_BAR; }
        if constexpr (!Epi::AFTER_DRAIN) { E(acc, cur, wr, wc, fr, fq); S.done(cur); }
        if (!has_next) break;
#pragma unroll
        for (int a = 0; a < 2; ++a)
#pragma unroll
            for (int b = 0; b < 2; ++b)
#pragma unroll
                for (int m = 0; m < 4; ++m)
#pragma unroll
                    for (int n = 0; n < 2; ++n) acc[a][b][m][n] = (f32x4){0.f, 0.f, 0.f, 0.f};
        cur = nxt; cA = nA; cB = nB; ++ui;
        if constexpr (ALIGN_EPI) { if (wr == 1) PG8_BAR; }
    }
    PG8_WAIT_V(0);
    if constexpr (!ALIGN_EPI) { if (wr == 0) PG8_BAR; }
    PG8_BAR;
    if constexpr (Epi::AFTER_DRAIN) { E.fused(acc, cur, wr, wc, fr, fq, lds, wid, lane); S.done(cur); }
#undef PG8_SA
#undef PG8_SB
#undef PG8_STAGE
#undef PG8_LDA
#undef PG8_LDB
#undef PG8_MMA
#undef PG8_WAIT_V
#undef PG8_WAIT_L
#undef PG8_BAR
#undef PG8_SCHED
}
}
constexpr int NWAVES = 8;
constexpr int MP = 16384, MS = 512, M = 16896, D = 1024, DFF = 2816, PLE = 256, SEQ = 4096, NB = 4, DB = 128, DSQ = 4;
constexpr int NBIN = 4352, NBIN_REAL = 4112, NCIN = 2816, NCIN_REAL = 2608;
constexpr int CMP_ROWS = 34816;
constexpr float ALPHA = 1.681792830507429f, LN_EPS = 1e-5f, NORM_EPS = 1e-6f;
constexpr size_t O_YP = 0, O_YS = 16777216, O_AV = 17301504, O_GSP = 19398656, O_GCP = 19922944, O_GSS = 19959808, O_GCS = 36737024,
                 O_KVP = 37916672, O_WINP = 54693888, O_KVS = 55742464, O_WINS = 56266752, O_END = 56528896;
constexpr size_t CTL_BYTES = 1u << 20;
constexpr size_t SZ_WUP = (size_t)5632 * 1024 * 2, SZ_WDN = (size_t)1024 * 2816 * 2, SZ_WG = (size_t)1024 * 1024 * 2, SZ_WP = (size_t)1024 * 256 * 2,
                 SZ_WAIN = (size_t)4096 * 1024 * 2, SZ_WAOUT = (size_t)1024 * 2048 * 2, SZ_WBIN = (size_t)NBIN * 1024 * 2, SZ_WCIN = (size_t)NCIN * 1024 * 2, SZ_WC1 = (size_t)256 * 2048 * 2;
constexpr size_t WS_WUP = CTL_BYTES, WS_WDN = WS_WUP + 8 * SZ_WUP, WS_WG = WS_WDN + 8 * SZ_WDN, WS_WP = WS_WG + 4 * SZ_WG, WS_WAIN = WS_WP + 4 * SZ_WP, WS_WAOUT = WS_WAIN + 2 * SZ_WAIN,
                 WS_WBIN = WS_WAOUT + 2 * SZ_WAOUT, WS_WBOUT = WS_WBIN + SZ_WBIN, WS_WCIN = WS_WBOUT + SZ_WG, WS_WCOUT = WS_WCIN + SZ_WCIN, WS_WC1 = WS_WCOUT + SZ_WG;
constexpr size_t WS_WSM = WS_WC1 + 2 * SZ_WC1;
constexpr size_t WS_X = WS_WSM + (size_t)2 * 16 * 128 * 128 * 2;
constexpr size_t WS_XN = WS_X + (size_t)M * 1024 * 4;
constexpr size_t WS_XNB = WS_XN + (size_t)M * 1024 * 2;
constexpr size_t WS_PRE = WS_XNB + (size_t)M * 1024 * 2;
constexpr size_t WS_H = WS_PRE + (size_t)M * 1024 * 4;
constexpr size_t WS_PBF = WS_H + (size_t)M * 2816 * 2;
constexpr size_t WS_PP = WS_PBF + (size_t)4 * M * 256 * 2;
constexpr size_t WS_SLAB = WS_PP + (size_t)4 * M * 1024 * 4;
constexpr size_t WS_MIX = WS_SLAB + (size_t)11 * MS * 1024 * 4;
constexpr size_t WA_U = WS_MIX, WA_V = WA_U + (size_t)M * 2048 * 2, WA_US = WA_V + (size_t)M * 2048 * 4, WA_ST = WA_US + (size_t)M * 2048 * 2, WA_END = WA_ST + (size_t)M * 8;
constexpr size_t GUNITS = 2048;
constexpr size_t WB_PROJ = WS_MIX, WB_W = WB_PROJ + (size_t)M * NBIN * 4, WB_U = WB_W + GUNITS * 64 * 128 * 4, WB_QG = WB_U + GUNITS * 64 * 128 * 4, WB_KD = WB_QG + GUNITS * 64 * 128 * 4,
                 WB_QK = WB_KD + GUNITS * 64 * 128 * 4, WB_EG = WB_QK + GUNITS * 64 * 64 * 4, WB_O = WB_EG + 65536, WB_OG = WB_O + (size_t)M * 1024 * 4, WB_END = WB_OG + (size_t)M * 1024 * 2;
constexpr size_t WC_PROJ = WS_MIX, WC_ACMP = WC_PROJ + (size_t)M * NCIN * 4, WC_HC = WC_ACMP + (size_t)2 * CMP_ROWS * 2048 * 2, WC_KCV = WC_HC + (size_t)2 * CMP_ROWS * 256 * 2,
                 WC_OA = WC_KCV + (size_t)2 * CMP_ROWS * 64 * 4, WC_KSB = WC_OA + (size_t)M * 1024 * 2, WC_VST = WC_KSB + (size_t)16 * SEQ * 64 * 2, WC_KWB = WC_VST + (size_t)16 * SEQ * 64 * 2, WC_VWT = WC_KWB + (size_t)16 * SEQ * 64 * 2,
                 WC_KCB = WC_VWT + (size_t)16 * SEQ * 64 * 2, WC_VCT = WC_KCB + (size_t)16 * 128 * 64 * 2, WC_END = WC_VCT + (size_t)16 * 128 * 64 * 2;
constexpr size_t WS_END = (WB_END > WC_END ? (WB_END > WA_END ? WB_END : WA_END) : (WC_END > WA_END ? WC_END : WA_END));
static_assert(WS_X % 256 == 0 && WS_MIX % 256 == 0 && WB_W % 256 == 0 && WC_ACMP % 256 == 0, "alignment");
constexpr int CW_TMO = 0, CW_BAR = 4096;
constexpr int LDS_BYTES = 147456, MISC_OFF = LDS_BYTES - 512;

#define GAS __attribute__((address_space(1)))
#define LAS __attribute__((address_space(3)))
typedef unsigned short bf16;
typedef float f32x4 __attribute__((ext_vector_type(4)));
typedef float f32x2 __attribute__((ext_vector_type(2)));
typedef unsigned u32x2 __attribute__((ext_vector_type(2)));
typedef unsigned u32x4 __attribute__((ext_vector_type(4)));
#define LDS_WAIT() asm volatile("s_waitcnt lgkmcnt(0)" ::: "memory")
__device__ __forceinline__ unsigned f2bf(float f) { unsigned u = __builtin_bit_cast(unsigned, f); return (u + 0x7fffu + ((u >> 16) & 1u)) >> 16; }
typedef __bf16 hwbf16x2_t __attribute__((ext_vector_type(2)));
__device__ __forceinline__ unsigned pk2(float lo, float hi) { const f32x2 v = {lo, hi}; const hwbf16x2_t b = __builtin_convertvector(v, hwbf16x2_t); return __builtin_bit_cast(unsigned, b); }
__device__ __forceinline__ float bf2f(bf16 b) { return __builtin_bit_cast(float, ((unsigned)b) << 16); }
__device__ __forceinline__ float wave_sum(float v) {
#pragma unroll
    for (int o = 1; o < 64; o <<= 1) v += __shfl_xor(v, o);
    return v;
}
__device__ __forceinline__ float wave_max(float v) {
#pragma unroll
    for (int o = 1; o < 64; o <<= 1) v = fmaxf(v, __shfl_xor(v, o));
    return v;
}
__device__ __forceinline__ float sigmoid_f(float x) { return 1.0f / (1.0f + __expf(-x)); }
__device__ __forceinline__ float siluf(float x) { return x * sigmoid_f(x); }
__device__ __forceinline__ float readlane_f(float v, int k) { return __builtin_bit_cast(float, __builtin_amdgcn_readlane(__builtin_bit_cast(int, v), k)); }
typedef short bf16x8_t __attribute__((ext_vector_type(8)));
#define MFMA16(a, b, cc) __builtin_amdgcn_mfma_f32_16x16x32_bf16((a), (b), (cc), 0, 0, 0)
#define XB_TMO      128
#define XB_XCNT(j)  (256  + 64 * (j))
#define XB_XSUB(j)  (1280 + 64 * (j))
#define XB_XGEN(j)  (2304 + 64 * (j))
#define XB_TOP      3328
#define XB_TOPGEN   3392
#define XCD_BAR_WORDS 3456
#define XB_SPIN_CAP (1u << 18)

__device__ __forceinline__ unsigned xb_ld(unsigned* p)              { return __hip_atomic_load(p, __ATOMIC_RELAXED, __HIP_MEMORY_SCOPE_AGENT); }
__device__ __forceinline__ unsigned xb_add(unsigned* p, unsigned v) { return __hip_atomic_fetch_add(p, v, __ATOMIC_RELAXED, __HIP_MEMORY_SCOPE_AGENT); }
__device__ __forceinline__ unsigned xb_xcc_id() { return (unsigned)__builtin_amdgcn_s_getreg((3 << 11) | 20) & 0xFu; }
#define XB_SPIN(cond, bar) do { unsigned _sp = 0; while (cond) { __builtin_amdgcn_s_sleep(1); \
    if ((++_sp & 255u) == 0u) { if (xb_ld(&(bar)[XB_TMO])) break; if (_sp > XB_SPIN_CAP) { atomicAdd(&(bar)[XB_TMO], 1u); break; } } } } while (0)

struct XcdBarrier {
    unsigned* bar; unsigned x;
    volatile LAS unsigned* st;
};

__device__ __forceinline__ XcdBarrier xcd_barrier_post(unsigned* bar, volatile LAS unsigned* st) {
    XcdBarrier b; b.bar = bar; b.x = xb_xcc_id(); b.st = st;
    if (threadIdx.x == 0) (void)xb_add(&bar[XB_XCNT(b.x)], 1u);
    return b;
}
__device__ __forceinline__ void xcd_barrier_complete(unsigned* bar, unsigned x, unsigned& nloc, unsigned& nx) {
    const unsigned G = gridDim.x * gridDim.y * gridDim.z;
    unsigned sum, cnt, mine, sp = 0u;
    for (;;) {
        sum = 0u; cnt = 0u; mine = 0u;
#pragma unroll
        for (unsigned j = 0; j < 16; ++j) { const unsigned c = xb_ld(&bar[XB_XCNT(j)]); sum += c; cnt += (c > 0u) ? 1u : 0u; mine = (j == x) ? c : mine; }
        if (sum == G) break;
        __builtin_amdgcn_s_sleep(1);
        if ((++sp & 255u) == 0u) { if (xb_ld(&bar[XB_TMO])) break; if (sp > XB_SPIN_CAP) { atomicAdd(&bar[XB_TMO], 1u); break; } }
    }
    nloc = mine > 0u ? mine : 1u; nx = cnt > 0u ? cnt : 1u;
}

__device__ __forceinline__ void xcd_barrier(const XcdBarrier& b) {
    asm volatile("s_waitcnt vmcnt(0)" ::: "memory");
    __syncthreads();
    if (threadIdx.x == 0) {
        unsigned* bar = b.bar;
        __builtin_amdgcn_s_waitcnt(0);
        unsigned nloc = b.st[0], nx = b.st[1];
        if (nloc == 0u) { xcd_barrier_complete(bar, b.x, nloc, nx); b.st[0] = nloc; b.st[1] = nx; }
        const unsigned old = xb_add(&bar[XB_XSUB(b.x)], 1u);
        const unsigned gen = old / nloc;
        if (old + 1u == (gen + 1u) * nloc) {
            __builtin_amdgcn_fence(__ATOMIC_RELEASE, "agent");
            asm volatile("s_waitcnt vmcnt(0)" ::: "memory");
            const unsigned og = xb_add(&bar[XB_TOP], 1u);
            const unsigned tg = og / nx;
            if (og + 1u == (tg + 1u) * nx) xb_add(&bar[XB_TOPGEN], 1u);
            else XB_SPIN(xb_ld(&bar[XB_TOPGEN]) == tg, bar);
            __builtin_amdgcn_fence(__ATOMIC_ACQUIRE, "agent");
            xb_add(&bar[XB_XGEN(b.x)], 1u);
            asm volatile("s_waitcnt vmcnt(0)" ::: "memory");
        } else {
            XB_SPIN(xb_ld(&bar[XB_XGEN(b.x)]) == gen, bar);
            __builtin_amdgcn_fence(__ATOMIC_ACQUIRE, "agent");
            asm volatile("s_waitcnt vmcnt(0)" ::: "memory");
        }
    }
    __syncthreads();
}
enum { I_XP = 0, I_XS, I_GS, I_GCONV, I_CKV, I_CWIN, I_PT, I_PP, I_PS, I_LNG, I_LNB, I_WUP, I_WDN, I_WG, I_WPJ, I_AWIN, I_ALNG, I_ALNB, I_AWS, I_ABS, I_AWOUT,
       I_BWIN, I_BCONV, I_BALOG, I_BDT, I_BNG, I_BWOUT, I_CWIN_W, I_CGB, I_CPE, I_CW1, I_CW2, I_CWOUT, I_T5, N_IN };
struct Ctx {
    LAS unsigned char* lds; unsigned char* ws; float* out; const float* const* in;
    int tid, lane, wave, G, gw, NGW;
};
#define WSF(off) ((float*)(c.ws + (off)))
#define WSB(off) ((bf16*)(c.ws + (off)))

__device__ __forceinline__ void tr_item(const float* W, int K, int N, bf16* WT, int mode, LAS float* scr, int item, int lane) {
    const int nblk = (N + 31) >> 5, kb = item / nblk, nb = item - kb * nblk, k0 = 64 * kb, n0 = 32 * nb;
    const int nn = n0 + (lane & 31); const bool ok = nn < N;
#pragma unroll 8
    for (int i = 0; i < 32; ++i) { const int kk = 2 * i + (lane >> 5); scr[kk * 33 + (lane & 31)] = ok ? W[(size_t)(k0 + kk) * N + nn] : 0.f; }
    LDS_WAIT(); asm volatile("" ::: "memory");
    const int cch = lane & 7;
#pragma unroll
    for (int j = 0; j < 4; ++j) { const int nl = (lane >> 3) + 8 * j, n = n0 + nl; const LAS float* s = scr + (8 * cch) * 33 + nl;
        if (n < N) { u32x4 o; o.x = pk2(s[0 * 33], s[1 * 33]); o.y = pk2(s[2 * 33], s[3 * 33]); o.z = pk2(s[4 * 33], s[5 * 33]); o.w = pk2(s[6 * 33], s[7 * 33]);
            int drow = n; if (mode == 1) { const int half = n >= DFF ? 1 : 0, idx = n - half * DFF; drow = (idx >> 7) * 256 + half * 128 + (idx & 127); }
            *(u32x4*)(WT + (size_t)drow * K + k0 + 8 * cch) = o; } }
    LDS_WAIT(); asm volatile("" ::: "memory");
}
__device__ __forceinline__ void prologue_phase(const Ctx& c) {
    LAS float* scr = (LAS float*)(c.lds + c.wave * 16384);
    constexpr int IT_UP = 16 * 176, IT_DN = 44 * 32, IT_G = 16 * 32, IT_P = 4 * 32, IT_AIN = 16 * 128, IT_AOUT = 32 * 32, IT_BIN = 16 * 129, IT_CIN = 16 * 82, IT_C1 = 32 * 8;
    constexpr int NIT = 8 * IT_UP + 8 * IT_DN + 4 * IT_G + 4 * IT_P + 2 * IT_AIN + 2 * IT_AOUT + IT_BIN + IT_G + IT_CIN + IT_G + 2 * IT_C1;
    for (int it = c.gw; it < NIT; it += c.NGW) {
        int r = it, mi;
        if (r < 8 * IT_UP) { mi = r / IT_UP; tr_item(c.in[I_WUP] + (size_t)mi * 1024 * 5632, 1024, 5632, WSB(WS_WUP + mi * SZ_WUP), 1, scr, r - mi * IT_UP, c.lane); continue; } r -= 8 * IT_UP;
        if (r < 8 * IT_DN) { mi = r / IT_DN; tr_item(c.in[I_WDN] + (size_t)mi * 2816 * 1024, 2816, 1024, WSB(WS_WDN + mi * SZ_WDN), 0, scr, r - mi * IT_DN, c.lane); continue; } r -= 8 * IT_DN;
        if (r < 4 * IT_G) { mi = r / IT_G; tr_item(c.in[I_WG] + (size_t)mi * 1024 * 1024, 1024, 1024, WSB(WS_WG + mi * SZ_WG), 0, scr, r - mi * IT_G, c.lane); continue; } r -= 4 * IT_G;
        if (r < 4 * IT_P) { mi = r / IT_P; tr_item(c.in[I_WPJ] + (size_t)mi * 256 * 1024, 256, 1024, WSB(WS_WP + mi * SZ_WP), 0, scr, r - mi * IT_P, c.lane); continue; } r -= 4 * IT_P;
        if (r < 2 * IT_AIN) { mi = r / IT_AIN; tr_item(c.in[I_AWIN] + (size_t)mi * 1024 * 4096, 1024, 4096, WSB(WS_WAIN + mi * SZ_WAIN), 0, scr, r - mi * IT_AIN, c.lane); continue; } r -= 2 * IT_AIN;
        if (r < 2 * IT_AOUT) { mi = r / IT_AOUT; tr_item(c.in[I_AWOUT] + (size_t)mi * 2048 * 1024, 2048, 1024, WSB(WS_WAOUT + mi * SZ_WAOUT), 0, scr, r - mi * IT_AOUT, c.lane); continue; } r -= 2 * IT_AOUT;
        if (r < IT_BIN) { tr_item(c.in[I_BWIN], 1024, NBIN_REAL, WSB(WS_WBIN), 0, scr, r, c.lane); continue; } r -= IT_BIN;
        if (r < IT_G) { tr_item(c.in[I_BWOUT], 1024, 1024, WSB(WS_WBOUT), 0, scr, r, c.lane); continue; } r -= IT_G;
        if (r < IT_CIN) { tr_item(c.in[I_CWIN_W], 1024, NCIN_REAL, WSB(WS_WCIN), 0, scr, r, c.lane); continue; } r -= IT_CIN;
        if (r < IT_G) { tr_item(c.in[I_CWOUT], 1024, 1024, WSB(WS_WCOUT), 0, scr, r, c.lane); continue; } r -= IT_G;
        mi = r / IT_C1; tr_item(c.in[I_CW1] + (size_t)mi * 2048 * 256, 2048, 256, WSB(WS_WC1 + mi * SZ_WC1), 0, scr, r - mi * IT_C1, c.lane);
    }
    for (int i4 = c.gw * 64 + c.lane; i4 < 2 * 16 * 128 * 128 / 4; i4 += c.NGW * 64) { const int t = (i4 >> 5) & 127, s0 = (i4 & 31) * 4; const f32x4 w = *((const f32x4*)c.in[I_AWS] + i4);
        u32x2 o; o.x = pk2(s0 <= t ? w.x : 0.f, s0 + 1 <= t ? w.y : 0.f); o.y = pk2(s0 + 2 <= t ? w.z : 0.f, s0 + 3 <= t ? w.w : 0.f); *((u32x2*)WSB(WS_WSM) + i4) = o; }
    for (int r = c.gw; r < (NBIN - NBIN_REAL) + (NCIN - NCIN_REAL); r += c.NGW) {
        bf16* row = r < (NBIN - NBIN_REAL) ? WSB(WS_WBIN) + (size_t)(NBIN_REAL + r) * 1024 : WSB(WS_WCIN) + (size_t)(NCIN_REAL + r - (NBIN - NBIN_REAL)) * 1024;
        const u32x4 z = {0u, 0u, 0u, 0u}; *(u32x4*)(row + c.lane * 8) = z; *(u32x4*)(row + 512 + c.lane * 8) = z; }
    for (int row = c.gw; row < M; row += c.NGW) {
        const float* src = row < MP ? c.in[I_XP] + (size_t)row * 1024 : c.in[I_XS] + (size_t)(row - MP) * 1024;
        float* xd = WSF(WS_X) + (size_t)row * 1024; bf16* xn = WSB(WS_XNB) + (size_t)row * 1024;
#pragma unroll
        for (int j = 0; j < 4; ++j) { const f32x4 v = *((const f32x4*)src + c.lane + 64 * j); *((f32x4*)xd + c.lane + 64 * j) = v; u32x2 w; w.x = pk2(v.x, v.y); w.y = pk2(v.z, v.w); *((u32x2*)xn + c.lane + 64 * j) = w; }
    }
    for (int r = c.gw; r < 4 * M; r += c.NGW) {
        const int l = r / M, row = r - l * M;
        const float* src = row < MP ? c.in[I_PP] + ((size_t)l * MP + row) * 256 : c.in[I_PS] + ((size_t)l * MS + (row - MP)) * 256;
        const f32x4 v = *((const f32x4*)src + c.lane); u32x2 w; w.x = pk2(v.x, v.y); w.y = pk2(v.z, v.w); *((u32x2*)(WSB(WS_PBF) + (size_t)r * 256) + c.lane) = w;
    }
}
__device__ __forceinline__ void ln_phase(const Ctx& c, const float* g, const float* b, const int nsplit, const float sc) {
    f32x4 gv[4], bv[4];
#pragma unroll
    for (int j = 0; j < 4; ++j) { gv[j] = *((const f32x4*)g + c.lane + 64 * j); bv[j] = *((const f32x4*)b + c.lane + 64 * j); }
    for (int row = c.gw; row < M; row += c.NGW) {
        const f32x4* p = (const f32x4*)(WSF(WS_PRE) + (size_t)row * 1024) + c.lane;
        f32x4 v[4]; float s = 0.f;
        if (row < MP) {
#pragma unroll
            for (int j = 0; j < 4; ++j) v[j] = p[64 * j];
        } else {
            const f32x4* xq = (const f32x4*)(WSF(WS_X) + (size_t)row * 1024) + c.lane; const f32x4* sl = (const f32x4*)(WSF(WS_SLAB) + (size_t)(row - MP) * 1024) + c.lane;
#pragma unroll
            for (int j = 0; j < 4; ++j) { f32x4 a = {0.f, 0.f, 0.f, 0.f}; for (int k = 0; k < nsplit; ++k) a += sl[(size_t)k * (MS * 256) + 64 * j]; v[j] = xq[64 * j] * ALPHA + a * sc; }
        }
#pragma unroll
        for (int j = 0; j < 4; ++j) s += (v[j].x + v[j].y) + (v[j].z + v[j].w);
        const float mean = wave_sum(s) * (1.f / 1024.f); float s2 = 0.f;
#pragma unroll
        for (int j = 0; j < 4; ++j) { v[j] = v[j] - mean; s2 += (v[j].x * v[j].x + v[j].y * v[j].y) + (v[j].z * v[j].z + v[j].w * v[j].w); }
        const float rstd = 1.f / sqrtf(wave_sum(s2) * (1.f / 1024.f) + LN_EPS);
        float* xd = WSF(WS_X) + (size_t)row * 1024; bf16* xn = WSB(WS_XN) + (size_t)row * 1024;
#pragma unroll
        for (int j = 0; j < 4; ++j) { const f32x4 y = v[j] * rstd * gv[j] + bv[j]; *((f32x4*)xd + c.lane + 64 * j) = y; u32x2 w; w.x = pk2(y.x, y.y); w.y = pk2(y.z, y.w); *((u32x2*)xn + c.lane + 64 * j) = w; }
    }
}
__device__ __forceinline__ void a_stats_phase(const Ctx& c, int ia) {
    const float* lg = c.in[I_ALNG] + ia * 2048; const float* lb = c.in[I_ALNB] + ia * 2048;
    for (int row = c.gw; row < M; row += c.NGW) {
        const f32x4* p = (const f32x4*)(WSF(WA_V) + (size_t)row * 2048) + c.lane;
        f32x4 v[8]; float s = 0.f;
#pragma unroll
        for (int j = 0; j < 8; ++j) { v[j] = p[64 * j]; s += (v[j].x + v[j].y) + (v[j].z + v[j].w); }
        const float mean = wave_sum(s) * (1.f / 2048.f); float s2 = 0.f;
#pragma unroll
        for (int j = 0; j < 8; ++j) { v[j] = v[j] - mean; s2 += (v[j].x * v[j].x + v[j].y * v[j].y) + (v[j].z * v[j].z + v[j].w * v[j].w); }
        const float rstd = 1.f / sqrtf(wave_sum(s2) * (1.f / 2048.f) + LN_EPS);
        if (c.lane == 0) { WSF(WA_ST)[2 * row] = mean; WSF(WA_ST)[2 * row + 1] = rstd; }
        if (row >= MP) { float* o = c.out + O_AV + ((size_t)ia * MS + (row - MP)) * 2048;
#pragma unroll
            for (int j = 0; j < 8; ++j) { const f32x4 gg = *((const f32x4*)lg + c.lane + 64 * j), bb = *((const f32x4*)lb + c.lane + 64 * j); *((f32x4*)o + c.lane + 64 * j) = v[j] * rstd * gg + bb; } }
    }
}
__device__ __forceinline__ void a_sgu_phase(const Ctx& c, int ia) {
    const float* ws = c.in[I_AWS] + (size_t)ia * 16 * 128 * 128; const float* bs = c.in[I_ABS] + ia * 16 * 128; const bf16* wsm = WSB(WS_WSM) + (size_t)ia * 16 * 128 * 128;
    const float* lg = c.in[I_ALNG] + ia * 2048; const float* lb = c.in[I_ALNB] + ia * 2048;
    const float* V = WSF(WA_V); const float* ST = WSF(WA_ST); const bf16* U = WSB(WA_U); bf16* US = WSB(WA_US);
    for (int unit = blockIdx.x; unit < 2048 + DB; unit += c.G) {
        if (unit < 2048) {
            LAS bf16* vt = (LAS bf16*)c.lds; asm volatile("" : "+v"(vt));
            const int g = unit & 15, n = (unit >> 4) & 31, b = unit >> 9, rowbase = b * SEQ + n * 128;
            const int w = c.wave, fr = c.lane & 15, rq = c.lane >> 4, ta = w >> 1, dh = w & 1;
            bf16x8_t wf0[2], wf1[4];
            { const bf16* w0 = wsm + ((size_t)g * 128 + 16 * ta + fr) * 128 + 8 * rq; const bf16* w1 = wsm + ((size_t)g * 128 + 16 * (7 - ta) + fr) * 128 + 8 * rq;
#pragma unroll
              for (int ks = 0; ks < 2; ++ks) wf0[ks] = *(const bf16x8_t*)(w0 + 32 * ks);
#pragma unroll
              for (int ks = 0; ks < 4; ++ks) wf1[ks] = *(const bf16x8_t*)(w1 + 32 * ks); }
            __syncthreads();
            { const int d = c.tid & 127, sp = c.tid >> 7; const float gg = lg[g * 128 + d], bb = lb[g * 128 + d];
#pragma unroll 4
              for (int k = 0; k < 16; ++k) { const int s = 2 * (sp + 4 * k); const size_t r0 = rowbase + s;
                  const float v0 = (V[r0 * 2048 + g * 128 + d] - ST[2 * r0]) * ST[2 * r0 + 1] * gg + bb, v1 = (V[(r0 + 1) * 2048 + g * 128 + d] - ST[2 * r0 + 2]) * ST[2 * r0 + 3] * gg + bb;
                  *(LAS unsigned*)(vt + d * 132 + s) = pk2(v0, v1); } }
            __syncthreads();
            f32x4 acc[2][4];
#pragma unroll
            for (int e = 0; e < 2; ++e)
#pragma unroll
                for (int mb = 0; mb < 4; ++mb) acc[e][mb] = (f32x4){0.f, 0.f, 0.f, 0.f};
#pragma unroll
            for (int ks = 0; ks < 4; ++ks) {
#pragma unroll
                for (int mb = 0; mb < 4; ++mb) { const LAS bf16* xp = vt + (16 * (4 * dh + mb) + fr) * 132 + 32 * ks + 8 * rq; const u32x2 lo = *(const LAS u32x2*)xp, hi = *(const LAS u32x2*)(xp + 4);
                    const bf16x8_t xf = __builtin_bit_cast(bf16x8_t, (u32x4){lo.x, lo.y, hi.x, hi.y});
                    if (ks < 2) { if (2 * ks <= ta) acc[0][mb] = MFMA16(xf, wf0[ks < 2 ? ks : 0], acc[0][mb]); }
                    if (2 * ks <= 7 - ta) acc[1][mb] = MFMA16(xf, wf1[ks], acc[1][mb]); } }
#pragma unroll
            for (int e = 0; e < 2; ++e) { const int t = 16 * (e ? 7 - ta : ta) + fr; const float bias = bs[g * 128 + t]; const size_t o = (size_t)(rowbase + t) * 2048 + g * 128 + 64 * dh + 4 * rq;
#pragma unroll
                for (int mb = 0; mb < 4; ++mb) { const u32x2 uu = *(const u32x2*)(U + o + 16 * mb); const f32x4 sv = acc[e][mb] + bias;
                    u32x2 wv; wv.x = pk2(sv.x * bf2f((bf16)(uu.x & 0xffff)), sv.y * bf2f((bf16)(uu.x >> 16))); wv.y = pk2(sv.z * bf2f((bf16)(uu.y & 0xffff)), sv.w * bf2f((bf16)(uu.y >> 16)));
                    *(u32x2*)(US + o + 16 * mb) = wv; } }
        } else {
            const int sb = unit - 2048, c0 = c.tid * 4, g = c0 >> 7;
            const f32x4 gg = *(const f32x4*)(lg + c0), bb = *(const f32x4*)(lb + c0);
            f32x4 vnr[4];
#pragma unroll
            for (int t = 0; t < 4; ++t) { const int row = MP + 4 * sb + t; const f32x4 v = *(const f32x4*)(V + (size_t)row * 2048 + c0); vnr[t] = (v - ST[2 * row]) * ST[2 * row + 1] * gg + bb; }
#pragma unroll
            for (int t = 0; t < 4; ++t) { const int row = MP + 4 * sb + t; f32x4 sv = {0.f, 0.f, 0.f, 0.f};
#pragma unroll
                for (int s = 0; s <= t; ++s) sv += vnr[s] * ws[((size_t)g * 128 + t) * 128 + s];
                sv += bs[g * 128 + t];
                const u32x2 uu = *(const u32x2*)(U + (size_t)row * 2048 + c0);
                f32x4 y; y.x = sv.x * bf2f((bf16)(uu.x & 0xffff)); y.y = sv.y * bf2f((bf16)(uu.x >> 16)); y.z = sv.z * bf2f((bf16)(uu.y & 0xffff)); y.w = sv.w * bf2f((bf16)(uu.y >> 16));
                u32x2 w; w.x = pk2(y.x, y.y); w.y = pk2(y.z, y.w); *(u32x2*)(US + (size_t)row * 2048 + c0) = w; }
        }
    }
}
__device__ __forceinline__ void gdn_prep_phase(const Ctx& c) {
    const float* PJ = WSF(WB_PROJ); const float* cw = c.in[I_BCONV]; const float* alog = c.in[I_BALOG]; const float* dtb = c.in[I_BDT];
    bf16* GW = WSB(WB_W); float* GUT = WSF(WB_U); bf16* GQG = WSB(WB_QG); bf16* GKDT = WSB(WB_KD); bf16* GQK = WSB(WB_QK); float* GEG = WSF(WB_EG);
    for (int unit = blockIdx.x; unit < 2048 + 1024; unit += c.G) {
        __syncthreads();
        LAS float* lb = (LAS float*)c.lds; asm volatile("" : "+v"(lb));
        LAS float* kf = lb; LAS float* vf = kf + 64 * 129; LAS float* Am = vf + 64 * 129; LAS float* gc = Am + 64 * 64; LAS float* bt = gc + 64;
        LAS bf16* kb = (LAS bf16*)(bt + 64); LAS bf16* qb = kb + 64 * 136;
        if (unit < 2048) {
            const int ci = unit & 63, h = (unit >> 6) & 7, b = unit >> 9, rb = b * SEQ + ci * 64;
            if (c.tid < 64) { const size_t row = rb + c.tid; const float bl = PJ[row * NBIN + 4096 + h], al = PJ[row * NBIN + 4104 + h];
                const float x = al + dtb[h]; const float sp = x > 20.f ? x : log1pf(expf(x)); float g = -expf(alog[h]) * sp;
#pragma unroll
                for (int o = 1; o < 64; o <<= 1) { const float t = __shfl_up(g, o); if (c.lane >= o) g += t; }
                gc[c.tid] = g; bt[c.tid] = sigmoid_f(bl); }
            __syncthreads();
            { const int tk0 = c.wave * 8, tabs0 = ci * 64 + tk0; const size_t row0 = rb + tk0;
              f32x2 xr[3][11], wv[3][4];
#pragma unroll
              for (int part = 0; part < 3; ++part) { const int ch = part * 1024 + h * 128 + 2 * c.lane;
#pragma unroll
                  for (int j = 0; j < 4; ++j) wv[part][j] = *(const f32x2*)(cw + j * 3072 + ch);
#pragma unroll
                  for (int r = 0; r < 11; ++r) xr[part][r] = (tabs0 - 3 + r >= 0) ? *(const f32x2*)(PJ + (row0 + r - 3) * NBIN + ch) : (f32x2){0.f, 0.f}; }
#pragma unroll
              for (int i = 0; i < 8; ++i) { const int tk = tk0 + i;
#pragma unroll
                  for (int part = 0; part < 3; ++part) { float a0 = 0.f, a1 = 0.f;
#pragma unroll
                      for (int j = 0; j < 4; ++j) { a0 += xr[part][i + j].x * wv[part][j].x; a1 += xr[part][i + j].y * wv[part][j].y; }
                      a0 = siluf(a0); a1 = siluf(a1);
                      if (part < 2) { const float ss = wave_sum(a0 * a0 + a1 * a1); const float sc = (1.f / sqrtf(ss + NORM_EPS)) * (part == 0 ? 0.08838834764831845f : 1.f); a0 *= sc; a1 *= sc; }
                      if (part == 0) { *(LAS unsigned*)(qb + tk * 136 + 2 * c.lane) = pk2(a0, a1); const float eg = expf(gc[tk]); *(unsigned*)(GQG + (size_t)unit * 8192 + tk * 128 + 2 * c.lane) = pk2(a0 * eg, a1 * eg); }
                      else if (part == 1) { *(LAS unsigned*)(kb + tk * 136 + 2 * c.lane) = pk2(a0, a1); kf[tk * 129 + 2 * c.lane] = a0; kf[tk * 129 + 2 * c.lane + 1] = a1; }
                      else { vf[tk * 129 + 2 * c.lane] = a0; vf[tk * 129 + 2 * c.lane + 1] = a1; } } } }
            __syncthreads();
            { const int fr = c.lane & 15, rq = c.lane >> 4;
#pragma unroll 1
              for (int bi = c.wave; bi < 16; bi += 8) {
                  const int mbj = bi < 10 ? (bi == 0 ? 0 : bi == 1 ? 0 : bi == 2 ? 1 : bi == 3 ? 0 : bi == 4 ? 1 : bi == 5 ? 2 : bi == 6 ? 0 : bi == 7 ? 1 : bi == 8 ? 2 : 3) : (bi == 10 ? 1 : bi == 11 ? 2 : bi == 12 ? 3 : bi == 13 ? 2 : bi == 14 ? 3 : 3);
                  const int nbi = bi < 10 ? (bi == 0 ? 0 : bi <= 2 ? 1 : bi <= 5 ? 2 : 3) : (bi <= 12 ? 0 : bi <= 14 ? 1 : 2);
                  const int i = 16 * nbi + fr, j0 = 16 * mbj + 4 * rq;
                  f32x4 akk = {0.f, 0.f, 0.f, 0.f}, aqk = {0.f, 0.f, 0.f, 0.f};
                  if (bi < 10) {
#pragma unroll
                      for (int ks = 0; ks < 4; ++ks) { const bf16x8_t xk = *(const LAS bf16x8_t*)(kb + (16 * mbj + fr) * 136 + 32 * ks + 8 * rq), yk = *(const LAS bf16x8_t*)(kb + i * 136 + 32 * ks + 8 * rq), yq = *(const LAS bf16x8_t*)(qb + i * 136 + 32 * ks + 8 * rq);
                          akk = MFMA16(xk, yk, akk); aqk = MFMA16(xk, yq, aqk); } }
                  const float gi = gc[i], bi_ = bt[i]; f32x4 av, qv;
#pragma unroll
                  for (int r = 0; r < 4; ++r) { const int j = j0 + r; const float dec = (i >= j) ? expf(gi - gc[j]) : 0.f; av[r] = (i > j) ? bi_ * akk[r] * dec : 0.f; qv[r] = (i >= j) ? aqk[r] * dec : 0.f; }
                  *(LAS f32x4*)(Am + i * 64 + j0) = av; u32x2 wv; wv.x = pk2(qv[0], qv[1]); wv.y = pk2(qv[2], qv[3]); *(u32x2*)(GQK + ((size_t)unit * 64 + i) * 64 + j0) = wv; } }
            __syncthreads();
            if (c.tid < 256) { const bool isw = c.tid >= 128; const int cc = c.tid & 127; float x[64];
#pragma unroll
                for (int i = 0; i < 64; ++i) x[i] = 0.f;
#pragma unroll
                for (int i = 0; i < 64; ++i) { float r = isw ? kf[i * 129 + cc] * bt[i] * expf(gc[i]) : vf[i * 129 + cc] * bt[i];
#pragma unroll
                    for (int j4 = 0; j4 < (i + 3) / 4; ++j4) { const f32x4 a4 = *(const LAS f32x4*)(Am + i * 64 + 4 * j4); r -= (a4.x * x[4 * j4] + a4.y * x[4 * j4 + 1]) + (a4.z * x[4 * j4 + 2] + a4.w * x[4 * j4 + 3]); }
                    x[i] = r; if (isw) GW[((size_t)unit * 64 + i) * 128 + cc] = (bf16)f2bf(r); }
                if (!isw) { float* dst = GUT + ((size_t)unit * 128 + cc) * 64;
#pragma unroll
                    for (int k = 0; k < 16; ++k) *(f32x4*)(dst + 4 * k) = (f32x4){x[4 * k], x[4 * k + 1], x[4 * k + 2], x[4 * k + 3]}; } }
            for (int idx = c.tid; idx < 1024; idx += 512) { const int dk = idx & 127, ch = idx >> 7; const float gl = gc[63]; unsigned e[4];
#pragma unroll
                for (int k = 0; k < 4; ++k) { const int c0 = 8 * ch + 2 * k; e[k] = pk2(kf[c0 * 129 + dk] * expf(gl - gc[c0]), kf[(c0 + 1) * 129 + dk] * expf(gl - gc[c0 + 1])); }
                *(u32x4*)(GKDT + (size_t)unit * 8192 + dk * 64 + 8 * ch) = (u32x4){e[0], e[1], e[2], e[3]}; }
            if (c.tid == 0) GEG[unit] = expf(gc[63]);
        } else {
            const int su = unit - 2048, h = su & 7, b = su >> 3;
            LAS float* q4 = lb; LAS float* k4 = q4 + 512; LAS float* v4 = k4 + 512; LAS float* red = v4 + 512; LAS float* o4 = red + 512; LAS float* g4 = o4 + 512; LAS float* b4 = g4 + 4;
            const float* cst = c.in[I_GCONV] + (size_t)b * 3 * 3072;
            { const int t = c.tid >> 7, chl = c.tid & 127;
#pragma unroll
              for (int part = 0; part < 3; ++part) { const int ch = part * 1024 + h * 128 + chl; float a = 0.f;
#pragma unroll
                  for (int j = 0; j < 4; ++j) { const int mm = t + j; const float x = mm < 3 ? cst[mm * 3072 + ch] : PJ[(size_t)(MP + 4 * b + mm - 3) * NBIN + ch]; a += x * cw[j * 3072 + ch]; }
                  (part == 0 ? q4 : (part == 1 ? k4 : v4))[t * 128 + chl] = siluf(a); }
              if (c.tid < 4) { const size_t row = MP + 4 * b + c.tid; const float bl = PJ[row * NBIN + 4096 + h], al = PJ[row * NBIN + 4104 + h];
                  const float x = al + dtb[h]; const float sp = x > 20.f ? x : log1pf(expf(x)); g4[c.tid] = -expf(alog[h]) * sp; b4[c.tid] = sigmoid_f(bl); } }
            __syncthreads();
            { const int t = c.tid >> 7, chl = c.tid & 127; float sq = 0.f, sk = 0.f;
              for (int d = 0; d < 128; ++d) { const float a = q4[t * 128 + d], bb = k4[t * 128 + d]; sq += a * a; sk += bb * bb; }
              const float qv = q4[t * 128 + chl] * (1.f / sqrtf(sq + NORM_EPS)) * 0.08838834764831845f, kv = k4[t * 128 + chl] * (1.f / sqrtf(sk + NORM_EPS));
              __syncthreads();
              q4[t * 128 + chl] = qv; k4[t * 128 + chl] = kv; }
            __syncthreads();
            const int dv = c.tid & 127, part = c.tid >> 7;
            float S[32];
            const float* S0 = c.in[I_GS] + (((size_t)b * 8 + h) * 128 + part * 32) * 128 + dv;
#pragma unroll
            for (int i = 0; i < 32; ++i) S[i] = S0[(size_t)i * 128];
#pragma unroll 1
            for (int t = 0; t < 4; ++t) { const float a = expf(g4[t]); float p = 0.f;
#pragma unroll
                for (int i = 0; i < 32; ++i) p += k4[t * 128 + part * 32 + i] * S[i];
                red[part * 128 + dv] = p; __syncthreads();
                const float kS = (red[dv] + red[128 + dv]) + (red[256 + dv] + red[384 + dv]); const float vnew = b4[t] * (v4[t * 128 + dv] - a * kS); float po = 0.f;
#pragma unroll
                for (int i = 0; i < 32; ++i) { S[i] = a * S[i] + k4[t * 128 + part * 32 + i] * vnew; po += q4[t * 128 + part * 32 + i] * S[i]; }
                __syncthreads(); red[part * 128 + dv] = po; __syncthreads();
                if (part == 0) o4[t * 128 + dv] = (red[dv] + red[128 + dv]) + (red[256 + dv] + red[384 + dv]);
                __syncthreads(); }
            float* So = c.out + O_GSS + (((size_t)b * 8 + h) * 128 + part * 32) * 128 + dv;
#pragma unroll
            for (int i = 0; i < 32; ++i) So[(size_t)i * 128] = S[i];
            { const int t = c.tid >> 7; float ms = 0.f;
              for (int d = 0; d < 128; ++d) { const float o = o4[t * 128 + d]; ms += o * o; }
              const size_t row = MP + 4 * b + t; const float z = PJ[row * NBIN + 3072 + h * 128 + dv];
              const float y = o4[t * 128 + dv] * (1.f / sqrtf(ms * (1.f / 128.f) + NORM_EPS)) * c.in[I_BNG][dv] * siluf(z);
              WSB(WB_OG)[row * 1024 + h * 128 + dv] = (bf16)f2bf(y); }
        }
    }
    for (size_t idx = (size_t)blockIdx.x * 512 + c.tid; idx < 36864 + 1179648; idx += (size_t)c.G * 512) {
        if (idx < 36864) { const int b = (int)(idx / 9216), r = (int)(idx % 9216), j = r / 3072, ch = r % 3072; c.out[O_GCP + idx] = PJ[((size_t)b * SEQ + SEQ - 3 + j) * NBIN + ch]; }
        else { const size_t k = idx - 36864; const int b = (int)(k / 9216), r = (int)(k % 9216), j = r / 3072, ch = r % 3072; c.out[O_GCS + k] = PJ[((size_t)MP + 4 * b + 1 + j) * NBIN + ch]; }
    }
}
struct ScanFr { bf16x8_t a4[4], b2[2], kd[2]; f32x4 u; float eg; };
__device__ __forceinline__ void scan_load(ScanFr& f, const bf16* GW, const bf16* GQG, const bf16* GKDT, const bf16* GQK, const float* GUT, const float* GEG, size_t pu, int w, int fr, int rq, int dvs) {
    const int mb = w & 3; const bf16* a = (w < 4 ? GW : GQG) + pu * 8192 + (16 * mb + fr) * 128 + 8 * rq;
#pragma unroll
    for (int ks = 0; ks < 4; ++ks) f.a4[ks] = *(const bf16x8_t*)(a + 32 * ks);
    const bf16* q = GQK + pu * 4096 + (16 * mb + fr) * 64 + 8 * rq; f.b2[0] = *(const bf16x8_t*)q; f.b2[1] = *(const bf16x8_t*)(q + 32);
    const bf16* k = GKDT + pu * 8192 + (16 * w + fr) * 64 + 8 * rq; f.kd[0] = *(const bf16x8_t*)k; f.kd[1] = *(const bf16x8_t*)(k + 32);
    f.u = *(const f32x4*)(GUT + (pu * 128 + dvs * 16 + fr) * 64 + 16 * mb + 4 * rq); f.eg = GEG[pu];
}
__device__ __forceinline__ void gdn_scan_phase(const Ctx& c) {
    const bf16* GW = WSB(WB_W); const float* GUT = WSF(WB_U); const bf16* GQG = WSB(WB_QG); const bf16* GKDT = WSB(WB_KD); const bf16* GQK = WSB(WB_QK); const float* GEG = WSF(WB_EG);
    float* GO = WSF(WB_O);
    for (int uu = blockIdx.x; uu < 256; uu += c.G) {
        LAS unsigned char* L = c.lds; asm volatile("" : "+v"(L));
        LAS bf16* ST = (LAS bf16*)L; LAS bf16* VNT = ST + 16 * 136;
        const int bh = (uu & 7) * 4 + (uu >> 6), dvs = (uu >> 3) & 7, b = bh >> 3, h = bh & 7;
        const int w = c.wave, fr = c.lane & 15, rq = c.lane >> 4, mb = w & 3;
        __syncthreads();
        for (int i = c.tid; i < 16 * 136 / 2; i += 512) ((LAS unsigned*)ST)[i] = 0u;
        f32x4 Sacc = {0.f, 0.f, 0.f, 0.f};
        ScanFr cur, nxt; scan_load(cur, GW, GQG, GKDT, GQK, GUT, GEG, (size_t)bh * 64, w, fr, rq, dvs);
        for (int ci = 0; ci < 64; ++ci) {
            const size_t pu = (size_t)bh * 64 + ci;
            if (ci < 63) scan_load(nxt, GW, GQG, GKDT, GQK, GUT, GEG, pu + 1, w, fr, rq, dvs);
            __syncthreads();
            f32x4 acc = {0.f, 0.f, 0.f, 0.f};
#pragma unroll
            for (int ks = 0; ks < 4; ++ks) { const bf16x8_t y = *(const LAS bf16x8_t*)(ST + fr * 136 + 32 * ks + 8 * rq); acc = MFMA16(cur.a4[ks], y, acc); }
            if (w < 4) { const f32x4 vn = cur.u - acc; u32x2 wv; wv.x = pk2(vn[0], vn[1]); wv.y = pk2(vn[2], vn[3]); *(LAS u32x2*)(VNT + fr * 72 + 16 * mb + 4 * rq) = wv; }
            __syncthreads();
            const bf16x8_t y0 = *(const LAS bf16x8_t*)(VNT + fr * 72 + 8 * rq), y1 = *(const LAS bf16x8_t*)(VNT + fr * 72 + 32 + 8 * rq);
            if (w >= 4) { acc = MFMA16(cur.b2[0], y0, acc); acc = MFMA16(cur.b2[1], y1, acc);
                float* o = GO + ((size_t)b * SEQ + ci * 64 + 16 * mb + 4 * rq) * 1024 + h * 128 + dvs * 16 + fr;
#pragma unroll
                for (int i = 0; i < 4; ++i) o[(size_t)i * 1024] = acc[i]; }
            Sacc *= cur.eg; Sacc = MFMA16(cur.kd[0], y0, Sacc); Sacc = MFMA16(cur.kd[1], y1, Sacc);
            { u32x2 wv; wv.x = pk2(Sacc[0], Sacc[1]); wv.y = pk2(Sacc[2], Sacc[3]); *(LAS u32x2*)(ST + fr * 136 + 16 * w + 4 * rq) = wv; }
            cur = nxt;
        }
#pragma unroll
        for (int i = 0; i < 4; ++i) c.out[O_GSP + (((size_t)b * 8 + h) * 128 + 16 * w + 4 * rq + i) * 128 + dvs * 16 + fr] = Sacc[i];
    }
}
__device__ __forceinline__ void gdn_post_phase(const Ctx& c) {
    const float* GO = WSF(WB_O); const float* PJ = WSF(WB_PROJ); const float* ng = c.in[I_BNG];
    for (int row = c.gw; row < MP; row += c.NGW) {
        const f32x4* p = (const f32x4*)(GO + (size_t)row * 1024 + c.lane * 16); f32x4 v[4]; float s = 0.f;
#pragma unroll
        for (int j = 0; j < 4; ++j) { v[j] = p[j]; s += (v[j].x * v[j].x + v[j].y * v[j].y) + (v[j].z * v[j].z + v[j].w * v[j].w); }
        s += __shfl_xor(s, 1); s += __shfl_xor(s, 2); s += __shfl_xor(s, 4);
        const float r = 1.f / sqrtf(s * (1.f / 128.f) + NORM_EPS);
        const f32x4* zp = (const f32x4*)(PJ + (size_t)row * NBIN + 3072 + c.lane * 16); const f32x4* gp = (const f32x4*)(ng + (c.lane & 7) * 16);
        u32x2* op = (u32x2*)(WSB(WB_OG) + (size_t)row * 1024 + c.lane * 16);
#pragma unroll
        for (int j = 0; j < 4; ++j) { const f32x4 z = zp[j], g = gp[j]; f32x4 y; y.x = v[j].x * r * g.x * siluf(z.x); y.y = v[j].y * r * g.y * siluf(z.y); y.z = v[j].z * r * g.z * siluf(z.z); y.w = v[j].w * r * g.w * siluf(z.w);
            u32x2 w; w.x = pk2(y.x, y.y); w.y = pk2(y.z, y.w); op[j] = w; }
    }
}
__device__ const unsigned char T5_LUT[128] = {0, 1, 2, 3, 4, 5, 6, 7, 8, 9, 10, 11, 12, 13, 14, 15, 16, 16, 16, 17, 17, 18, 18, 18, 19, 19, 19, 20, 20, 20, 20, 21, 21, 21, 21, 22, 22, 22, 22, 22, 23, 23, 23, 23, 23, 23, 24, 24, 24, 24, 24, 24, 25, 25, 25, 25, 25, 25, 25, 26, 26, 26, 26, 26, 26, 26, 26, 27, 27, 27, 27, 27, 27, 27, 27, 27, 27, 28, 28, 28, 28, 28, 28, 28, 28, 28, 28, 29, 29, 29, 29, 29, 29, 29, 29, 29, 29, 29, 29, 30, 30, 30, 30, 30, 30, 30, 30, 30, 30, 30, 30, 30, 30, 31, 31, 31, 31, 31, 31, 31, 31, 31, 31, 31, 31, 31, 31, 31};
__device__ __forceinline__ void nsa_prep_phase(const Ctx& c) {
    const float* PJ = WSF(WC_PROJ);
    for (size_t i4 = (size_t)blockIdx.x * 512 + c.tid; i4 < (size_t)M * 256; i4 += (size_t)c.G * 512) { const size_t row = i4 >> 8; const int c4 = (int)(i4 & 255);
        const f32x4 v = *(const f32x4*)(PJ + row * NCIN + 1024 + c4 * 4);
        if (row < MP) *(f32x4*)(c.out + O_KVP + row * 1024 + c4 * 4) = v; else *(f32x4*)(c.out + O_KVS + (row - MP) * 1024 + c4 * 4) = v; }
    for (size_t i4 = (size_t)blockIdx.x * 512 + c.tid; i4 < (size_t)(2048 + MS) * 128; i4 += (size_t)c.G * 512) { const size_t r = i4 >> 7; const int c4 = (int)(i4 & 127);
        const size_t row = r < 2048 ? (r >> 9) * SEQ + (SEQ - 512) + (r & 511) : MP + (r - 2048);
        const f32x4 v = *(const f32x4*)(PJ + row * NCIN + 2048 + c4 * 4);
        if (r < 2048) *(f32x4*)(c.out + O_WINP + r * 512 + c4 * 4) = v; else *(f32x4*)(c.out + O_WINS + (r - 2048) * 512 + c4 * 4) = v; }
    { LAS bf16* vt = (LAS bf16*)c.lds;
      bf16* KSB = WSB(WC_KSB); bf16* VST = WSB(WC_VST); bf16* KWB = WSB(WC_KWB); bf16* VWT = WSB(WC_VWT);
      for (int u = blockIdx.x; u < 256; u += c.G) { const int b = u >> 6, tb = u & 63; const size_t row0 = (size_t)b * SEQ + 64 * tb;
          __syncthreads();
          for (int idx = c.tid; idx < 64 * 256; idx += 512) { const int t = idx >> 8, q = idx & 255, sect = q >> 6, c4 = q & 63;
              const f32x4 v = *(const f32x4*)(PJ + (row0 + t) * NCIN + 1536 + sect * 256 + c4 * 4); u32x2 w; w.x = pk2(v.x, v.y); w.y = pk2(v.z, v.w);
              const int g = c4 >> 4, d = (c4 & 15) * 4;
              if (sect == 0) *(u32x2*)(KSB + (((size_t)(b * 4 + g) * SEQ + 64 * tb + t) * 64 + d)) = w;
              else if (sect == 2) *(u32x2*)(KWB + (((size_t)(b * 4 + g) * SEQ + 64 * tb + t) * 64 + d)) = w;
              else *(LAS u32x2*)(vt + t * 520 + (sect == 1 ? 0 : 256) + c4 * 4) = w; }
          __syncthreads();
          for (int idx = c.tid; idx < 512 * 8; idx += 512) { const int col = idx >> 3, ch = idx & 7; unsigned short e[8];
#pragma unroll
              for (int k = 0; k < 8; ++k) e[k] = vt[(8 * ch + k) * 520 + col];
              u32x4 w; w.x = e[0] | ((unsigned)e[1] << 16); w.y = e[2] | ((unsigned)e[3] << 16); w.z = e[4] | ((unsigned)e[5] << 16); w.w = e[6] | ((unsigned)e[7] << 16);
              const int cc = col & 255, g = cc >> 6, d = cc & 63; bf16* dst = (col < 256 ? VST : VWT) + ((size_t)(b * 4 + g) * 64 + d) * SEQ + 64 * tb + 8 * ch;
              *(u32x4*)dst = w; } }
      __syncthreads(); }
    bf16* AC = WSB(WC_ACMP); const float* pe = c.in[I_CPE]; const int* pt = (const int*)c.in[I_PT]; const float* ckv = c.in[I_CKV];
    for (int R = c.gw; R < 2 * CMP_ROWS; R += c.NGW) {
        const int which = R >= CMP_ROWS ? 1 : 0, r = R - which * CMP_ROWS;
        const float* src; size_t lstride;
        if (r < 2048) { const int g = r & 3, n = (r >> 2) & 127, b = r >> 9; src = PJ + ((size_t)b * SEQ + 32 * n) * NCIN + 1024 + which * 256 + g * 64; lstride = NCIN; }
        else { const int q = r - 2048, g = q & 3, n = (q >> 2) & 63, b = q >> 8; const int page = pt[b * 16 + (n >> 2)];
            src = ckv + (((size_t)page * 128 + (n & 3) * 32) * 16 + which * 4 + g) * 64; lstride = 1024; }
#pragma unroll
        for (int k = 0; k < 8; ++k) { const int idx = c.lane + 64 * k, l = idx >> 4, d4 = idx & 15;
            const f32x4 v = *(const f32x4*)(src + (size_t)l * lstride + d4 * 4) + *(const f32x4*)(pe + (which * 32 + l) * 64 + d4 * 4);
            u32x2 w; w.x = pk2(v.x, v.y); w.y = pk2(v.z, v.w); *(u32x2*)(AC + (size_t)R * 2048 + l * 64 + d4 * 4) = w; }
    }
}
__device__ __forceinline__ void nsa_cmp2_phase(const Ctx& c) {
    LAS float* w2 = (LAS float*)c.lds;
    __syncthreads();
    for (int i = c.tid; i < 2 * 256 * 64 / 4; i += 512) *(LAS f32x4*)(w2 + 4 * i) = *((const f32x4*)c.in[I_CW2] + i);
    __syncthreads();
    const bf16* HC = WSB(WC_HC); float* KCV = WSF(WC_KCV);
    for (int R = c.gw; R < 2 * CMP_ROWS; R += c.NGW) {
        const LAS float* w = w2 + (R >= CMP_ROWS ? 256 * 64 : 0) + c.lane; const u32x4* hp = (const u32x4*)(HC + (size_t)R * 256); float a = 0.f;
#pragma unroll 4
        for (int k8 = 0; k8 < 32; ++k8) { const u32x4 hv = hp[k8]; const unsigned hw[4] = {hv.x, hv.y, hv.z, hv.w};
#pragma unroll
            for (int j = 0; j < 4; ++j) { a += bf2f((bf16)(hw[j] & 0xffff)) * w[(8 * k8 + 2 * j) * 64]; a += bf2f((bf16)(hw[j] >> 16)) * w[(8 * k8 + 2 * j + 1) * 64]; } }
        KCV[(size_t)R * 64 + c.lane] = a;
        { const int which = R >= CMP_ROWS ? 1 : 0, r = R - which * CMP_ROWS;
          if (r < 2048) { const int g = r & 3, n = (r >> 2) & 127, b = r >> 9; if (which == 0) WSB(WC_KCB)[((size_t)(b * 4 + g) * 128 + n) * 64 + c.lane] = (bf16)f2bf(a); else WSB(WC_VCT)[((size_t)(b * 4 + g) * 64 + c.lane) * 128 + n] = (bf16)f2bf(a); } }
    }
}
struct AttSt { float m[4], l[4]; f32x4 o[4]; };
__device__ __forceinline__ void att_reset(AttSt& s) {
#pragma unroll
    for (int h = 0; h < 4; ++h) { s.m[h] = -1e30f; s.l[h] = 0.f; s.o[h] = (f32x4){0.f, 0.f, 0.f, 0.f}; } }
__device__ __forceinline__ void att_scores(const LAS float* qs, const LAS float* tabl, const float* kptr, bool valid, int dist, int g, float (&s)[4]) {
    const f32x4* kp = (const f32x4*)kptr;
    f32x4 kv[16];
#pragma unroll
    for (int u = 0; u < 16; ++u) kv[u] = kp[u];
    float s0 = 0.f, s1 = 0.f, s2 = 0.f, s3 = 0.f;
#pragma unroll 1
    for (int h = 0; h < 4; ++h) {
        float a = 0.f;
#pragma unroll
        for (int u = 0; u < 16; ++u) { const f32x4 q = *(const LAS f32x4*)(qs + h * 64 + u * 4); a += (q.x * kv[u].x + q.y * kv[u].y) + (q.z * kv[u].z + q.w * kv[u].w); }
        s0 = h == 0 ? a : s0; s1 = h == 1 ? a : s1; s2 = h == 2 ? a : s2; s3 = h == 3 ? a : s3; }
    s[0] = s0; s[1] = s1; s[2] = s2; s[3] = s3;
    const int dd = dist < 0 ? 0 : dist; const int bk = dd < 128 ? (int)T5_LUT[dd] : 31;
    const f32x4 bias = *(const LAS f32x4*)(tabl + bk * 16 + g * 4);
#pragma unroll
    for (int h = 0; h < 4; ++h) s[h] = valid ? s[h] + bias[h] : -1e30f;
}
__device__ __forceinline__ void att_pv(AttSt& st, LAS f32x4* P, LAS unsigned long long* R, const float (&p)[4], const float* rowp, int voff, int lane) {
    P[lane] = (f32x4){p[0], p[1], p[2], p[3]}; R[lane] = (unsigned long long)rowp;
    LDS_WAIT();
#pragma unroll
    for (int i = 0; i < 16; ++i) { const int key = 4 * i + (lane >> 4); const f32x4 p4 = P[key]; const float* rp = (const float*)R[key];
        const f32x4 v = *(const f32x4*)(rp + voff + (lane & 15) * 4);
        st.o[0] += v * p4.x; st.o[1] += v * p4.y; st.o[2] += v * p4.z; st.o[3] += v * p4.w; }
    LDS_WAIT();
}
__device__ __forceinline__ void att_block(AttSt& st, const LAS float* qs, const LAS float* tabl, LAS f32x4* P, LAS unsigned long long* R, const float* kptr, const float* safe, bool valid, int dist, int voff, int g, int lane) {
    const float* rowp = valid ? kptr : safe; float s[4], p[4];
    att_scores(qs, tabl, rowp, valid, dist, g, s);
#pragma unroll
    for (int h = 0; h < 4; ++h) { const float mx = wave_max(s[h]), mn = fmaxf(st.m[h], mx), sc = __expf(st.m[h] - mn); p[h] = valid ? __expf(s[h] - mn) : 0.f;
        st.l[h] = st.l[h] * sc + wave_sum(p[h]); st.o[h] *= sc; st.m[h] = mn; }
    att_pv(st, P, R, p, rowp, voff, lane);
}
__device__ __forceinline__ void att_finish(AttSt& st, const float (&gate)[4], f32x4 (&acc)[4]) {
#pragma unroll
    for (int h = 0; h < 4; ++h) { f32x4 o = st.o[h];
#pragma unroll
        for (int k = 0; k < 4; ++k) { o[k] += __shfl_xor(o[k], 16); o[k] += __shfl_xor(o[k], 32); }
        const float inv = st.l[h] > 0.f ? gate[h] / st.l[h] : 0.f; acc[h] += o * inv; }
}
__device__ __forceinline__ void nsa_attn_phase(const Ctx& c, const int item0) {
    LAS float* tabl = (LAS float*)c.lds;
    LAS float* qs = tabl + 512 + c.wave * 768;
    LAS f32x4* P = (LAS f32x4*)(qs + 256); LAS unsigned long long* R = (LAS unsigned long long*)(qs + 512); LAS float* pcs = qs + 640;
    __syncthreads();
    for (int i = c.tid; i < 512; i += 512) tabl[i] = c.in[I_T5][i];
    __syncthreads();
    const float* PJ = WSF(WC_PROJ); const float* KCV = WSF(WC_KCV); const float* gb = c.in[I_CGB]; const int* pt = (const int*)c.in[I_PT]; const float* ckv = c.in[I_CKV]; const float* cwin = c.in[I_CWIN];
    bf16* OA = WSB(WC_OA);
    for (int item = item0 + c.gw; item < 65536 + 2048; item += c.NGW) {
        int lane = c.lane; asm volatile("" : "+v"(lane));
        const bool smp = item >= 65536; int b, g, t, qpos, ncmp, nslc; size_t row;
        if (!smp) { g = item & 3; b = (item >> 2) & 3; t = item >> 4; qpos = t; row = (size_t)b * SEQ + t; ncmp = 128; nslc = 64; }
        else { const int q = item - 65536; g = q & 3; t = (q >> 2) & 3; b = q >> 4; qpos = 2048 + t; row = (size_t)MP + 4 * b + t; ncmp = 64; nslc = 33; }
        const float* qrow = PJ + row * NCIN;
        { const f32x4 qv = *(const f32x4*)(qrow + g * 256 + lane * 4); *(LAS f32x4*)(qs + lane * 4) = qv * 0.125f; }
        float gv = 0.f; if (lane < 12) { const int gi = (lane >> 2) * 16 + g * 4 + (lane & 3); gv = sigmoid_f(qrow[2560 + gi] + gb[gi]); }
        float gate_c[4], gate_s[4], gate_w[4];
#pragma unroll
        for (int h = 0; h < 4; ++h) { gate_c[h] = readlane_f(gv, h); gate_s[h] = readlane_f(gv, 4 + h); gate_w[h] = readlane_f(gv, 8 + h); }
        LDS_WAIT();
        f32x4 acc[4];
#pragma unroll
        for (int h = 0; h < 4; ++h) acc[h] = (f32x4){0.f, 0.f, 0.f, 0.f};
        AttSt st;
        float ps;
        { const size_t kc0 = smp ? (size_t)2048 + ((size_t)b * 64) * 4 + g : ((size_t)b * 128) * 4 + g;
          const float* safe = KCV; float s0[4], s1[4];
          const int n0 = lane, n1 = lane + 64; const int d0 = qpos - (32 * n0 + 31), d1 = qpos - (32 * n1 + 31);
          const bool v0 = n0 < ncmp && d0 >= 0, v1 = n1 < ncmp && d1 >= 0;
          const float* k0p = v0 ? KCV + (kc0 + 4 * (size_t)n0) * 64 : safe; const float* k1p = v1 ? KCV + (kc0 + 4 * (size_t)n1) * 64 : safe;
          att_scores(qs, tabl, k0p, v0, d0, g, s0); att_scores(qs, tabl, k1p, v1, d1, g, s1);
          att_reset(st); float p0[4], p1[4], pc0 = 0.f, pc1 = 0.f;
#pragma unroll
          for (int h = 0; h < 4; ++h) { const float mx = wave_max(fmaxf(s0[h], s1[h])); p0[h] = v0 ? __expf(s0[h] - mx) : 0.f; p1[h] = v1 ? __expf(s1[h] - mx) : 0.f;
              const float l = wave_sum(p0[h] + p1[h]); const float inv = l > 0.f ? 1.f / l : 0.f; p0[h] *= inv; p1[h] *= inv; pc0 += p0[h]; pc1 += p1[h]; st.l[h] = l > 0.f ? 1.f : 0.f; }
          att_pv(st, P, R, p0, k0p, CMP_ROWS * 64, lane); att_pv(st, P, R, p1, k1p, CMP_ROWS * 64, lane);
          att_finish(st, gate_c, acc);
          pcs[lane] = pc0; pcs[64 + lane] = pc1; LDS_WAIT();
          ps = (2 * lane + 1 < ncmp) ? pcs[2 * lane] + pcs[2 * lane + 1] : 0.f; LDS_WAIT(); }
        const int jq = qpos >> 6; unsigned long long sel;
        { const bool forced = (lane == 0) || (lane == jq) || (lane == jq - 1);
          float sc = forced ? 100.f : (lane > jq ? -1.f : ps); if (lane >= nslc) sc = -__builtin_inff();
          int cnt = 0;
#pragma unroll 4
          for (int k = 0; k < 64; ++k) { const float sk = readlane_f(sc, k); cnt += (sk > sc || (sk == sc && k < lane)) ? 1 : 0; }
          sel = __ballot(cnt < 16); }
        att_reset(st);
        { const float* safe = qrow + 1536;
          unsigned long long todo = sel & (jq >= 63 ? ~0ull : ((1ull << (jq + 1)) - 1ull));
          while (todo) { const int j = __builtin_ctzll(todo); todo &= todo - 1ull;
              const int kpos = 64 * j + lane; const bool valid = kpos <= qpos; const float* kptr;
              if (!smp) kptr = PJ + ((size_t)b * SEQ + kpos) * NCIN + 1536 + g * 64;
              else if (j < 32) { const int page = pt[b * 16 + (j >> 1)]; kptr = ckv + (((size_t)page * 128 + (j & 1) * 64 + lane) * 16 + 8 + g) * 64; }
              else kptr = PJ + ((size_t)MP + 4 * b + (lane & 3)) * NCIN + 1536 + g * 64;
              att_block(st, qs, tabl, P, R, kptr, safe, valid, qpos - kpos, 256, g, lane); } }
        att_finish(st, gate_s, acc);
        att_reset(st);
        { const float* safe = qrow + 2048;
          for (int cb = 0; cb < 8; ++cb) { const int kpos = qpos - 511 + 64 * cb + lane; if (qpos - 511 + 64 * cb + 63 < 0) continue;
              const bool valid = kpos >= 0; const float* kptr;
              if (!smp) kptr = PJ + ((size_t)b * SEQ + (valid ? kpos : 0)) * NCIN + 2048 + g * 64;
              else if (kpos < 2048) kptr = cwin + (((size_t)b * 512 + (kpos - 1536)) * 2) * 256 + g * 64;
              else kptr = PJ + ((size_t)MP + 4 * b + (kpos - 2048)) * NCIN + 2048 + g * 64;
              att_block(st, qs, tabl, P, R, kptr, safe, valid, qpos - kpos, 256, g, lane); } }
        att_finish(st, gate_w, acc);
        if (lane < 16) {
#pragma unroll
            for (int h = 0; h < 4; ++h) { u32x2 w; w.x = pk2(acc[h].x, acc[h].y); w.y = pk2(acc[h].z, acc[h].w); *(u32x2*)(OA + row * 1024 + (g * 4 + h) * 64 + lane * 4) = w; } }
    }
}
constexpr int AT_ROWB = 144;
constexpr int AT_KB = 0, AT_VB = 2 * 64 * AT_ROWB, AT_PS = 4 * 64 * AT_ROWB, AT_SEL = AT_PS + 4 * 64 * 64 * 4, AT_BIAS = AT_SEL + 512, AT_END = AT_BIAS + 16 * 128 * 4;
static_assert(AT_END <= MISC_OFF, "attention LDS map");
struct AtRegs { u32x4 k, v; };
__device__ __forceinline__ AtRegs at_load(const bf16* kbase, const bf16* vbase, int vpitch, int tid) {
    AtRegs r; r.k = *(const u32x4*)(kbase + tid * 8); r.v = *(const u32x4*)(vbase + (size_t)(tid >> 3) * vpitch + (tid & 7) * 8); return r; }
__device__ __forceinline__ void at_store(LAS unsigned char* L, int buf, const AtRegs& r, int tid) {
    *(LAS u32x4*)(L + AT_KB + buf * 64 * AT_ROWB + (tid >> 3) * AT_ROWB + (tid & 7) * 16) = r.k; *(LAS u32x4*)(L + AT_VB + buf * 64 * AT_ROWB + (tid >> 3) * AT_ROWB + (tid & 7) * 16) = r.v; }
__device__ __forceinline__ void at_qk(LAS unsigned char* L, int buf, const bf16x8_t (&qf)[2][2], f32x4 (&st)[4][2], int fr, int rq) {
#pragma unroll
    for (int mb = 0; mb < 4; ++mb) { st[mb][0] = (f32x4){0.f, 0.f, 0.f, 0.f}; st[mb][1] = (f32x4){0.f, 0.f, 0.f, 0.f}; }
#pragma unroll
    for (int s = 0; s < 2; ++s)
#pragma unroll
        for (int mb = 0; mb < 4; ++mb) { const bf16x8_t kf = *(const LAS bf16x8_t*)(L + AT_KB + buf * 64 * AT_ROWB + (16 * mb + fr) * AT_ROWB + (32 * s + 8 * rq) * 2);
            st[mb][0] = MFMA16(kf, qf[0][s], st[mb][0]); st[mb][1] = MFMA16(kf, qf[1][s], st[mb][1]); }
}
__device__ __forceinline__ void at_pv(LAS unsigned char* L, int buf, const f32x4 (&st)[4][2], f32x4 (&ot)[4][2], int fr, int rq) {
#pragma unroll
    for (int s = 0; s < 2; ++s) { bf16x8_t pf[2];
#pragma unroll
        for (int nb = 0; nb < 2; ++nb) { u32x4 w; w.x = pk2(st[2 * s][nb].x, st[2 * s][nb].y); w.y = pk2(st[2 * s][nb].z, st[2 * s][nb].w); w.z = pk2(st[2 * s + 1][nb].x, st[2 * s + 1][nb].y); w.w = pk2(st[2 * s + 1][nb].z, st[2 * s + 1][nb].w);
            pf[nb] = __builtin_bit_cast(bf16x8_t, w); }
#pragma unroll
        for (int mb = 0; mb < 4; ++mb) { const LAS unsigned char* vp = L + AT_VB + buf * 64 * AT_ROWB + (16 * mb + fr) * AT_ROWB + (32 * s + 4 * rq) * 2;
            u32x4 w; const u32x2 lo = *(const LAS u32x2*)vp, hi = *(const LAS u32x2*)(vp + 32); w.x = lo.x; w.y = lo.y; w.z = hi.x; w.w = hi.y; const bf16x8_t vf = __builtin_bit_cast(bf16x8_t, w);
            ot[mb][0] = MFMA16(vf, pf[0], ot[mb][0]); ot[mb][1] = MFMA16(vf, pf[1], ot[mb][1]); } }
}
template <int MODE> __device__ __forceinline__ void at_softmax(f32x4 (&st)[4][2], f32x4 (&ot)[4][2], float (&m)[2], float (&l)[2], const bool (&rowok)[2], float cb, const LAS float* bias_h, int dist0  , int wlim) {
#pragma unroll
    for (int nb = 0; nb < 2; ++nb) { float mx = -1e30f;
#pragma unroll
        for (int mb = 0; mb < 4; ++mb)
#pragma unroll
            for (int i = 0; i < 4; ++i) { float s;
                if (MODE == 0) s = rowok[nb] ? st[mb][nb][i] + cb : -1e30f;
                else { const int dist = dist0 + 16 * nb - 16 * mb - i; const bool ok = rowok[nb] && dist >= 0 && dist < wlim; const int dd = dist < 0 ? 0 : (dist > 127 ? 127 : dist); const float bv = bias_h[dd]; s = ok ? st[mb][nb][i] + bv : -1e30f; }
                st[mb][nb][i] = s; mx = fmaxf(mx, s); }
        mx = fmaxf(mx, __shfl_xor(mx, 16)); mx = fmaxf(mx, __shfl_xor(mx, 32));
        const float mn = fmaxf(m[nb], mx), sc = __expf(m[nb] - mn); float ls = 0.f;
#pragma unroll
        for (int mb = 0; mb < 4; ++mb)
#pragma unroll
            for (int i = 0; i < 4; ++i) { const float s = st[mb][nb][i]; const float pe = __expf(s - mn); const float p = s > -1e29f ? pe : 0.f; st[mb][nb][i] = p; ls += p; }
        l[nb] = l[nb] * sc + ls; m[nb] = mn;
#pragma unroll
        for (int mb = 0; mb < 4; ++mb) ot[mb][nb] *= sc; }
}
template <bool ADD> __device__ __forceinline__ void at_finish(f32x4 (&ot)[4][2], float (&l)[2], const float (&gate)[2], LAS f32x4* park, int lane) {
#pragma unroll
    for (int nb = 0; nb < 2; ++nb) { float Ls = l[nb]; Ls += __shfl_xor(Ls, 16); Ls += __shfl_xor(Ls, 32); const float inv = Ls > 0.f ? gate[nb] / Ls : 0.f;
#pragma unroll
        for (int mb = 0; mb < 4; ++mb) { f32x4 v = ot[mb][nb] * inv; if (ADD) v += park[(mb * 2 + nb) * 64 + lane]; ot[mb][nb] = v; } }
}
__device__ __forceinline__ void at_park(const f32x4 (&ot)[4][2], LAS f32x4* park, int lane) {
#pragma unroll
    for (int nb = 0; nb < 2; ++nb)
#pragma unroll
        for (int mb = 0; mb < 4; ++mb) park[(mb * 2 + nb) * 64 + lane] = ot[mb][nb];
}
__device__ __forceinline__ void nsa_attn_prompt_phase(const Ctx& c) {
    const float* PJ = WSF(WC_PROJ); const float* gb = c.in[I_CGB]; bf16* OA = WSB(WC_OA);
    const bf16* KSB = WSB(WC_KSB); const bf16* VST = WSB(WC_VST); const bf16* KWB = WSB(WC_KWB); const bf16* VWT = WSB(WC_VWT); const bf16* KCB = WSB(WC_KCB); const bf16* VCT = WSB(WC_VCT);
    __syncthreads();
    { LAS float* bt = (LAS float*)(c.lds + AT_BIAS);
      for (int i = c.tid; i < 16 * 128; i += 512) { const int h = i >> 7, d = i & 127; bt[i] = c.in[I_T5][(int)T5_LUT[d] * 16 + h]; } }
    __syncthreads();
    for (int u = blockIdx.x; u < 1024; u += c.G) {
        LAS unsigned char* L = c.lds; asm volatile("" : "+v"(L));
        int tid = c.tid; asm volatile("" : "+v"(tid));
        const int lane = tid & 63, fr = lane & 15, rq = lane >> 4, w = c.wave, hg = w >> 1, tq0 = (w & 1) * 32;
        const int bg = (u & 255) >> 4, r16 = u & 15, k4 = u >> 8, qb = k4 == 0 ? r16 : (k4 == 1 ? 31 - r16 : (k4 == 2 ? 32 + r16 : 63 - r16)), b = bg >> 2, g = bg & 3, h = g * 4 + hg;
        const LAS float* bias_h = (const LAS float*)(L + AT_BIAS) + h * 128; const float cb = bias_h[127];
        LAS float* PS = (LAS float*)(L + AT_PS); LAS unsigned long long* SEL = (LAS unsigned long long*)(L + AT_SEL);
        bf16x8_t qf[2][2]; float gate_c[2], gate_s[2], gate_w[2]; size_t row[2];
#pragma unroll
        for (int nb = 0; nb < 2; ++nb) { row[nb] = (size_t)b * SEQ + 64 * qb + tq0 + 16 * nb + fr; const float* qr = PJ + row[nb] * NCIN;
#pragma unroll
            for (int s = 0; s < 2; ++s) { const f32x4 a = *(const f32x4*)(qr + h * 64 + 32 * s + 8 * rq) * 0.125f, bq = *(const f32x4*)(qr + h * 64 + 32 * s + 8 * rq + 4) * 0.125f;
                u32x4 wv; wv.x = pk2(a.x, a.y); wv.y = pk2(a.z, a.w); wv.z = pk2(bq.x, bq.y); wv.w = pk2(bq.z, bq.w); qf[nb][s] = __builtin_bit_cast(bf16x8_t, wv); }
            gate_c[nb] = sigmoid_f(qr[2560 + h] + gb[h]); gate_s[nb] = sigmoid_f(qr[2576 + h] + gb[16 + h]); gate_w[nb] = sigmoid_f(qr[2592 + h] + gb[32 + h]); }
        f32x4 ot[4][2], st[4][2]; float m[2], l[2]; bool rowok[2] = {true, true};
        LAS f32x4* park = (LAS f32x4*)(L + AT_PS) + w * 512;
#pragma unroll
        for (int mb = 0; mb < 4; ++mb) { ot[mb][0] = (f32x4){0.f, 0.f, 0.f, 0.f}; ot[mb][1] = (f32x4){0.f, 0.f, 0.f, 0.f}; }
        const int tl0 = 64 * qb + tq0 + fr;
        { __syncthreads();
          const AtRegs r0 = at_load(KCB + (size_t)bg * 128 * 64, VCT + (size_t)bg * 64 * 128, 128, tid), r1 = at_load(KCB + ((size_t)bg * 128 + 64) * 64, VCT + (size_t)bg * 64 * 128 + 64, 128, tid);
          at_store(L, 0, r0, tid); at_store(L, 1, r1, tid);
          __syncthreads();
          float cm[2] = {-1e30f, -1e30f}, cl[2] = {0.f, 0.f};
#pragma unroll
          for (int cc = 0; cc < 2; ++cc) { at_qk(L, cc, qf, st, fr, rq);
#pragma unroll
              for (int nb = 0; nb < 2; ++nb) { float mx = -1e30f; const int t = tl0 + 16 * nb;
#pragma unroll
                  for (int mb = 0; mb < 4; ++mb)
#pragma unroll
                      for (int i = 0; i < 4; ++i) { const int n = 64 * cc + 16 * mb + 4 * rq + i, dist = t - (32 * n + 31);
                          const float bv = bias_h[dist < 0 ? 0 : (dist > 127 ? 127 : dist)]; const float sv = dist >= 0 ? st[mb][nb][i] + bv : -1e30f; st[mb][nb][i] = sv; mx = fmaxf(mx, sv); }
                  mx = fmaxf(mx, __shfl_xor(mx, 16)); mx = fmaxf(mx, __shfl_xor(mx, 32));
                  const float mn = fmaxf(cm[nb], mx); float ls = 0.f;
#pragma unroll
                  for (int mb = 0; mb < 4; ++mb)
#pragma unroll
                      for (int i = 0; i < 4; ++i) { const float pe = __expf(st[mb][nb][i] - mn); ls += st[mb][nb][i] > -1e29f ? pe : 0.f; }
                  cl[nb] = cl[nb] * __expf(cm[nb] - mn) + ls; cm[nb] = mn; } }
          float cinv[2];
#pragma unroll
          for (int nb = 0; nb < 2; ++nb) { float ls = cl[nb]; ls += __shfl_xor(ls, 16); ls += __shfl_xor(ls, 32); cinv[nb] = ls > 0.f ? 1.f / ls : 0.f; l[nb] = ls > 0.f ? 0.25f : 0.f; }
#pragma unroll
          for (int cc = 0; cc < 2; ++cc) { at_qk(L, cc, qf, st, fr, rq);
#pragma unroll
              for (int nb = 0; nb < 2; ++nb) { const int t = tl0 + 16 * nb; LAS float* psr = PS + ((hg * 64 + tq0 + 16 * nb + fr) * 64 + 2 * rq) + 32 * cc;
#pragma unroll
                  for (int mb = 0; mb < 4; ++mb) {
#pragma unroll
                      for (int i = 0; i < 4; ++i) { const int n = 64 * cc + 16 * mb + 4 * rq + i, dist = t - (32 * n + 31);
                          const float bv = bias_h[dist < 0 ? 0 : (dist > 127 ? 127 : dist)]; const float pe = __expf(fminf(st[mb][nb][i] + bv - cm[nb], 0.f)) * cinv[nb]; st[mb][nb][i] = dist >= 0 ? pe : 0.f; }
                      *(LAS f32x2*)(psr + 8 * mb) = (f32x2){st[mb][nb][0] + st[mb][nb][1], st[mb][nb][2] + st[mb][nb][3]}; } }
              at_pv(L, cc, st, ot, fr, rq); }
          at_finish<false>(ot, l, gate_c, park, lane);
        }
        __syncthreads();
        { for (int i8 = 0; i8 < 8; ++i8) { const int tq = 8 * w + i8; unsigned long long sel;
              if (qb <= 15) sel = (2ull << qb) - 1ull;
              else { const float ps = (PS[(0 * 64 + tq) * 64 + lane] + PS[(1 * 64 + tq) * 64 + lane]) + (PS[(2 * 64 + tq) * 64 + lane] + PS[(3 * 64 + tq) * 64 + lane]);
                  const bool forced = (lane == 0) || (lane == qb) || (lane == qb - 1); const float sc = forced ? 100.f : (lane > qb ? -1.f : ps); int cnt = 0;
#pragma unroll 4
                  for (int k = 0; k < 64; ++k) { const float sk = readlane_f(sc, k); cnt += (sk > sc || (sk == sc && k < lane)) ? 1 : 0; }
                  sel = __ballot(cnt < 16) & ((2ull << qb) - 1ull); }
              if (lane == 0) SEL[tq] = sel; } }
        __syncthreads();
        unsigned long long selm[2], uni;
        { selm[0] = SEL[tq0 + fr]; selm[1] = SEL[tq0 + 16 + fr]; unsigned long long a = SEL[lane];
#pragma unroll
          for (int o = 1; o < 64; o <<= 1) a |= __shfl_xor(a, o);
          uni = a; }
        at_park(ot, park, lane);
#pragma unroll
        for (int mb = 0; mb < 4; ++mb) { ot[mb][0] = (f32x4){0.f, 0.f, 0.f, 0.f}; ot[mb][1] = (f32x4){0.f, 0.f, 0.f, 0.f}; }
        m[0] = m[1] = -1e30f; l[0] = l[1] = 0.f;
        { unsigned long long todo = __builtin_amdgcn_readfirstlane((unsigned)uni) | ((unsigned long long)__builtin_amdgcn_readfirstlane((unsigned)(uni >> 32)) << 32);
          int j = __builtin_ctzll(todo), buf = 0;
          AtRegs rg = at_load(KSB + ((size_t)bg * SEQ + 64 * j) * 64, VST + (size_t)bg * 64 * SEQ + 64 * j, SEQ, tid);
          for (;;) { at_store(L, buf, rg, tid); todo &= todo - 1ull; const bool more = todo != 0ull; const int jn = more ? __builtin_ctzll(todo) : 0;
              __syncthreads();
              if (more) rg = at_load(KSB + ((size_t)bg * SEQ + 64 * jn) * 64, VST + (size_t)bg * 64 * SEQ + 64 * jn, SEQ, tid);
              at_qk(L, buf, qf, st, fr, rq);
              rowok[0] = (selm[0] >> j) & 1ull; rowok[1] = (selm[1] >> j) & 1ull;
              if (j + 3 <= qb) at_softmax<0>(st, ot, m, l, rowok, cb, bias_h, 0, 0); else at_softmax<1>(st, ot, m, l, rowok, cb, bias_h, tl0 - (64 * j + 4 * rq), 1 << 30);
              at_pv(L, buf, st, ot, fr, rq);
              if (!more) break; j = jn; buf ^= 1; }
          at_finish<true>(ot, l, gate_s, park, lane); at_park(ot, park, lane); }
        __syncthreads();
#pragma unroll
        for (int mb = 0; mb < 4; ++mb) { ot[mb][0] = (f32x4){0.f, 0.f, 0.f, 0.f}; ot[mb][1] = (f32x4){0.f, 0.f, 0.f, 0.f}; }
        m[0] = m[1] = -1e30f; l[0] = l[1] = 0.f; rowok[0] = rowok[1] = true;
        { int j = qb >= 8 ? qb - 8 : 0, buf = 0;
          AtRegs rg = at_load(KWB + ((size_t)bg * SEQ + 64 * j) * 64, VWT + (size_t)bg * 64 * SEQ + 64 * j, SEQ, tid);
          for (;;) { at_store(L, buf, rg, tid); const bool more = j < qb; const int jn = j + 1;
              __syncthreads();
              if (more) rg = at_load(KWB + ((size_t)bg * SEQ + 64 * jn) * 64, VWT + (size_t)bg * 64 * SEQ + 64 * jn, SEQ, tid);
              at_qk(L, buf, qf, st, fr, rq);
              if (j + 3 <= qb && j + 8 > qb) at_softmax<0>(st, ot, m, l, rowok, cb, bias_h, 0, 0); else at_softmax<1>(st, ot, m, l, rowok, cb, bias_h, tl0 - (64 * j + 4 * rq), 512);
              at_pv(L, buf, st, ot, fr, rq);
              if (!more) break; j = jn; buf ^= 1; }
          at_finish<true>(ot, l, gate_w, park, lane); }
#pragma unroll
        for (int nb = 0; nb < 2; ++nb)
#pragma unroll
            for (int mb = 0; mb < 4; ++mb) { u32x2 wv; wv.x = pk2(ot[mb][nb].x, ot[mb][nb].y); wv.y = pk2(ot[mb][nb].z, ot[mb][nb].w); *(u32x2*)(OA + row[nb] * 1024 + h * 64 + 16 * mb + 4 * rq) = wv; }
    }
}
constexpr int PH_PER_SUB = 9, N_PHASES = 2 + 12 * PH_PER_SUB;
struct Args { const float* in[N_IN]; float* out; unsigned char* ws; int ph_lo, ph_hi, bli, pad; };
__host__ __device__ inline bool phase_exists(int ph) {
    if (ph < 2) return true; const int r = ph - 2, sub3 = r / PH_PER_SUB, slot = r % PH_PER_SUB, L = sub3 / 3, s = sub3 % 3, kind = (L == 1) ? 1 : (L == 2 ? 2 : 0);
    if (slot == 0 || slot == 5 || slot == 6) return true;
    if (slot == 7) return s == 2;
    if (slot == 8) return false;
    if (s != 1) return false;
    if (kind == 0) return slot <= 2; if (kind == 1) return slot <= 3; return true;
}

#ifndef PROBE
#define PROBE 0
#endif
#define TW(cls, ...) do { __VA_ARGS__; if (PROBE == (cls)) { __VA_ARGS__; } } while (0)
#define IN(k) (lo <= (k) && (k) < hi)
#define SEAM(k) do { if (IN(k) && (k) + 1 < hi) xcd_barrier(bar); } while (0)
template <int L, int S> __device__ __forceinline__ void run_sub(const Ctx& c, const XcdBarrier& bar, const int lo, const int hi) {
    constexpr int kind = (L == 1) ? 1 : (L == 2 ? 2 : 0), ia = (L == 3) ? 1 : 0, base = 2 + (3 * L + S) * PH_PER_SUB;
    LAS unsigned char* ring = c.lds;
    if (IN(base)) {
        if constexpr (S != 1) { constexpr int j = S >> 1; pg8::Gemm g{S == 0 ? WSB(WS_XNB) : WSB(WS_XN), WSB(WS_WUP + (size_t)(2 * L + j) * SZ_WUP), M, 5632, 1024}; pg8::StaticOrder So; So.init(M, 5632, c.G, (int)blockIdx.x);
            pg8::EpiGate E{WSB(WS_H), DFF}; TW(1, pg8::gemm_phase<pg8::EpiGate, pg8::StaticOrder, true, true>(ring, g, So, E)); }
        else if constexpr (kind == 0) { pg8::Gemm g{WSB(WS_XN), WSB(WS_WAIN + (size_t)ia * SZ_WAIN), M, 4096, 1024}; pg8::StaticOrder So; So.init(M, 4096, c.G, (int)blockIdx.x);
            pg8::EpiAin E{WSB(WA_U), WSF(WA_V)}; TW(1, pg8::gemm_phase<pg8::EpiAin, pg8::StaticOrder, true, true>(ring, g, So, E)); }
        else { constexpr int N = kind == 1 ? NBIN : NCIN; pg8::Gemm g{WSB(WS_XN), kind == 1 ? WSB(WS_WBIN) : WSB(WS_WCIN), M, N, 1024}; pg8::StaticOrder So; So.init(M, N, c.G, (int)blockIdx.x);
            pg8::EpiF32 E{WSF(WS_MIX), N}; TW(1, pg8::gemm_phase<pg8::EpiF32, pg8::StaticOrder, true, true>(ring, g, So, E)); }
    } SEAM(base);
    if constexpr (S == 1) {
        if (IN(base + 1)) { if constexpr (kind == 0) TW(4, a_stats_phase(c, ia)); else if constexpr (kind == 1) TW(6, gdn_prep_phase(c)); else TW(9, nsa_prep_phase(c)); } SEAM(base + 1);
        if (IN(base + 2)) { if constexpr (kind == 0) TW(5, a_sgu_phase(c, ia)); else if constexpr (kind == 1) TW(7, gdn_scan_phase(c));
            else {
                { pg8::Gemm g{WSB(WC_ACMP), WSB(WS_WC1), CMP_ROWS, 256, 2048}; pg8::StaticOrder So; So.init(CMP_ROWS, 256, c.G, (int)blockIdx.x);
                  pg8::EpiCmp E{WSB(WC_HC)}; TW(1, pg8::gemm_phase<pg8::EpiCmp, pg8::StaticOrder, true, true>(ring, g, So, E)); }
                { pg8::Gemm g{WSB(WC_ACMP) + (size_t)CMP_ROWS * 2048, WSB(WS_WC1 + SZ_WC1), CMP_ROWS, 256, 2048}; pg8::StaticOrder So; So.init(CMP_ROWS, 256, c.G, (int)((blockIdx.x + 128u) % (unsigned)c.G));
                  pg8::EpiCmp E{WSB(WC_HC) + (size_t)CMP_ROWS * 256}; TW(1, pg8::gemm_phase<pg8::EpiCmp, pg8::StaticOrder, true, true>(ring, g, So, E)); } } } SEAM(base + 2);
        if constexpr (kind != 0) { if (IN(base + 3)) { if constexpr (kind == 1) TW(8, gdn_post_phase(c)); else TW(10, nsa_cmp2_phase(c)); } SEAM(base + 3); }
        if constexpr (kind == 2) { if (IN(base + 4)) TW(11, nsa_attn_prompt_phase(c)); TW(12, nsa_attn_phase(c, 65536)); SEAM(base + 4); }
    }
    constexpr int KOUT = (S != 1) ? DFF : (kind == 0 ? 2048 : 1024); constexpr float SCL = (S != 1) ? 0.5f : 1.f;
    if (IN(base + 5)) {
        const bf16* A; const bf16* Bt;
        if constexpr (S != 1) { A = WSB(WS_H); Bt = WSB(WS_WDN + (size_t)(2 * L + (S >> 1)) * SZ_WDN); }
        else if constexpr (kind == 0) { A = WSB(WA_US); Bt = WSB(WS_WAOUT + (size_t)ia * SZ_WAOUT); }
        else if constexpr (kind == 1) { A = WSB(WB_OG); Bt = WSB(WS_WBOUT); }
        else { A = WSB(WC_OA); Bt = WSB(WS_WCOUT); }
        { pg8::Gemm g{A, Bt, MP, 1024, KOUT, KOUT}; pg8::StaticOrder So; So.init(MP, 1024, c.G, (int)blockIdx.x);
          pg8::EpiResid E{WSF(WS_X), WSF(WS_PRE), ALPHA, SCL}; TW(1, pg8::gemm_phase<pg8::EpiResid, pg8::StaticOrder, true, true>(ring, g, So, E)); }
        { pg8::Gemm g{A + (size_t)MP * KOUT, Bt, MS, 1024, 256, KOUT}; pg8::SplitOrder So{2, 4, KOUT / 256, 256, c.G, (int)blockIdx.x};
          pg8::EpiSlab E{WSF(WS_SLAB), 256, (size_t)MS * 1024}; TW(1, pg8::gemm_phase<pg8::EpiSlab, pg8::SplitOrder, true, true>(ring, g, So, E)); }
    } SEAM(base + 5);
    if (IN(base + 6)) { TW(3, ln_phase(c, c.in[I_LNG] + (size_t)(3 * L + S) * 1024, c.in[I_LNB] + (size_t)(3 * L + S) * 1024, KOUT / 256, SCL)); } SEAM(base + 6);
    if constexpr (S == 2) { if (IN(base + 7)) { pg8::Gemm g{WSB(WS_XN), WSB(WS_WG + (size_t)L * SZ_WG), M, 1024, 1024}; pg8::StaticOrder So; So.init(M, 1024, c.G, (int)blockIdx.x);
            pg8::EpiPle E{WSF(WS_X), WSF(WS_PP) + (size_t)L * M * 1024, WSB(WS_XNB), L == 3 ? c.out : nullptr}; pg8::gemm_phase<pg8::EpiPle, pg8::StaticOrder, true, true>(ring, g, So, E); } SEAM(base + 7); }
}
template <int l> __device__ __forceinline__ void ple_proj(const Ctx& c) {
    pg8::Gemm g{WSB(WS_PBF) + (size_t)l * M * 256, WSB(WS_WP + l * SZ_WP), M, 1024, 256}; pg8::StaticOrder So; So.init(M, 1024, c.G, (int)blockIdx.x);
    pg8::EpiF32 E{WSF(WS_PP) + (size_t)l * M * 1024, 1024}; TW(1, pg8::gemm_phase<pg8::EpiF32, pg8::StaticOrder, true, true>(c.lds, g, So, E));
}
__global__ void __launch_bounds__(NWAVES * 64, 2) fwd(Args args) {
    extern __shared__ __attribute__((aligned(16))) unsigned char lds_raw[];
    Ctx c; c.lds = (LAS unsigned char*)lds_raw; c.ws = args.ws; c.out = args.out; c.in = args.in;
    c.tid = threadIdx.x; c.lane = c.tid & 63; c.wave = __builtin_amdgcn_readfirstlane(c.tid >> 6); c.G = gridDim.x; c.gw = blockIdx.x * NWAVES + c.wave; c.NGW = c.G * NWAVES;
    volatile LAS unsigned* MISC = (volatile LAS unsigned*)(c.lds + MISC_OFF);
    for (int u = c.tid; u < 128; u += NWAVES * 64) MISC[u] = 0u;
    __syncthreads();
    unsigned* ctl = (unsigned*)c.ws;
    XcdBarrier bar = xcd_barrier_post(ctl + CW_BAR + args.bli * XCD_BAR_WORDS, MISC + 8);
    const int lo = args.ph_lo, hi = args.ph_hi;
    if (IN(0)) { TW(13, prologue_phase(c)); } SEAM(0);
    if (IN(1)) { ple_proj<0>(c); ple_proj<1>(c); ple_proj<2>(c); ple_proj<3>(c); } SEAM(1);
    run_sub<0, 0>(c, bar, lo, hi); run_sub<0, 1>(c, bar, lo, hi); run_sub<0, 2>(c, bar, lo, hi);
    run_sub<1, 0>(c, bar, lo, hi); run_sub<1, 1>(c, bar, lo, hi); run_sub<1, 2>(c, bar, lo, hi);
    run_sub<2, 0>(c, bar, lo, hi); run_sub<2, 1>(c, bar, lo, hi); run_sub<2, 2>(c, bar, lo, hi);
    run_sub<3, 0>(c, bar, lo, hi); run_sub<3, 1>(c, bar, lo, hi); run_sub<3, 2>(c, bar, lo, hi);
}
#undef IN
#undef SEAM

#ifndef ONE_LAUNCH
#define ONE_LAUNCH 1
#endif
extern "C" void kernel_launch(void* const* d_in, const int* in_sizes, int n_in, void* d_out, int out_size, void* d_ws, size_t ws_size, hipStream_t stream) {
    static int grid = 0;
    if (grid == 0) {
        if (n_in != N_IN || (size_t)out_size != O_END || ws_size < WS_END) { fprintf(stderr, "kernel_launch: unexpected problem: n_in %d out %d ws %zu (need %zu)\n", n_in, out_size, ws_size, (size_t)WS_END); grid = -1; return; }
        int dev = 0, cus = 0, per_cu = 0;
        if (hipGetDevice(&dev) != hipSuccess || hipDeviceGetAttribute(&cus, hipDeviceAttributeMultiprocessorCount, dev) != hipSuccess) { grid = -1; return; }
        if (hipFuncSetAttribute((const void*)fwd, hipFuncAttributeMaxDynamicSharedMemorySize, LDS_BYTES) != hipSuccess) { fprintf(stderr, "kernel_launch: hipFuncSetAttribute failed\n"); grid = -1; return; }
        if (hipOccupancyMaxActiveBlocksPerMultiprocessor(&per_cu, (const void*)fwd, NWAVES * 64, LDS_BYTES) != hipSuccess || per_cu < 1) fprintf(stderr, "kernel_launch: occupancy query says %d\n", per_cu);
        (void)hipGetLastError();
        grid = cus;
    }
    if (grid < 0) return;
    (void)hipMemsetAsync(d_ws, 0, CTL_BYTES, stream);
    Args a{};
    for (int i = 0; i < N_IN; ++i) a.in[i] = (const float*)d_in[i];
    a.out = (float*)d_out; a.ws = (unsigned char*)d_ws; a.pad = 0;
#if ONE_LAUNCH
    a.ph_lo = 0; a.ph_hi = N_PHASES; a.bli = 0;
    hipLaunchKernelGGL(fwd, dim3(grid), dim3(NWAVES * 64), LDS_BYTES, stream, a);
#else
    for (int ph = 0; ph < N_PHASES; ++ph) { if (!phase_exists(ph)) continue; a.ph_lo = ph; a.ph_hi = ph + 1; a.bli = 0;
        hipLaunchKernelGGL(fwd, dim3(grid), dim3(NWAVES * 64), LDS_BYTES, stream, a); }
#endif
}
```

```cpp
#include <hip/hip_runtime.h>
#include <cstdio>
#include <cstdint>
namespace pg8 {
#define PG8_LAS __attribute__((address_space(3)))
typedef unsigned short bf16_t;
typedef short bf16x8 __attribute__((ext_vector_type(8)));
typedef float f32x4 __attribute__((ext_vector_type(4)));
typedef unsigned u32x4 __attribute__((ext_vector_type(4)));
constexpr int BM = 256, BK = 64, HALF = 128, HTB = HALF * BK * 2  , STAGE_BYTES = 8 * HTB, NXCD = 8, WGM = 8;

__host__ __device__ __forceinline__ int lds_byte(int r, int c) { const int st = (r >> 4) * 2 + (c >> 5), rr = r & 15, cc = c & 31, ob = rr * 64 + cc * 2; return st * 1024 + (ob ^ (((ob >> 9) & 1) << 5)); }
__host__ __device__ __forceinline__ void stage_rc(int b, int& R, int& C) { const int st = b / 1024, sb = b % 1024, swz = sb ^ (((sb >> 9) & 1) << 5); R = (st >> 1) * 16 + swz / 64; C = (st & 1) * 32 + (swz % 64) / 2; }
__host__ __device__ __forceinline__ int perm32(int rho) { const int n = rho >> 4, i = rho & 15; return 8 * (i >> 2) + 4 * n + (i & 3); }

struct Unit { int pm, pn, ko; };
struct Gemm { const bf16_t* A; const bf16_t* Bt; int M, N, K, ld; };

struct StaticOrder {
    int nM, nN, nwg, G, c;
    __host__ __device__ void init(int M, int N, int G_, int c_) { nM = M / BM; nN = N / BM; nwg = nM * nN; G = G_; c = c_; }
    __host__ __device__ bool next(int i, Unit& u) const {
        const long L = (long)i * G + c; if (L >= nwg) return false;
        int wgid = (int)L; { const int q = nwg / NXCD, r = nwg % NXCD, xcd = wgid % NXCD, off = wgid / NXCD; wgid = (xcd < r ? xcd * (q + 1) : r * (q + 1) + (xcd - r) * q) + off; }
        const int nig = WGM * nN, gid = wgid / nig, fm = gid * WGM, gsz = (nM - fm) < WGM ? (nM - fm) : WGM;
        u.pm = fm + ((wgid % nig) % gsz); u.pn = (wgid % nig) / gsz; u.ko = 0; return true;
    }
    __device__ __forceinline__ void a_ready(const Unit&) const {}
    __device__ __forceinline__ void done(const Unit&) const {}
};

__device__ __forceinline__ unsigned cvt_pk_bf16(float lo, float hi) { unsigned r; asm volatile("v_cvt_pk_bf16_f32 %0, %1, %2" : "=v"(r) : "v"(lo), "v"(hi)); return r; }
typedef unsigned u32x2 __attribute__((ext_vector_type(2)));
__device__ __forceinline__ float fast_sigmoid(float x) { return __frcp_rn(1.0f + __expf(-x)); }
__device__ __forceinline__ float silu_f(float x) { return x * fast_sigmoid(x); }
__device__ __forceinline__ float gelu_tanh_f(float x) { const float y = 1.5957691216057308f * (x + 0.044715f * x * x * x); return x * fast_sigmoid(y); }
__device__ __forceinline__ u32x2 pack4(f32x4 v) { u32x2 w; w.x = cvt_pk_bf16(v[0], v[1]); w.y = cvt_pk_bf16(v[2], v[3]); return w; }

struct EpiGate {
    static constexpr bool PERM = false, AFTER_DRAIN = false;
    bf16_t* H; int ldh;
    __device__ __forceinline__ void operator()(const f32x4 (&acc)[2][2][4][2], const Unit& u, int wr, int wc, int fr, int fq) const {
        const int row0 = u.pm * BM + wr * 64 + fr, col0 = u.pn * HALF + wc * 32 + 4 * fq;
#pragma unroll
        for (int ai = 0; ai < 2; ++ai)
#pragma unroll
            for (int m = 0; m < 4; ++m) { bf16_t* rowp = H + (size_t)(row0 + ai * HALF + m * 16) * ldh + col0;
#pragma unroll
                for (int n = 0; n < 2; ++n) { const f32x4 a = acc[ai][0][m][n], b = acc[ai][1][m][n]; f32x4 h;
#pragma unroll
                    for (int j = 0; j < 4; ++j) h[j] = silu_f(a[j]) * b[j];
                    *(u32x2*)(rowp + n * 16) = pack4(h); } }
    }
};
struct EpiResid {
    static constexpr bool PERM = false, AFTER_DRAIN = false;
    const float* X; float* PRE; float alpha, s;
    __device__ __forceinline__ void operator()(const f32x4 (&acc)[2][2][4][2], const Unit& u, int wr, int wc, int fr, int fq) const {
        const int row0 = u.pm * BM + wr * 64 + fr, col0 = u.pn * BM + wc * 32 + 4 * fq;
#pragma unroll
        for (int ai = 0; ai < 2; ++ai)
#pragma unroll
            for (int m = 0; m < 4; ++m) { const size_t off = (size_t)(row0 + ai * HALF + m * 16) * 1024 + col0;
#pragma unroll
                for (int bj = 0; bj < 2; ++bj)
#pragma unroll
                    for (int n = 0; n < 2; ++n) { const f32x4 x = *(const f32x4*)(X + off + bj * HALF + n * 16); *(f32x4*)(PRE + off + bj * HALF + n * 16) = x * alpha + acc[ai][bj][m][n] * s; } }
    }
};
struct EpiF32 {
    static constexpr bool PERM = false, AFTER_DRAIN = false;
    float* C; int ldc;
    __device__ __forceinline__ void operator()(const f32x4 (&acc)[2][2][4][2], const Unit& u, int wr, int wc, int fr, int fq) const {
        const int row0 = u.pm * BM + wr * 64 + fr, col0 = u.pn * BM + wc * 32 + 4 * fq;
#pragma unroll
        for (int ai = 0; ai < 2; ++ai)
#pragma unroll
            for (int m = 0; m < 4; ++m) { float* rowp = C + (size_t)(row0 + ai * HALF + m * 16) * ldc + col0;
#pragma unroll
                for (int bj = 0; bj < 2; ++bj)
#pragma unroll
                    for (int n = 0; n < 2; ++n) *(f32x4*)(rowp + bj * HALF + n * 16) = acc[ai][bj][m][n]; }
    }
};
struct EpiPle {
    static constexpr bool PERM = false, AFTER_DRAIN = false;
    float* X; const float* P; bf16_t* XN; float* OUT;
    __device__ __forceinline__ void operator()(const f32x4 (&acc)[2][2][4][2], const Unit& u, int wr, int wc, int fr, int fq) const {
        const int row0 = u.pm * BM + wr * 64 + fr, col0 = u.pn * BM + wc * 32 + 4 * fq;
#pragma unroll
        for (int ai = 0; ai < 2; ++ai)
#pragma unroll
            for (int m = 0; m < 4; ++m) { const size_t off = (size_t)(row0 + ai * HALF + m * 16) * 1024 + col0;
#pragma unroll
                for (int bj = 0; bj < 2; ++bj)
#pragma unroll
                    for (int n = 0; n < 2; ++n) { const size_t o = off + bj * HALF + n * 16; const f32x4 x = *(const f32x4*)(X + o), p = *(const f32x4*)(P + o), a = acc[ai][bj][m][n]; f32x4 y;
#pragma unroll
                        for (int j = 0; j < 4; ++j) y[j] = x[j] + fast_sigmoid(a[j]) * p[j];
                        *(f32x4*)(X + o) = y; *(u32x2*)(XN + o) = pack4(y); if (OUT) *(f32x4*)(OUT + o) = y; } }
    }
};
struct EpiAin {
    static constexpr bool PERM = false, AFTER_DRAIN = false;
    bf16_t* U; float* V;
    __device__ __forceinline__ void operator()(const f32x4 (&acc)[2][2][4][2], const Unit& u, int wr, int wc, int fr, int fq) const {
        const int row0 = u.pm * BM + wr * 64 + fr; const bool isu = u.pn < 8; const int col0 = (isu ? u.pn : u.pn - 8) * BM + wc * 32 + 4 * fq;
#pragma unroll
        for (int ai = 0; ai < 2; ++ai)
#pragma unroll
            for (int m = 0; m < 4; ++m) { const size_t off = (size_t)(row0 + ai * HALF + m * 16) * 2048 + col0;
#pragma unroll
                for (int bj = 0; bj < 2; ++bj)
#pragma unroll
                    for (int n = 0; n < 2; ++n) { const f32x4 a = acc[ai][bj][m][n]; f32x4 y;
#pragma unroll
                        for (int j = 0; j < 4; ++j) y[j] = gelu_tanh_f(a[j]);
                        if (isu) *(u32x2*)(U + off + bj * HALF + n * 16) = pack4(y); else *(f32x4*)(V + off + bj * HALF + n * 16) = y; } }
    }
};
struct EpiCmp {
    static constexpr bool PERM = false, AFTER_DRAIN = false;
    bf16_t* HC;
    __device__ __forceinline__ void operator()(const f32x4 (&acc)[2][2][4][2], const Unit& u, int wr, int wc, int fr, int fq) const {
        const int row0 = u.pm * BM + wr * 64 + fr, col0 = u.pn * BM + wc * 32 + 4 * fq;
#pragma unroll
        for (int ai = 0; ai < 2; ++ai)
#pragma unroll
            for (int m = 0; m < 4; ++m) { bf16_t* rowp = HC + (size_t)(row0 + ai * HALF + m * 16) * 256 + col0;
#pragma unroll
                for (int bj = 0; bj < 2; ++bj)
#pragma unroll
                    for (int n = 0; n < 2; ++n) { const f32x4 a = acc[ai][bj][m][n]; f32x4 y;
#pragma unroll
                        for (int j = 0; j < 4; ++j) y[j] = gelu_tanh_f(a[j]);
                        *(u32x2*)(rowp + bj * HALF + n * 16) = pack4(y); } }
    }
};

struct SplitOrder {
    int nM, nN, nsplit, ksplit, G, c;
    __device__ __forceinline__ bool next(int i, Unit& u) const { const int L = i * G + c, nt = nM * nN; if (L >= nsplit * nt) return false; const int sp = L / nt, t = L - sp * nt; u.pm = t / nN; u.pn = t - u.pm * nN; u.ko = sp * ksplit; return true; }
    __device__ __forceinline__ void a_ready(const Unit&) const {}
    __device__ __forceinline__ void done(const Unit&) const {}
};
struct EpiSlab {
    static constexpr bool PERM = false, AFTER_DRAIN = false;
    float* S; int ksplit; size_t slab;
    __device__ __forceinline__ void operator()(const f32x4 (&acc)[2][2][4][2], const Unit& u, int wr, int wc, int fr, int fq) const {
        const int row0 = u.pm * BM + wr * 64 + fr, col0 = u.pn * BM + wc * 32 + 4 * fq; float* base = S + (size_t)(u.ko / ksplit) * slab;
#pragma unroll
        for (int ai = 0; ai < 2; ++ai)
#pragma unroll
            for (int m = 0; m < 4; ++m) { float* rowp = base + (size_t)(row0 + ai * HALF + m * 16) * 1024 + col0;
#pragma unroll
                for (int bj = 0; bj < 2; ++bj)
#pragma unroll
                    for (int n = 0; n < 2; ++n) *(f32x4*)(rowp + bj * HALF + n * 16) = acc[ai][bj][m][n]; }
    }
};
template <class Epi, class Sched, bool ALIGN_EPI = false, bool SP2 = false>
__device__ __forceinline__ void gemm_phase(PG8_LAS unsigned char* lds, const Gemm g, const Sched& S, const Epi& E) {
    const int tid = threadIdx.x, wid = __builtin_amdgcn_readfirstlane(tid >> 6), lane = tid & 63, wr = wid >> 2, wc = wid & 3, fr = lane & 15, fq = lane >> 4;
    const int K = g.K, LD = g.ld ? g.ld : g.K, nt = K / BK;
    unsigned voffA[2], voffB[2];
#pragma unroll
    for (int i = 0; i < 2; ++i) { int R, C; stage_rc(tid * 16 + i * 8192, R, C); const int Rb = Epi::PERM ? ((R & ~31) + perm32(R & 31)) : R;
        voffA[i] = (unsigned)(R * LD + C) * 2u; voffB[i] = (unsigned)(Rb * LD + C) * 2u; }
    const size_t kstep = (size_t)(BK * 2);
    const size_t hstep = (size_t)HALF * LD * 2;
    const size_t tstep = 2 * hstep;
    const unsigned ldsw = (unsigned)wid * 1024u;
    const int aoff = lds_byte(wr * 64 + fr, fq * 8), boff = lds_byte(wc * 32 + fr, fq * 8);
#define PG8_SA(b, h) (((b) * 2 + (h)) * HTB)
#define PG8_SB(b, h) ((4 + (b) * 2 + (h)) * HTB)
#define PG8_STAGE(bufoff, gbase, voff) do { _Pragma("unroll") for (int _i = 0; _i < 2; ++_i) \
        __builtin_amdgcn_global_load_lds((const unsigned*)((const char*)(gbase) + (voff)[_i]), (PG8_LAS unsigned*)(lds + (bufoff) + ldsw + _i * 8192), 16, 0, 0); } while (0)
#define PG8_LDA(dst, b, h) do { _Pragma("unroll") for (int m = 0; m < 4; ++m) _Pragma("unroll") for (int k = 0; k < 2; ++k) dst[m][k] = *(const PG8_LAS bf16x8*)(lds + PG8_SA(b, h) + aoff + m * 2048 + k * 1024); } while (0)
#define PG8_LDB(dst, b, h) do { _Pragma("unroll") for (int n = 0; n < 2; ++n) _Pragma("unroll") for (int k = 0; k < 2; ++k) dst[n][k] = *(const PG8_LAS bf16x8*)(lds + PG8_SB(b, h) + boff + n * 2048 + k * 1024); } while (0)
#define PG8_MMA(ai, bj, At, Bt) do { __builtin_amdgcn_s_setprio(1); _Pragma("unroll") for (int m = 0; m < 4; ++m) _Pragma("unroll") for (int n = 0; n < 2; ++n) _Pragma("unroll") for (int k = 0; k < 2; ++k) \
        acc[ai][bj][m][n] = __builtin_amdgcn_mfma_f32_16x16x32_bf16(Bt[n][k], At[m][k], acc[ai][bj][m][n], 0, 0, 0); __builtin_amdgcn_s_setprio(0); } while (0)
#define PG8_WAIT_V(n) asm volatile("s_waitcnt vmcnt(" #n ")" ::: "memory")
#define PG8_WAIT_L(n) asm volatile("s_waitcnt lgkmcnt(" #n ")" ::: "memory")
#define PG8_BAR __builtin_amdgcn_s_barrier()
#define PG8_SCHED __builtin_amdgcn_sched_barrier(0)
    Unit cur, nxt; int ui = 0;
    if (!S.next(0, cur)) return;
    f32x4 acc[2][2][4][2];
#pragma unroll
    for (int a = 0; a < 2; ++a)
#pragma unroll
        for (int b = 0; b < 2; ++b)
#pragma unroll
            for (int m = 0; m < 4; ++m)
#pragma unroll
                for (int n = 0; n < 2; ++n) acc[a][b][m][n] = (f32x4){0.f, 0.f, 0.f, 0.f};
    bf16x8 At[4][2], B0[2][2], B1[2][2];
    const char* cA = (const char*)g.A + (size_t)cur.pm * tstep + (size_t)cur.ko * 2; const char* cB = (const char*)g.Bt + (size_t)cur.pn * tstep + (size_t)cur.ko * 2;
    S.a_ready(cur);
    if constexpr (SP2) {
        PG8_STAGE(PG8_SB(0, 0), cB, voffB); PG8_STAGE(PG8_SB(0, 1), cB + hstep, voffB); PG8_STAGE(PG8_SA(0, 0), cA, voffA); PG8_STAGE(PG8_SA(0, 1), cA + hstep, voffA);
        if (wr == 1) PG8_BAR;
        PG8_WAIT_V(2); PG8_BAR;
        PG8_STAGE(PG8_SB(1, 0), cB + kstep, voffB); PG8_STAGE(PG8_SA(1, 0), cA + kstep, voffA); PG8_STAGE(PG8_SB(1, 1), cB + hstep + kstep, voffB);
        PG8_WAIT_V(6); PG8_BAR;
    } else {
        PG8_STAGE(PG8_SB(0, 0), cB, voffB); PG8_STAGE(PG8_SA(0, 0), cA, voffA); PG8_STAGE(PG8_SB(0, 1), cB + hstep, voffB); PG8_STAGE(PG8_SA(0, 1), cA + hstep, voffA);
        if (wr == 1) PG8_BAR;
        PG8_WAIT_V(4); PG8_BAR;
        PG8_STAGE(PG8_SB(1, 0), cB + kstep, voffB); PG8_STAGE(PG8_SA(1, 0), cA + kstep, voffA); PG8_STAGE(PG8_SB(1, 1), cB + hstep + kstep, voffB);
        PG8_WAIT_V(6); PG8_BAR;
    }
    for (;;) {
        const bool has_next = S.next(ui + 1, nxt);
        const char* nA = has_next ? (const char*)g.A + (size_t)nxt.pm * tstep + (size_t)nxt.ko * 2 : cA; const char* nB = has_next ? (const char*)g.Bt + (size_t)nxt.pn * tstep + (size_t)nxt.ko * 2 : cB;
        for (int t = 0; t < nt; t += 2) {
            const bool last = (t == nt - 2);
            const char* a1 = cA + (size_t)(t + 1) * kstep;
            const char* a2 = last ? nA : cA + (size_t)(t + 2) * kstep; const char* b2 = last ? nB : cB + (size_t)(t + 2) * kstep;
            const char* a3 = a2 + kstep; const char* b3 = b2 + kstep;
            if (last && has_next) S.a_ready(nxt);
            if constexpr (SP2) {
            PG8_LDB(B0, 0, 0); PG8_LDB(B1, 0, 1); PG8_SCHED; PG8_LDA(At, 0, 0); PG8_STAGE(PG8_SA(1, 1), a1 + hstep, voffA);
            PG8_WAIT_V(8); PG8_WAIT_L(0); PG8_BAR; PG8_MMA(0, 0, At, B0); PG8_MMA(0, 1, At, B1); PG8_BAR; PG8_SCHED;
            PG8_LDA(At, 0, 1); PG8_STAGE(PG8_SB(0, 0), b2, voffB); PG8_STAGE(PG8_SB(0, 1), b2 + hstep, voffB); PG8_STAGE(PG8_SA(0, 0), a2, voffA);
            PG8_WAIT_V(8); PG8_WAIT_L(0); PG8_BAR; PG8_MMA(1, 0, At, B0); PG8_MMA(1, 1, At, B1); PG8_BAR; PG8_SCHED;
            PG8_LDB(B0, 1, 0); PG8_LDB(B1, 1, 1); PG8_SCHED; PG8_LDA(At, 1, 0); PG8_STAGE(PG8_SA(0, 1), a2 + hstep, voffA);
            PG8_WAIT_V(8); PG8_WAIT_L(0); PG8_BAR; PG8_MMA(0, 0, At, B0); PG8_MMA(0, 1, At, B1); PG8_BAR; PG8_SCHED;
            PG8_LDA(At, 1, 1); PG8_STAGE(PG8_SB(1, 0), b3, voffB); PG8_STAGE(PG8_SB(1, 1), b3 + hstep, voffB); PG8_STAGE(PG8_SA(1, 0), a3, voffA);
            PG8_WAIT_V(8); PG8_WAIT_L(0); PG8_BAR; PG8_MMA(1, 0, At, B0); PG8_MMA(1, 1, At, B1); PG8_BAR; PG8_SCHED;
            } else {
            PG8_LDB(B0, 0, 0); PG8_SCHED; PG8_LDA(At, 0, 0); PG8_STAGE(PG8_SA(1, 1), a1 + hstep, voffA);
            PG8_WAIT_L(8); PG8_BAR; PG8_WAIT_L(0); PG8_MMA(0, 0, At, B0); PG8_BAR; PG8_SCHED;
            PG8_LDB(B1, 0, 1); PG8_STAGE(PG8_SB(0, 0), b2, voffB);
            PG8_BAR; PG8_WAIT_L(0); PG8_MMA(0, 1, At, B1); PG8_BAR;
            PG8_LDA(At, 0, 1); PG8_STAGE(PG8_SA(0, 0), a2, voffA);
            PG8_BAR; PG8_WAIT_L(0); PG8_MMA(1, 0, At, B0); PG8_BAR; PG8_SCHED;
            PG8_STAGE(PG8_SB(0, 1), b2 + hstep, voffB);
            PG8_WAIT_V(6); PG8_BAR; PG8_MMA(1, 1, At, B1); PG8_BAR;
            PG8_LDB(B0, 1, 0); PG8_SCHED; PG8_LDA(At, 1, 0); PG8_STAGE(PG8_SA(0, 1), a2 + hstep, voffA);
            PG8_WAIT_L(8); PG8_BAR; PG8_WAIT_L(0); PG8_MMA(0, 0, At, B0); PG8_BAR; PG8_SCHED;
            PG8_LDB(B1, 1, 1); PG8_STAGE(PG8_SB(1, 0), b3, voffB);
            PG8_BAR; PG8_WAIT_L(0); PG8_MMA(0, 1, At, B1); PG8_BAR;
            PG8_LDA(At, 1, 1); PG8_STAGE(PG8_SA(1, 0), a3, voffA);
            PG8_BAR; PG8_WAIT_L(0); PG8_MMA(1, 0, At, B0); PG8_BAR; PG8_SCHED;
            PG8_STAGE(PG8_SB(1, 1), b3 + hstep, voffB);
            PG8_WAIT_V(6); PG8_BAR; PG8_MMA(1, 1, At, B1); PG8_BAR;
            }
        }
        if constexpr (ALIGN_EPI) { if (wr == 0) PG8_BAR; }
        if constexpr (!Epi::AFTER_DRAIN) { E(acc, cur, wr, wc, fr, fq); S.done(cur); }
        if (!has_next) break;
#pragma unroll
        for (int a = 0; a < 2; ++a)
#pragma unroll
            for (int b = 0; b < 2; ++b)
#pragma unroll
                for (int m = 0; m < 4; ++m)
#pragma unroll
                    for (int n = 0; n < 2; ++n) acc[a][b][m][n] = (f32x4){0.f, 0.f, 0.f, 0.f};
        cur = nxt; cA = nA; cB = nB; ++ui;
        if constexpr (ALIGN_EPI) { if (wr == 1) PG8_BAR; }
    }
    PG8_WAIT_V(0);
    if constexpr (!ALIGN_EPI) { if (wr == 0) PG8_BAR; }
    PG8_BAR;
    if constexpr (Epi::AFTER_DRAIN) { E.fused(acc, cur, wr, wc, fr, fq, lds, wid, lane); S.done(cur); }
#undef PG8_SA
#undef PG8_SB
#undef PG8_STAGE
#undef PG8_LDA
#undef PG8_LDB
#undef PG8_MMA
#undef PG8_WAIT_V
#undef PG8_WAIT_L
#undef PG8_BAR
#undef PG8_SCHED
}
}
constexpr int NWAVES = 8;
constexpr int MP = 16384, MS = 512, M = 16896, D = 1024, DFF = 2816, PLE = 256, SEQ = 4096, NB = 4, DB = 128, DSQ = 4;
constexpr int NBIN = 4352, NBIN_REAL = 4112, NCIN = 2816, NCIN_REAL = 2608;
constexpr int CMP_ROWS = 34816;
constexpr float ALPHA = 1.681792830507429f, LN_EPS = 1e-5f, NORM_EPS = 1e-6f;
constexpr size_t O_YP = 0, O_YS = 16777216, O_AV = 17301504, O_GSP = 19398656, O_GCP = 19922944, O_GSS = 19959808, O_GCS = 36737024,
                 O_KVP = 37916672, O_WINP = 54693888, O_KVS = 55742464, O_WINS = 56266752, O_END = 56528896;
constexpr size_t CTL_BYTES = 1u << 20;
constexpr size_t SZ_WUP = (size_t)5632 * 1024 * 2, SZ_WDN = (size_t)1024 * 2816 * 2, SZ_WG = (size_t)1024 * 1024 * 2, SZ_WP = (size_t)1024 * 256 * 2,
                 SZ_WAIN = (size_t)4096 * 1024 * 2, SZ_WAOUT = (size_t)1024 * 2048 * 2, SZ_WBIN = (size_t)NBIN * 1024 * 2, SZ_WCIN = (size_t)NCIN * 1024 * 2, SZ_WC1 = (size_t)256 * 2048 * 2;
constexpr size_t WS_WUP = CTL_BYTES, WS_WDN = WS_WUP + 8 * SZ_WUP, WS_WG = WS_WDN + 8 * SZ_WDN, WS_WP = WS_WG + 4 * SZ_WG, WS_WAIN = WS_WP + 4 * SZ_WP, WS_WAOUT = WS_WAIN + 2 * SZ_WAIN,
                 WS_WBIN = WS_WAOUT + 2 * SZ_WAOUT, WS_WBOUT = WS_WBIN + SZ_WBIN, WS_WCIN = WS_WBOUT + SZ_WG, WS_WCOUT = WS_WCIN + SZ_WCIN, WS_WC1 = WS_WCOUT + SZ_WG;
constexpr size_t WS_WSM = WS_WC1 + 2 * SZ_WC1;
constexpr size_t WS_X = WS_WSM + (size_t)2 * 16 * 128 * 128 * 2;
constexpr size_t WS_XN = WS_X + (size_t)M * 1024 * 4;
constexpr size_t WS_XNB = WS_XN + (size_t)M * 1024 * 2;
constexpr size_t WS_PRE = WS_XNB + (size_t)M * 1024 * 2;
constexpr size_t WS_H = WS_PRE + (size_t)M * 1024 * 4;
constexpr size_t WS_PBF = WS_H + (size_t)M * 2816 * 2;
constexpr size_t WS_PP = WS_PBF + (size_t)4 * M * 256 * 2;
constexpr size_t WS_SLAB = WS_PP + (size_t)4 * M * 1024 * 4;
constexpr size_t WS_MIX = WS_SLAB + (size_t)11 * MS * 1024 * 4;
constexpr size_t WA_U = WS_MIX, WA_V = WA_U + (size_t)M * 2048 * 2, WA_US = WA_V + (size_t)M * 2048 * 4, WA_ST = WA_US + (size_t)M * 2048 * 2, WA_END = WA_ST + (size_t)M * 8;
constexpr size_t GUNITS = 2048;
constexpr size_t WB_PROJ = WS_MIX, WB_W = WB_PROJ + (size_t)M * NBIN * 4, WB_U = WB_W + GUNITS * 64 * 128 * 4, WB_QG = WB_U + GUNITS * 64 * 128 * 4, WB_KD = WB_QG + GUNITS * 64 * 128 * 4,
                 WB_QK = WB_KD + GUNITS * 64 * 128 * 4, WB_EG = WB_QK + GUNITS * 64 * 64 * 4, WB_O = WB_EG + 65536, WB_OG = WB_O + (size_t)M * 1024 * 4, WB_END = WB_OG + (size_t)M * 1024 * 2;
constexpr size_t WC_PROJ = WS_MIX, WC_ACMP = WC_PROJ + (size_t)M * NCIN * 4, WC_HC = WC_ACMP + (size_t)2 * CMP_ROWS * 2048 * 2, WC_KCV = WC_HC + (size_t)2 * CMP_ROWS * 256 * 2,
                 WC_OA = WC_KCV + (size_t)2 * CMP_ROWS * 64 * 4, WC_KSB = WC_OA + (size_t)M * 1024 * 2, WC_VST = WC_KSB + (size_t)16 * SEQ * 64 * 2, WC_KWB = WC_VST + (size_t)16 * SEQ * 64 * 2, WC_VWT = WC_KWB + (size_t)16 * SEQ * 64 * 2,
                 WC_KCB = WC_VWT + (size_t)16 * SEQ * 64 * 2, WC_VCT = WC_KCB + (size_t)16 * 128 * 64 * 2, WC_END = WC_VCT + (size_t)16 * 128 * 64 * 2;
constexpr size_t WS_END = (WB_END > WC_END ? (WB_END > WA_END ? WB_END : WA_END) : (WC_END > WA_END ? WC_END : WA_END));
static_assert(WS_X % 256 == 0 && WS_MIX % 256 == 0 && WB_W % 256 == 0 && WC_ACMP % 256 == 0, "alignment");
constexpr int CW_TMO = 0, CW_BAR = 4096;
constexpr int LDS_BYTES = 147456, MISC_OFF = LDS_BYTES - 512;

#define GAS __attribute__((address_space(1)))
#define LAS __attribute__((address_space(3)))
typedef unsigned short bf16;
typedef float f32x4 __attribute__((ext_vector_type(4)));
typedef float f32x2 __attribute__((ext_vector_type(2)));
typedef unsigned u32x2 __attribute__((ext_vector_type(2)));
typedef unsigned u32x4 __attribute__((ext_vector_type(4)));
#define LDS_WAIT() asm volatile("s_waitcnt lgkmcnt(0)" ::: "memory")
__device__ __forceinline__ unsigned f2bf(float f) { unsigned u = __builtin_bit_cast(unsigned, f); return (u + 0x7fffu + ((u >> 16) & 1u)) >> 16; }
typedef __bf16 hwbf16x2_t __attribute__((ext_vector_type(2)));
__device__ __forceinline__ unsigned pk2(float lo, float hi) { const f32x2 v = {lo, hi}; const hwbf16x2_t b = __builtin_convertvector(v, hwbf16x2_t); return __builtin_bit_cast(unsigned, b); }
__device__ __forceinline__ float bf2f(bf16 b) { return __builtin_bit_cast(float, ((unsigned)b) << 16); }
__device__ __forceinline__ float wave_sum(float v) {
#pragma unroll
    for (int o = 1; o < 64; o <<= 1) v += __shfl_xor(v, o);
    return v;
}
__device__ __forceinline__ float wave_max(float v) {
#pragma unroll
    for (int o = 1; o < 64; o <<= 1) v = fmaxf(v, __shfl_xor(v, o));
    return v;
}
__device__ __forceinline__ float sigmoid_f(float x) { return 1.0f / (1.0f + __expf(-x)); }
__device__ __forceinline__ float siluf(float x) { return x * sigmoid_f(x); }
__device__ __forceinline__ float readlane_f(float v, int k) { return __builtin_bit_cast(float, __builtin_amdgcn_readlane(__builtin_bit_cast(int, v), k)); }
typedef short bf16x8_t __attribute__((ext_vector_type(8)));
#define MFMA16(a, b, cc) __builtin_amdgcn_mfma_f32_16x16x32_bf16((a), (b), (cc), 0, 0, 0)
#define XB_TMO      128
#define XB_XCNT(j)  (256  + 64 * (j))
#define XB_XSUB(j)  (1280 + 64 * (j))
#define XB_XGEN(j)  (2304 + 64 * (j))
#define XB_TOP      3328
#define XB_TOPGEN   3392
#define XCD_BAR_WORDS 3456
#define XB_SPIN_CAP (1u << 18)

__device__ __forceinline__ unsigned xb_ld(unsigned* p)              { return __hip_atomic_load(p, __ATOMIC_RELAXED, __HIP_MEMORY_SCOPE_AGENT); }
__device__ __forceinline__ unsigned xb_add(unsigned* p, unsigned v) { return __hip_atomic_fetch_add(p, v, __ATOMIC_RELAXED, __HIP_MEMORY_SCOPE_AGENT); }
__device__ __forceinline__ unsigned xb_xcc_id() { return (unsigned)__builtin_amdgcn_s_getreg((3 << 11) | 20) & 0xFu; }
#define XB_SPIN(cond, bar) do { unsigned _sp = 0; while (cond) { __builtin_amdgcn_s_sleep(1); \
    if ((++_sp & 255u) == 0u) { if (xb_ld(&(bar)[XB_TMO])) break; if (_sp > XB_SPIN_CAP) { atomicAdd(&(bar)[XB_TMO], 1u); break; } } } } while (0)

struct XcdBarrier {
    unsigned* bar; unsigned x;
    volatile LAS unsigned* st;
};

__device__ __forceinline__ XcdBarrier xcd_barrier_post(unsigned* bar, volatile LAS unsigned* st) {
    XcdBarrier b; b.bar = bar; b.x = xb_xcc_id(); b.st = st;
    if (threadIdx.x == 0) (void)xb_add(&bar[XB_XCNT(b.x)], 1u);
    return b;
}
__device__ __forceinline__ void xcd_barrier_complete(unsigned* bar, unsigned x, unsigned& nloc, unsigned& nx) {
    const unsigned G = gridDim.x * gridDim.y * gridDim.z;
    unsigned sum, cnt, mine, sp = 0u;
    for (;;) {
        sum = 0u; cnt = 0u; mine = 0u;
#pragma unroll
        for (unsigned j = 0; j < 16; ++j) { const unsigned c = xb_ld(&bar[XB_XCNT(j)]); sum += c; cnt += (c > 0u) ? 1u : 0u; mine = (j == x) ? c : mine; }
        if (sum == G) break;
        __builtin_amdgcn_s_sleep(1);
        if ((++sp & 255u) == 0u) { if (xb_ld(&bar[XB_TMO])) break; if (sp > XB_SPIN_CAP) { atomicAdd(&bar[XB_TMO], 1u); break; } }
    }
    nloc = mine > 0u ? mine : 1u; nx = cnt > 0u ? cnt : 1u;
}

__device__ __forceinline__ void xcd_barrier(const XcdBarrier& b) {
    asm volatile("s_waitcnt vmcnt(0)" ::: "memory");
    __syncthreads();
    if (threadIdx.x == 0) {
        unsigned* bar = b.bar;
        __builtin_amdgcn_s_waitcnt(0);
        unsigned nloc = b.st[0], nx = b.st[1];
        if (nloc == 0u) { xcd_barrier_complete(bar, b.x, nloc, nx); b.st[0] = nloc; b.st[1] = nx; }
        const unsigned old = xb_add(&bar[XB_XSUB(b.x)], 1u);
        const unsigned gen = old / nloc;
        if (old + 1u == (gen + 1u) * nloc) {
            __builtin_amdgcn_fence(__ATOMIC_RELEASE, "agent");
            asm volatile("s_waitcnt vmcnt(0)" ::: "memory");
            const unsigned og = xb_add(&bar[XB_TOP], 1u);
            const unsigned tg = og / nx;
            if (og + 1u == (tg + 1u) * nx) xb_add(&bar[XB_TOPGEN], 1u);
            else XB_SPIN(xb_ld(&bar[XB_TOPGEN]) == tg, bar);
            __builtin_amdgcn_fence(__ATOMIC_ACQUIRE, "agent");
            xb_add(&bar[XB_XGEN(b.x)], 1u);
            asm volatile("s_waitcnt vmcnt(0)" ::: "memory");
        } else {
            XB_SPIN(xb_ld(&bar[XB_XGEN(b.x)]) == gen, bar);
            __builtin_amdgcn_fence(__ATOMIC_ACQUIRE, "agent");
            asm volatile("s_waitcnt vmcnt(0)" ::: "memory");
        }
    }
    __syncthreads();
}
enum { I_XP = 0, I_XS, I_GS, I_GCONV, I_CKV, I_CWIN, I_PT, I_PP, I_PS, I_LNG, I_LNB, I_WUP, I_WDN, I_WG, I_WPJ, I_AWIN, I_ALNG, I_ALNB, I_AWS, I_ABS, I_AWOUT,
       I_BWIN, I_BCONV, I_BALOG, I_BDT, I_BNG, I_BWOUT, I_CWIN_W, I_CGB, I_CPE, I_CW1, I_CW2, I_CWOUT, I_T5, N_IN };
struct Ctx {
    LAS unsigned char* lds; unsigned char* ws; float* out; const float* const* in;
    int tid, lane, wave, G, gw, NGW;
};
#define WSF(off) ((float*)(c.ws + (off)))
#define WSB(off) ((bf16*)(c.ws + (off)))

__device__ __forceinline__ void tr_item(const float* W, int K, int N, bf16* WT, int mode, LAS float* scr, int item, int lane) {
    const int nblk = (N + 63) >> 6, kb = item / nblk, nb = item - kb * nblk, k0 = 64 * kb, n0 = 64 * nb;
    const int r = lane >> 4, c4 = lane & 15; const bool ok = n0 + 4 * c4 < N;
    f32x4 v[16];
#pragma unroll
    for (int i = 0; i < 16; ++i) v[i] = ok ? *(const f32x4*)(W + (size_t)(k0 + 4 * i + r) * N + n0 + 4 * c4) : (f32x4){0.f, 0.f, 0.f, 0.f};
#pragma unroll
    for (int i = 0; i < 16; ++i) { LAS float* d = scr + (4 * i + r) * 65 + 4 * c4; d[0] = v[i].x; d[1] = v[i].y; d[2] = v[i].z; d[3] = v[i].w; }
    LDS_WAIT(); asm volatile("" ::: "memory");
#pragma unroll
    for (int j = 0; j < 8; ++j) { const int id = lane + 64 * j, nl = id >> 3, cch = id & 7, n = n0 + nl; const LAS float* s = scr + (8 * cch) * 65 + nl;
        if (n < N) { u32x4 o; o.x = pk2(s[0 * 65], s[1 * 65]); o.y = pk2(s[2 * 65], s[3 * 65]); o.z = pk2(s[4 * 65], s[5 * 65]); o.w = pk2(s[6 * 65], s[7 * 65]);
            int drow = n; if (mode == 1) { const int half = n >= DFF ? 1 : 0, idx = n - half * DFF; drow = (idx >> 7) * 256 + half * 128 + (idx & 127); }
            *(u32x4*)(WT + (size_t)drow * K + k0 + 8 * cch) = o; } }
    LDS_WAIT(); asm volatile("" ::: "memory");
}
__device__ __forceinline__ void prologue_phase(const Ctx& c) {
    LAS float* scr = (LAS float*)(c.lds + c.wave * 16640);
    constexpr int IT_UP = 16 * 88, IT_DN = 44 * 16, IT_G = 16 * 16, IT_P = 4 * 16, IT_AIN = 16 * 64, IT_AOUT = 32 * 16, IT_BIN = 16 * 65, IT_CIN = 16 * 41, IT_C1 = 32 * 4;
    constexpr int NIT = 8 * IT_UP + 8 * IT_DN + 4 * IT_G + 4 * IT_P + 2 * IT_AIN + 2 * IT_AOUT + IT_BIN + IT_G + IT_CIN + IT_G + 2 * IT_C1;
    for (int it = c.gw; it < NIT; it += c.NGW) {
        int r = it, mi;
        if (r < 8 * IT_UP) { mi = r / IT_UP; tr_item(c.in[I_WUP] + (size_t)mi * 1024 * 5632, 1024, 5632, WSB(WS_WUP + mi * SZ_WUP), 1, scr, r - mi * IT_UP, c.lane); continue; } r -= 8 * IT_UP;
        if (r < 8 * IT_DN) { mi = r / IT_DN; tr_item(c.in[I_WDN] + (size_t)mi * 2816 * 1024, 2816, 1024, WSB(WS_WDN + mi * SZ_WDN), 0, scr, r - mi * IT_DN, c.lane); continue; } r -= 8 * IT_DN;
        if (r < 4 * IT_G) { mi = r / IT_G; tr_item(c.in[I_WG] + (size_t)mi * 1024 * 1024, 1024, 1024, WSB(WS_WG + mi * SZ_WG), 0, scr, r - mi * IT_G, c.lane); continue; } r -= 4 * IT_G;
        if (r < 4 * IT_P) { mi = r / IT_P; tr_item(c.in[I_WPJ] + (size_t)mi * 256 * 1024, 256, 1024, WSB(WS_WP + mi * SZ_WP), 0, scr, r - mi * IT_P, c.lane); continue; } r -= 4 * IT_P;
        if (r < 2 * IT_AIN) { mi = r / IT_AIN; tr_item(c.in[I_AWIN] + (size_t)mi * 1024 * 4096, 1024, 4096, WSB(WS_WAIN + mi * SZ_WAIN), 0, scr, r - mi * IT_AIN, c.lane); continue; } r -= 2 * IT_AIN;
        if (r < 2 * IT_AOUT) { mi = r / IT_AOUT; tr_item(c.in[I_AWOUT] + (size_t)mi * 2048 * 1024, 2048, 1024, WSB(WS_WAOUT + mi * SZ_WAOUT), 0, scr, r - mi * IT_AOUT, c.lane); continue; } r -= 2 * IT_AOUT;
        if (r < IT_BIN) { tr_item(c.in[I_BWIN], 1024, NBIN_REAL, WSB(WS_WBIN), 0, scr, r, c.lane); continue; } r -= IT_BIN;
        if (r < IT_G) { tr_item(c.in[I_BWOUT], 1024, 1024, WSB(WS_WBOUT), 0, scr, r, c.lane); continue; } r -= IT_G;
        if (r < IT_CIN) { tr_item(c.in[I_CWIN_W], 1024, NCIN_REAL, WSB(WS_WCIN), 0, scr, r, c.lane); continue; } r -= IT_CIN;
        if (r < IT_G) { tr_item(c.in[I_CWOUT], 1024, 1024, WSB(WS_WCOUT), 0, scr, r, c.lane); continue; } r -= IT_G;
        mi = r / IT_C1; tr_item(c.in[I_CW1] + (size_t)mi * 2048 * 256, 2048, 256, WSB(WS_WC1 + mi * SZ_WC1), 0, scr, r - mi * IT_C1, c.lane);
    }
    for (int i4 = c.gw * 64 + c.lane; i4 < 2 * 16 * 128 * 128 / 4; i4 += c.NGW * 64) { const int t = (i4 >> 5) & 127, s0 = (i4 & 31) * 4; const f32x4 w = *((const f32x4*)c.in[I_AWS] + i4);
        u32x2 o; o.x = pk2(s0 <= t ? w.x : 0.f, s0 + 1 <= t ? w.y : 0.f); o.y = pk2(s0 + 2 <= t ? w.z : 0.f, s0 + 3 <= t ? w.w : 0.f); *((u32x2*)WSB(WS_WSM) + i4) = o; }
    for (int r = c.gw; r < (NBIN - NBIN_REAL) + (NCIN - NCIN_REAL); r += c.NGW) {
        bf16* row = r < (NBIN - NBIN_REAL) ? WSB(WS_WBIN) + (size_t)(NBIN_REAL + r) * 1024 : WSB(WS_WCIN) + (size_t)(NCIN_REAL + r - (NBIN - NBIN_REAL)) * 1024;
        const u32x4 z = {0u, 0u, 0u, 0u}; *(u32x4*)(row + c.lane * 8) = z; *(u32x4*)(row + 512 + c.lane * 8) = z; }
    for (int row = c.gw; row < M; row += c.NGW) {
        const float* src = row < MP ? c.in[I_XP] + (size_t)row * 1024 : c.in[I_XS] + (size_t)(row - MP) * 1024;
        float* xd = WSF(WS_X) + (size_t)row * 1024; bf16* xn = WSB(WS_XNB) + (size_t)row * 1024;
#pragma unroll
        for (int j = 0; j < 4; ++j) { const f32x4 v = *((const f32x4*)src + c.lane + 64 * j); *((f32x4*)xd + c.lane + 64 * j) = v; u32x2 w; w.x = pk2(v.x, v.y); w.y = pk2(v.z, v.w); *((u32x2*)xn + c.lane + 64 * j) = w; }
    }
    for (int r = c.gw; r < 4 * M; r += c.NGW) {
        const int l = r / M, row = r - l * M;
        const float* src = row < MP ? c.in[I_PP] + ((size_t)l * MP + row) * 256 : c.in[I_PS] + ((size_t)l * MS + (row - MP)) * 256;
        const f32x4 v = *((const f32x4*)src + c.lane); u32x2 w; w.x = pk2(v.x, v.y); w.y = pk2(v.z, v.w); *((u32x2*)(WSB(WS_PBF) + (size_t)r * 256) + c.lane) = w;
    }
}
__device__ __forceinline__ void ln_phase(const Ctx& c, const float* g, const float* b, const int nsplit, const float sc) {
    f32x4 gv[4], bv[4];
#pragma unroll
    for (int j = 0; j < 4; ++j) { gv[j] = *((const f32x4*)g + c.lane + 64 * j); bv[j] = *((const f32x4*)b + c.lane + 64 * j); }
    for (int row = c.gw; row < M; row += c.NGW) {
        const f32x4* p = (const f32x4*)(WSF(WS_PRE) + (size_t)row * 1024) + c.lane;
        f32x4 v[4]; float s = 0.f;
        if (row < MP) {
#pragma unroll
            for (int j = 0; j < 4; ++j) v[j] = p[64 * j];
        } else {
            const f32x4* xq = (const f32x4*)(WSF(WS_X) + (size_t)row * 1024) + c.lane; const f32x4* sl = (const f32x4*)(WSF(WS_SLAB) + (size_t)(row - MP) * 1024) + c.lane;
#pragma unroll
            for (int j = 0; j < 4; ++j) { f32x4 a = {0.f, 0.f, 0.f, 0.f}; for (int k = 0; k < nsplit; ++k) a += sl[(size_t)k * (MS * 256) + 64 * j]; v[j] = xq[64 * j] * ALPHA + a * sc; }
        }
#pragma unroll
        for (int j = 0; j < 4; ++j) s += (v[j].x + v[j].y) + (v[j].z + v[j].w);
        const float mean = wave_sum(s) * (1.f / 1024.f); float s2 = 0.f;
#pragma unroll
        for (int j = 0; j < 4; ++j) { v[j] = v[j] - mean; s2 += (v[j].x * v[j].x + v[j].y * v[j].y) + (v[j].z * v[j].z + v[j].w * v[j].w); }
        const float rstd = 1.f / sqrtf(wave_sum(s2) * (1.f / 1024.f) + LN_EPS);
        float* xd = WSF(WS_X) + (size_t)row * 1024; bf16* xn = WSB(WS_XN) + (size_t)row * 1024;
#pragma unroll
        for (int j = 0; j < 4; ++j) { const f32x4 y = v[j] * rstd * gv[j] + bv[j]; *((f32x4*)xd + c.lane + 64 * j) = y; u32x2 w; w.x = pk2(y.x, y.y); w.y = pk2(y.z, y.w); *((u32x2*)xn + c.lane + 64 * j) = w; }
    }
}
__device__ __forceinline__ void a_stats_phase(const Ctx& c, int ia) {
    const float* lg = c.in[I_ALNG] + ia * 2048; const float* lb = c.in[I_ALNB] + ia * 2048;
    for (int row = c.gw; row < M; row += c.NGW) {
        const f32x4* p = (const f32x4*)(WSF(WA_V) + (size_t)row * 2048) + c.lane;
        f32x4 v[8]; float s = 0.f;
#pragma unroll
        for (int j = 0; j < 8; ++j) { v[j] = p[64 * j]; s += (v[j].x + v[j].y) + (v[j].z + v[j].w); }
        const float mean = wave_sum(s) * (1.f / 2048.f); float s2 = 0.f;
#pragma unroll
        for (int j = 0; j < 8; ++j) { v[j] = v[j] - mean; s2 += (v[j].x * v[j].x + v[j].y * v[j].y) + (v[j].z * v[j].z + v[j].w * v[j].w); }
        const float rstd = 1.f / sqrtf(wave_sum(s2) * (1.f / 2048.f) + LN_EPS);
        if (c.lane == 0) { WSF(WA_ST)[2 * row] = mean; WSF(WA_ST)[2 * row + 1] = rstd; }
        if (row >= MP) { float* o = c.out + O_AV + ((size_t)ia * MS + (row - MP)) * 2048;
#pragma unroll
            for (int j = 0; j < 8; ++j) { const f32x4 gg = *((const f32x4*)lg + c.lane + 64 * j), bb = *((const f32x4*)lb + c.lane + 64 * j); *((f32x4*)o + c.lane + 64 * j) = v[j] * rstd * gg + bb; } }
    }
}
__device__ __forceinline__ void a_sgu_phase(const Ctx& c, int ia) {
    const float* ws = c.in[I_AWS] + (size_t)ia * 16 * 128 * 128; const float* bs = c.in[I_ABS] + ia * 16 * 128; const bf16* wsm = WSB(WS_WSM) + (size_t)ia * 16 * 128 * 128;
    const float* lg = c.in[I_ALNG] + ia * 2048; const float* lb = c.in[I_ALNB] + ia * 2048;
    const float* V = WSF(WA_V); const float* ST = WSF(WA_ST); const bf16* U = WSB(WA_U); bf16* US = WSB(WA_US);
    for (int unit = blockIdx.x; unit < 2048 + DB; unit += c.G) {
        if (unit < 2048) {
            LAS bf16* vt = (LAS bf16*)c.lds; asm volatile("" : "+v"(vt));
            const int g = unit & 15, n = (unit >> 4) & 31, b = unit >> 9, rowbase = b * SEQ + n * 128;
            const int w = c.wave, fr = c.lane & 15, rq = c.lane >> 4, ta = w >> 1, dh = w & 1;
            bf16x8_t wf0[2], wf1[4];
            { const bf16* w0 = wsm + ((size_t)g * 128 + 16 * ta + fr) * 128 + 8 * rq; const bf16* w1 = wsm + ((size_t)g * 128 + 16 * (7 - ta) + fr) * 128 + 8 * rq;
#pragma unroll
              for (int ks = 0; ks < 2; ++ks) wf0[ks] = *(const bf16x8_t*)(w0 + 32 * ks);
#pragma unroll
              for (int ks = 0; ks < 4; ++ks) wf1[ks] = *(const bf16x8_t*)(w1 + 32 * ks); }
            __syncthreads();
            { const int d = c.tid & 127, sp = c.tid >> 7; const float gg = lg[g * 128 + d], bb = lb[g * 128 + d];
#pragma unroll 4
              for (int k = 0; k < 16; ++k) { const int s = 2 * (sp + 4 * k); const size_t r0 = rowbase + s;
                  const float v0 = (V[r0 * 2048 + g * 128 + d] - ST[2 * r0]) * ST[2 * r0 + 1] * gg + bb, v1 = (V[(r0 + 1) * 2048 + g * 128 + d] - ST[2 * r0 + 2]) * ST[2 * r0 + 3] * gg + bb;
                  *(LAS unsigned*)(vt + d * 132 + s) = pk2(v0, v1); } }
            __syncthreads();
            f32x4 acc[2][4];
#pragma unroll
            for (int e = 0; e < 2; ++e)
#pragma unroll
                for (int mb = 0; mb < 4; ++mb) acc[e][mb] = (f32x4){0.f, 0.f, 0.f, 0.f};
#pragma unroll
            for (int ks = 0; ks < 4; ++ks) {
#pragma unroll
                for (int mb = 0; mb < 4; ++mb) { const LAS bf16* xp = vt + (16 * (4 * dh + mb) + fr) * 132 + 32 * ks + 8 * rq; const u32x2 lo = *(const LAS u32x2*)xp, hi = *(const LAS u32x2*)(xp + 4);
                    const bf16x8_t xf = __builtin_bit_cast(bf16x8_t, (u32x4){lo.x, lo.y, hi.x, hi.y});
                    if (ks < 2) { if (2 * ks <= ta) acc[0][mb] = MFMA16(xf, wf0[ks < 2 ? ks : 0], acc[0][mb]); }
                    if (2 * ks <= 7 - ta) acc[1][mb] = MFMA16(xf, wf1[ks], acc[1][mb]); } }
#pragma unroll
            for (int e = 0; e < 2; ++e) { const int t = 16 * (e ? 7 - ta : ta) + fr; const float bias = bs[g * 128 + t]; const size_t o = (size_t)(rowbase + t) * 2048 + g * 128 + 64 * dh + 4 * rq;
#pragma unroll
                for (int mb = 0; mb < 4; ++mb) { const u32x2 uu = *(const u32x2*)(U + o + 16 * mb); const f32x4 sv = acc[e][mb] + bias;
                    u32x2 wv; wv.x = pk2(sv.x * bf2f((bf16)(uu.x & 0xffff)), sv.y * bf2f((bf16)(uu.x >> 16))); wv.y = pk2(sv.z * bf2f((bf16)(uu.y & 0xffff)), sv.w * bf2f((bf16)(uu.y >> 16)));
                    *(u32x2*)(US + o + 16 * mb) = wv; } }
        } else {
            const int sb = unit - 2048, c0 = c.tid * 4, g = c0 >> 7;
            const f32x4 gg = *(const f32x4*)(lg + c0), bb = *(const f32x4*)(lb + c0);
            f32x4 vnr[4];
#pragma unroll
            for (int t = 0; t < 4; ++t) { const int row = MP + 4 * sb + t; const f32x4 v = *(const f32x4*)(V + (size_t)row * 2048 + c0); vnr[t] = (v - ST[2 * row]) * ST[2 * row + 1] * gg + bb; }
#pragma unroll
            for (int t = 0; t < 4; ++t) { const int row = MP + 4 * sb + t; f32x4 sv = {0.f, 0.f, 0.f, 0.f};
#pragma unroll
                for (int s = 0; s <= t; ++s) sv += vnr[s] * ws[((size_t)g * 128 + t) * 128 + s];
                sv += bs[g * 128 + t];
                const u32x2 uu = *(const u32x2*)(U + (size_t)row * 2048 + c0);
                f32x4 y; y.x = sv.x * bf2f((bf16)(uu.x & 0xffff)); y.y = sv.y * bf2f((bf16)(uu.x >> 16)); y.z = sv.z * bf2f((bf16)(uu.y & 0xffff)); y.w = sv.w * bf2f((bf16)(uu.y >> 16));
                u32x2 w; w.x = pk2(y.x, y.y); w.y = pk2(y.z, y.w); *(u32x2*)(US + (size_t)row * 2048 + c0) = w; }
        }
    }
}
__device__ __forceinline__ void gdn_prep_phase(const Ctx& c) {
    const float* PJ = WSF(WB_PROJ); const float* cw = c.in[I_BCONV]; const float* alog = c.in[I_BALOG]; const float* dtb = c.in[I_BDT];
    bf16* GW = WSB(WB_W); float* GUT = WSF(WB_U); bf16* GQG = WSB(WB_QG); bf16* GKDT = WSB(WB_KD); bf16* GQK = WSB(WB_QK); float* GEG = WSF(WB_EG);
    for (int unit = blockIdx.x; unit < 2048 + 1024; unit += c.G) {
        __syncthreads();
        LAS float* lb = (LAS float*)c.lds; asm volatile("" : "+v"(lb));
        LAS float* kf = lb; LAS float* vf = kf + 64 * 129; LAS float* Am = vf + 64 * 129; LAS float* gc = Am + 64 * 64; LAS float* bt = gc + 64;
        LAS bf16* kb = (LAS bf16*)(bt + 64); LAS bf16* qb = kb + 64 * 136;
        if (unit < 2048) {
            const int ci = unit & 63, h = (unit >> 6) & 7, b = unit >> 9, rb = b * SEQ + ci * 64;
            if (c.tid < 64) { const size_t row = rb + c.tid; const float bl = PJ[row * NBIN + 4096 + h], al = PJ[row * NBIN + 4104 + h];
                const float x = al + dtb[h]; const float sp = x > 20.f ? x : log1pf(expf(x)); float g = -expf(alog[h]) * sp;
#pragma unroll
                for (int o = 1; o < 64; o <<= 1) { const float t = __shfl_up(g, o); if (c.lane >= o) g += t; }
                gc[c.tid] = g; bt[c.tid] = sigmoid_f(bl); }
            __syncthreads();
            { const int tk0 = c.wave * 8, tabs0 = ci * 64 + tk0; const size_t row0 = rb + tk0;
              f32x2 xr[3][11], wv[3][4];
#pragma unroll
              for (int part = 0; part < 3; ++part) { const int ch = part * 1024 + h * 128 + 2 * c.lane;
#pragma unroll
                  for (int j = 0; j < 4; ++j) wv[part][j] = *(const f32x2*)(cw + j * 3072 + ch);
#pragma unroll
                  for (int r = 0; r < 11; ++r) xr[part][r] = (tabs0 - 3 + r >= 0) ? *(const f32x2*)(PJ + (row0 + r - 3) * NBIN + ch) : (f32x2){0.f, 0.f}; }
#pragma unroll
              for (int i = 0; i < 8; ++i) { const int tk = tk0 + i;
#pragma unroll
                  for (int part = 0; part < 3; ++part) { float a0 = 0.f, a1 = 0.f;
#pragma unroll
                      for (int j = 0; j < 4; ++j) { a0 += xr[part][i + j].x * wv[part][j].x; a1 += xr[part][i + j].y * wv[part][j].y; }
                      a0 = siluf(a0); a1 = siluf(a1);
                      if (part < 2) { const float ss = wave_sum(a0 * a0 + a1 * a1); const float sc = (1.f / sqrtf(ss + NORM_EPS)) * (part == 0 ? 0.08838834764831845f : 1.f); a0 *= sc; a1 *= sc; }
                      if (part == 0) { *(LAS unsigned*)(qb + tk * 136 + 2 * c.lane) = pk2(a0, a1); const float eg = expf(gc[tk]); *(unsigned*)(GQG + (size_t)unit * 8192 + tk * 128 + 2 * c.lane) = pk2(a0 * eg, a1 * eg); }
                      else if (part == 1) { *(LAS unsigned*)(kb + tk * 136 + 2 * c.lane) = pk2(a0, a1); kf[tk * 129 + 2 * c.lane] = a0; kf[tk * 129 + 2 * c.lane + 1] = a1; }
                      else { vf[tk * 129 + 2 * c.lane] = a0; vf[tk * 129 + 2 * c.lane + 1] = a1; } } } }
            __syncthreads();
            { const int fr = c.lane & 15, rq = c.lane >> 4;
#pragma unroll 1
              for (int bi = c.wave; bi < 16; bi += 8) {
                  const int mbj = bi < 10 ? (bi == 0 ? 0 : bi == 1 ? 0 : bi == 2 ? 1 : bi == 3 ? 0 : bi == 4 ? 1 : bi == 5 ? 2 : bi == 6 ? 0 : bi == 7 ? 1 : bi == 8 ? 2 : 3) : (bi == 10 ? 1 : bi == 11 ? 2 : bi == 12 ? 3 : bi == 13 ? 2 : bi == 14 ? 3 : 3);
                  const int nbi = bi < 10 ? (bi == 0 ? 0 : bi <= 2 ? 1 : bi <= 5 ? 2 : 3) : (bi <= 12 ? 0 : bi <= 14 ? 1 : 2);
                  const int i = 16 * nbi + fr, j0 = 16 * mbj + 4 * rq;
                  f32x4 akk = {0.f, 0.f, 0.f, 0.f}, aqk = {0.f, 0.f, 0.f, 0.f};
                  if (bi < 10) {
#pragma unroll
                      for (int ks = 0; ks < 4; ++ks) { const bf16x8_t xk = *(const LAS bf16x8_t*)(kb + (16 * mbj + fr) * 136 + 32 * ks + 8 * rq), yk = *(const LAS bf16x8_t*)(kb + i * 136 + 32 * ks + 8 * rq), yq = *(const LAS bf16x8_t*)(qb + i * 136 + 32 * ks + 8 * rq);
                          akk = MFMA16(xk, yk, akk); aqk = MFMA16(xk, yq, aqk); } }
                  const float gi = gc[i], bi_ = bt[i]; f32x4 av, qv;
#pragma unroll
                  for (int r = 0; r < 4; ++r) { const int j = j0 + r; const float dec = (i >= j) ? expf(gi - gc[j]) : 0.f; av[r] = (i > j) ? bi_ * akk[r] * dec : 0.f; qv[r] = (i >= j) ? aqk[r] * dec : 0.f; }
                  *(LAS f32x4*)(Am + i * 64 + j0) = av; u32x2 wv; wv.x = pk2(qv[0], qv[1]); wv.y = pk2(qv[2], qv[3]); *(u32x2*)(GQK + ((size_t)unit * 64 + i) * 64 + j0) = wv; } }
            __syncthreads();
            if (c.tid < 256) { const bool isw = c.tid >= 128; const int cc = c.tid & 127; float x[64];
#pragma unroll
                for (int i = 0; i < 64; ++i) x[i] = 0.f;
#pragma unroll
                for (int i = 0; i < 64; ++i) { float r = isw ? kf[i * 129 + cc] * bt[i] * expf(gc[i]) : vf[i * 129 + cc] * bt[i];
                    float pa[4] = {0.f, 0.f, 0.f, 0.f};
#pragma unroll
                    for (int j4 = 0; j4 < (i + 3) / 4; ++j4) { const f32x4 a4 = *(const LAS f32x4*)(Am + i * 64 + 4 * j4); pa[j4 & 3] += (a4.x * x[4 * j4] + a4.y * x[4 * j4 + 1]) + (a4.z * x[4 * j4 + 2] + a4.w * x[4 * j4 + 3]); }
                    r -= (pa[0] + pa[1]) + (pa[2] + pa[3]);
                    x[i] = r; if (isw) GW[((size_t)unit * 64 + i) * 128 + cc] = (bf16)f2bf(r); }
                if (!isw) { float* dst = GUT + ((size_t)unit * 128 + cc) * 64;
#pragma unroll
                    for (int k = 0; k < 16; ++k) *(f32x4*)(dst + 4 * k) = (f32x4){x[4 * k], x[4 * k + 1], x[4 * k + 2], x[4 * k + 3]}; } }
            for (int idx = c.tid; idx < 1024; idx += 512) { const int dk = idx & 127, ch = idx >> 7; const float gl = gc[63]; unsigned e[4];
#pragma unroll
                for (int k = 0; k < 4; ++k) { const int c0 = 8 * ch + 2 * k; e[k] = pk2(kf[c0 * 129 + dk] * expf(gl - gc[c0]), kf[(c0 + 1) * 129 + dk] * expf(gl - gc[c0 + 1])); }
                *(u32x4*)(GKDT + (size_t)unit * 8192 + dk * 64 + 8 * ch) = (u32x4){e[0], e[1], e[2], e[3]}; }
            if (c.tid == 0) GEG[unit] = expf(gc[63]);
        } else {
            const int su = unit - 2048, h = su & 7, b = su >> 3;
            LAS float* q4 = lb; LAS float* k4 = q4 + 512; LAS float* v4 = k4 + 512; LAS float* red = v4 + 512; LAS float* o4 = red + 512; LAS float* g4 = o4 + 512; LAS float* b4 = g4 + 4;
            const float* cst = c.in[I_GCONV] + (size_t)b * 3 * 3072;
            { const int t = c.tid >> 7, chl = c.tid & 127;
#pragma unroll
              for (int part = 0; part < 3; ++part) { const int ch = part * 1024 + h * 128 + chl; float a = 0.f;
#pragma unroll
                  for (int j = 0; j < 4; ++j) { const int mm = t + j; const float x = mm < 3 ? cst[mm * 3072 + ch] : PJ[(size_t)(MP + 4 * b + mm - 3) * NBIN + ch]; a += x * cw[j * 3072 + ch]; }
                  (part == 0 ? q4 : (part == 1 ? k4 : v4))[t * 128 + chl] = siluf(a); }
              if (c.tid < 4) { const size_t row = MP + 4 * b + c.tid; const float bl = PJ[row * NBIN + 4096 + h], al = PJ[row * NBIN + 4104 + h];
                  const float x = al + dtb[h]; const float sp = x > 20.f ? x : log1pf(expf(x)); g4[c.tid] = -expf(alog[h]) * sp; b4[c.tid] = sigmoid_f(bl); } }
            __syncthreads();
            { const int t = c.tid >> 7, chl = c.tid & 127; float sq = 0.f, sk = 0.f;
              for (int d = 0; d < 128; ++d) { const float a = q4[t * 128 + d], bb = k4[t * 128 + d]; sq += a * a; sk += bb * bb; }
              const float qv = q4[t * 128 + chl] * (1.f / sqrtf(sq + NORM_EPS)) * 0.08838834764831845f, kv = k4[t * 128 + chl] * (1.f / sqrtf(sk + NORM_EPS));
              __syncthreads();
              q4[t * 128 + chl] = qv; k4[t * 128 + chl] = kv; }
            __syncthreads();
            const int dv = c.tid & 127, part = c.tid >> 7;
            float S[32];
            const float* S0 = c.in[I_GS] + (((size_t)b * 8 + h) * 128 + part * 32) * 128 + dv;
#pragma unroll
            for (int i = 0; i < 32; ++i) S[i] = S0[(size_t)i * 128];
#pragma unroll 1
            for (int t = 0; t < 4; ++t) { const float a = expf(g4[t]); float p = 0.f;
#pragma unroll
                for (int i = 0; i < 32; ++i) p += k4[t * 128 + part * 32 + i] * S[i];
                red[part * 128 + dv] = p; __syncthreads();
                const float kS = (red[dv] + red[128 + dv]) + (red[256 + dv] + red[384 + dv]); const float vnew = b4[t] * (v4[t * 128 + dv] - a * kS); float po = 0.f;
#pragma unroll
                for (int i = 0; i < 32; ++i) { S[i] = a * S[i] + k4[t * 128 + part * 32 + i] * vnew; po += q4[t * 128 + part * 32 + i] * S[i]; }
                __syncthreads(); red[part * 128 + dv] = po; __syncthreads();
                if (part == 0) o4[t * 128 + dv] = (red[dv] + red[128 + dv]) + (red[256 + dv] + red[384 + dv]);
                __syncthreads(); }
            float* So = c.out + O_GSS + (((size_t)b * 8 + h) * 128 + part * 32) * 128 + dv;
#pragma unroll
            for (int i = 0; i < 32; ++i) So[(size_t)i * 128] = S[i];
            { const int t = c.tid >> 7; float ms = 0.f;
              for (int d = 0; d < 128; ++d) { const float o = o4[t * 128 + d]; ms += o * o; }
              const size_t row = MP + 4 * b + t; const float z = PJ[row * NBIN + 3072 + h * 128 + dv];
              const float y = o4[t * 128 + dv] * (1.f / sqrtf(ms * (1.f / 128.f) + NORM_EPS)) * c.in[I_BNG][dv] * siluf(z);
              WSB(WB_OG)[row * 1024 + h * 128 + dv] = (bf16)f2bf(y); }
        }
    }
    for (size_t idx = (size_t)blockIdx.x * 512 + c.tid; idx < 36864 + 1179648; idx += (size_t)c.G * 512) {
        if (idx < 36864) { const int b = (int)(idx / 9216), r = (int)(idx % 9216), j = r / 3072, ch = r % 3072; c.out[O_GCP + idx] = PJ[((size_t)b * SEQ + SEQ - 3 + j) * NBIN + ch]; }
        else { const size_t k = idx - 36864; const int b = (int)(k / 9216), r = (int)(k % 9216), j = r / 3072, ch = r % 3072; c.out[O_GCS + k] = PJ[((size_t)MP + 4 * b + 1 + j) * NBIN + ch]; }
    }
}
struct ScanFr { bf16x8_t a4[4], b2[2], kd[2]; f32x4 u; float eg; };
__device__ __forceinline__ void scan_load(ScanFr& f, const bf16* GW, const bf16* GQG, const bf16* GKDT, const bf16* GQK, const float* GUT, const float* GEG, size_t pu, int w, int fr, int rq, int dvs) {
    const int mb = w & 3; const bf16* a = (w < 4 ? GW : GQG) + pu * 8192 + (16 * mb + fr) * 128 + 8 * rq;
#pragma unroll
    for (int ks = 0; ks < 4; ++ks) f.a4[ks] = *(const bf16x8_t*)(a + 32 * ks);
    const bf16* q = GQK + pu * 4096 + (16 * mb + fr) * 64 + 8 * rq; f.b2[0] = *(const bf16x8_t*)q; f.b2[1] = *(const bf16x8_t*)(q + 32);
    const bf16* k = GKDT + pu * 8192 + (16 * w + fr) * 64 + 8 * rq; f.kd[0] = *(const bf16x8_t*)k; f.kd[1] = *(const bf16x8_t*)(k + 32);
    f.u = *(const f32x4*)(GUT + (pu * 128 + dvs * 16 + fr) * 64 + 16 * mb + 4 * rq); f.eg = GEG[pu];
}
__device__ __forceinline__ void gdn_scan_phase(const Ctx& c) {
    const bf16* GW = WSB(WB_W); const float* GUT = WSF(WB_U); const bf16* GQG = WSB(WB_QG); const bf16* GKDT = WSB(WB_KD); const bf16* GQK = WSB(WB_QK); const float* GEG = WSF(WB_EG);
    float* GO = WSF(WB_O);
    for (int uu = blockIdx.x; uu < 256; uu += c.G) {
        LAS unsigned char* L = c.lds; asm volatile("" : "+v"(L));
        LAS bf16* ST = (LAS bf16*)L; LAS bf16* VNT = ST + 16 * 136;
        const int bh = (uu & 7) * 4 + (uu >> 6), dvs = (uu >> 3) & 7, b = bh >> 3, h = bh & 7;
        const int w = c.wave, fr = c.lane & 15, rq = c.lane >> 4, mb = w & 3;
        __syncthreads();
        for (int i = c.tid; i < 16 * 136 / 2; i += 512) ((LAS unsigned*)ST)[i] = 0u;
        f32x4 Sacc = {0.f, 0.f, 0.f, 0.f};
        ScanFr cur, nxt; scan_load(cur, GW, GQG, GKDT, GQK, GUT, GEG, (size_t)bh * 64, w, fr, rq, dvs);
        for (int ci = 0; ci < 64; ++ci) {
            const size_t pu = (size_t)bh * 64 + ci;
            if (ci < 63) scan_load(nxt, GW, GQG, GKDT, GQK, GUT, GEG, pu + 1, w, fr, rq, dvs);
            __syncthreads();
            f32x4 acc = {0.f, 0.f, 0.f, 0.f};
#pragma unroll
            for (int ks = 0; ks < 4; ++ks) { const bf16x8_t y = *(const LAS bf16x8_t*)(ST + fr * 136 + 32 * ks + 8 * rq); acc = MFMA16(cur.a4[ks], y, acc); }
            if (w < 4) { const f32x4 vn = cur.u - acc; u32x2 wv; wv.x = pk2(vn[0], vn[1]); wv.y = pk2(vn[2], vn[3]); *(LAS u32x2*)(VNT + fr * 72 + 16 * mb + 4 * rq) = wv; }
            __syncthreads();
            const bf16x8_t y0 = *(const LAS bf16x8_t*)(VNT + fr * 72 + 8 * rq), y1 = *(const LAS bf16x8_t*)(VNT + fr * 72 + 32 + 8 * rq);
            if (w >= 4) { acc = MFMA16(cur.b2[0], y0, acc); acc = MFMA16(cur.b2[1], y1, acc);
                float* o = GO + ((size_t)b * SEQ + ci * 64 + 16 * mb + 4 * rq) * 1024 + h * 128 + dvs * 16 + fr;
#pragma unroll
                for (int i = 0; i < 4; ++i) o[(size_t)i * 1024] = acc[i]; }
            Sacc *= cur.eg; Sacc = MFMA16(cur.kd[0], y0, Sacc); Sacc = MFMA16(cur.kd[1], y1, Sacc);
            { u32x2 wv; wv.x = pk2(Sacc[0], Sacc[1]); wv.y = pk2(Sacc[2], Sacc[3]); *(LAS u32x2*)(ST + fr * 136 + 16 * w + 4 * rq) = wv; }
            cur = nxt;
        }
#pragma unroll
        for (int i = 0; i < 4; ++i) c.out[O_GSP + (((size_t)b * 8 + h) * 128 + 16 * w + 4 * rq + i) * 128 + dvs * 16 + fr] = Sacc[i];
    }
}
__device__ __forceinline__ void gdn_post_phase(const Ctx& c) {
    const float* GO = WSF(WB_O); const float* PJ = WSF(WB_PROJ); const float* ng = c.in[I_BNG];
    for (int row = c.gw; row < MP; row += c.NGW) {
        const f32x4* p = (const f32x4*)(GO + (size_t)row * 1024 + c.lane * 16); f32x4 v[4]; float s = 0.f;
#pragma unroll
        for (int j = 0; j < 4; ++j) { v[j] = p[j]; s += (v[j].x * v[j].x + v[j].y * v[j].y) + (v[j].z * v[j].z + v[j].w * v[j].w); }
        s += __shfl_xor(s, 1); s += __shfl_xor(s, 2); s += __shfl_xor(s, 4);
        const float r = 1.f / sqrtf(s * (1.f / 128.f) + NORM_EPS);
        const f32x4* zp = (const f32x4*)(PJ + (size_t)row * NBIN + 3072 + c.lane * 16); const f32x4* gp = (const f32x4*)(ng + (c.lane & 7) * 16);
        u32x2* op = (u32x2*)(WSB(WB_OG) + (size_t)row * 1024 + c.lane * 16);
#pragma unroll
        for (int j = 0; j < 4; ++j) { const f32x4 z = zp[j], g = gp[j]; f32x4 y; y.x = v[j].x * r * g.x * siluf(z.x); y.y = v[j].y * r * g.y * siluf(z.y); y.z = v[j].z * r * g.z * siluf(z.z); y.w = v[j].w * r * g.w * siluf(z.w);
            u32x2 w; w.x = pk2(y.x, y.y); w.y = pk2(y.z, y.w); op[j] = w; }
    }
}
__device__ const unsigned char T5_LUT[128] = {0, 1, 2, 3, 4, 5, 6, 7, 8, 9, 10, 11, 12, 13, 14, 15, 16, 16, 16, 17, 17, 18, 18, 18, 19, 19, 19, 20, 20, 20, 20, 21, 21, 21, 21, 22, 22, 22, 22, 22, 23, 23, 23, 23, 23, 23, 24, 24, 24, 24, 24, 24, 25, 25, 25, 25, 25, 25, 25, 26, 26, 26, 26, 26, 26, 26, 26, 27, 27, 27, 27, 27, 27, 27, 27, 27, 27, 28, 28, 28, 28, 28, 28, 28, 28, 28, 28, 29, 29, 29, 29, 29, 29, 29, 29, 29, 29, 29, 29, 30, 30, 30, 30, 30, 30, 30, 30, 30, 30, 30, 30, 30, 30, 31, 31, 31, 31, 31, 31, 31, 31, 31, 31, 31, 31, 31, 31, 31};
__device__ __forceinline__ void nsa_prep_phase(const Ctx& c) {
    const float* PJ = WSF(WC_PROJ);
    for (size_t i4 = (size_t)blockIdx.x * 512 + c.tid; i4 < (size_t)M * 256; i4 += (size_t)c.G * 512) { const size_t row = i4 >> 8; const int c4 = (int)(i4 & 255);
        const f32x4 v = *(const f32x4*)(PJ + row * NCIN + 1024 + c4 * 4);
        if (row < MP) *(f32x4*)(c.out + O_KVP + row * 1024 + c4 * 4) = v; else *(f32x4*)(c.out + O_KVS + (row - MP) * 1024 + c4 * 4) = v; }
    for (size_t i4 = (size_t)blockIdx.x * 512 + c.tid; i4 < (size_t)(2048 + MS) * 128; i4 += (size_t)c.G * 512) { const size_t r = i4 >> 7; const int c4 = (int)(i4 & 127);
        const size_t row = r < 2048 ? (r >> 9) * SEQ + (SEQ - 512) + (r & 511) : MP + (r - 2048);
        const f32x4 v = *(const f32x4*)(PJ + row * NCIN + 2048 + c4 * 4);
        if (r < 2048) *(f32x4*)(c.out + O_WINP + r * 512 + c4 * 4) = v; else *(f32x4*)(c.out + O_WINS + (r - 2048) * 512 + c4 * 4) = v; }
    { LAS bf16* vt = (LAS bf16*)c.lds;
      bf16* KSB = WSB(WC_KSB); bf16* VST = WSB(WC_VST); bf16* KWB = WSB(WC_KWB); bf16* VWT = WSB(WC_VWT);
      for (int u = blockIdx.x; u < 256; u += c.G) { const int b = u >> 6, tb = u & 63; const size_t row0 = (size_t)b * SEQ + 64 * tb;
          __syncthreads();
          for (int idx = c.tid; idx < 64 * 256; idx += 512) { const int t = idx >> 8, q = idx & 255, sect = q >> 6, c4 = q & 63;
              const f32x4 v = *(const f32x4*)(PJ + (row0 + t) * NCIN + 1536 + sect * 256 + c4 * 4); u32x2 w; w.x = pk2(v.x, v.y); w.y = pk2(v.z, v.w);
              const int g = c4 >> 4, d = (c4 & 15) * 4;
              if (sect == 0) *(u32x2*)(KSB + (((size_t)(b * 4 + g) * SEQ + 64 * tb + t) * 64 + d)) = w;
              else if (sect == 2) *(u32x2*)(KWB + (((size_t)(b * 4 + g) * SEQ + 64 * tb + t) * 64 + d)) = w;
              else *(LAS u32x2*)(vt + t * 520 + (sect == 1 ? 0 : 256) + c4 * 4) = w; }
          __syncthreads();
          for (int idx = c.tid; idx < 512 * 8; idx += 512) { const int col = idx >> 3, ch = idx & 7; unsigned short e[8];
#pragma unroll
              for (int k = 0; k < 8; ++k) e[k] = vt[(8 * ch + k) * 520 + col];
              u32x4 w; w.x = e[0] | ((unsigned)e[1] << 16); w.y = e[2] | ((unsigned)e[3] << 16); w.z = e[4] | ((unsigned)e[5] << 16); w.w = e[6] | ((unsigned)e[7] << 16);
              const int cc = col & 255, g = cc >> 6, d = cc & 63; bf16* dst = (col < 256 ? VST : VWT) + ((size_t)(b * 4 + g) * 64 + d) * SEQ + 64 * tb + 8 * ch;
              *(u32x4*)dst = w; } }
      __syncthreads(); }
    bf16* AC = WSB(WC_ACMP); const float* pe = c.in[I_CPE]; const int* pt = (const int*)c.in[I_PT]; const float* ckv = c.in[I_CKV];
    for (int R = c.gw; R < 2 * CMP_ROWS; R += c.NGW) {
        const int which = R >= CMP_ROWS ? 1 : 0, r = R - which * CMP_ROWS;
        const float* src; size_t lstride;
        if (r < 2048) { const int g = r & 3, n = (r >> 2) & 127, b = r >> 9; src = PJ + ((size_t)b * SEQ + 32 * n) * NCIN + 1024 + which * 256 + g * 64; lstride = NCIN; }
        else { const int q = r - 2048, g = q & 3, n = (q >> 2) & 63, b = q >> 8; const int page = pt[b * 16 + (n >> 2)];
            src = ckv + (((size_t)page * 128 + (n & 3) * 32) * 16 + which * 4 + g) * 64; lstride = 1024; }
#pragma unroll
        for (int k = 0; k < 8; ++k) { const int idx = c.lane + 64 * k, l = idx >> 4, d4 = idx & 15;
            const f32x4 v = *(const f32x4*)(src + (size_t)l * lstride + d4 * 4) + *(const f32x4*)(pe + (which * 32 + l) * 64 + d4 * 4);
            u32x2 w; w.x = pk2(v.x, v.y); w.y = pk2(v.z, v.w); *(u32x2*)(AC + (size_t)R * 2048 + l * 64 + d4 * 4) = w; }
    }
}
__device__ __forceinline__ void nsa_cmp2_phase(const Ctx& c) {
    LAS float* w2 = (LAS float*)c.lds;
    __syncthreads();
    for (int i = c.tid; i < 2 * 256 * 64 / 4; i += 512) *(LAS f32x4*)(w2 + 4 * i) = *((const f32x4*)c.in[I_CW2] + i);
    __syncthreads();
    const bf16* HC = WSB(WC_HC); float* KCV = WSF(WC_KCV);
    for (int R = c.gw; R < 2 * CMP_ROWS; R += c.NGW) {
        const LAS float* w = w2 + (R >= CMP_ROWS ? 256 * 64 : 0) + c.lane; const u32x4* hp = (const u32x4*)(HC + (size_t)R * 256); float a = 0.f;
#pragma unroll 4
        for (int k8 = 0; k8 < 32; ++k8) { const u32x4 hv = hp[k8]; const unsigned hw[4] = {hv.x, hv.y, hv.z, hv.w};
#pragma unroll
            for (int j = 0; j < 4; ++j) { a += bf2f((bf16)(hw[j] & 0xffff)) * w[(8 * k8 + 2 * j) * 64]; a += bf2f((bf16)(hw[j] >> 16)) * w[(8 * k8 + 2 * j + 1) * 64]; } }
        KCV[(size_t)R * 64 + c.lane] = a;
        { const int which = R >= CMP_ROWS ? 1 : 0, r = R - which * CMP_ROWS;
          if (r < 2048) { const int g = r & 3, n = (r >> 2) & 127, b = r >> 9; if (which == 0) WSB(WC_KCB)[((size_t)(b * 4 + g) * 128 + n) * 64 + c.lane] = (bf16)f2bf(a); else WSB(WC_VCT)[((size_t)(b * 4 + g) * 64 + c.lane) * 128 + n] = (bf16)f2bf(a); } }
    }
}
struct AttSt { float m[4], l[4]; f32x4 o[4]; };
__device__ __forceinline__ void att_reset(AttSt& s) {
#pragma unroll
    for (int h = 0; h < 4; ++h) { s.m[h] = -1e30f; s.l[h] = 0.f; s.o[h] = (f32x4){0.f, 0.f, 0.f, 0.f}; } }
__device__ __forceinline__ void att_scores(const LAS float* qs, const LAS float* tabl, const float* kptr, bool valid, int dist, int g, float (&s)[4]) {
    const f32x4* kp = (const f32x4*)kptr;
    f32x4 kv[16];
#pragma unroll
    for (int u = 0; u < 16; ++u) kv[u] = kp[u];
    float s0 = 0.f, s1 = 0.f, s2 = 0.f, s3 = 0.f;
#pragma unroll 1
    for (int h = 0; h < 4; ++h) {
        float a = 0.f;
#pragma unroll
        for (int u = 0; u < 16; ++u) { const f32x4 q = *(const LAS f32x4*)(qs + h * 64 + u * 4); a += (q.x * kv[u].x + q.y * kv[u].y) + (q.z * kv[u].z + q.w * kv[u].w); }
        s0 = h == 0 ? a : s0; s1 = h == 1 ? a : s1; s2 = h == 2 ? a : s2; s3 = h == 3 ? a : s3; }
    s[0] = s0; s[1] = s1; s[2] = s2; s[3] = s3;
    const int dd = dist < 0 ? 0 : dist; const int bk = dd < 128 ? (int)T5_LUT[dd] : 31;
    const f32x4 bias = *(const LAS f32x4*)(tabl + bk * 16 + g * 4);
#pragma unroll
    for (int h = 0; h < 4; ++h) s[h] = valid ? s[h] + bias[h] : -1e30f;
}
__device__ __forceinline__ void att_pv(AttSt& st, LAS f32x4* P, LAS unsigned long long* R, const float (&p)[4], const float* rowp, int voff, int lane) {
    P[lane] = (f32x4){p[0], p[1], p[2], p[3]}; R[lane] = (unsigned long long)rowp;
    LDS_WAIT();
#pragma unroll
    for (int i = 0; i < 16; ++i) { const int key = 4 * i + (lane >> 4); const f32x4 p4 = P[key]; const float* rp = (const float*)R[key];
        const f32x4 v = *(const f32x4*)(rp + voff + (lane & 15) * 4);
        st.o[0] += v * p4.x; st.o[1] += v * p4.y; st.o[2] += v * p4.z; st.o[3] += v * p4.w; }
    LDS_WAIT();
}
__device__ __forceinline__ void att_block(AttSt& st, const LAS float* qs, const LAS float* tabl, LAS f32x4* P, LAS unsigned long long* R, const float* kptr, const float* safe, bool valid, int dist, int voff, int g, int lane) {
    const float* rowp = valid ? kptr : safe; float s[4], p[4];
    att_scores(qs, tabl, rowp, valid, dist, g, s);
#pragma unroll
    for (int h = 0; h < 4; ++h) { const float mx = wave_max(s[h]), mn = fmaxf(st.m[h], mx), sc = __expf(st.m[h] - mn); p[h] = valid ? __expf(s[h] - mn) : 0.f;
        st.l[h] = st.l[h] * sc + wave_sum(p[h]); st.o[h] *= sc; st.m[h] = mn; }
    att_pv(st, P, R, p, rowp, voff, lane);
}
__device__ __forceinline__ void att_finish(AttSt& st, const float (&gate)[4], f32x4 (&acc)[4]) {
#pragma unroll
    for (int h = 0; h < 4; ++h) { f32x4 o = st.o[h];
#pragma unroll
        for (int k = 0; k < 4; ++k) { o[k] += __shfl_xor(o[k], 16); o[k] += __shfl_xor(o[k], 32); }
        const float inv = st.l[h] > 0.f ? gate[h] / st.l[h] : 0.f; acc[h] += o * inv; }
}
__device__ __forceinline__ void nsa_attn_phase(const Ctx& c, const int item0) {
    LAS float* tabl = (LAS float*)c.lds;
    LAS float* qs = tabl + 512 + c.wave * 768;
    LAS f32x4* P = (LAS f32x4*)(qs + 256); LAS unsigned long long* R = (LAS unsigned long long*)(qs + 512); LAS float* pcs = qs + 640;
    __syncthreads();
    for (int i = c.tid; i < 512; i += 512) tabl[i] = c.in[I_T5][i];
    __syncthreads();
    const float* PJ = WSF(WC_PROJ); const float* KCV = WSF(WC_KCV); const float* gb = c.in[I_CGB]; const int* pt = (const int*)c.in[I_PT]; const float* ckv = c.in[I_CKV]; const float* cwin = c.in[I_CWIN];
    bf16* OA = WSB(WC_OA);
    for (int item = item0 + c.gw; item < 65536 + 2048; item += c.NGW) {
        int lane = c.lane; asm volatile("" : "+v"(lane));
        const bool smp = item >= 65536; int b, g, t, qpos, ncmp, nslc; size_t row;
        if (!smp) { g = item & 3; b = (item >> 2) & 3; t = item >> 4; qpos = t; row = (size_t)b * SEQ + t; ncmp = 128; nslc = 64; }
        else { const int q = item - 65536; g = q & 3; t = (q >> 2) & 3; b = q >> 4; qpos = 2048 + t; row = (size_t)MP + 4 * b + t; ncmp = 64; nslc = 33; }
        const float* qrow = PJ + row * NCIN;
        { const f32x4 qv = *(const f32x4*)(qrow + g * 256 + lane * 4); *(LAS f32x4*)(qs + lane * 4) = qv * 0.125f; }
        float gv = 0.f; if (lane < 12) { const int gi = (lane >> 2) * 16 + g * 4 + (lane & 3); gv = sigmoid_f(qrow[2560 + gi] + gb[gi]); }
        float gate_c[4], gate_s[4], gate_w[4];
#pragma unroll
        for (int h = 0; h < 4; ++h) { gate_c[h] = readlane_f(gv, h); gate_s[h] = readlane_f(gv, 4 + h); gate_w[h] = readlane_f(gv, 8 + h); }
        LDS_WAIT();
        f32x4 acc[4];
#pragma unroll
        for (int h = 0; h < 4; ++h) acc[h] = (f32x4){0.f, 0.f, 0.f, 0.f};
        AttSt st;
        float ps;
        { const size_t kc0 = smp ? (size_t)2048 + ((size_t)b * 64) * 4 + g : ((size_t)b * 128) * 4 + g;
          const float* safe = KCV; float s0[4], s1[4];
          const int n0 = lane, n1 = lane + 64; const int d0 = qpos - (32 * n0 + 31), d1 = qpos - (32 * n1 + 31);
          const bool v0 = n0 < ncmp && d0 >= 0, v1 = n1 < ncmp && d1 >= 0;
          const float* k0p = v0 ? KCV + (kc0 + 4 * (size_t)n0) * 64 : safe; const float* k1p = v1 ? KCV + (kc0 + 4 * (size_t)n1) * 64 : safe;
          att_scores(qs, tabl, k0p, v0, d0, g, s0); att_scores(qs, tabl, k1p, v1, d1, g, s1);
          att_reset(st); float p0[4], p1[4], pc0 = 0.f, pc1 = 0.f;
#pragma unroll
          for (int h = 0; h < 4; ++h) { const float mx = wave_max(fmaxf(s0[h], s1[h])); p0[h] = v0 ? __expf(s0[h] - mx) : 0.f; p1[h] = v1 ? __expf(s1[h] - mx) : 0.f;
              const float l = wave_sum(p0[h] + p1[h]); const float inv = l > 0.f ? 1.f / l : 0.f; p0[h] *= inv; p1[h] *= inv; pc0 += p0[h]; pc1 += p1[h]; st.l[h] = l > 0.f ? 1.f : 0.f; }
          att_pv(st, P, R, p0, k0p, CMP_ROWS * 64, lane); att_pv(st, P, R, p1, k1p, CMP_ROWS * 64, lane);
          att_finish(st, gate_c, acc);
          pcs[lane] = pc0; pcs[64 + lane] = pc1; LDS_WAIT();
          ps = (2 * lane + 1 < ncmp) ? pcs[2 * lane] + pcs[2 * lane + 1] : 0.f; LDS_WAIT(); }
        const int jq = qpos >> 6; unsigned long long sel;
        { const bool forced = (lane == 0) || (lane == jq) || (lane == jq - 1);
          float sc = forced ? 100.f : (lane > jq ? -1.f : ps); if (lane >= nslc) sc = -__builtin_inff();
          int cnt = 0;
#pragma unroll 4
          for (int k = 0; k < 64; ++k) { const float sk = readlane_f(sc, k); cnt += (sk > sc || (sk == sc && k < lane)) ? 1 : 0; }
          sel = __ballot(cnt < 16); }
        att_reset(st);
        { const float* safe = qrow + 1536;
          unsigned long long todo = sel & (jq >= 63 ? ~0ull : ((1ull << (jq + 1)) - 1ull));
          while (todo) { const int j = __builtin_ctzll(todo); todo &= todo - 1ull;
              const int kpos = 64 * j + lane; const bool valid = kpos <= qpos; const float* kptr;
              if (!smp) kptr = PJ + ((size_t)b * SEQ + kpos) * NCIN + 1536 + g * 64;
              else if (j < 32) { const int page = pt[b * 16 + (j >> 1)]; kptr = ckv + (((size_t)page * 128 + (j & 1) * 64 + lane) * 16 + 8 + g) * 64; }
              else kptr = PJ + ((size_t)MP + 4 * b + (lane & 3)) * NCIN + 1536 + g * 64;
              att_block(st, qs, tabl, P, R, kptr, safe, valid, qpos - kpos, 256, g, lane); } }
        att_finish(st, gate_s, acc);
        att_reset(st);
        { const float* safe = qrow + 2048;
          for (int cb = 0; cb < 8; ++cb) { const int kpos = qpos - 511 + 64 * cb + lane; if (qpos - 511 + 64 * cb + 63 < 0) continue;
              const bool valid = kpos >= 0; const float* kptr;
              if (!smp) kptr = PJ + ((size_t)b * SEQ + (valid ? kpos : 0)) * NCIN + 2048 + g * 64;
              else if (kpos < 2048) kptr = cwin + (((size_t)b * 512 + (kpos - 1536)) * 2) * 256 + g * 64;
              else kptr = PJ + ((size_t)MP + 4 * b + (kpos - 2048)) * NCIN + 2048 + g * 64;
              att_block(st, qs, tabl, P, R, kptr, safe, valid, qpos - kpos, 256, g, lane); } }
        att_finish(st, gate_w, acc);
        if (lane < 16) {
#pragma unroll
            for (int h = 0; h < 4; ++h) { u32x2 w; w.x = pk2(acc[h].x, acc[h].y); w.y = pk2(acc[h].z, acc[h].w); *(u32x2*)(OA + row * 1024 + (g * 4 + h) * 64 + lane * 4) = w; } }
    }
}
constexpr int AT_ROWB = 144;
constexpr int AT_KB = 0, AT_VB = 2 * 64 * AT_ROWB, AT_PS = 4 * 64 * AT_ROWB, AT_SEL = AT_PS + 4 * 64 * 64 * 4, AT_BIAS = AT_SEL + 512, AT_END = AT_BIAS + 16 * 128 * 4;
static_assert(AT_END <= MISC_OFF, "attention LDS map");
struct AtRegs { u32x4 k, v; };
__device__ __forceinline__ AtRegs at_load(const bf16* kbase, const bf16* vbase, int vpitch, int tid) {
    AtRegs r; r.k = *(const u32x4*)(kbase + tid * 8); r.v = *(const u32x4*)(vbase + (size_t)(tid >> 3) * vpitch + (tid & 7) * 8); return r; }
__device__ __forceinline__ void at_store(LAS unsigned char* L, int buf, const AtRegs& r, int tid) {
    *(LAS u32x4*)(L + AT_KB + buf * 64 * AT_ROWB + (tid >> 3) * AT_ROWB + (tid & 7) * 16) = r.k; *(LAS u32x4*)(L + AT_VB + buf * 64 * AT_ROWB + (tid >> 3) * AT_ROWB + (tid & 7) * 16) = r.v; }
__device__ __forceinline__ void at_qk(LAS unsigned char* L, int buf, const bf16x8_t (&qf)[2][2], f32x4 (&st)[4][2], int fr, int rq) {
#pragma unroll
    for (int mb = 0; mb < 4; ++mb) { st[mb][0] = (f32x4){0.f, 0.f, 0.f, 0.f}; st[mb][1] = (f32x4){0.f, 0.f, 0.f, 0.f}; }
#pragma unroll
    for (int s = 0; s < 2; ++s)
#pragma unroll
        for (int mb = 0; mb < 4; ++mb) { const bf16x8_t kf = *(const LAS bf16x8_t*)(L + AT_KB + buf * 64 * AT_ROWB + (16 * mb + fr) * AT_ROWB + (32 * s + 8 * rq) * 2);
            st[mb][0] = MFMA16(kf, qf[0][s], st[mb][0]); st[mb][1] = MFMA16(kf, qf[1][s], st[mb][1]); }
}
__device__ __forceinline__ void at_pv(LAS unsigned char* L, int buf, const f32x4 (&st)[4][2], f32x4 (&ot)[4][2], int fr, int rq) {
#pragma unroll
    for (int s = 0; s < 2; ++s) { bf16x8_t pf[2];
#pragma unroll
        for (int nb = 0; nb < 2; ++nb) { u32x4 w; w.x = pk2(st[2 * s][nb].x, st[2 * s][nb].y); w.y = pk2(st[2 * s][nb].z, st[2 * s][nb].w); w.z = pk2(st[2 * s + 1][nb].x, st[2 * s + 1][nb].y); w.w = pk2(st[2 * s + 1][nb].z, st[2 * s + 1][nb].w);
            pf[nb] = __builtin_bit_cast(bf16x8_t, w); }
#pragma unroll
        for (int mb = 0; mb < 4; ++mb) { const LAS unsigned char* vp = L + AT_VB + buf * 64 * AT_ROWB + (16 * mb + fr) * AT_ROWB + (32 * s + 4 * rq) * 2;
            u32x4 w; const u32x2 lo = *(const LAS u32x2*)vp, hi = *(const LAS u32x2*)(vp + 32); w.x = lo.x; w.y = lo.y; w.z = hi.x; w.w = hi.y; const bf16x8_t vf = __builtin_bit_cast(bf16x8_t, w);
            ot[mb][0] = MFMA16(vf, pf[0], ot[mb][0]); ot[mb][1] = MFMA16(vf, pf[1], ot[mb][1]); } }
}
template <int MODE> __device__ __forceinline__ void at_softmax(f32x4 (&st)[4][2], f32x4 (&ot)[4][2], float (&m)[2], float (&l)[2], const bool (&rowok)[2], float cb, const LAS float* bias_h, int dist0  , int wlim) {
#pragma unroll
    for (int nb = 0; nb < 2; ++nb) { float mx = -1e30f;
#pragma unroll
        for (int mb = 0; mb < 4; ++mb) {
            if (MODE == 2) st[mb][nb] = st[mb][nb] + cb;
            else if (MODE == 0) { const f32x4 t = st[mb][nb] + cb; st[mb][nb] = rowok[nb] ? t : (f32x4){-1e30f, -1e30f, -1e30f, -1e30f}; }
            else {
#pragma unroll
                for (int i = 0; i < 4; ++i) { const int dist = dist0 + 16 * nb - 16 * mb - i; const bool ok = rowok[nb] && dist >= 0 && dist < wlim; const int dd = dist < 0 ? 0 : (dist > 127 ? 127 : dist); const float bv = bias_h[dd]; st[mb][nb][i] = ok ? st[mb][nb][i] + bv : -1e30f; } }
            mx = fmaxf(fmaxf(mx, fmaxf(st[mb][nb][0], st[mb][nb][1])), fmaxf(st[mb][nb][2], st[mb][nb][3])); }
        mx = fmaxf(mx, __shfl_xor(mx, 16)); mx = fmaxf(mx, __shfl_xor(mx, 32));
        const float mn = fmaxf(m[nb], mx), sc = __builtin_amdgcn_exp2f(m[nb] - mn); float ls = 0.f;
#pragma unroll
        for (int mb = 0; mb < 4; ++mb) { const f32x4 d = st[mb][nb] - mn; f32x4 p;
#pragma unroll
            for (int i = 0; i < 4; ++i) { const float pe = __builtin_amdgcn_exp2f(d[i]); p[i] = (MODE == 1) ? (st[mb][nb][i] > -1e29f ? pe : 0.f) : pe; }
            st[mb][nb] = p; ls += (p[0] + p[1]) + (p[2] + p[3]); }
        l[nb] = l[nb] * sc + ls; m[nb] = mn;
#pragma unroll
        for (int mb = 0; mb < 4; ++mb) ot[mb][nb] *= sc; }
}
template <bool ADD> __device__ __forceinline__ void at_finish(f32x4 (&ot)[4][2], float (&l)[2], const float (&gate)[2], LAS f32x4* park, int lane) {
#pragma unroll
    for (int nb = 0; nb < 2; ++nb) { float Ls = l[nb]; Ls += __shfl_xor(Ls, 16); Ls += __shfl_xor(Ls, 32); const float inv = Ls > 0.f ? gate[nb] / Ls : 0.f;
#pragma unroll
        for (int mb = 0; mb < 4; ++mb) { f32x4 v = ot[mb][nb] * inv; if (ADD) v += park[(mb * 2 + nb) * 64 + lane]; ot[mb][nb] = v; } }
}
__device__ __forceinline__ void at_park(const f32x4 (&ot)[4][2], LAS f32x4* park, int lane) {
#pragma unroll
    for (int nb = 0; nb < 2; ++nb)
#pragma unroll
        for (int mb = 0; mb < 4; ++mb) park[(mb * 2 + nb) * 64 + lane] = ot[mb][nb];
}
__device__ __forceinline__ void nsa_attn_prompt_phase(const Ctx& c) {
    const float* PJ = WSF(WC_PROJ); const float* gb = c.in[I_CGB]; bf16* OA = WSB(WC_OA);
    const bf16* KSB = WSB(WC_KSB); const bf16* VST = WSB(WC_VST); const bf16* KWB = WSB(WC_KWB); const bf16* VWT = WSB(WC_VWT); const bf16* KCB = WSB(WC_KCB); const bf16* VCT = WSB(WC_VCT);
    __syncthreads();
    { LAS float* bt = (LAS float*)(c.lds + AT_BIAS);
      for (int i = c.tid; i < 16 * 128; i += 512) { const int h = i >> 7, d = i & 127; bt[i] = c.in[I_T5][(int)T5_LUT[d] * 16 + h] * 1.4426950408889634f; } }
    __syncthreads();
    for (int u = blockIdx.x; u < 1024; u += c.G) {
        LAS unsigned char* L = c.lds; asm volatile("" : "+v"(L));
        int tid = c.tid; asm volatile("" : "+v"(tid));
        const int lane = tid & 63, fr = lane & 15, rq = lane >> 4, w = c.wave, hg = w >> 1, tq0 = (w & 1) * 32;
        const int bg = (u & 255) >> 4, r16 = u & 15, k4 = u >> 8, qb = k4 == 0 ? r16 : (k4 == 1 ? 31 - r16 : (k4 == 2 ? 32 + r16 : 63 - r16)), b = bg >> 2, g = bg & 3, h = g * 4 + hg;
        const LAS float* bias_h = (const LAS float*)(L + AT_BIAS) + h * 128; const float cb = bias_h[127];
        LAS float* PS = (LAS float*)(L + AT_PS); LAS unsigned long long* SEL = (LAS unsigned long long*)(L + AT_SEL);
        bf16x8_t qf[2][2]; float gate_c[2], gate_s[2], gate_w[2]; size_t row[2];
#pragma unroll
        for (int nb = 0; nb < 2; ++nb) { row[nb] = (size_t)b * SEQ + 64 * qb + tq0 + 16 * nb + fr; const float* qr = PJ + row[nb] * NCIN;
#pragma unroll
            for (int s = 0; s < 2; ++s) { const f32x4 a = *(const f32x4*)(qr + h * 64 + 32 * s + 8 * rq) * 0.18033688011112042f, bq = *(const f32x4*)(qr + h * 64 + 32 * s + 8 * rq + 4) * 0.18033688011112042f;
                u32x4 wv; wv.x = pk2(a.x, a.y); wv.y = pk2(a.z, a.w); wv.z = pk2(bq.x, bq.y); wv.w = pk2(bq.z, bq.w); qf[nb][s] = __builtin_bit_cast(bf16x8_t, wv); }
            gate_c[nb] = sigmoid_f(qr[2560 + h] + gb[h]); gate_s[nb] = sigmoid_f(qr[2576 + h] + gb[16 + h]); gate_w[nb] = sigmoid_f(qr[2592 + h] + gb[32 + h]); }
        f32x4 ot[4][2], st[4][2]; float m[2], l[2]; bool rowok[2] = {true, true};
        LAS f32x4* park = (LAS f32x4*)(L + AT_PS) + w * 512;
#pragma unroll
        for (int mb = 0; mb < 4; ++mb) { ot[mb][0] = (f32x4){0.f, 0.f, 0.f, 0.f}; ot[mb][1] = (f32x4){0.f, 0.f, 0.f, 0.f}; }
        const int tl0 = 64 * qb + tq0 + fr;
        { __syncthreads();
          const AtRegs r0 = at_load(KCB + (size_t)bg * 128 * 64, VCT + (size_t)bg * 64 * 128, 128, tid), r1 = at_load(KCB + ((size_t)bg * 128 + 64) * 64, VCT + (size_t)bg * 64 * 128 + 64, 128, tid);
          at_store(L, 0, r0, tid); at_store(L, 1, r1, tid);
          __syncthreads();
          float cm[2] = {-1e30f, -1e30f}, cl[2] = {0.f, 0.f};
#pragma unroll
          for (int cc = 0; cc < 2; ++cc) { at_qk(L, cc, qf, st, fr, rq);
#pragma unroll
              for (int nb = 0; nb < 2; ++nb) { float mx = -1e30f; const int t = tl0 + 16 * nb;
#pragma unroll
                  for (int mb = 0; mb < 4; ++mb)
#pragma unroll
                      for (int i = 0; i < 4; ++i) { const int n = 64 * cc + 16 * mb + 4 * rq + i, dist = t - (32 * n + 31);
                          const float bv = bias_h[dist < 0 ? 0 : (dist > 127 ? 127 : dist)]; const float sv = dist >= 0 ? st[mb][nb][i] + bv : -1e30f; st[mb][nb][i] = sv; mx = fmaxf(mx, sv); }
                  mx = fmaxf(mx, __shfl_xor(mx, 16)); mx = fmaxf(mx, __shfl_xor(mx, 32));
                  const float mn = fmaxf(cm[nb], mx); float ls = 0.f;
#pragma unroll
                  for (int mb = 0; mb < 4; ++mb)
#pragma unroll
                      for (int i = 0; i < 4; ++i) { const float pe = __builtin_amdgcn_exp2f(st[mb][nb][i] - mn); ls += st[mb][nb][i] > -1e29f ? pe : 0.f; }
                  cl[nb] = cl[nb] * __builtin_amdgcn_exp2f(cm[nb] - mn) + ls; cm[nb] = mn; } }
          float cinv[2];
#pragma unroll
          for (int nb = 0; nb < 2; ++nb) { float ls = cl[nb]; ls += __shfl_xor(ls, 16); ls += __shfl_xor(ls, 32); cinv[nb] = ls > 0.f ? 1.f / ls : 0.f; l[nb] = ls > 0.f ? 0.25f : 0.f; }
#pragma unroll
          for (int cc = 0; cc < 2; ++cc) { at_qk(L, cc, qf, st, fr, rq);
#pragma unroll
              for (int nb = 0; nb < 2; ++nb) { const int t = tl0 + 16 * nb; LAS float* psr = PS + ((hg * 64 + tq0 + 16 * nb + fr) * 64 + 2 * rq) + 32 * cc;
#pragma unroll
                  for (int mb = 0; mb < 4; ++mb) {
#pragma unroll
                      for (int i = 0; i < 4; ++i) { const int n = 64 * cc + 16 * mb + 4 * rq + i, dist = t - (32 * n + 31);
                          const float bv = bias_h[dist < 0 ? 0 : (dist > 127 ? 127 : dist)]; const float pe = __builtin_amdgcn_exp2f(fminf(st[mb][nb][i] + bv - cm[nb], 0.f)) * cinv[nb]; st[mb][nb][i] = dist >= 0 ? pe : 0.f; }
                      *(LAS f32x2*)(psr + 8 * mb) = (f32x2){st[mb][nb][0] + st[mb][nb][1], st[mb][nb][2] + st[mb][nb][3]}; } }
              at_pv(L, cc, st, ot, fr, rq); }
          at_finish<false>(ot, l, gate_c, park, lane);
        }
        __syncthreads();
        { for (int i8 = 0; i8 < 8; ++i8) { const int tq = 8 * w + i8; unsigned long long sel;
              if (qb <= 15) sel = (2ull << qb) - 1ull;
              else { const float ps = (PS[(0 * 64 + tq) * 64 + lane] + PS[(1 * 64 + tq) * 64 + lane]) + (PS[(2 * 64 + tq) * 64 + lane] + PS[(3 * 64 + tq) * 64 + lane]);
                  const bool forced = (lane == 0) || (lane == qb) || (lane == qb - 1); const float sc = forced ? 100.f : (lane > qb ? -1.f : ps); int cnt = 0;
#pragma unroll 4
                  for (int k = 0; k < 64; ++k) { const float sk = readlane_f(sc, k); cnt += (sk > sc || (sk == sc && k < lane)) ? 1 : 0; }
                  sel = __ballot(cnt < 16) & ((2ull << qb) - 1ull); }
              if (lane == 0) SEL[tq] = sel; } }
        __syncthreads();
        unsigned long long selm[2], uni;
        { selm[0] = SEL[tq0 + fr]; selm[1] = SEL[tq0 + 16 + fr]; unsigned long long a = SEL[lane];
#pragma unroll
          for (int o = 1; o < 64; o <<= 1) a |= __shfl_xor(a, o);
          uni = a; }
        at_park(ot, park, lane);
#pragma unroll
        for (int mb = 0; mb < 4; ++mb) { ot[mb][0] = (f32x4){0.f, 0.f, 0.f, 0.f}; ot[mb][1] = (f32x4){0.f, 0.f, 0.f, 0.f}; }
        m[0] = m[1] = -1e30f; l[0] = l[1] = 0.f;
        { unsigned long long todo = __builtin_amdgcn_readfirstlane((unsigned)uni) | ((unsigned long long)__builtin_amdgcn_readfirstlane((unsigned)(uni >> 32)) << 32);
          int j = __builtin_ctzll(todo), buf = 0;
          AtRegs rg = at_load(KSB + ((size_t)bg * SEQ + 64 * j) * 64, VST + (size_t)bg * 64 * SEQ + 64 * j, SEQ, tid);
          for (;;) { at_store(L, buf, rg, tid); todo &= todo - 1ull; const bool more = todo != 0ull; const int jn = more ? __builtin_ctzll(todo) : 0;
              __syncthreads();
              if (more) rg = at_load(KSB + ((size_t)bg * SEQ + 64 * jn) * 64, VST + (size_t)bg * 64 * SEQ + 64 * jn, SEQ, tid);
              at_qk(L, buf, qf, st, fr, rq);
              rowok[0] = (selm[0] >> j) & 1ull; rowok[1] = (selm[1] >> j) & 1ull;
              if (j + 3 <= qb) at_softmax<0>(st, ot, m, l, rowok, cb, bias_h, 0, 0); else at_softmax<1>(st, ot, m, l, rowok, cb, bias_h, tl0 - (64 * j + 4 * rq), 1 << 30);
              at_pv(L, buf, st, ot, fr, rq);
              if (!more) break; j = jn; buf ^= 1; }
          at_finish<true>(ot, l, gate_s, park, lane); at_park(ot, park, lane); }
        __syncthreads();
#pragma unroll
        for (int mb = 0; mb < 4; ++mb) { ot[mb][0] = (f32x4){0.f, 0.f, 0.f, 0.f}; ot[mb][1] = (f32x4){0.f, 0.f, 0.f, 0.f}; }
        m[0] = m[1] = -1e30f; l[0] = l[1] = 0.f; rowok[0] = rowok[1] = true;
        { int j = qb >= 8 ? qb - 8 : 0, buf = 0;
          AtRegs rg = at_load(KWB + ((size_t)bg * SEQ + 64 * j) * 64, VWT + (size_t)bg * 64 * SEQ + 64 * j, SEQ, tid);
          for (;;) { at_store(L, buf, rg, tid); const bool more = j < qb; const int jn = j + 1;
              __syncthreads();
              if (more) rg = at_load(KWB + ((size_t)bg * SEQ + 64 * jn) * 64, VWT + (size_t)bg * 64 * SEQ + 64 * jn, SEQ, tid);
              at_qk(L, buf, qf, st, fr, rq);
              if (j + 3 <= qb && j + 8 > qb) at_softmax<2>(st, ot, m, l, rowok, cb, bias_h, 0, 0); else at_softmax<1>(st, ot, m, l, rowok, cb, bias_h, tl0 - (64 * j + 4 * rq), 512);
              at_pv(L, buf, st, ot, fr, rq);
              if (!more) break; j = jn; buf ^= 1; }
          at_finish<true>(ot, l, gate_w, park, lane); }
#pragma unroll
        for (int nb = 0; nb < 2; ++nb)
#pragma unroll
            for (int mb = 0; mb < 4; ++mb) { u32x2 wv; wv.x = pk2(ot[mb][nb].x, ot[mb][nb].y); wv.y = pk2(ot[mb][nb].z, ot[mb][nb].w); *(u32x2*)(OA + row[nb] * 1024 + h * 64 + 16 * mb + 4 * rq) = wv; }
    }
}
constexpr int PH_PER_SUB = 9, N_PHASES = 2 + 12 * PH_PER_SUB;
struct Args { const float* in[N_IN]; float* out; unsigned char* ws; int ph_lo, ph_hi, bli, pad; };
__host__ __device__ inline bool phase_exists(int ph) {
    if (ph < 2) return true; const int r = ph - 2, sub3 = r / PH_PER_SUB, slot = r % PH_PER_SUB, L = sub3 / 3, s = sub3 % 3, kind = (L == 1) ? 1 : (L == 2 ? 2 : 0);
    if (slot == 0 || slot == 5 || slot == 6) return true;
    if (slot == 7) return s == 2;
    if (slot == 8) return false;
    if (s != 1) return false;
    if (kind == 0) return slot <= 2; if (kind == 1) return slot <= 3; return true;
}

#ifndef PROBE
#define PROBE 0
#endif
#define TW(cls, ...) do { __VA_ARGS__; if (PROBE == (cls)) { __VA_ARGS__; } } while (0)
#define IN(k) (lo <= (k) && (k) < hi)
#define SEAM(k) do { if (IN(k) && (k) + 1 < hi) xcd_barrier(bar); } while (0)
template <int L, int S> __device__ __forceinline__ void run_sub(const Ctx& c, const XcdBarrier& bar, const int lo, const int hi) {
    constexpr int kind = (L == 1) ? 1 : (L == 2 ? 2 : 0), ia = (L == 3) ? 1 : 0, base = 2 + (3 * L + S) * PH_PER_SUB;
    LAS unsigned char* ring = c.lds;
    if (IN(base)) {
        if constexpr (S != 1) { constexpr int j = S >> 1; pg8::Gemm g{S == 0 ? WSB(WS_XNB) : WSB(WS_XN), WSB(WS_WUP + (size_t)(2 * L + j) * SZ_WUP), M, 5632, 1024}; pg8::StaticOrder So; So.init(M, 5632, c.G, (int)blockIdx.x);
            pg8::EpiGate E{WSB(WS_H), DFF}; TW(1, pg8::gemm_phase<pg8::EpiGate, pg8::StaticOrder, true, true>(ring, g, So, E)); }
        else if constexpr (kind == 0) { pg8::Gemm g{WSB(WS_XN), WSB(WS_WAIN + (size_t)ia * SZ_WAIN), M, 4096, 1024}; pg8::StaticOrder So; So.init(M, 4096, c.G, (int)blockIdx.x);
            pg8::EpiAin E{WSB(WA_U), WSF(WA_V)}; TW(1, pg8::gemm_phase<pg8::EpiAin, pg8::StaticOrder, true, true>(ring, g, So, E)); }
        else { constexpr int N = kind == 1 ? NBIN : NCIN; pg8::Gemm g{WSB(WS_XN), kind == 1 ? WSB(WS_WBIN) : WSB(WS_WCIN), M, N, 1024}; pg8::StaticOrder So; So.init(M, N, c.G, (int)blockIdx.x);
            pg8::EpiF32 E{WSF(WS_MIX), N}; TW(1, pg8::gemm_phase<pg8::EpiF32, pg8::StaticOrder, true, true>(ring, g, So, E)); }
    } SEAM(base);
    if constexpr (S == 1) {
        if (IN(base + 1)) { if constexpr (kind == 0) TW(4, a_stats_phase(c, ia)); else if constexpr (kind == 1) TW(6, gdn_prep_phase(c)); else TW(9, nsa_prep_phase(c)); } SEAM(base + 1);
        if (IN(base + 2)) { if constexpr (kind == 0) TW(5, a_sgu_phase(c, ia)); else if constexpr (kind == 1) TW(7, gdn_scan_phase(c));
            else {
                { pg8::Gemm g{WSB(WC_ACMP), WSB(WS_WC1), CMP_ROWS, 256, 2048}; pg8::StaticOrder So; So.init(CMP_ROWS, 256, c.G, (int)blockIdx.x);
                  pg8::EpiCmp E{WSB(WC_HC)}; TW(1, pg8::gemm_phase<pg8::EpiCmp, pg8::StaticOrder, true, true>(ring, g, So, E)); }
                { pg8::Gemm g{WSB(WC_ACMP) + (size_t)CMP_ROWS * 2048, WSB(WS_WC1 + SZ_WC1), CMP_ROWS, 256, 2048}; pg8::StaticOrder So; So.init(CMP_ROWS, 256, c.G, (int)((blockIdx.x + 128u) % (unsigned)c.G));
                  pg8::EpiCmp E{WSB(WC_HC) + (size_t)CMP_ROWS * 256}; TW(1, pg8::gemm_phase<pg8::EpiCmp, pg8::StaticOrder, true, true>(ring, g, So, E)); } } } SEAM(base + 2);
        if constexpr (kind != 0) { if (IN(base + 3)) { if constexpr (kind == 1) TW(8, gdn_post_phase(c)); else TW(10, nsa_cmp2_phase(c)); } SEAM(base + 3); }
        if constexpr (kind == 2) { if (IN(base + 4)) TW(11, nsa_attn_prompt_phase(c)); TW(12, nsa_attn_phase(c, 65536)); SEAM(base + 4); }
    }
    constexpr int KOUT = (S != 1) ? DFF : (kind == 0 ? 2048 : 1024); constexpr float SCL = (S != 1) ? 0.5f : 1.f;
    if (IN(base + 5)) {
        const bf16* A; const bf16* Bt;
        if constexpr (S != 1) { A = WSB(WS_H); Bt = WSB(WS_WDN + (size_t)(2 * L + (S >> 1)) * SZ_WDN); }
        else if constexpr (kind == 0) { A = WSB(WA_US); Bt = WSB(WS_WAOUT + (size_t)ia * SZ_WAOUT); }
        else if constexpr (kind == 1) { A = WSB(WB_OG); Bt = WSB(WS_WBOUT); }
        else { A = WSB(WC_OA); Bt = WSB(WS_WCOUT); }
        { pg8::Gemm g{A, Bt, MP, 1024, KOUT, KOUT}; pg8::StaticOrder So; So.init(MP, 1024, c.G, (int)blockIdx.x);
          pg8::EpiResid E{WSF(WS_X), WSF(WS_PRE), ALPHA, SCL}; TW(1, pg8::gemm_phase<pg8::EpiResid, pg8::StaticOrder, true, true>(ring, g, So, E)); }
        { pg8::Gemm g{A + (size_t)MP * KOUT, Bt, MS, 1024, 256, KOUT}; pg8::SplitOrder So{2, 4, KOUT / 256, 256, c.G, (int)blockIdx.x};
          pg8::EpiSlab E{WSF(WS_SLAB), 256, (size_t)MS * 1024}; TW(1, pg8::gemm_phase<pg8::EpiSlab, pg8::SplitOrder, true, true>(ring, g, So, E)); }
    } SEAM(base + 5);
    if (IN(base + 6)) { TW(3, ln_phase(c, c.in[I_LNG] + (size_t)(3 * L + S) * 1024, c.in[I_LNB] + (size_t)(3 * L + S) * 1024, KOUT / 256, SCL)); } SEAM(base + 6);
    if constexpr (S == 2) { if (IN(base + 7)) { pg8::Gemm g{WSB(WS_XN), WSB(WS_WG + (size_t)L * SZ_WG), M, 1024, 1024}; pg8::StaticOrder So; So.init(M, 1024, c.G, (int)blockIdx.x);
            pg8::EpiPle E{WSF(WS_X), WSF(WS_PP) + (size_t)L * M * 1024, WSB(WS_XNB), L == 3 ? c.out : nullptr}; pg8::gemm_phase<pg8::EpiPle, pg8::StaticOrder, true, true>(ring, g, So, E); } SEAM(base + 7); }
}
template <int l> __device__ __forceinline__ void ple_proj(const Ctx& c) {
    pg8::Gemm g{WSB(WS_PBF) + (size_t)l * M * 256, WSB(WS_WP + l * SZ_WP), M, 1024, 256}; pg8::StaticOrder So; So.init(M, 1024, c.G, (int)blockIdx.x);
    pg8::EpiF32 E{WSF(WS_PP) + (size_t)l * M * 1024, 1024}; TW(1, pg8::gemm_phase<pg8::EpiF32, pg8::StaticOrder, true, true>(c.lds, g, So, E));
}
__global__ void __launch_bounds__(NWAVES * 64, 2) fwd(Args args) {
    extern __shared__ __attribute__((aligned(16))) unsigned char lds_raw[];
    Ctx c; c.lds = (LAS unsigned char*)lds_raw; c.ws = args.ws; c.out = args.out; c.in = args.in;
    c.tid = threadIdx.x; c.lane = c.tid & 63; c.wave = __builtin_amdgcn_readfirstlane(c.tid >> 6); c.G = gridDim.x; c.gw = blockIdx.x * NWAVES + c.wave; c.NGW = c.G * NWAVES;
    volatile LAS unsigned* MISC = (volatile LAS unsigned*)(c.lds + MISC_OFF);
    for (int u = c.tid; u < 128; u += NWAVES * 64) MISC[u] = 0u;
    __syncthreads();
    unsigned* ctl = (unsigned*)c.ws;
    XcdBarrier bar = xcd_barrier_post(ctl + CW_BAR + args.bli * XCD_BAR_WORDS, MISC + 8);
    const int lo = args.ph_lo, hi = args.ph_hi;
    if (IN(0)) { TW(13, prologue_phase(c)); } SEAM(0);
    if (IN(1)) { ple_proj<0>(c); ple_proj<1>(c); ple_proj<2>(c); ple_proj<3>(c); } SEAM(1);
    run_sub<0, 0>(c, bar, lo, hi); run_sub<0, 1>(c, bar, lo, hi); run_sub<0, 2>(c, bar, lo, hi);
    run_sub<1, 0>(c, bar, lo, hi); run_sub<1, 1>(c, bar, lo, hi); run_sub<1, 2>(c, bar, lo, hi);
    run_sub<2, 0>(c, bar, lo, hi); run_sub<2, 1>(c, bar, lo, hi); run_sub<2, 2>(c, bar, lo, hi);
    run_sub<3, 0>(c, bar, lo, hi); run_sub<3, 1>(c, bar, lo, hi); run_sub<3, 2>(c, bar, lo, hi);
}
#undef IN
#undef SEAM

#ifndef ONE_LAUNCH
#define ONE_LAUNCH 1
#endif
extern "C" void kernel_launch(void* const* d_in, const int* in_sizes, int n_in, void* d_out, int out_size, void* d_ws, size_t ws_size, hipStream_t stream) {
    static int grid = 0;
    if (grid == 0) {
        if (n_in != N_IN || (size_t)out_size != O_END || ws_size < WS_END) { fprintf(stderr, "kernel_launch: unexpected problem: n_in %d out %d ws %zu (need %zu)\n", n_in, out_size, ws_size, (size_t)WS_END); grid = -1; return; }
        int dev = 0, cus = 0, per_cu = 0;
        if (hipGetDevice(&dev) != hipSuccess || hipDeviceGetAttribute(&cus, hipDeviceAttributeMultiprocessorCount, dev) != hipSuccess) { grid = -1; return; }
        if (hipFuncSetAttribute((const void*)fwd, hipFuncAttributeMaxDynamicSharedMemorySize, LDS_BYTES) != hipSuccess) { fprintf(stderr, "kernel_launch: hipFuncSetAttribute failed\n"); grid = -1; return; }
        if (hipOccupancyMaxActiveBlocksPerMultiprocessor(&per_cu, (const void*)fwd, NWAVES * 64, LDS_BYTES) != hipSuccess || per_cu < 1) fprintf(stderr, "kernel_launch: occupancy query says %d\n", per_cu);
        (void)hipGetLastError();
        grid = cus;
    }
    if (grid < 0) return;
    (void)hipMemsetAsync(d_ws, 0, CTL_BYTES, stream);
    Args a{};
    for (int i = 0; i < N_IN; ++i) a.in[i] = (const float*)d_in[i];
    a.out = (float*)d_out; a.ws = (unsigned char*)d_ws; a.pad = 0;
#if ONE_LAUNCH
    a.ph_lo = 0; a.ph_hi = N_PHASES; a.bli = 0;
    hipLaunchKernelGGL(fwd, dim3(grid), dim3(NWAVES * 64), LDS_BYTES, stream, a);
#else
    for (int ph = 0; ph < N_PHASES; ++ph) { if (!phase_exists(ph)) continue; a.ph_lo = ph; a.ph_hi = ph + 1; a.bli = 0;
        hipLaunchKernelGGL(fwd, dim3(grid), dim3(NWAVES * 64), LDS_BYTES, stream, a); }
#endif
}
```
